# Optimizing an MI355X kernel written in HIP

```python
import jax, jax.numpy as jnp
from jax import lax
import numpy as np

D_MODEL = 1024
BATCH = 32
SEQ = 2048
DEPTH = 4

CTX_LEN = 256
GRID_W = 64
N_MIXERS = 4
N_LAYERS_A = (DEPTH + 3) // 4
N_LAYERS_B = (DEPTH + 2) // 4
N_LAYERS_C = (DEPTH + 1) // 4
N_LAYERS_D = DEPTH // 4
N_DENSE = (DEPTH + 1) // 2
N_MOE = DEPTH // 2
NORM_EPS = 1e-6
NEG_INF = -1e30

D_RNN = 1280
LRU_BLOCKS = 8
LRU_BW = D_RNN // LRU_BLOCKS
CONV_W = 4
LRU_C = 8.0

D_SGU = 2 * D_MODEL
SGU_CHUNK = 128
SGU_GROUPS = 8
SGU_GD = D_SGU // SGU_GROUPS

POOL_WINDOWS = (2, 4, 8, 16)
POOL_GD = D_MODEL // len(POOL_WINDOWS)

NA_HEADS = 16
NA_HD = D_MODEL // NA_HEADS
NA_KH = 8
NA_KW = 16

D_FF = 7 * D_MODEL // 2
N_EXPERTS = 8
TOP_K = 2

kernel_name = 'hybrid_interleaved_diffusion_block'


def rms_norm(x, g):
    xf = x.astype(jnp.float32)
    y = xf * lax.rsqrt(jnp.mean(xf * xf, axis=-1, keepdims=True) + NORM_EPS)
    return (y * g.astype(jnp.float32)).astype(x.dtype)


def layer_norm(x, g, b):
    xf = x.astype(jnp.float32)
    mu = jnp.mean(xf, axis=-1, keepdims=True)
    var = jnp.mean(jnp.square(xf - mu), axis=-1, keepdims=True)
    y = (xf - mu) * lax.rsqrt(var + NORM_EPS)
    return (y * g.astype(jnp.float32) + b.astype(jnp.float32)).astype(x.dtype)


def modulate(h, shift, scale):
    return h * (1 + scale) + shift


def centred_dwconv(x, w, b):
    n = x.shape[1]
    left = CONV_W // 2
    xp = jnp.pad(x, ((0, 0), (left, CONV_W - 1 - left), (0, 0)))
    y = b + xp[:, 0:n] * w[0]
    for k in range(1, CONV_W):
        y = y + xp[:, k:k + n] * w[k]
    return y


def block_diag_linear(x, w, b):
    bsz, n, _ = x.shape
    xb = x.reshape(bsz, n, LRU_BLOCKS, LRU_BW)
    y = jnp.einsum('bnkc,kcd->bnkd', xb, w.astype(jnp.float32))
    return y.reshape(bsz, n, D_RNN) + b.astype(jnp.float32)


def rglru_coeffs(xc, w_a, b_a, w_i, b_i, lam):
    xf = xc.astype(jnp.float32)
    r = jax.nn.sigmoid(block_diag_linear(xf, w_a, b_a))
    i = jax.nn.sigmoid(block_diag_linear(xf, w_i, b_i))
    log_a = -LRU_C * r * jax.nn.softplus(-lam.astype(jnp.float32))
    a = jnp.exp(log_a)
    mult = jnp.sqrt(-jnp.expm1(2.0 * log_a))
    return a, mult * (i * xf)


def _lin_combine(left, right):
    a1, b1 = left
    a2, b2 = right
    return a1 * a2, a2 * b1 + b2


def linear_scan(a, b, h0=None):
    if h0 is not None:
        b = b.at[:, 0].add(a[:, 0] * h0)
    return lax.associative_scan(_lin_combine, (a, b), axis=1)[1]


def _flip_if(t, rev):
    return jnp.flip(t, axis=1) if rev else t


def mixer_rglru(h_lat, h_ctx, w_in, conv_w, conv_b, w_a, b_a, w_i, b_i, lam, w_out, need_ctx):
    xr_l, gr_l = jnp.split(h_lat @ w_in, 2, axis=-1)
    xc_l = centred_dwconv(xr_l, conv_w, conv_b)
    xc_c = centred_dwconv(h_ctx @ w_in[:, :D_RNN], conv_w, conv_b)
    ys_l, ys_c = [], []
    for d in range(2):
        rev = d == 1
        a_c, b_c = rglru_coeffs(_flip_if(xc_c, rev), w_a[d], b_a[d], w_i[d], b_i[d], lam[d])
        hs_c = linear_scan(a_c, b_c)
        a_l, b_l = rglru_coeffs(_flip_if(xc_l, rev), w_a[d], b_a[d], w_i[d], b_i[d], lam[d])
        hs_l = linear_scan(a_l, b_l, hs_c[:, -1])
        ys_l.append(_flip_if(hs_l, rev))
        ys_c.append(_flip_if(hs_c, rev))
    y_l = ((ys_l[0] + ys_l[1]).astype(h_lat.dtype) * jax.nn.gelu(gr_l)) @ w_out
    y_c = None
    if need_ctx:
        gr_c = h_ctx @ w_in[:, D_RNN:]
        y_c = ((ys_c[0] + ys_c[1]).astype(h_ctx.dtype) * jax.nn.gelu(gr_c)) @ w_out
    return y_l, y_c


def mixer_sgu(h, w_in, b_in, ln_g, ln_b, w_s, b_s, w_out):
    bsz, n, _ = h.shape
    z = jax.nn.gelu(h @ w_in + b_in)
    u, v = jnp.split(z, 2, axis=-1)
    v = layer_norm(v, ln_g, ln_b)
    v = v.reshape(bsz, n // SGU_CHUNK, SGU_CHUNK, SGU_GROUPS, SGU_GD)
    v = jnp.einsum('gpq,bcqgd->bcpgd', w_s, v) + b_s.T[:, :, None]
    return (u * v.reshape(bsz, n, D_SGU)) @ w_out


def centred_mean_minus_self(x, w):
    n = x.shape[1]
    xf = x.astype(jnp.float32)
    cs = jnp.pad(jnp.cumsum(xf, axis=1), ((0, 0), (1, 0), (0, 0)))
    t = jnp.arange(n)
    lo = jnp.clip(t - w // 2, 0, n - 1)
    hi = jnp.clip(t + w // 2 - 1, 0, n - 1)
    s = jnp.take(cs, hi + 1, axis=1) - jnp.take(cs, lo, axis=1)
    cnt = (hi - lo + 1).astype(jnp.float32)[None, :, None]
    return (s / cnt - xf).astype(x.dtype)


def mixer_pool(h, w_g, b_g, ls):
    parts = []
    for g, w in enumerate(POOL_WINDOWS):
        hg = h[..., g * POOL_GD:(g + 1) * POOL_GD]
        parts.append(centred_mean_minus_self(hg, w) @ w_g[g] + b_g[g])
    return jnp.concatenate(parts, axis=-1) * ls


def mixer_na(h_lat, h_ctx, w_qkv, q_g, k_g, rpb, w_o, need_ctx):
    bsz, n, _ = h_lat.shape
    lc = h_ctx.shape[1]
    rows = n // GRID_W
    kh = min(NA_KH, rows)
    scale = NA_HD ** -0.5

    z = (h_lat @ w_qkv).reshape(bsz, rows, GRID_W, 3, NA_HEADS, NA_HD)
    q_l = rms_norm(z[:, :, :, 0], q_g)
    k_l = rms_norm(z[:, :, :, 1], k_g)
    v_l = z[:, :, :, 2]
    if need_ctx:
        zc = (h_ctx @ w_qkv).reshape(bsz, lc, 3, NA_HEADS, NA_HD)
        q_c = rms_norm(zc[:, :, 0], q_g)
        k_c = rms_norm(zc[:, :, 1], k_g)
        v_c = zc[:, :, 2]
    else:
        zc = (h_ctx @ w_qkv[:, D_MODEL:]).reshape(bsz, lc, 2, NA_HEADS, NA_HD)
        k_c = rms_norm(zc[:, :, 0], k_g)
        v_c = zc[:, :, 1]

    col = np.arange(GRID_W)
    col_start = np.clip(col - NA_KW // 2, 0, GRID_W - NA_KW)
    nb_mask = jnp.asarray((col[None, :] >= col_start[:, None]) & (col[None, :] < col_start[:, None] + NA_KW))
    dc_idx = np.clip(col[None, :] - col[:, None], -(NA_KW - 1), NA_KW - 1) + NA_KW - 1
    rpb_cols = rpb.astype(jnp.float32)[:, :, dc_idx]

    def row_block(r):
        r0 = jnp.clip(r - kh // 2, 0, rows - kh)
        q = lax.dynamic_index_in_dim(q_l, r, axis=1, keepdims=False)
        k = lax.dynamic_slice_in_dim(k_l, r0, kh, axis=1)
        v = lax.dynamic_slice_in_dim(v_l, r0, kh, axis=1)
        s_nb = jnp.einsum('bihd,bajhd->bhiaj', q, k, preferred_element_type=jnp.float32) * scale
        bias = lax.dynamic_slice_in_dim(rpb_cols, r0 - r + NA_KH - 1, kh, axis=1)
        s_nb = s_nb + jnp.transpose(bias, (0, 2, 1, 3))[None]
        s_nb = jnp.where(nb_mask[:, None, :], s_nb, NEG_INF)
        s_cx = jnp.einsum('bihd,bmhd->bhim', q, k_c, preferred_element_type=jnp.float32) * scale
        s = jnp.concatenate([s_nb.reshape(bsz, NA_HEADS, GRID_W, kh * GRID_W), s_cx], axis=-1)
        p = jax.nn.softmax(s, axis=-1).astype(v.dtype)
        p_nb = p[..., :kh * GRID_W].reshape(bsz, NA_HEADS, GRID_W, kh, GRID_W)
        o = jnp.einsum('bhiaj,bajhd->bihd', p_nb, v)
        return o + jnp.einsum('bhim,bmhd->bihd', p[..., kh * GRID_W:], v_c)

    o = lax.map(row_block, jnp.arange(rows))
    y_l = jnp.transpose(o, (1, 0, 2, 3, 4)).reshape(bsz, n, D_MODEL) @ w_o
    y_c = None
    if need_ctx:
        s = jnp.einsum('bqhd,bkhd->bhqk', q_c, k_c, preferred_element_type=jnp.float32) * scale
        p = jax.nn.softmax(s, axis=-1).astype(v_c.dtype)
        y_c = jnp.einsum('bhqk,bkhd->bqhd', p, v_c).reshape(bsz, lc, D_MODEL) @ w_o
    return y_l, y_c


def swiglu(h, w1, w3, w2):
    return (jax.nn.silu(h @ w1) * (h @ w3)) @ w2


def moe_swiglu(h, w_r, b_r, w1, w3, w2):
    logits = (h @ w_r).astype(jnp.float32) + b_r.astype(jnp.float32)
    top_v, top_i = lax.top_k(logits, TOP_K)
    top_w = jax.nn.softmax(top_v, axis=-1)
    gates = jnp.sum(jax.nn.one_hot(top_i, N_EXPERTS, dtype=jnp.float32) * top_w[..., None], axis=-2)
    out = None
    for e in range(N_EXPERTS):
        ye = gates[..., e:e + 1].astype(h.dtype) * swiglu(h, w1[e], w3[e], w2[e])
        out = ye if out is None else out + ye
    return out


def setup_inputs(seed: int = 0) -> dict:
    key = jax.random.key(seed)
    ks = iter(jax.random.split(key, 48))

    def nrm(shape, scale):
        return scale * jax.random.normal(next(ks), shape, jnp.float32)

    def gain(shape):
        return 1.0 + 0.02 * jax.random.normal(next(ks), shape, jnp.float32)

    d = D_MODEL
    u = jax.random.uniform(next(ks), (N_LAYERS_A, 2, D_RNN), jnp.float32, 0.9, 0.999)
    s = u ** (1.0 / LRU_C)
    lru_lambda = jnp.log(s) - jnp.log1p(-s)
    return {
        'x': nrm((BATCH, SEQ, d), 1.0),
        'c': nrm((BATCH, d), 1.0),
        'ctx': nrm((BATCH, CTX_LEN, d), 1.0),
        'c_ctx': nrm((d,), 1.0),
        'mod_w': nrm((DEPTH, d, 6 * d), d ** -0.5),
        'mod_b': nrm((DEPTH, 6 * d), 0.01),
        'norm1_g': gain((DEPTH, d)),
        'norm2_g': gain((DEPTH, d)),
        'lru_w_in': nrm((N_LAYERS_A, d, 2 * D_RNN), d ** -0.5),
        'lru_conv_w': nrm((N_LAYERS_A, CONV_W, D_RNN), CONV_W ** -0.5),
        'lru_conv_b': nrm((N_LAYERS_A, D_RNN), 0.01),
        'lru_w_a': nrm((N_LAYERS_A, 2, LRU_BLOCKS, LRU_BW, LRU_BW), LRU_BW ** -0.5),
        'lru_b_a': nrm((N_LAYERS_A, 2, D_RNN), 0.01),
        'lru_w_i': nrm((N_LAYERS_A, 2, LRU_BLOCKS, LRU_BW, LRU_BW), LRU_BW ** -0.5),
        'lru_b_i': nrm((N_LAYERS_A, 2, D_RNN), 0.01),
        'lru_lambda': lru_lambda,
        'lru_w_out': nrm((N_LAYERS_A, D_RNN, d), D_RNN ** -0.5),
        'sgu_w_in': nrm((N_LAYERS_B, d, 2 * D_SGU), d ** -0.5),
        'sgu_b_in': nrm((N_LAYERS_B, 2 * D_SGU), 0.01),
        'sgu_ln_g': gain((N_LAYERS_B, D_SGU)),
        'sgu_ln_b': nrm((N_LAYERS_B, D_SGU), 0.01),
        'sgu_w_s': nrm((N_LAYERS_B, SGU_GROUPS, SGU_CHUNK, SGU_CHUNK), SGU_CHUNK ** -0.5),
        'sgu_b_s': gain((N_LAYERS_B, SGU_GROUPS, SGU_CHUNK)),
        'sgu_w_out': nrm((N_LAYERS_B, D_SGU, d), D_SGU ** -0.5),
        'pool_w': nrm((N_LAYERS_C, len(POOL_WINDOWS), POOL_GD, POOL_GD), POOL_GD ** -0.5),
        'pool_b': nrm((N_LAYERS_C, len(POOL_WINDOWS), POOL_GD), 0.01),
        'pool_scale': gain((N_LAYERS_C, d)),
        'na_w_qkv': nrm((N_LAYERS_D, d, 3 * d), d ** -0.5),
        'na_q_g': gain((N_LAYERS_D, NA_HD)),
        'na_k_g': gain((N_LAYERS_D, NA_HD)),
        'na_rpb': nrm((N_LAYERS_D, NA_HEADS, 2 * NA_KH - 1, 2 * NA_KW - 1), 0.02),
        'na_w_o': nrm((N_LAYERS_D, d, d), d ** -0.5),
        'ffn_w1': nrm((N_DENSE, d, D_FF), d ** -0.5),
        'ffn_w3': nrm((N_DENSE, d, D_FF), d ** -0.5),
        'ffn_w2': nrm((N_DENSE, D_FF, d), D_FF ** -0.5),
        'moe_w_r': nrm((N_MOE, d, N_EXPERTS), d ** -0.5),
        'moe_b_r': nrm((N_MOE, N_EXPERTS), 0.01),
        'moe_w1': nrm((N_MOE, N_EXPERTS, d, D_FF), d ** -0.5),
        'moe_w3': nrm((N_MOE, N_EXPERTS, d, D_FF), d ** -0.5),
        'moe_w2': nrm((N_MOE, N_EXPERTS, D_FF, d), D_FF ** -0.5),
    }


def channel_mixer(f, i, ffn_w1, ffn_w3, ffn_w2, moe_w_r, moe_b_r, moe_w1, moe_w3, moe_w2):
    k = i // 2
    if i % 2 == 0:
        return swiglu(f, ffn_w1[k], ffn_w3[k], ffn_w2[k])
    return moe_swiglu(f, moe_w_r[k], moe_b_r[k], moe_w1[k], moe_w3[k], moe_w2[k])


def reference(x, c, ctx, c_ctx, mod_w, mod_b, norm1_g, norm2_g,
              lru_w_in, lru_conv_w, lru_conv_b, lru_w_a, lru_b_a, lru_w_i, lru_b_i, lru_lambda, lru_w_out,
              sgu_w_in, sgu_b_in, sgu_ln_g, sgu_ln_b, sgu_w_s, sgu_b_s, sgu_w_out,
              pool_w, pool_b, pool_scale,
              na_w_qkv, na_q_g, na_k_g, na_rpb, na_w_o,
              ffn_w1, ffn_w3, ffn_w2,
              moe_w_r, moe_b_r, moe_w1, moe_w3, moe_w2):
    h_lat, h_ctx = x, ctx
    s_lat = jax.nn.silu(c)[:, None, :]
    s_ctx = jax.nn.silu(c_ctx)[None, None, :]
    for i in range(DEPTH):
        kind, j = i % N_MIXERS, i // N_MIXERS
        ctx_out = i != DEPTH - 1
        ctx_in = ctx_out or kind in (0, 3)
        m_l = jnp.split(s_lat @ mod_w[i] + mod_b[i], 6, axis=-1)
        u_l = modulate(rms_norm(h_lat, norm1_g[i]), m_l[0], m_l[1])
        m_c, u_c = None, None
        if ctx_in:
            m_c = jnp.split(s_ctx @ mod_w[i] + mod_b[i], 6, axis=-1)
            u_c = modulate(rms_norm(h_ctx, norm1_g[i]), m_c[0], m_c[1])
        if kind == 0:
            y_l, y_c = mixer_rglru(u_l, u_c, lru_w_in[j], lru_conv_w[j], lru_conv_b[j], lru_w_a[j], lru_b_a[j],
                                   lru_w_i[j], lru_b_i[j], lru_lambda[j], lru_w_out[j], ctx_out)
        elif kind == 1:
            y_l = mixer_sgu(u_l, sgu_w_in[j], sgu_b_in[j], sgu_ln_g[j], sgu_ln_b[j], sgu_w_s[j], sgu_b_s[j], sgu_w_out[j])
            y_c = mixer_sgu(u_c, sgu_w_in[j], sgu_b_in[j], sgu_ln_g[j], sgu_ln_b[j], sgu_w_s[j], sgu_b_s[j], sgu_w_out[j]) if ctx_out else None
        elif kind == 2:
            y_l = mixer_pool(u_l, pool_w[j], pool_b[j], pool_scale[j])
            y_c = mixer_pool(u_c, pool_w[j], pool_b[j], pool_scale[j]) if ctx_out else None
        else:
            y_l, y_c = mixer_na(u_l, u_c, na_w_qkv[j], na_q_g[j], na_k_g[j], na_rpb[j], na_w_o[j], ctx_out)
        h_lat = h_lat + m_l[2] * y_l
        f_l = modulate(rms_norm(h_lat, norm2_g[i]), m_l[3], m_l[4])
        h_lat = h_lat + m_l[5] * channel_mixer(f_l, i, ffn_w1, ffn_w3, ffn_w2, moe_w_r, moe_b_r, moe_w1, moe_w3, moe_w2)
        if ctx_out:
            h_ctx = h_ctx + m_c[2] * y_c
            f_c = modulate(rms_norm(h_ctx, norm2_g[i]), m_c[3], m_c[4])
            h_ctx = h_ctx + m_c[5] * channel_mixer(f_c, i, ffn_w1, ffn_w3, ffn_w2, moe_w_r, moe_b_r, moe_w1, moe_w3, moe_w2)
    return h_lat
```

```cpp
#include <hip/hip_runtime.h>
#include <cstdio>
#include <cstdint>

#ifndef MK_DEBUG
#define MK_DEBUG 0
#endif
#ifndef MK_MULTI
#define MK_MULTI 0
#endif

#define LAS __attribute__((address_space(3)))
typedef unsigned short bf16_t;
typedef short bf16x8 __attribute__((ext_vector_type(8)));
typedef short s16x4 __attribute__((ext_vector_type(4)));
typedef float f32x4 __attribute__((ext_vector_type(4)));
typedef float f32x2 __attribute__((ext_vector_type(2)));
typedef unsigned u32x4 __attribute__((ext_vector_type(4)));
typedef unsigned u32x2 __attribute__((ext_vector_type(2)));

constexpr int D = 1024, NB = 32, SEQ = 2048, CTXL = 256;
constexpr int RL = NB * SEQ, RC = NB * CTXL, RA = RL + RC;
constexpr int DRNN = 1280, LBW = 160, DSGU = 2048, DFF = 3584, NE = 8;
constexpr int MODW = 6 * D;
constexpr int MPAD = 75776;
constexpr float NORM_EPS = 1e-6f;
constexpr int NWAVES = 8, NTHR = 512;

constexpr size_t MiB = 1u << 20;
constexpr size_t WS_CTL = 0, CTL_BYTES = 1 * MiB;
constexpr size_t WS_MODV = 1 * MiB;
constexpr size_t WS_HCTX = 5 * MiB;
constexpr size_t WS_LRU_WIN = 37 * MiB;
constexpr size_t WS_LRU_WA = WS_LRU_WIN + 5 * MiB;
constexpr size_t WS_LRU_WI = WS_LRU_WA + 1 * MiB;
constexpr size_t WS_LRU_WOUT = WS_LRU_WI + 1 * MiB;
constexpr size_t WS_SGU_WIN = WS_LRU_WOUT + 3 * MiB;
constexpr size_t WS_SGU_WS = WS_SGU_WIN + 8 * MiB;
constexpr size_t WS_SGU_WOUT = WS_SGU_WS + 1 * MiB;
constexpr size_t WS_POOL_W = WS_SGU_WOUT + 4 * MiB;
constexpr size_t WS_NA_WQKV = WS_POOL_W + 1 * MiB;
constexpr size_t WS_NA_WO = WS_NA_WQKV + 6 * MiB;
constexpr size_t WS_FFN_W13 = WS_NA_WO + 2 * MiB;
constexpr size_t WS_FFN_W2 = WS_FFN_W13 + 28 * MiB;
constexpr size_t WS_MOE_W13 = WS_FFN_W2 + 14 * MiB;
constexpr size_t WS_MOE_W2 = WS_MOE_W13 + 112 * MiB;
constexpr size_t WS_ROUTE = WS_MOE_W2 + 56 * MiB;
constexpr size_t WS_U = WS_ROUTE + 4 * MiB;
constexpr size_t WS_BIG = WS_U + 148 * MiB;
constexpr size_t WS_END = WS_BIG + 666 * MiB;
constexpr size_t WS_DBG = WS_END;
static_assert(WS_MOE_W13 == 111 * MiB && WS_BIG == 431 * MiB && WS_END == 1097 * MiB, "ws map");
constexpr size_t RT_E = 0;
constexpr size_t RT_W = 512 * 1024;
constexpr size_t RT_TOK = 1280 * 1024;
constexpr size_t RT_GW = 2048 * 1024;
constexpr size_t RT_ST = 2816 * 1024;
static_assert(RT_W >= (size_t)RA * 4 && RT_TOK - RT_W >= (size_t)RA * 8 && RT_GW - RT_TOK >= (size_t)2 * MPAD * 4 && RT_ST - RT_GW >= (size_t)2 * MPAD * 4 && 4 * MiB - RT_ST >= (size_t)RA * 8, "route map");
constexpr size_t BG_XG = 0, BG_Y = 360 * MiB;
constexpr size_t BG_HID = 0;
constexpr size_t BG_Z = 0;
constexpr size_t BG_FS1 = 0, BG_MHID = 148 * MiB;
constexpr size_t BG_PD = 0;
constexpr size_t BG_QKV = 0, BG_O = 432 * MiB;
static_assert(BG_MHID + (size_t)MPAD * DFF * 2 <= 666 * MiB && BG_O + (size_t)RL * D * 2 <= 666 * MiB && BG_Y + (size_t)RA * DRNN * 2 <= 666 * MiB, "big map");
constexpr int CW_BAR = 4096;
constexpr int CW_CNT = 16384;
constexpr int CW_CUR = 16384 + 256;
constexpr int CW_DBG = 32768;

constexpr int LDS_BYTES = 163840;
constexpr int LDS_AUX = 131072;
constexpr int LDS_CTL = LDS_BYTES - 256;

__device__ __forceinline__ float bf2f(unsigned b) { return __uint_as_float(b << 16); }
__device__ __forceinline__ unsigned pk2(float lo, float hi) { unsigned r; asm volatile("v_cvt_pk_bf16_f32 %0, %1, %2" : "=v"(r) : "v"(lo), "v"(hi)); return r; }
__device__ __forceinline__ float lo_bf(unsigned w) { return __uint_as_float(w << 16); }
__device__ __forceinline__ float hi_bf(unsigned w) { return __uint_as_float(w & 0xffff0000u); }
__device__ __forceinline__ float wave_sum(float v) {
#pragma unroll
    for (int o = 1; o < 64; o <<= 1) v += __shfl_xor(v, o);
    return v;
}
__device__ __forceinline__ float sigmoid_f(float x) { return 1.0f / (1.0f + __expf(-x)); }
__device__ __forceinline__ float silu_f(float x) { return x / (1.0f + __expf(-x)); }
__device__ __forceinline__ float gelu_tanh_f(float x) { const float z = 0.7978845608028654f * (x + 0.044715f * x * x * x); return x / (1.0f + __expf(-2.0f * z)); }
__device__ __forceinline__ unsigned lds_add(LAS unsigned* p, unsigned v) { return __hip_atomic_fetch_add(p, v, __ATOMIC_RELAXED, __HIP_MEMORY_SCOPE_WORKGROUP); }
#define LDS_WAIT() asm volatile("s_waitcnt lgkmcnt(0)" ::: "memory")
#define VM_WAIT() asm volatile("s_waitcnt vmcnt(0)" ::: "memory")

#define XB_TMO      128
#define XB_XCNT(j)  (256  + 64 * (j))
#define XB_XSUB(j)  (1280 + 64 * (j))
#define XB_XGEN(j)  (2304 + 64 * (j))
#define XB_TOP      3328
#define XB_TOPGEN   3392
#define XCD_BAR_WORDS 3456
#define XB_SPIN_CAP (1u << 18)
__device__ __forceinline__ unsigned xb_ld(unsigned* p)              { return __hip_atomic_load(p, __ATOMIC_RELAXED, __HIP_MEMORY_SCOPE_AGENT); }
__device__ __forceinline__ unsigned xb_add(unsigned* p, unsigned v) { return __hip_atomic_fetch_add(p, v, __ATOMIC_RELAXED, __HIP_MEMORY_SCOPE_AGENT); }
__device__ __forceinline__ unsigned xb_xcc_id() { return (unsigned)__builtin_amdgcn_s_getreg((3 << 11) | 20) & 0xFu; }
#define XB_SPIN(cond, bar) do { unsigned _sp = 0; while (cond) { __builtin_amdgcn_s_sleep(1); \
    if ((++_sp & 255u) == 0u) { if (xb_ld(&(bar)[XB_TMO])) break; if (_sp > XB_SPIN_CAP) { atomicAdd(&(bar)[XB_TMO], 1u); break; } } } } while (0)
struct XcdBarrier { unsigned* bar; unsigned x; volatile LAS unsigned* st; };
__device__ __forceinline__ XcdBarrier xcd_barrier_post(unsigned* bar, volatile LAS unsigned* st) {
    XcdBarrier b; b.bar = bar; b.x = xb_xcc_id(); b.st = st;
    if (threadIdx.x == 0) (void)xb_add(&bar[XB_XCNT(b.x)], 1u);
    return b;
}
__device__ __forceinline__ void xcd_barrier_complete(unsigned* bar, unsigned x, unsigned& nloc, unsigned& nx) {
    const unsigned G = gridDim.x * gridDim.y * gridDim.z;
    unsigned sum, cnt, mine, sp = 0u;
    for (;;) {
        sum = 0u; cnt = 0u; mine = 0u;
#pragma unroll
        for (unsigned j = 0; j < 16; ++j) { const unsigned c = xb_ld(&bar[XB_XCNT(j)]); sum += c; cnt += (c > 0u) ? 1u : 0u; mine = (j == x) ? c : mine; }
        if (sum == G) break;
        __builtin_amdgcn_s_sleep(1);
        if ((++sp & 255u) == 0u) { if (xb_ld(&bar[XB_TMO])) break; if (sp > XB_SPIN_CAP) { atomicAdd(&bar[XB_TMO], 1u); break; } }
    }
    nloc = mine > 0u ? mine : 1u; nx = cnt > 0u ? cnt : 1u;
}
__device__ __forceinline__ void xcd_barrier(const XcdBarrier& b) {
    asm volatile("s_waitcnt vmcnt(0)" ::: "memory");
    __syncthreads();
    if (threadIdx.x == 0) {
        unsigned* bar = b.bar;
        __builtin_amdgcn_s_waitcnt(0);
        unsigned nloc = b.st[0], nx = b.st[1];
        if (nloc == 0u) { xcd_barrier_complete(bar, b.x, nloc, nx); b.st[0] = nloc; b.st[1] = nx; }
        const unsigned old = xb_add(&bar[XB_XSUB(b.x)], 1u);
        const unsigned gen = old / nloc;
        if (old + 1u == (gen + 1u) * nloc) {
            __builtin_amdgcn_fence(__ATOMIC_RELEASE, "agent");
            asm volatile("s_waitcnt vmcnt(0)" ::: "memory");
            const unsigned og = xb_add(&bar[XB_TOP], 1u);
            const unsigned tg = og / nx;
            if (og + 1u == (tg + 1u) * nx) xb_add(&bar[XB_TOPGEN], 1u);
            else XB_SPIN(xb_ld(&bar[XB_TOPGEN]) == tg, bar);
            __builtin_amdgcn_fence(__ATOMIC_ACQUIRE, "agent");
            xb_add(&bar[XB_XGEN(b.x)], 1u);
            asm volatile("s_waitcnt vmcnt(0)" ::: "memory");
        } else {
            XB_SPIN(xb_ld(&bar[XB_XGEN(b.x)]) == gen, bar);
            __builtin_amdgcn_fence(__ATOMIC_ACQUIRE, "agent");
            asm volatile("s_waitcnt vmcnt(0)" ::: "memory");
        }
    }
    __syncthreads();
}

struct Params {
    const float* in[40];
    float* out; unsigned char* ws;
    int ph_lo, ph_hi;
};
enum In { I_X = 0, I_C, I_CTX, I_CCTX, I_MODW, I_MODB, I_N1G, I_N2G, I_LRU_WIN, I_LRU_CW, I_LRU_CB, I_LRU_WA, I_LRU_BA, I_LRU_WI, I_LRU_BI, I_LRU_LAM, I_LRU_WOUT,
          I_SGU_WIN, I_SGU_BIN, I_SGU_LNG, I_SGU_LNB, I_SGU_WS, I_SGU_BS, I_SGU_WOUT, I_POOL_W, I_POOL_B, I_POOL_S, I_NA_WQKV, I_NA_QG, I_NA_KG, I_NA_RPB, I_NA_WO,
          I_FFN_W1, I_FFN_W3, I_FFN_W2, I_MOE_WR, I_MOE_BR, I_MOE_W1, I_MOE_W3, I_MOE_W2 };

namespace pg8 {
constexpr int BM = 256, BK = 64, HALF = 128, HTB = HALF * BK * 2, STAGE_BYTES = 8 * HTB, NXCD = 8, WGM = 8;
__device__ __forceinline__ int lds_byte(int r, int c) { const int st = (r >> 4) * 2 + (c >> 5), rr = r & 15, cc = c & 31, ob = rr * 64 + cc * 2; return st * 1024 + (ob ^ (((ob >> 9) & 1) << 5)); }
__device__ __forceinline__ void stage_rc(int b, int& R, int& C) { const int st = b / 1024, sb = b % 1024, swz = sb ^ (((sb >> 9) & 1) << 5); R = (st >> 1) * 16 + swz / 64; C = (st & 1) * 32 + (swz % 64) / 2; }
__device__ __forceinline__ int perm32(int rho) { const int n = rho >> 4, i = rho & 15; return 8 * (i >> 2) + 4 * n + (i & 3); }

struct Unit { int pm, pn, e; const char* a; const char* b; };
struct Sched {
    int nM, nN, G, c;
    const char* A; size_t a_tile, a_pn;
    const char* B; size_t b_tile, b_e;
    const LAS int* tstart;
    __device__ __forceinline__ bool next(int i, Unit& u) const {
        const int nwg = nM * nN; const long L = (long)i * G + c; if (L >= nwg) return false;
        int wgid = (int)L; { const int q = nwg / NXCD, r = nwg % NXCD, xcd = wgid % NXCD, off = wgid / NXCD; wgid = (xcd < r ? xcd * (q + 1) : r * (q + 1) + (xcd - r) * q) + off; }
        const int nig = WGM * nN, gid = wgid / nig, fm = gid * WGM, gsz = (nM - fm) < WGM ? (nM - fm) : WGM;
        u.pm = fm + ((wgid % nig) % gsz); u.pn = (wgid % nig) / gsz;
        int e = 0;
        if (tstart) {
#pragma unroll
            for (int k = 1; k < 8; ++k) e += (u.pm >= tstart[k]) ? 1 : 0;
        }
        u.e = e; u.a = A + (size_t)u.pm * a_tile + (size_t)u.pn * a_pn; u.b = B + (size_t)e * b_e + (size_t)u.pn * b_tile;
        return true;
    }
};

template <class Epi>
__device__ __forceinline__ void gemm_phase(LAS unsigned char* lds, const int lda, const int K, const Sched& S, const Epi& E) {
    const int tid = threadIdx.x, wid = __builtin_amdgcn_readfirstlane(tid >> 6), lane = tid & 63, wr = wid >> 2, wc = wid & 3, fr = lane & 15, fq = lane >> 4;
    const int nt = K / BK;
    unsigned voffA[2], voffB[2];
#pragma unroll
    for (int i = 0; i < 2; ++i) { int R, C; stage_rc(tid * 16 + i * 8192, R, C); const int Rb = Epi::PERM ? ((R & ~31) + perm32(R & 31)) : R;
        voffA[i] = (unsigned)(R * lda + C) * 2u; voffB[i] = (unsigned)(Rb * K + C) * 2u; }
    const size_t kstep = (size_t)(BK * 2);
    const size_t hstepA = (size_t)HALF * lda * 2, hstepB = (size_t)HALF * K * 2;
    const unsigned ldsw = (unsigned)wid * 1024u;
    const int aoff = lds_byte(wr * 64 + fr, fq * 8), boff = lds_byte(wc * 32 + fr, fq * 8);
#define PG8_SA(b, h) (((b) * 2 + (h)) * HTB)
#define PG8_SB(b, h) ((4 + (b) * 2 + (h)) * HTB)
#define PG8_STAGE(bufoff, gbase, voff) do { _Pragma("unroll") for (int _i = 0; _i < 2; ++_i) \
        __builtin_amdgcn_global_load_lds((const unsigned*)((const char*)(gbase) + (voff)[_i]), (LAS unsigned*)(lds + (bufoff) + ldsw + _i * 8192), 16, 0, 0); } while (0)
#define PG8_LDA(dst, b, h) do { _Pragma("unroll") for (int m = 0; m < 4; ++m) _Pragma("unroll") for (int k = 0; k < 2; ++k) dst[m][k] = *(const LAS bf16x8*)(lds + PG8_SA(b, h) + aoff + m * 2048 + k * 1024); } while (0)
#define PG8_LDB(dst, b, h) do { _Pragma("unroll") for (int n = 0; n < 2; ++n) _Pragma("unroll") for (int k = 0; k < 2; ++k) dst[n][k] = *(const LAS bf16x8*)(lds + PG8_SB(b, h) + boff + n * 2048 + k * 1024); } while (0)
#define PG8_MMA(ai, bj, At, Bt) do { __builtin_amdgcn_s_setprio(1); _Pragma("unroll") for (int m = 0; m < 4; ++m) _Pragma("unroll") for (int n = 0; n < 2; ++n) _Pragma("unroll") for (int k = 0; k < 2; ++k) \
        acc[ai][bj][m][n] = __builtin_amdgcn_mfma_f32_16x16x32_bf16(Bt[n][k], At[m][k], acc[ai][bj][m][n], 0, 0, 0); __builtin_amdgcn_s_setprio(0); } while (0)
#define PG8_WAIT_V(n) asm volatile("s_waitcnt vmcnt(" #n ")" ::: "memory")
#define PG8_WAIT_L(n) asm volatile("s_waitcnt lgkmcnt(" #n ")" ::: "memory")
#define PG8_BAR __builtin_amdgcn_s_barrier()
#define PG8_SCHED __builtin_amdgcn_sched_barrier(0)
    Unit cur, nxt; int ui = 0;
    if (!S.next(0, cur)) return;
    f32x4 acc[2][2][4][2];
#pragma unroll
    for (int a = 0; a < 2; ++a)
#pragma unroll
        for (int b = 0; b < 2; ++b)
#pragma unroll
            for (int m = 0; m < 4; ++m)
#pragma unroll
                for (int n = 0; n < 2; ++n) acc[a][b][m][n] = (f32x4){0.f, 0.f, 0.f, 0.f};
    bf16x8 At[4][2], B0[2][2], B1[2][2];
    const char* cA = cur.a; const char* cB = cur.b;
    PG8_STAGE(PG8_SB(0, 0), cB, voffB); PG8_STAGE(PG8_SB(0, 1), cB + hstepB, voffB); PG8_STAGE(PG8_SA(0, 0), cA, voffA); PG8_STAGE(PG8_SA(0, 1), cA + hstepA, voffA);
    if (wr == 1) PG8_BAR;
    PG8_WAIT_V(2); PG8_BAR;
    PG8_STAGE(PG8_SB(1, 0), cB + kstep, voffB); PG8_STAGE(PG8_SA(1, 0), cA + kstep, voffA); PG8_STAGE(PG8_SB(1, 1), cB + hstepB + kstep, voffB);
    PG8_WAIT_V(6); PG8_BAR;
    for (;;) {
        const bool has_next = S.next(ui + 1, nxt);
        const char* nA = has_next ? nxt.a : cA; const char* nB = has_next ? nxt.b : cB;
        for (int t = 0; t < nt; t += 2) {
            const bool last = (t == nt - 2);
            const char* a1 = cA + (size_t)(t + 1) * kstep;
            const char* a2 = last ? nA : cA + (size_t)(t + 2) * kstep; const char* b2 = last ? nB : cB + (size_t)(t + 2) * kstep;
            const char* a3 = a2 + kstep; const char* b3 = b2 + kstep;
            PG8_LDB(B0, 0, 0); PG8_LDB(B1, 0, 1); PG8_SCHED; PG8_LDA(At, 0, 0); PG8_STAGE(PG8_SA(1, 1), a1 + hstepA, voffA);
            PG8_WAIT_V(8); PG8_WAIT_L(0); PG8_BAR; PG8_MMA(0, 0, At, B0); PG8_MMA(0, 1, At, B1); PG8_BAR; PG8_SCHED;
            PG8_LDA(At, 0, 1); PG8_STAGE(PG8_SB(0, 0), b2, voffB); PG8_STAGE(PG8_SB(0, 1), b2 + hstepB, voffB); PG8_STAGE(PG8_SA(0, 0), a2, voffA);
            PG8_WAIT_V(8); PG8_WAIT_L(0); PG8_BAR; PG8_MMA(1, 0, At, B0); PG8_MMA(1, 1, At, B1); PG8_BAR; PG8_SCHED;
            PG8_LDB(B0, 1, 0); PG8_LDB(B1, 1, 1); PG8_SCHED; PG8_LDA(At, 1, 0); PG8_STAGE(PG8_SA(0, 1), a2 + hstepA, voffA);
            PG8_WAIT_V(8); PG8_WAIT_L(0); PG8_BAR; PG8_MMA(0, 0, At, B0); PG8_MMA(0, 1, At, B1); PG8_BAR; PG8_SCHED;
            PG8_LDA(At, 1, 1); PG8_STAGE(PG8_SB(1, 0), b3, voffB); PG8_STAGE(PG8_SB(1, 1), b3 + hstepB, voffB); PG8_STAGE(PG8_SA(1, 0), a3, voffA);
            PG8_WAIT_V(8); PG8_WAIT_L(0); PG8_BAR; PG8_MMA(1, 0, At, B0); PG8_MMA(1, 1, At, B1); PG8_BAR; PG8_SCHED;
        }
        if (wr == 0) PG8_BAR;
        E(acc, cur, wr, wc, fr, fq);
        if (!has_next) break;
#pragma unroll
        for (int a = 0; a < 2; ++a)
#pragma unroll
            for (int b = 0; b < 2; ++b)
#pragma unroll
                for (int m = 0; m < 4; ++m)
#pragma unroll
                    for (int n = 0; n < 2; ++n) acc[a][b][m][n] = (f32x4){0.f, 0.f, 0.f, 0.f};
        cur = nxt; cA = nA; cB = nB; ++ui;
        if (wr == 1) PG8_BAR;
    }
    PG8_WAIT_V(0);
    PG8_BAR;
#undef PG8_SA
#undef PG8_SB
#undef PG8_STAGE
#undef PG8_LDA
#undef PG8_LDB
#undef PG8_MMA
#undef PG8_WAIT_V
#undef PG8_WAIT_L
#undef PG8_BAR
#undef PG8_SCHED
}

template <int ACT> struct EpiBf16 {
    static constexpr bool PERM = true;
    bf16_t* O; int ldc; const float* bias;
    __device__ __forceinline__ void operator()(const f32x4 (&acc)[2][2][4][2], const Unit& u, int wr, int wc, int fr, int fq) const {
        const int row0 = u.pm * BM + wr * 64 + fr; const int col0 = u.pn * BM + wc * 32 + 8 * fq;
        f32x4 bv[2][2];
#pragma unroll
        for (int bj = 0; bj < 2; ++bj)
#pragma unroll
            for (int n = 0; n < 2; ++n) bv[bj][n] = bias ? *(const f32x4*)(bias + col0 + bj * HALF + 4 * n) : (f32x4){0.f, 0.f, 0.f, 0.f};
#pragma unroll
        for (int ai = 0; ai < 2; ++ai)
#pragma unroll
            for (int m = 0; m < 4; ++m) { bf16_t* rowp = O + (size_t)(row0 + ai * HALF + m * 16) * ldc + col0;
#pragma unroll
                for (int bj = 0; bj < 2; ++bj) { f32x4 v0 = acc[ai][bj][m][0] + bv[bj][0], v1 = acc[ai][bj][m][1] + bv[bj][1];
                    if (ACT == 1) {
#pragma unroll
                        for (int j = 0; j < 4; ++j) { v0[j] = gelu_tanh_f(v0[j]); v1[j] = gelu_tanh_f(v1[j]); } }
                    u32x4 w; w.x = pk2(v0[0], v0[1]); w.y = pk2(v0[2], v0[3]); w.z = pk2(v1[0], v1[1]); w.w = pk2(v1[2], v1[3]);
                    *(u32x4*)(rowp + bj * HALF) = w; } }
    }
};
struct EpiSwiGLU {
    static constexpr bool PERM = true;
    bf16_t* H; int ldh;
    __device__ __forceinline__ void operator()(const f32x4 (&acc)[2][2][4][2], const Unit& u, int wr, int wc, int fr, int fq) const {
        const int row0 = u.pm * BM + wr * 64 + fr; const int col0 = u.pn * HALF + wc * 32 + 8 * fq;
#pragma unroll
        for (int ai = 0; ai < 2; ++ai)
#pragma unroll
            for (int m = 0; m < 4; ++m) { bf16_t* rowp = H + (size_t)(row0 + ai * HALF + m * 16) * ldh + col0;
                f32x4 h0, h1;
#pragma unroll
                for (int j = 0; j < 4; ++j) { h0[j] = silu_f(acc[ai][0][m][0][j]) * acc[ai][1][m][0][j]; h1[j] = silu_f(acc[ai][0][m][1][j]) * acc[ai][1][m][1][j]; }
                u32x4 w; w.x = pk2(h0[0], h0[1]); w.y = pk2(h0[2], h0[3]); w.z = pk2(h1[0], h1[1]); w.w = pk2(h1[2], h1[3]);
                *(u32x4*)rowp = w; }
    }
};
struct EpiResid {
    static constexpr bool PERM = false;
    const float* src_lat; const float* src_ctx; float* dst_lat; float* dst_ctx; const float* gate;
    const float* bias; const float* cscale;
    __device__ __forceinline__ void operator()(const f32x4 (&acc)[2][2][4][2], const Unit& u, int wr, int wc, int fr, int fq) const {
        const bool isctx = u.pm >= RL / BM; const int mb = isctx ? 32 : (u.pm >> 3);
        const size_t trow = isctx ? (size_t)(u.pm - RL / BM) * BM : (size_t)u.pm * BM;
        const float* src = (isctx ? src_ctx : src_lat) + trow * D; float* dst = (isctx ? dst_ctx : dst_lat) + trow * D;
        const float* g = gate + (size_t)mb * MODW;
        const int col0 = u.pn * BM + wc * 32 + 4 * fq;
        f32x4 gv[2][2], bv[2][2], sv[2][2];
#pragma unroll
        for (int bj = 0; bj < 2; ++bj)
#pragma unroll
            for (int n = 0; n < 2; ++n) { const int c = col0 + bj * HALF + n * 16; gv[bj][n] = *(const f32x4*)(g + c);
                bv[bj][n] = bias ? *(const f32x4*)(bias + c) : (f32x4){0.f, 0.f, 0.f, 0.f}; sv[bj][n] = cscale ? *(const f32x4*)(cscale + c) : (f32x4){1.f, 1.f, 1.f, 1.f}; }
#pragma unroll
        for (int ai = 0; ai < 2; ++ai)
#pragma unroll
            for (int m = 0; m < 4; ++m) { const size_t off = (size_t)(ai * HALF + wr * 64 + m * 16 + fr) * D + col0;
#pragma unroll
                for (int bj = 0; bj < 2; ++bj)
#pragma unroll
                    for (int n = 0; n < 2; ++n) { const f32x4 s = *(const f32x4*)(src + off + bj * HALF + n * 16);
                        *(f32x4*)(dst + off + bj * HALF + n * 16) = s + gv[bj][n] * ((acc[ai][bj][m][n] + bv[bj][n]) * sv[bj][n]); } }
    }
};
struct EpiMoeDown {
    static constexpr bool PERM = false;
    float* h_lat; float* h_ctx; const float* gate; const int* tok; const float* gw;
    __device__ __forceinline__ void operator()(const f32x4 (&acc)[2][2][4][2], const Unit& u, int wr, int wc, int fr, int fq) const {
        const int col0 = u.pn * BM + wc * 32 + 4 * fq;
#pragma unroll
        for (int ai = 0; ai < 2; ++ai)
#pragma unroll
            for (int m = 0; m < 4; ++m) { const int pos = u.pm * BM + ai * HALF + wr * 64 + m * 16 + fr; const int t = tok[pos];
                if (t >= 0) { const float w = gw[pos]; const bool isctx = t >= RL; const int mb = isctx ? 32 : (t >> 11);
                    float* dst = isctx ? h_ctx + (size_t)(t - RL) * D : h_lat + (size_t)t * D; const float* g = gate + (size_t)mb * MODW;
#pragma unroll
                    for (int bj = 0; bj < 2; ++bj)
#pragma unroll
                        for (int n = 0; n < 2; ++n) { const int c = col0 + bj * HALF + n * 16; const f32x4 s = *(const f32x4*)(dst + c); const f32x4 gg = *(const f32x4*)(g + c);
                            *(f32x4*)(dst + c) = s + gg * (acc[ai][bj][m][n] * w); } } }
    }
};
}

struct Frame {
    LAS unsigned char* lds;
    int tid, lane, wave, bid, G;
    const Params* p;
    unsigned char* ws; unsigned* ctl;
    float* modv; float* hctx; bf16_t* U;
};
#define WSP(T, off) ((T*)(F.ws + (off)))
__device__ __forceinline__ const float* INP(const Frame& F, int i) { return F.p->in[i]; }

__device__ __forceinline__ void cvt_item(const float* W, int K, int N, bf16_t* WT, int mode, LAS float* scr, int item, int lane) {
    const int nblk = N / 32, kb = item / nblk, nb = item % nblk, k0 = 64 * kb, n0 = 32 * nb;
#pragma unroll 8
    for (int i = 0; i < 32; ++i) { const int kk = 2 * i + (lane >> 5); scr[kk * 33 + (lane & 31)] = W[(size_t)(k0 + kk) * N + n0 + (lane & 31)]; }
    LDS_WAIT();
    const int c = lane & 7;
#pragma unroll
    for (int j = 0; j < 4; ++j) { const int n = (lane >> 3) + 8 * j; const LAS float* s = scr + (8 * c) * 33 + n;
        u32x4 o; o.x = pk2(s[0 * 33], s[1 * 33]); o.y = pk2(s[2 * 33], s[3 * 33]); o.z = pk2(s[4 * 33], s[5 * 33]); o.w = pk2(s[6 * 33], s[7 * 33]);
        const int nn = n0 + n; const int drow = mode == 0 ? nn : (256 * (nn >> 7) + (nn & 127) + (mode == 2 ? 128 : 0));
        *(u32x4*)(WT + (size_t)drow * K + k0 + 8 * c) = o; }
    LDS_WAIT();
}
struct CvtJob { const float* src; bf16_t* dst; int K, N, mode; };
__device__ __forceinline__ void cvt_jobs_run(const Frame& F, const CvtJob* jobs, int njobs) {
    (void)jobs; (void)njobs;
}
__device__ __forceinline__ void cvt_run_job(const Frame& F, const CvtJob j, int& base) {
    LAS float* scr = (LAS float*)(F.lds + F.wave * 16384);
    const int gw = F.bid * NWAVES + F.wave, NGW = F.G * NWAVES;
    const int n = (j.K / 64) * (j.N / 32);
    int start = (gw - base) % NGW; if (start < 0) start += NGW;
    for (int it = start; it < n; it += NGW) cvt_item(j.src, j.K, j.N, j.dst, j.mode, scr, it, F.lane);
    base = (base + n) % NGW;
}
__device__ __forceinline__ void phase_cvt_small(const Frame& F) {
    int base = 0;
    cvt_run_job(F, CvtJob{INP(F, I_LRU_WIN), WSP(bf16_t, WS_LRU_WIN), 1024, 2560, 0}, base);
    cvt_run_job(F, CvtJob{INP(F, I_LRU_WOUT), WSP(bf16_t, WS_LRU_WOUT), 1280, 1024, 0}, base);
    cvt_run_job(F, CvtJob{INP(F, I_SGU_WIN), WSP(bf16_t, WS_SGU_WIN), 1024, 4096, 0}, base);
    cvt_run_job(F, CvtJob{INP(F, I_SGU_WOUT), WSP(bf16_t, WS_SGU_WOUT), 2048, 1024, 0}, base);
    for (int g = 0; g < 4; ++g) cvt_run_job(F, CvtJob{INP(F, I_POOL_W) + (size_t)g * 65536, WSP(bf16_t, WS_POOL_W) + (size_t)g * 65536, 256, 256, 0}, base);
    cvt_run_job(F, CvtJob{INP(F, I_NA_WQKV), WSP(bf16_t, WS_NA_WQKV), 1024, 3072, 0}, base);
    cvt_run_job(F, CvtJob{INP(F, I_NA_WO), WSP(bf16_t, WS_NA_WO), 1024, 1024, 0}, base);
    for (int l = 0; l < 2; ++l) {
        cvt_run_job(F, CvtJob{INP(F, I_FFN_W1) + (size_t)l * D * DFF, WSP(bf16_t, WS_FFN_W13) + (size_t)l * 2 * DFF * D, 1024, DFF, 1}, base);
        cvt_run_job(F, CvtJob{INP(F, I_FFN_W3) + (size_t)l * D * DFF, WSP(bf16_t, WS_FFN_W13) + (size_t)l * 2 * DFF * D, 1024, DFF, 2}, base);
        cvt_run_job(F, CvtJob{INP(F, I_FFN_W2) + (size_t)l * D * DFF, WSP(bf16_t, WS_FFN_W2) + (size_t)l * D * DFF, DFF, 1024, 0}, base);
    }
    const size_t gt = (size_t)F.bid * NTHR + F.tid, GT = (size_t)F.G * NTHR;
    { const float* wa = INP(F, I_LRU_WA); const float* wi = INP(F, I_LRU_WI); bf16_t* da = WSP(bf16_t, WS_LRU_WA); bf16_t* di = WSP(bf16_t, WS_LRU_WI);
      for (size_t i = gt; i < (size_t)16 * 160 * 160; i += GT) { const int mat = (int)(i / 25600), rem = (int)(i % 25600), n = rem / 160, k = rem % 160;
          da[i] = (bf16_t)(pk2(wa[(size_t)mat * 25600 + k * 160 + n], 0.f) & 0xffffu); di[i] = (bf16_t)(pk2(wi[(size_t)mat * 25600 + k * 160 + n], 0.f) & 0xffffu); } }
    { const float* w = INP(F, I_SGU_WS); bf16_t* d = WSP(bf16_t, WS_SGU_WS);
      for (size_t i = gt; i < (size_t)8 * 128 * 128; i += GT) d[i] = (bf16_t)(pk2(w[i], 0.f) & 0xffffu); }
}
__device__ __forceinline__ void phase_cvt_moe(const Frame& F, int l2) {
    int base = 0;
    for (int e = 0; e < NE; ++e) {
        const size_t so = ((size_t)l2 * NE + e) * D * DFF;
        cvt_run_job(F, CvtJob{INP(F, I_MOE_W1) + so, WSP(bf16_t, WS_MOE_W13) + (size_t)e * 2 * DFF * D, 1024, DFF, 1}, base);
        cvt_run_job(F, CvtJob{INP(F, I_MOE_W3) + so, WSP(bf16_t, WS_MOE_W13) + (size_t)e * 2 * DFF * D, 1024, DFF, 2}, base);
        cvt_run_job(F, CvtJob{INP(F, I_MOE_W2) + so, WSP(bf16_t, WS_MOE_W2) + (size_t)e * D * DFF, DFF, 1024, 0}, base);
    }
}

__device__ __forceinline__ void phase_mod(const Frame& F) {
    LAS float* sL = (LAS float*)F.lds;
    __syncthreads();
    const float* c = INP(F, I_C); const float* cc = INP(F, I_CCTX);
    for (int i = F.tid; i < 33 * 1024; i += NTHR) { const int b = i >> 10, k = i & 1023; const float v = b < 32 ? c[b * 1024 + k] : cc[k]; sL[i] = silu_f(v); }
    __syncthreads();
    for (int unit = F.bid; unit < 48; unit += F.G) {
        const int l = unit / 12, col = (unit % 12) * 512 + F.tid;
        const float* w = INP(F, I_MODW) + (size_t)l * 1024 * MODW + col;
        float acc[33];
#pragma unroll
        for (int b = 0; b < 33; ++b) acc[b] = 0.f;
        for (int k = 0; k < 1024; k += 4) {
            const float w0 = w[(size_t)k * MODW], w1 = w[(size_t)(k + 1) * MODW], w2 = w[(size_t)(k + 2) * MODW], w3 = w[(size_t)(k + 3) * MODW];
#pragma unroll
            for (int b = 0; b < 33; ++b) { const f32x4 s = *(const LAS f32x4*)(sL + b * 1024 + k); acc[b] += s[0] * w0 + s[1] * w1 + s[2] * w2 + s[3] * w3; }
        }
        const float mb = INP(F, I_MODB)[l * MODW + col];
#pragma unroll
        for (int b = 0; b < 33; ++b) F.modv[((size_t)l * 33 + b) * MODW + col] = acc[b] + mb;
    }
    __syncthreads();
}

struct NormCtx { const float* src_lat; const float* src_ctx; const float* gain; const float* mod; int which; };
__device__ __forceinline__ void norm_row(const Frame& F, const NormCtx& N, int r, f32x4 (&y)[4]) {
    const float* src = r < RL ? N.src_lat + (size_t)r * D : N.src_ctx + (size_t)(r - RL) * D;
    const int mb = r < RL ? (r >> 11) : 32;
    const float* sh = N.mod + (size_t)mb * MODW + N.which * 3 * D; const float* sc = sh + D;
    f32x4 v[4]; float ss = 0.f;
#pragma unroll
    for (int j = 0; j < 4; ++j) { v[j] = *(const f32x4*)(src + 4 * F.lane + 256 * j); ss += (v[j][0] * v[j][0] + v[j][1] * v[j][1]) + (v[j][2] * v[j][2] + v[j][3] * v[j][3]); }
    const float rstd = 1.0f / sqrtf(wave_sum(ss) * (1.0f / D) + NORM_EPS);
#pragma unroll
    for (int j = 0; j < 4; ++j) { const int c = 4 * F.lane + 256 * j; const f32x4 g = *(const f32x4*)(N.gain + c), s1 = *(const f32x4*)(sc + c), s0 = *(const f32x4*)(sh + c);
        y[j] = (v[j] * rstd * g) * (s1 + 1.0f) + s0; }
}
__device__ __forceinline__ void store_row_bf16(const Frame& F, bf16_t* dst, const f32x4 (&y)[4]) {
#pragma unroll
    for (int j = 0; j < 4; ++j) { u32x2 w; w.x = pk2(y[j][0], y[j][1]); w.y = pk2(y[j][2], y[j][3]); *(u32x2*)(dst + 4 * F.lane + 256 * j) = w; }
}
__device__ __forceinline__ void phase_norm(const Frame& F, const NormCtx& N, int nrows) {
    const int gw = F.bid * NWAVES + F.wave, NGW = F.G * NWAVES;
    for (int r = gw; r < nrows; r += NGW) { f32x4 y[4]; norm_row(F, N, r, y); store_row_bf16(F, F.U + (size_t)r * D, y); }
}
__device__ __forceinline__ void phase_route(const Frame& F, const NormCtx& N, int nrows, int l2) {
    LAS float* wrL = (LAS float*)F.lds;
    LAS unsigned* hist = (LAS unsigned*)(F.lds + 32768);
    __syncthreads();
    const float* wr = INP(F, I_MOE_WR) + (size_t)l2 * D * NE; const float* br = INP(F, I_MOE_BR) + l2 * NE;
    for (int i = F.tid; i < D * NE; i += NTHR) wrL[i] = wr[i];
    if (F.tid < 16) hist[F.tid] = 0u;
    __syncthreads();
    int* re = WSP(int, WS_ROUTE + RT_E); float* rw = WSP(float, WS_ROUTE + RT_W);
    const int gw = F.bid * NWAVES + F.wave, NGW = F.G * NWAVES;
    for (int r = gw; r < nrows; r += NGW) {
        f32x4 y[4]; norm_row(F, N, r, y);
        float lg[NE];
#pragma unroll
        for (int e = 0; e < NE; ++e) lg[e] = 0.f;
#pragma unroll
        for (int j = 0; j < 4; ++j)
#pragma unroll
            for (int q = 0; q < 4; ++q) { const int c = 4 * F.lane + 256 * j + q; const f32x4 wa = *(const LAS f32x4*)(wrL + c * 8), wb = *(const LAS f32x4*)(wrL + c * 8 + 4); const float yv = y[j][q];
                lg[0] += yv * wa[0]; lg[1] += yv * wa[1]; lg[2] += yv * wa[2]; lg[3] += yv * wa[3]; lg[4] += yv * wb[0]; lg[5] += yv * wb[1]; lg[6] += yv * wb[2]; lg[7] += yv * wb[3]; }
#pragma unroll
        for (int e = 0; e < NE; ++e) lg[e] = wave_sum(lg[e]) + br[e];
        int e0 = 0; float v0 = lg[0];
#pragma unroll
        for (int e = 1; e < NE; ++e) if (lg[e] > v0) { v0 = lg[e]; e0 = e; }
        int e1 = -1; float v1 = -3.0e38f;
#pragma unroll
        for (int e = 0; e < NE; ++e) if (e != e0 && lg[e] > v1) { v1 = lg[e]; e1 = e; }
        const float w0 = 1.0f / (1.0f + __expf(v1 - v0)), w1 = 1.0f - w0;
        if (F.lane == 0) { re[r] = e0 | (e1 << 8); rw[2 * r] = w0; rw[2 * r + 1] = w1; lds_add(&hist[e0], 1u); lds_add(&hist[8 + e1], 1u); }
    }
    __syncthreads();
    if (F.tid < 16 && hist[F.tid]) atomicAdd(F.ctl + CW_CNT + 64 * l2 + F.tid, hist[F.tid]);
    int* tok = WSP(int, WS_ROUTE + RT_TOK);
    for (size_t i = (size_t)F.bid * NTHR + F.tid; i < (size_t)2 * MPAD; i += (size_t)F.G * NTHR) tok[i] = -1;
    __syncthreads();
}
__device__ __forceinline__ int pad256(int x) { return (x + 255) & ~255; }
__device__ __forceinline__ void phase_scatter(const Frame& F, const NormCtx& N, int nrows, int l2) {
    LAS unsigned* bcnt = (LAS unsigned*)F.lds;
    LAS unsigned* bbase = (LAS unsigned*)(F.lds + 64);
    __syncthreads();
    if (F.tid < 16) bcnt[F.tid] = 0u;
    __syncthreads();
    const int RPB = (nrows + F.G - 1) / F.G, rb0 = F.bid * RPB, rb1 = min(nrows, rb0 + RPB);
    const int* re = WSP(const int, WS_ROUTE + RT_E); const float* rw = WSP(const float, WS_ROUTE + RT_W);
    int* tok = WSP(int, WS_ROUTE + RT_TOK); float* gwl = WSP(float, WS_ROUTE + RT_GW);
    bf16_t* FS0 = F.U; bf16_t* FS1 = WSP(bf16_t, WS_BIG + BG_FS1);
    const int myr = rb0 + F.wave + 8 * F.lane; const bool have = myr < rb1;
    int e0 = 0, e1 = 0; unsigned li0 = 0, li1 = 0; float w0 = 0.f, w1 = 0.f;
    if (have) { const int ee = re[myr]; e0 = ee & 255; e1 = (ee >> 8) & 255; w0 = rw[2 * myr]; w1 = rw[2 * myr + 1]; li0 = lds_add(&bcnt[e0], 1u); li1 = lds_add(&bcnt[8 + e1], 1u); }
    __syncthreads();
    const unsigned* cnt = F.ctl + CW_CNT + 64 * l2;
    if (F.tid < 16) { const int s = F.tid >> 3, e = F.tid & 7; unsigned off = 0; for (int k = 0; k < e; ++k) off += (unsigned)pad256((int)cnt[s * 8 + k]);
        unsigned b = 0; if (bcnt[F.tid]) b = atomicAdd(F.ctl + CW_CUR + 64 * l2 + F.tid, bcnt[F.tid]); bbase[F.tid] = off + b; }
    __syncthreads();
    const int p0 = (int)(bbase[e0] + li0), p1 = (int)(bbase[8 + e1] + li1);
    const int nmine = (rb1 - rb0 - F.wave + 7) / 8;
    for (int i = 0; i < nmine; ++i) {
        const int r = rb0 + F.wave + 8 * i;
        const int q0 = __shfl(p0, i), q1 = __shfl(p1, i); const float g0 = __shfl(w0, i), g1 = __shfl(w1, i);
        f32x4 y[4]; norm_row(F, N, r, y);
        store_row_bf16(F, FS0 + (size_t)q0 * D, y); store_row_bf16(F, FS1 + (size_t)q1 * D, y);
        if (F.lane == 0) { tok[q0] = r; gwl[q0] = g0; tok[MPAD + q1] = r; gwl[MPAD + q1] = g1; }
    }
    if (F.bid < 16) { const int s = F.bid >> 3, e = F.bid & 7; int off = 0; for (int k = 0; k < e; ++k) off += pad256((int)cnt[s * 8 + k]);
        const int c = (int)cnt[s * 8 + e], pe = pad256(c); bf16_t* base = (s ? FS1 : FS0) + (size_t)(off + c) * D;
        for (int i = F.tid; i < (pe - c) * (D / 8); i += NTHR) *(u32x4*)(base + (size_t)i * 8) = (u32x4){0u, 0u, 0u, 0u}; }
    __syncthreads();
}
__device__ __forceinline__ int moe_tile_table(const Frame& F, int l2, int s, LAS int* tstart) {
    __syncthreads();
    if (F.tid == 0) { const unsigned* cnt = F.ctl + CW_CNT + 64 * l2 + 8 * s; int t = 0; for (int e = 0; e < NE; ++e) { tstart[e] = t; t += pad256((int)cnt[e]) >> 8; } tstart[8] = t; }
    __syncthreads();
    return tstart[8];
}

__device__ __forceinline__ void phase_scan(const Frame& F, bool need_ctx) {
    LAS bf16_t* xcA = (LAS bf16_t*)F.lds;
    LAS float* aL = (LAS float*)(F.lds + 21504);
    LAS float* bL = (LAS float*)(F.lds + 21504 + 40960);
    const bf16_t* XG = WSP(const bf16_t, WS_BIG + BG_XG); bf16_t* Y = WSP(bf16_t, WS_BIG + BG_Y);
    const float* cw = INP(F, I_LRU_CW); const float* cb = INP(F, I_LRU_CB);
    const int fr = F.lane & 15, fq = F.lane >> 4, w = F.wave;
    for (int unit = F.bid; unit < NB * 8; unit += F.G) {
        const int b = unit >> 3, kb = unit & 7, ch0 = kb * LBW;
        for (int d = 0; d < 2; ++d) {
            float carry = 0.f;
            bf16x8 Ba[2][5], Bi[2][5]; float biasa[2] = {0.f, 0.f}, biasi[2] = {0.f, 0.f}, sp[2] = {0.f, 0.f};
            if (w < 5) {
                const bf16_t* wa = WSP(const bf16_t, WS_LRU_WA) + (size_t)(d * 8 + kb) * 25600; const bf16_t* wi = WSP(const bf16_t, WS_LRU_WI) + (size_t)(d * 8 + kb) * 25600;
#pragma unroll
                for (int n2 = 0; n2 < 2; ++n2) { const int cch = 32 * w + 16 * n2 + fr;
#pragma unroll
                    for (int ks = 0; ks < 5; ++ks) { Ba[n2][ks] = *(const bf16x8*)(wa + cch * 160 + 32 * ks + 8 * fq); Bi[n2][ks] = *(const bf16x8*)(wi + cch * 160 + 32 * ks + 8 * fq); }
                    biasa[n2] = INP(F, I_LRU_BA)[d * DRNN + ch0 + cch]; biasi[n2] = INP(F, I_LRU_BI)[d * DRNN + ch0 + cch];
                    const float lam = INP(F, I_LRU_LAM)[d * DRNN + ch0 + cch]; sp[n2] = 8.0f * (lam > 0.f ? log1pf(expf(-lam)) : (-lam + log1pf(expf(lam)))); }
            }
            for (int seg = 0; seg < 2; ++seg) {
                const int L = seg ? SEQ : CTXL; const size_t rowbase = seg ? (size_t)b * SEQ : (size_t)RL + (size_t)b * CTXL;
                const bool do_out = seg == 1 || need_ctx;
                for (int ci = 0; ci < L / 64; ++ci) {
                    const int t0 = d ? L - 64 * (ci + 1) : 64 * ci;
                    for (int e = F.tid; e < 64 * 40; e += NTHR) { const int tt = e / 40, c4 = e % 40, t = t0 + tt, ch = ch0 + 4 * c4;
                        f32x4 acc = *(const f32x4*)(cb + ch);
#pragma unroll
                        for (int k = 0; k < 4; ++k) { const int tp = t - 2 + k; if (tp >= 0 && tp < L) { const u32x2 xr = *(const u32x2*)(XG + (rowbase + tp) * 2560 + ch); const f32x4 wv = *(const f32x4*)(cw + k * DRNN + ch);
                                acc[0] += lo_bf(xr.x) * wv[0]; acc[1] += hi_bf(xr.x) * wv[1]; acc[2] += lo_bf(xr.y) * wv[2]; acc[3] += hi_bf(xr.y) * wv[3]; } }
                        u32x2 o; o.x = pk2(acc[0], acc[1]); o.y = pk2(acc[2], acc[3]); *(LAS u32x2*)(xcA + tt * 168 + 4 * c4) = o; }
                    __syncthreads();
                    if (w < 5) {
#pragma unroll
                        for (int mt = 0; mt < 4; ++mt) {
                            f32x4 ra[2] = {{0.f, 0.f, 0.f, 0.f}, {0.f, 0.f, 0.f, 0.f}}, ri[2] = {{0.f, 0.f, 0.f, 0.f}, {0.f, 0.f, 0.f, 0.f}};
#pragma unroll
                            for (int ks = 0; ks < 5; ++ks) { const bf16x8 a = *(const LAS bf16x8*)(xcA + (16 * mt + fr) * 168 + 32 * ks + 8 * fq);
#pragma unroll
                                for (int n2 = 0; n2 < 2; ++n2) { ra[n2] = __builtin_amdgcn_mfma_f32_16x16x32_bf16(a, Ba[n2][ks], ra[n2], 0, 0, 0); ri[n2] = __builtin_amdgcn_mfma_f32_16x16x32_bf16(a, Bi[n2][ks], ri[n2], 0, 0, 0); } }
#pragma unroll
                            for (int n2 = 0; n2 < 2; ++n2)
#pragma unroll
                                for (int j = 0; j < 4; ++j) { const int tt = 16 * mt + 4 * fq + j, cch = 32 * w + 16 * n2 + fr; const float xcv = bf2f(xcA[tt * 168 + cch]);
                                    const float r = sigmoid_f(ra[n2][j] + biasa[n2]), ig = sigmoid_f(ri[n2][j] + biasi[n2]); const float la = -r * sp[n2];
                                    aL[tt * 160 + cch] = expf(la); bL[tt * 160 + cch] = sqrtf(-expm1f(2.0f * la)) * (ig * xcv); }
                        }
                    }
                    __syncthreads();
                    if (F.tid < LBW) { float h = carry;
                        for (int s = 0; s < 64; ++s) { const int tt = d ? 63 - s : s; h = aL[tt * 160 + F.tid] * h + bL[tt * 160 + F.tid]; bL[tt * 160 + F.tid] = h; }
                        carry = h; }
                    __syncthreads();
                    if (do_out) for (int e = F.tid; e < 64 * 80; e += NTHR) { const int tt = e / 80, c2 = e % 80; const size_t row = rowbase + t0 + tt; const float h0 = bL[tt * 160 + 2 * c2], h1 = bL[tt * 160 + 2 * c2 + 1];
                        unsigned* yp = (unsigned*)(Y + row * DRNN + ch0 + 2 * c2);
                        if (d == 0) *yp = pk2(h0, h1);
                        else { const unsigned pv = *yp; const unsigned gv = *(const unsigned*)(XG + row * 2560 + DRNN + ch0 + 2 * c2);
                            *yp = pk2((lo_bf(pv) + h0) * gelu_tanh_f(lo_bf(gv)), (hi_bf(pv) + h1) * gelu_tanh_f(hi_bf(gv))); } }
                }
            }
        }
        __syncthreads();
    }
}

__device__ __forceinline__ void phase_sgu_stats(const Frame& F) {
    const bf16_t* Z = WSP(const bf16_t, WS_BIG + BG_Z); float* st = WSP(float, WS_ROUTE + RT_ST);
    const int gw = F.bid * NWAVES + F.wave, NGW = F.G * NWAVES;
    for (int r = gw; r < RA; r += NGW) {
        const bf16_t* v = Z + (size_t)r * 4096 + DSGU; float x[32]; float s = 0.f;
#pragma unroll
        for (int j = 0; j < 4; ++j) { const u32x4 q = *(const u32x4*)(v + 8 * F.lane + 512 * j);
            x[8 * j + 0] = lo_bf(q.x); x[8 * j + 1] = hi_bf(q.x); x[8 * j + 2] = lo_bf(q.y); x[8 * j + 3] = hi_bf(q.y); x[8 * j + 4] = lo_bf(q.z); x[8 * j + 5] = hi_bf(q.z); x[8 * j + 6] = lo_bf(q.w); x[8 * j + 7] = hi_bf(q.w); }
#pragma unroll
        for (int i = 0; i < 32; ++i) s += x[i];
        const float mean = wave_sum(s) * (1.0f / DSGU); float q2 = 0.f;
#pragma unroll
        for (int i = 0; i < 32; ++i) { const float dlt = x[i] - mean; q2 += dlt * dlt; }
        const float rstd = 1.0f / sqrtf(wave_sum(q2) * (1.0f / DSGU) + NORM_EPS);
        if (F.lane == 0) { st[2 * r] = mean; st[2 * r + 1] = rstd; }
    }
}
__device__ __forceinline__ void phase_sgu_spatial(const Frame& F) {
    LAS bf16_t* vT = (LAS bf16_t*)F.lds;
    bf16_t* Z = WSP(bf16_t, WS_BIG + BG_Z); const float* st = WSP(const float, WS_ROUTE + RT_ST);
    const bf16_t* wsb = WSP(const bf16_t, WS_SGU_WS);
    const float* lng = INP(F, I_SGU_LNG); const float* lnb = INP(F, I_SGU_LNB); const float* bs = INP(F, I_SGU_BS);
    const int fr = F.lane & 15, fq = F.lane >> 4, w = F.wave;
    for (int unit = F.bid; unit < 576 * 8; unit += F.G) {
        const int cu = unit >> 3, g = unit & 7;
        const size_t row0 = cu < 512 ? (size_t)(cu >> 4) * SEQ + (size_t)(cu & 15) * 128 : (size_t)RL + (size_t)((cu - 512) >> 1) * CTXL + (size_t)((cu - 512) & 1) * 128;
        {
            const int q8 = F.tid & 15, d8 = F.tid >> 4; const int dcol = 256 * g + 8 * d8;
            float gg[8], bb[8];
#pragma unroll
            for (int j = 0; j < 8; ++j) { gg[j] = lng[dcol + j]; bb[j] = lnb[dcol + j]; }
            float x[8][8];
#pragma unroll
            for (int i = 0; i < 8; ++i) { const size_t r = row0 + 8 * q8 + i; const u32x4 q = *(const u32x4*)(Z + r * 4096 + DSGU + dcol); const float mean = st[2 * r], rstd = st[2 * r + 1];
                const float raw[8] = {lo_bf(q.x), hi_bf(q.x), lo_bf(q.y), hi_bf(q.y), lo_bf(q.z), hi_bf(q.z), lo_bf(q.w), hi_bf(q.w)};
#pragma unroll
                for (int j = 0; j < 8; ++j) x[i][j] = (raw[j] - mean) * rstd * gg[j] + bb[j]; }
#pragma unroll
            for (int j = 0; j < 8; ++j) { u32x4 o; o.x = pk2(x[0][j], x[1][j]); o.y = pk2(x[2][j], x[3][j]); o.z = pk2(x[4][j], x[5][j]); o.w = pk2(x[6][j], x[7][j]);
                *(LAS u32x4*)(vT + (8 * d8 + j) * 136 + 8 * q8) = o; }
        }
        __syncthreads();
        {
            bf16x8 af[4];
#pragma unroll
            for (int ks = 0; ks < 4; ++ks) af[ks] = *(const bf16x8*)(wsb + ((size_t)g * 128 + 16 * w + fr) * 128 + 32 * ks + 8 * fq);
            const int p = 16 * w + fr; const float bias = bs[g * 128 + p];
#pragma unroll 4
            for (int nt = 0; nt < 16; ++nt) { f32x4 acc = {0.f, 0.f, 0.f, 0.f};
#pragma unroll
                for (int ks = 0; ks < 4; ++ks) { const bf16x8 bfv = *(const LAS bf16x8*)(vT + (16 * nt + fr) * 136 + 32 * ks + 8 * fq); acc = __builtin_amdgcn_mfma_f32_16x16x32_bf16(bfv, af[ks], acc, 0, 0, 0); }
                u32x2* zp = (u32x2*)(Z + (row0 + p) * 4096 + 256 * g + 16 * nt + 4 * fq); const u32x2 uu = *zp;
                u32x2 o; o.x = pk2(lo_bf(uu.x) * (acc[0] + bias), hi_bf(uu.x) * (acc[1] + bias)); o.y = pk2(lo_bf(uu.y) * (acc[2] + bias), hi_bf(uu.y) * (acc[3] + bias)); *zp = o; }
        }
        __syncthreads();
    }
}

__device__ __forceinline__ void phase_pool_diff(const Frame& F) {
    bf16_t* PD = WSP(bf16_t, WS_BIG + BG_PD);
    for (size_t i = (size_t)F.bid * NTHR + F.tid; i < (size_t)RA * 128; i += (size_t)F.G * NTHR) {
        const int r = (int)(i >> 7), cg = (int)(i & 127), wn = 2 << (cg >> 5);
        int t, L; size_t base; if (r < RL) { t = r & (SEQ - 1); L = SEQ; base = (size_t)(r - t); } else { t = (r - RL) & (CTXL - 1); L = CTXL; base = (size_t)(r - t); }
        const int lo = max(t - wn / 2, 0), hi = min(t + wn / 2 - 1, L - 1);
        float s[8] = {0.f, 0.f, 0.f, 0.f, 0.f, 0.f, 0.f, 0.f}, self[8];
        for (int q = lo; q <= hi; ++q) { const u32x4 v = *(const u32x4*)(F.U + (base + q) * D + 8 * cg);
            const float x[8] = {lo_bf(v.x), hi_bf(v.x), lo_bf(v.y), hi_bf(v.y), lo_bf(v.z), hi_bf(v.z), lo_bf(v.w), hi_bf(v.w)};
#pragma unroll
            for (int j = 0; j < 8; ++j) { s[j] += x[j]; if (q == t) self[j] = x[j]; } }
        const float inv = 1.0f / (float)(hi - lo + 1);
        u32x4 o; o.x = pk2(s[0] * inv - self[0], s[1] * inv - self[1]); o.y = pk2(s[2] * inv - self[2], s[3] * inv - self[3]); o.z = pk2(s[4] * inv - self[4], s[5] * inv - self[5]); o.w = pk2(s[6] * inv - self[6], s[7] * inv - self[7]);
        *(u32x4*)(PD + (size_t)r * D + 8 * cg) = o;
    }
}

__device__ __forceinline__ void phase_qknorm(const Frame& F) {
    bf16_t* QKV = WSP(bf16_t, WS_BIG + BG_QKV); const float* qg = INP(F, I_NA_QG); const float* kg = INP(F, I_NA_KG);
    const int sub = F.lane & 7;
    for (size_t i = ((size_t)F.bid * NTHR + F.tid) >> 3; i < (size_t)RA * 32; i += ((size_t)F.G * NTHR) >> 3) {
        const size_t r = i >> 5; const int hh = (int)(i & 31);
        bf16_t* p = QKV + r * 3072 + hh * 64 + 8 * sub; const u32x4 v = *(const u32x4*)p;
        float x[8] = {lo_bf(v.x), hi_bf(v.x), lo_bf(v.y), hi_bf(v.y), lo_bf(v.z), hi_bf(v.z), lo_bf(v.w), hi_bf(v.w)};
        float ss = 0.f;
#pragma unroll
        for (int j = 0; j < 8; ++j) ss += x[j] * x[j];
        ss += __shfl_xor(ss, 1); ss += __shfl_xor(ss, 2); ss += __shfl_xor(ss, 4);
        const float rstd = 1.0f / sqrtf(ss * (1.0f / 64.0f) + NORM_EPS); const float* g = (hh < 16 ? qg : kg) + 8 * sub; const float sc = hh < 16 ? 0.125f : 1.0f;
#pragma unroll
        for (int j = 0; j < 8; ++j) x[j] = x[j] * rstd * g[j] * sc;
        u32x4 o; o.x = pk2(x[0], x[1]); o.y = pk2(x[2], x[3]); o.z = pk2(x[4], x[5]); o.w = pk2(x[6], x[7]); *(u32x4*)p = o;
    }
}

__device__ __forceinline__ void phase_na(const Frame& F) {
    const bf16_t* QKV = WSP(const bf16_t, WS_BIG + BG_QKV); bf16_t* O = WSP(bf16_t, WS_BIG + BG_O); const float* rpb = INP(F, I_NA_RPB);
    const int hf = F.wave >> 2, qg = F.wave & 3, fr = F.lane & 15, fq = F.lane >> 4, ht = F.tid & 255;
    LAS bf16_t* Kt = (LAS bf16_t*)(F.lds + hf * 18432);
    LAS bf16_t* Vt = Kt + 64 * 72;
    for (int up = F.bid; up < NB * 32 * 8; up += F.G) {
        const int hp = up & 7, r = (up >> 3) & 31, b = up >> 8, h = 2 * hp + hf;
        const int r0 = min(max(r - 4, 0), 24);
        const size_t qrow = (size_t)b * SEQ + (size_t)r * 64 + 16 * qg + fr;
        bf16x8 qf[2];
#pragma unroll
        for (int ks = 0; ks < 2; ++ks) qf[ks] = *(const bf16x8*)(QKV + qrow * 3072 + h * 64 + 32 * ks + 8 * fq);
        f32x4 o[4] = {{0.f, 0.f, 0.f, 0.f}, {0.f, 0.f, 0.f, 0.f}, {0.f, 0.f, 0.f, 0.f}, {0.f, 0.f, 0.f, 0.f}}; float mrun = -1.0e30f, lrun = 0.f;
        const int cq = 16 * qg + fr, cstart = min(max(cq - 8, 0), 48);
        for (int tile = 0; tile < 12; ++tile) {
            const size_t krow0 = tile < 8 ? (size_t)b * SEQ + (size_t)(r0 + tile) * 64 : (size_t)RL + (size_t)b * CTXL + (size_t)(tile - 8) * 64;
            __syncthreads();
#pragma unroll
            for (int it = 0; it < 2; ++it) { const int e = ht + 256 * it, key = e >> 3, d8 = e & 7; const bf16_t* kp = QKV + (krow0 + key) * 3072 + D + h * 64 + 8 * d8;
                *(LAS u32x4*)(Kt + key * 72 + 8 * d8) = *(const u32x4*)kp; const u32x4 vv = *(const u32x4*)(kp + D);
                LAS bf16_t* vp = Vt + (8 * d8) * 72 + key;
                vp[0 * 72] = (bf16_t)(vv.x & 0xffffu); vp[1 * 72] = (bf16_t)(vv.x >> 16); vp[2 * 72] = (bf16_t)(vv.y & 0xffffu); vp[3 * 72] = (bf16_t)(vv.y >> 16);
                vp[4 * 72] = (bf16_t)(vv.z & 0xffffu); vp[5 * 72] = (bf16_t)(vv.z >> 16); vp[6 * 72] = (bf16_t)(vv.w & 0xffffu); vp[7 * 72] = (bf16_t)(vv.w >> 16); }
            __syncthreads();
            f32x4 st[4]; float tmax = -1.0e30f;
#pragma unroll
            for (int nt = 0; nt < 4; ++nt) { f32x4 a = {0.f, 0.f, 0.f, 0.f};
#pragma unroll
                for (int ks = 0; ks < 2; ++ks) { const bf16x8 kf = *(const LAS bf16x8*)(Kt + (16 * nt + fr) * 72 + 32 * ks + 8 * fq); a = __builtin_amdgcn_mfma_f32_16x16x32_bf16(kf, qf[ks], a, 0, 0, 0); }
                if (tile < 8) { const float* bp = rpb + ((size_t)h * 15 + (r0 + tile - r + 7)) * 31;
#pragma unroll
                    for (int j = 0; j < 4; ++j) { const int ck = 16 * nt + 4 * fq + j; const bool valid = ck >= cstart && ck < cstart + 16; const int dc = min(max(ck - cq, -15), 15) + 15;
                        a[j] = valid ? a[j] + bp[dc] : -1.0e30f; } }
                st[nt] = a; tmax = fmaxf(tmax, fmaxf(fmaxf(a[0], a[1]), fmaxf(a[2], a[3]))); }
            tmax = fmaxf(tmax, __shfl_xor(tmax, 16)); tmax = fmaxf(tmax, __shfl_xor(tmax, 32));
            const float mnew = fmaxf(mrun, tmax), alpha = __expf(mrun - mnew); float psum = 0.f;
#pragma unroll
            for (int nt = 0; nt < 4; ++nt)
#pragma unroll
                for (int j = 0; j < 4; ++j) { const float pv = __expf(st[nt][j] - mnew); st[nt][j] = pv; psum += pv; }
            psum += __shfl_xor(psum, 16); psum += __shfl_xor(psum, 32);
            lrun = lrun * alpha + psum; mrun = mnew;
#pragma unroll
            for (int dt = 0; dt < 4; ++dt) o[dt] = o[dt] * alpha;
#pragma unroll
            for (int s2 = 0; s2 < 2; ++s2) { u32x4 pw; pw.x = pk2(st[2 * s2][0], st[2 * s2][1]); pw.y = pk2(st[2 * s2][2], st[2 * s2][3]); pw.z = pk2(st[2 * s2 + 1][0], st[2 * s2 + 1][1]); pw.w = pk2(st[2 * s2 + 1][2], st[2 * s2 + 1][3]);
                const bf16x8 pb = __builtin_bit_cast(bf16x8, pw);
#pragma unroll
                for (int dt = 0; dt < 4; ++dt) { const LAS bf16_t* vr = Vt + (16 * dt + fr) * 72 + 32 * s2 + 4 * fq; const u32x2 v0 = *(const LAS u32x2*)vr, v1 = *(const LAS u32x2*)(vr + 16);
                    u32x4 vw; vw.x = v0.x; vw.y = v0.y; vw.z = v1.x; vw.w = v1.y;
                    o[dt] = __builtin_amdgcn_mfma_f32_16x16x32_bf16(__builtin_bit_cast(bf16x8, vw), pb, o[dt], 0, 0, 0); } }
        }
        const float inv = 1.0f / lrun;
#pragma unroll
        for (int dt = 0; dt < 4; ++dt) { u32x2 w2; w2.x = pk2(o[dt][0] * inv, o[dt][1] * inv); w2.y = pk2(o[dt][2] * inv, o[dt][3] * inv); *(u32x2*)(O + qrow * D + h * 64 + 16 * dt + 4 * fq) = w2; }
    }
    __syncthreads();
}

constexpr int NPH = 36;
__device__ __forceinline__ pg8::Sched mk_sched(const Frame& F, int nM, int nN, const bf16_t* A, int lda, const bf16_t* B, int K) {
    pg8::Sched S; S.nM = nM; S.nN = nN; S.G = F.G; S.c = F.bid; S.A = (const char*)A; S.a_tile = (size_t)256 * lda * 2; S.a_pn = 0;
    S.B = (const char*)B; S.b_tile = (size_t)256 * K * 2; S.b_e = 0; S.tstart = nullptr; return S;
}
__global__ void __launch_bounds__(NTHR, 2) fwd(Params P) {
    extern __shared__ __attribute__((aligned(16))) unsigned char lds_raw[];
    Frame F; F.lds = (LAS unsigned char*)lds_raw; F.tid = threadIdx.x; F.lane = F.tid & 63; F.wave = __builtin_amdgcn_readfirstlane(F.tid >> 6); F.bid = blockIdx.x; F.G = gridDim.x;
    F.p = &P; F.ws = P.ws; F.ctl = (unsigned*)(P.ws + WS_CTL); F.modv = (float*)(P.ws + WS_MODV); F.hctx = (float*)(P.ws + WS_HCTX); F.U = (bf16_t*)(P.ws + WS_U);
    if (F.tid < 64) ((LAS unsigned*)(F.lds + LDS_CTL))[F.tid] = 0u;
    __syncthreads();
    const int lo = P.ph_lo, hi = P.ph_hi;
    XcdBarrier bar; bar.bar = F.ctl + CW_BAR; bar.x = 0; bar.st = (volatile LAS unsigned*)(F.lds + LDS_CTL);
    if (hi - lo > 1) bar = xcd_barrier_post(F.ctl + CW_BAR, (volatile LAS unsigned*)(F.lds + LDS_CTL));
#define IN(k) (lo <= (k) && (k) < hi)
#define SEAM(k) do { if (IN(k) && IN((k) + 1)) xcd_barrier(bar); } while (0)
    float* const out = P.out; float* const hctx = F.hctx;
    const float* const x = INP(F, I_X); const float* const ctx = INP(F, I_CTX);
    LAS unsigned char* const gl = F.lds;
    LAS int* const tstart = (LAS int*)(F.lds + LDS_AUX);
    bf16_t* const BIG = (bf16_t*)(P.ws + WS_BIG);
#define MODL(l) (F.modv + (size_t)(l) * 33 * MODW)

    if (IN(0)) { phase_cvt_small(F); phase_mod(F); } SEAM(0);
    if (IN(1)) { NormCtx N{x, ctx, INP(F, I_N1G), MODL(0), 0}; phase_norm(F, N, RA); } SEAM(1);
    if (IN(2)) { pg8::Sched S = mk_sched(F, RA / 256, 10, F.U, D, WSP(bf16_t, WS_LRU_WIN), D); pg8::EpiBf16<0> E{(bf16_t*)(P.ws + WS_BIG + BG_XG), 2560, nullptr}; pg8::gemm_phase(gl, D, D, S, E); } SEAM(2);
    if (IN(3)) { phase_scan(F, true); } SEAM(3);
    if (IN(4)) { pg8::Sched S = mk_sched(F, RA / 256, 4, (bf16_t*)(P.ws + WS_BIG + BG_Y), DRNN, WSP(bf16_t, WS_LRU_WOUT), DRNN);
                 pg8::EpiResid E{x, ctx, out, hctx, MODL(0) + 2 * D, nullptr, nullptr}; pg8::gemm_phase(gl, DRNN, DRNN, S, E); } SEAM(4);
    if (IN(5)) { NormCtx N{out, hctx, INP(F, I_N2G), MODL(0), 1}; phase_norm(F, N, RA); } SEAM(5);
    if (IN(6)) { pg8::Sched S = mk_sched(F, RA / 256, 28, F.U, D, WSP(bf16_t, WS_FFN_W13), D); pg8::EpiSwiGLU E{(bf16_t*)(P.ws + WS_BIG + BG_HID), DFF}; pg8::gemm_phase(gl, D, D, S, E); } SEAM(6);
    if (IN(7)) { pg8::Sched S = mk_sched(F, RA / 256, 4, (bf16_t*)(P.ws + WS_BIG + BG_HID), DFF, WSP(bf16_t, WS_FFN_W2), DFF);
                 pg8::EpiResid E{out, hctx, out, hctx, MODL(0) + 5 * D, nullptr, nullptr}; pg8::gemm_phase(gl, DFF, DFF, S, E); } SEAM(7);
    if (IN(8)) { NormCtx N{out, hctx, INP(F, I_N1G) + D, MODL(1), 0}; phase_norm(F, N, RA); phase_cvt_moe(F, 0); } SEAM(8);
    if (IN(9)) { pg8::Sched S = mk_sched(F, RA / 256, 16, F.U, D, WSP(bf16_t, WS_SGU_WIN), D); pg8::EpiBf16<1> E{(bf16_t*)(P.ws + WS_BIG + BG_Z), 4096, INP(F, I_SGU_BIN)}; pg8::gemm_phase(gl, D, D, S, E); } SEAM(9);
    if (IN(10)) { phase_sgu_stats(F); } SEAM(10);
    if (IN(11)) { phase_sgu_spatial(F); } SEAM(11);
    if (IN(12)) { pg8::Sched S = mk_sched(F, RA / 256, 4, (bf16_t*)(P.ws + WS_BIG + BG_Z), 4096, WSP(bf16_t, WS_SGU_WOUT), DSGU);
                  pg8::EpiResid E{out, hctx, out, hctx, MODL(1) + 2 * D, nullptr, nullptr}; pg8::gemm_phase(gl, 4096, DSGU, S, E); } SEAM(12);
    if (IN(13)) { NormCtx N{out, hctx, INP(F, I_N2G) + D, MODL(1), 1}; phase_route(F, N, RA, 0); } SEAM(13);
    if (IN(14)) { NormCtx N{out, hctx, INP(F, I_N2G) + D, MODL(1), 1}; phase_scatter(F, N, RA, 0); } SEAM(14);
#define MOE_UP(ph, l2, s) if (IN(ph)) { const int nt_ = moe_tile_table(F, l2, s, tstart); \
        pg8::Sched S = mk_sched(F, nt_, 28, (s) ? (bf16_t*)(P.ws + WS_BIG + BG_FS1) : F.U, D, WSP(bf16_t, WS_MOE_W13), D); S.b_e = (size_t)2 * DFF * D * 2; S.tstart = tstart; \
        pg8::EpiSwiGLU E{(bf16_t*)(P.ws + WS_BIG + BG_MHID), DFF}; pg8::gemm_phase(gl, D, D, S, E); } SEAM(ph)
#define MOE_DOWN(ph, l2, s, layer) if (IN(ph)) { const int nt_ = moe_tile_table(F, l2, s, tstart); \
        pg8::Sched S = mk_sched(F, nt_, 4, (bf16_t*)(P.ws + WS_BIG + BG_MHID), DFF, WSP(bf16_t, WS_MOE_W2), DFF); S.b_e = (size_t)D * DFF * 2; S.tstart = tstart; \
        pg8::EpiMoeDown E{out, hctx, MODL(layer) + 5 * D, WSP(const int, WS_ROUTE + RT_TOK) + (s) * MPAD, WSP(const float, WS_ROUTE + RT_GW) + (s) * MPAD}; pg8::gemm_phase(gl, DFF, DFF, S, E); } SEAM(ph)
    MOE_UP(15, 0, 0); MOE_DOWN(16, 0, 0, 1); MOE_UP(17, 0, 1); MOE_DOWN(18, 0, 1, 1);
    if (IN(19)) { NormCtx N{out, hctx, INP(F, I_N1G) + 2 * D, MODL(2), 0}; phase_norm(F, N, RA); phase_cvt_moe(F, 1); } SEAM(19);
    if (IN(20)) { phase_pool_diff(F); } SEAM(20);
    if (IN(21)) { pg8::Sched S = mk_sched(F, RA / 256, 4, (bf16_t*)(P.ws + WS_BIG + BG_PD), D, WSP(bf16_t, WS_POOL_W), 256); S.a_pn = 512; S.b_tile = (size_t)256 * 256 * 2;
                  pg8::EpiResid E{out, hctx, out, hctx, MODL(2) + 2 * D, INP(F, I_POOL_B), INP(F, I_POOL_S)}; pg8::gemm_phase(gl, D, 256, S, E); } SEAM(21);
    if (IN(22)) { NormCtx N{out, hctx, INP(F, I_N2G) + 2 * D, MODL(2), 1}; phase_norm(F, N, RA); } SEAM(22);
    if (IN(23)) { pg8::Sched S = mk_sched(F, RA / 256, 28, F.U, D, WSP(bf16_t, WS_FFN_W13) + (size_t)2 * DFF * D, D); pg8::EpiSwiGLU E{(bf16_t*)(P.ws + WS_BIG + BG_HID), DFF}; pg8::gemm_phase(gl, D, D, S, E); } SEAM(23);
    if (IN(24)) { pg8::Sched S = mk_sched(F, RA / 256, 4, (bf16_t*)(P.ws + WS_BIG + BG_HID), DFF, WSP(bf16_t, WS_FFN_W2) + (size_t)D * DFF, DFF);
                  pg8::EpiResid E{out, hctx, out, hctx, MODL(2) + 5 * D, nullptr, nullptr}; pg8::gemm_phase(gl, DFF, DFF, S, E); } SEAM(24);
    if (IN(25)) { NormCtx N{out, hctx, INP(F, I_N1G) + 3 * D, MODL(3), 0}; phase_norm(F, N, RA); } SEAM(25);
    if (IN(26)) { pg8::Sched S = mk_sched(F, RA / 256, 12, F.U, D, WSP(bf16_t, WS_NA_WQKV), D); pg8::EpiBf16<0> E{(bf16_t*)(P.ws + WS_BIG + BG_QKV), 3072, nullptr}; pg8::gemm_phase(gl, D, D, S, E); } SEAM(26);
    if (IN(27)) { phase_qknorm(F); } SEAM(27);
    if (IN(28)) { phase_na(F); } SEAM(28);
    if (IN(29)) { pg8::Sched S = mk_sched(F, RL / 256, 4, (bf16_t*)(P.ws + WS_BIG + BG_O), D, WSP(bf16_t, WS_NA_WO), D);
                  pg8::EpiResid E{out, hctx, out, hctx, MODL(3) + 2 * D, nullptr, nullptr}; pg8::gemm_phase(gl, D, D, S, E); } SEAM(29);
    if (IN(30)) { NormCtx N{out, hctx, INP(F, I_N2G) + 3 * D, MODL(3), 1}; phase_route(F, N, RL, 1); } SEAM(30);
    if (IN(31)) { NormCtx N{out, hctx, INP(F, I_N2G) + 3 * D, MODL(3), 1}; phase_scatter(F, N, RL, 1); } SEAM(31);
    MOE_UP(32, 1, 0); MOE_DOWN(33, 1, 0, 3); MOE_UP(34, 1, 1); MOE_DOWN(35, 1, 1, 3);
#undef IN
#undef SEAM
    (void)BIG;
}

#if MK_DEBUG
constexpr int NSAMP = 1024;
struct DbgBuf { unsigned long long addr[NSAMP]; float val[NSAMP]; int kind[NSAMP]; };
__device__ inline float bfr(float x) { return bf2f(pk2(x, 0.f) & 0xffffu); }
__device__ inline unsigned hsh(unsigned a) { a ^= a >> 16; a *= 0x7feb352du; a ^= a >> 15; a *= 0x846ca68bu; a ^= a >> 16; return a; }
__device__ inline int srow(int i, int nrows) { const int k = (i >> 1) & 15;
    const int f = k == 0 ? 0 : k == 1 ? 1 : k == 2 ? 63 : k == 3 ? 64 : k == 4 ? 255 : k == 5 ? 256 : k == 6 ? 2047 : k == 7 ? 2048 : k == 8 ? 4095 : k == 9 ? 30000 : k == 10 ? 65535 : k == 11 ? 65536 : k == 12 ? 65537 : k == 13 ? 65791 : k == 14 ? 65792 : 73727;
    int r = (i & 1) ? (int)(hsh(i * 7919u + 13u) % (unsigned)nrows) : f; return r < nrows ? r : r % nrows; }
__device__ inline double ddot(const bf16_t* a, const float* w, int ldw, int K) { double s = 0; for (int k = 0; k < K; ++k) s += (double)bf2f(a[k]) * (double)bfr(w[(size_t)k * ldw]); return s; }
__device__ inline const float* hrow(const Params& P, const float* lat, const float* ctxp, int r) { return r < RL ? lat + (size_t)r * D : ctxp + (size_t)(r - RL) * D; }
__device__ inline double dnorm_elem(const Params& P, const float* src, const float* gain, const float* mod, int which, int r, int c) {
    double ss = 0; for (int k = 0; k < D; ++k) ss += (double)src[k] * src[k]; const double rstd = 1.0 / sqrt(ss / D + 1e-6); const int mb = r < RL ? r >> 11 : 32;
    const float* sh = mod + (size_t)mb * MODW + which * 3 * D; return (double)src[c] * rstd * gain[c] * (1.0 + sh[D + c]) + sh[c]; }
__device__ inline double dsilu(double x) { return x / (1.0 + exp(-x)); }
__device__ inline double dgelu(double x) { return 0.5 * x * (1.0 + tanh(0.7978845608028654 * (x + 0.044715 * x * x * x))); }
__device__ inline int moe_expert_of_pos(const unsigned* cnt, int pos) { int off = 0; for (int e = 0; e < NE; ++e) { const int pe = ((int)cnt[e] + 255) & ~255; if (pos < off + pe) return e; off += pe; } return -1; }

__global__ void chk_expect(Params P, int ph) {
    DbgBuf* B = (DbgBuf*)(P.ws + WS_DBG); const int i = blockIdx.x * blockDim.x + threadIdx.x; if (i >= NSAMP) return;
    unsigned char* ws = P.ws; float* modv = (float*)(ws + WS_MODV); float* hctx = (float*)(ws + WS_HCTX); bf16_t* U = (bf16_t*)(ws + WS_U); const unsigned* ctl = (const unsigned*)(ws + WS_CTL);
    unsigned long long addr = 0; float val = 0.f; int kind = 0;
    const unsigned hh = hsh(i * 2654435761u + ph * 97u);
#define SETBF(p, v) do { addr = (unsigned long long)(p); val = (float)(v); kind = 1; } while (0)
#define SETF(p, v) do { addr = (unsigned long long)(p); val = (float)(v); kind = 2; } while (0)
    const int layer = ph < 8 ? 0 : ph < 19 ? 1 : ph < 25 ? 2 : 3;
    const float* modl = modv + (size_t)layer * 33 * MODW;
    if (ph == 0) {
        if (i < 256) { const int l = i & 3, b = (i >> 2) % 33, j = hh % MODW; double s = 0; for (int k = 0; k < D; ++k) { const double cv = b < 32 ? P.in[I_C][b * D + k] : P.in[I_CCTX][k]; s += dsilu(cv) * P.in[I_MODW][((size_t)l * D + k) * MODW + j]; }
            SETF(modv + ((size_t)l * 33 + b) * MODW + j, s + P.in[I_MODB][l * MODW + j]); }
        else { const int m = i % 12; const unsigned h2 = hsh(hh);
            if (m == 0) { const int n = hh % 2560, k = h2 % 1024; SETBF((bf16_t*)(ws + WS_LRU_WIN) + (size_t)n * 1024 + k, bfr(P.in[I_LRU_WIN][(size_t)k * 2560 + n])); }
            if (m == 1) { const int mat = hh % 16, n = h2 % 160, k = (h2 >> 8) % 160; SETBF((bf16_t*)(ws + WS_LRU_WA) + (size_t)mat * 25600 + n * 160 + k, bfr(P.in[I_LRU_WA][(size_t)mat * 25600 + k * 160 + n])); }
            if (m == 2) { const int mat = hh % 16, n = h2 % 160, k = (h2 >> 8) % 160; SETBF((bf16_t*)(ws + WS_LRU_WI) + (size_t)mat * 25600 + n * 160 + k, bfr(P.in[I_LRU_WI][(size_t)mat * 25600 + k * 160 + n])); }
            if (m == 3) { const int n = hh % 1024, k = h2 % 1280; SETBF((bf16_t*)(ws + WS_LRU_WOUT) + (size_t)n * 1280 + k, bfr(P.in[I_LRU_WOUT][(size_t)k * 1024 + n])); }
            if (m == 4) { const int n = hh % 4096, k = h2 % 1024; SETBF((bf16_t*)(ws + WS_SGU_WIN) + (size_t)n * 1024 + k, bfr(P.in[I_SGU_WIN][(size_t)k * 4096 + n])); }
            if (m == 5) { const int e = hh % (8 * 128 * 128); SETBF((bf16_t*)(ws + WS_SGU_WS) + e, bfr(P.in[I_SGU_WS][e])); }
            if (m == 6) { const int n = hh % 1024, k = h2 % 2048; SETBF((bf16_t*)(ws + WS_SGU_WOUT) + (size_t)n * 2048 + k, bfr(P.in[I_SGU_WOUT][(size_t)k * 1024 + n])); }
            if (m == 7) { const int g = hh % 4, n = h2 % 256, k = (h2 >> 8) % 256; SETBF((bf16_t*)(ws + WS_POOL_W) + (size_t)g * 65536 + n * 256 + k, bfr(P.in[I_POOL_W][(size_t)g * 65536 + k * 256 + n])); }
            if (m == 8) { const int n = hh % 3072, k = h2 % 1024; SETBF((bf16_t*)(ws + WS_NA_WQKV) + (size_t)n * 1024 + k, bfr(P.in[I_NA_WQKV][(size_t)k * 3072 + n])); }
            if (m == 9) { const int n = hh % 1024, k = h2 % 1024; SETBF((bf16_t*)(ws + WS_NA_WO) + (size_t)n * 1024 + k, bfr(P.in[I_NA_WO][(size_t)k * 1024 + n])); }
            if (m == 10) { const int l = hh & 1, which = (hh >> 1) & 1, n = (hh >> 2) % DFF, k = h2 % 1024; const float* src = P.in[which ? I_FFN_W3 : I_FFN_W1] + (size_t)l * D * DFF;
                SETBF((bf16_t*)(ws + WS_FFN_W13) + (size_t)l * 2 * DFF * D + (size_t)(256 * (n >> 7) + (n & 127) + which * 128) * 1024 + k, bfr(src[(size_t)k * DFF + n])); }
            if (m == 11) { const int l = hh & 1, n = (hh >> 1) % 1024, k = h2 % DFF; SETBF((bf16_t*)(ws + WS_FFN_W2) + (size_t)l * D * DFF + (size_t)n * DFF + k, bfr(P.in[I_FFN_W2][(size_t)l * D * DFF + (size_t)k * 1024 + n])); } }
    }
    if (ph == 1 || ph == 5 || ph == 8 || ph == 19 || ph == 22 || ph == 25) { const int which = (ph == 5 || ph == 22) ? 1 : 0; const int r = srow(i, RA), c = hh % D;
        const float* src = ph == 1 ? hrow(P, P.in[I_X], P.in[I_CTX], r) : hrow(P, P.out, hctx, r);
        SETBF(U + (size_t)r * D + c, dnorm_elem(P, src, P.in[which ? I_N2G : I_N1G] + layer * D, modl, which, r, c)); }
    if (ph == 8 || ph == 19) { if (i >= 512) { const int l2 = ph == 8 ? 0 : 1; const unsigned h2 = hsh(hh); const int e = hh & 7, which = (hh >> 3) % 3;
            if (which < 2) { const int n = (hh >> 5) % DFF, k = h2 % 1024; const float* src = P.in[which ? I_MOE_W3 : I_MOE_W1] + ((size_t)l2 * NE + e) * D * DFF;
                SETBF((bf16_t*)(ws + WS_MOE_W13) + (size_t)e * 2 * DFF * D + (size_t)(256 * (n >> 7) + (n & 127) + which * 128) * 1024 + k, bfr(src[(size_t)k * DFF + n])); }
            else { const int n = (hh >> 5) % 1024, k = h2 % DFF; SETBF((bf16_t*)(ws + WS_MOE_W2) + (size_t)e * D * DFF + (size_t)n * DFF + k, bfr(P.in[I_MOE_W2][((size_t)l2 * NE + e) * D * DFF + (size_t)k * 1024 + n])); } } }
    if (ph == 2) { const int r = srow(i, RA), c = hh % 2560; SETBF((bf16_t*)(ws + WS_BIG + BG_XG) + (size_t)r * 2560 + c, ddot(U + (size_t)r * D, P.in[I_LRU_WIN] + c, 2560, D)); }
    if (ph == 3 && i < 64) {
        const int b = hh % NB, ch = (hh >> 8) % DRNN, kb = ch / LBW; const bf16_t* XG = (const bf16_t*)(ws + WS_BIG + BG_XG);
        double hs0 = 0, hs1 = 0, hs2 = 0, hs3 = 0;
        for (int d = 0; d < 2; ++d) { double h = 0; const double lam = P.in[I_LRU_LAM][d * DRNN + ch]; const double sp = 8.0 * log1p(exp(-lam));
            for (int seg = 0; seg < 2; ++seg) { const int L = seg ? SEQ : CTXL; const size_t rowbase = seg ? (size_t)b * SEQ : (size_t)RL + (size_t)b * CTXL;
                for (int s = 0; s < L; ++s) { const int t = d ? L - 1 - s : s; double da = P.in[I_LRU_BA][d * DRNN + ch], di = P.in[I_LRU_BI][d * DRNN + ch]; double xself = 0;
                    for (int c2 = 0; c2 < LBW; ++c2) { const int cc = kb * LBW + c2; float acc = P.in[I_LRU_CB][cc];
                        for (int k = 0; k < 4; ++k) { const int tp = t - 2 + k; if (tp >= 0 && tp < L) acc += bf2f(XG[(rowbase + tp) * 2560 + cc]) * P.in[I_LRU_CW][k * DRNN + cc]; }
                        const double xc = bfr(acc); if (cc == ch) xself = xc;
                        da += xc * bfr(P.in[I_LRU_WA][((size_t)(d * 8 + kb) * LBW + c2) * LBW + (ch - kb * LBW)]); di += xc * bfr(P.in[I_LRU_WI][((size_t)(d * 8 + kb) * LBW + c2) * LBW + (ch - kb * LBW)]); }
                    const double r = 1.0 / (1.0 + exp(-da)), ig = 1.0 / (1.0 + exp(-di)), la = -r * sp, a = exp(la), mult = sqrt(-expm1(2.0 * la));
                    h = a * h + mult * ig * xself;
                    if (seg == 1 && t == 0) hs0 += h; if (seg == 1 && t == 777) hs1 += h; if (seg == 1 && t == 2047) hs2 += h; if (seg == 0 && t == 128) hs3 += h; } } }
#define SCAN_SLOT(q, row_, hv) do { const size_t row = (row_); const double g = bf2f(XG[row * 2560 + DRNN + ch]); const int slot = 256 + i * 4 + (q); \
            B->addr[slot] = (unsigned long long)((bf16_t*)(ws + WS_BIG + BG_Y) + row * DRNN + ch); B->val[slot] = (float)((hv) * dgelu(g)); B->kind[slot] = 1; } while (0)
        SCAN_SLOT(0, (size_t)b * SEQ + 0, hs0); SCAN_SLOT(1, (size_t)b * SEQ + 777, hs1); SCAN_SLOT(2, (size_t)b * SEQ + 2047, hs2); SCAN_SLOT(3, (size_t)RL + (size_t)b * CTXL + 128, hs3);
#undef SCAN_SLOT
    }
    if (ph == 3 && i >= 256 && i < 512) return;
    if (ph == 4) { const int r = srow(i, RA), c = hh % D, mb = r < RL ? r >> 11 : 32; const double dt = ddot((bf16_t*)(ws + WS_BIG + BG_Y) + (size_t)r * DRNN, P.in[I_LRU_WOUT] + c, D, DRNN);
        SETF((r < RL ? P.out + (size_t)r * D : hctx + (size_t)(r - RL) * D) + c, hrow(P, P.in[I_X], P.in[I_CTX], r)[c] + modl[(size_t)mb * MODW + 2 * D + c] * dt); }
    if (ph == 6 || ph == 23) { const int l = ph == 6 ? 0 : 1; const int r = srow(i, RA), c = hh % DFF; const bf16_t* a = U + (size_t)r * D;
        const double v1 = ddot(a, P.in[I_FFN_W1] + (size_t)l * D * DFF + c, DFF, D), v3 = ddot(a, P.in[I_FFN_W3] + (size_t)l * D * DFF + c, DFF, D);
        SETBF((bf16_t*)(ws + WS_BIG + BG_HID) + (size_t)r * DFF + c, dsilu(v1) * v3); }
    if (ph == 7 || ph == 24) { const int l = ph == 7 ? 0 : 1; const int r = srow(i, RA), c = hh % D, mb = r < RL ? r >> 11 : 32;
        const double dt = ddot((bf16_t*)(ws + WS_BIG + BG_HID) + (size_t)r * DFF, P.in[I_FFN_W2] + (size_t)l * D * DFF + c, D, DFF); float* hp = (r < RL ? P.out + (size_t)r * D : hctx + (size_t)(r - RL) * D) + c;
        SETF(hp, *hp + modl[(size_t)mb * MODW + 5 * D + c] * dt); }
    if (ph == 9) { const int r = srow(i, RA), c = hh % 4096; SETBF((bf16_t*)(ws + WS_BIG + BG_Z) + (size_t)r * 4096 + c, dgelu(ddot(U + (size_t)r * D, P.in[I_SGU_WIN] + c, 4096, D) + P.in[I_SGU_BIN][c])); }
    if (ph == 10) { const int r = srow(i >> 1, RA); const bf16_t* v = (const bf16_t*)(ws + WS_BIG + BG_Z) + (size_t)r * 4096 + DSGU; double s = 0, q = 0; for (int k = 0; k < DSGU; ++k) s += bf2f(v[k]); s /= DSGU;
        for (int k = 0; k < DSGU; ++k) { const double dl = bf2f(v[k]) - s; q += dl * dl; } float* st = (float*)(ws + WS_ROUTE + RT_ST);
        if (i & 1) SETF(st + 2 * r + 1, 1.0 / sqrt(q / DSGU + 1e-6)); else SETF(st + 2 * r, s); }
    if (ph == 11) { const int r = srow(i, RA), c = hh % DSGU, g = c >> 8; const bf16_t* Z = (const bf16_t*)(ws + WS_BIG + BG_Z); const float* st = (const float*)(ws + WS_ROUTE + RT_ST);
        int p; size_t row0; if (r < RL) { p = r & 127; row0 = (size_t)r - p; } else { p = (r - RL) & 127; row0 = (size_t)r - p; }
        double s = 0; for (int q = 0; q < 128; ++q) { const size_t rr = row0 + q; const double vn = bfr((float)((bf2f(Z[rr * 4096 + DSGU + c]) - st[2 * rr]) * st[2 * rr + 1] * P.in[I_SGU_LNG][c] + P.in[I_SGU_LNB][c]));
            s += (double)bfr(P.in[I_SGU_WS][((size_t)g * 128 + p) * 128 + q]) * vn; }
        SETBF((bf16_t*)(ws + WS_BIG + BG_Z) + (size_t)r * 4096 + c, bf2f(Z[(size_t)r * 4096 + c]) * (s + P.in[I_SGU_BS][g * 128 + p])); }
    if (ph == 12) { const int r = srow(i, RA), c = hh % D, mb = r < RL ? r >> 11 : 32; const double dt = ddot((bf16_t*)(ws + WS_BIG + BG_Z) + (size_t)r * 4096, P.in[I_SGU_WOUT] + c, D, DSGU);
        float* hp = (r < RL ? P.out + (size_t)r * D : hctx + (size_t)(r - RL) * D) + c; SETF(hp, *hp + modl[(size_t)mb * MODW + 2 * D + c] * dt); }
    if (ph == 13 || ph == 30) { const int l2 = ph == 13 ? 0 : 1, nrows = ph == 13 ? RA : RL; const int r = srow(i, nrows); const float* src = hrow(P, P.out, hctx, r);
        double ss = 0; for (int k = 0; k < D; ++k) ss += (double)src[k] * src[k]; const double rstd = 1.0 / sqrt(ss / D + 1e-6); const int mb = r < RL ? r >> 11 : 32; const float* sh = modl + (size_t)mb * MODW + 3 * D;
        double l0 = 0, l1 = 0, l2v = 0, l3 = 0, l4 = 0, l5 = 0, l6 = 0, l7 = 0;
        for (int k = 0; k < D; ++k) { const double f = (double)src[k] * rstd * P.in[I_N2G][layer * D + k] * (1.0 + sh[D + k]) + sh[k]; const float* wr = P.in[I_MOE_WR] + ((size_t)l2 * D + k) * NE;
            l0 += f * wr[0]; l1 += f * wr[1]; l2v += f * wr[2]; l3 += f * wr[3]; l4 += f * wr[4]; l5 += f * wr[5]; l6 += f * wr[6]; l7 += f * wr[7]; }
        const float* brp = P.in[I_MOE_BR] + l2 * NE; l0 += brp[0]; l1 += brp[1]; l2v += brp[2]; l3 += brp[3]; l4 += brp[4]; l5 += brp[5]; l6 += brp[6]; l7 += brp[7];
        int e0 = 0; double v0 = l0;
#define UPD0(e, v) if ((v) > v0) { v0 = (v); e0 = (e); }
        UPD0(1, l1) UPD0(2, l2v) UPD0(3, l3) UPD0(4, l4) UPD0(5, l5) UPD0(6, l6) UPD0(7, l7)
        int e1 = -1; double v1 = -1e300;
#define UPD1(e, v) if ((e) != e0 && (v) > v1) { v1 = (v); e1 = (e); }
        UPD1(0, l0) UPD1(1, l1) UPD1(2, l2v) UPD1(3, l3) UPD1(4, l4) UPD1(5, l5) UPD1(6, l6) UPD1(7, l7)
        double third = -1e300;
#define UPD2(e, v) if ((e) != e0 && (e) != e1 && (v) > third) third = (v);
        UPD2(0, l0) UPD2(1, l1) UPD2(2, l2v) UPD2(3, l3) UPD2(4, l4) UPD2(5, l5) UPD2(6, l6) UPD2(7, l7)
#undef UPD0
#undef UPD1
#undef UPD2
        if (v0 - v1 > 1e-3 && v1 - third > 1e-3) { if (i & 1) { addr = (unsigned long long)((int*)(ws + WS_ROUTE + RT_E) + r); val = __int_as_float(e0 | (e1 << 8)); kind = 3; }
            else SETF((float*)(ws + WS_ROUTE + RT_W) + 2 * r, 1.0 / (1.0 + exp(v1 - v0))); } }
    if (ph == 15 || ph == 17 || ph == 32 || ph == 34 || ph == 16 || ph == 18 || ph == 33 || ph == 35) {
        const int l2 = ph < 20 ? 0 : 1, s = (ph == 17 || ph == 18 || ph == 34 || ph == 35) ? 1 : 0; const bool up = (ph == 15 || ph == 17 || ph == 32 || ph == 34);
        const unsigned* cnt = ctl + CW_CNT + 64 * l2 + 8 * s; int total = 0; for (int e = 0; e < NE; ++e) total += ((int)cnt[e] + 255) & ~255;
        const int pos = (i < 64) ? ((i & 1) ? (i >> 1) * 256 % total : min(total - 1, (i >> 1) * 256 + 255)) : (int)(hh % (unsigned)total);
        const int t = ((const int*)(ws + WS_ROUTE + RT_TOK))[s * MPAD + pos]; const int e = moe_expert_of_pos(cnt, pos);
        if (t >= 0 && e >= 0) { const bf16_t* fs = (s ? (const bf16_t*)(ws + WS_BIG + BG_FS1) : U) + (size_t)pos * D; bf16_t* hid = (bf16_t*)(ws + WS_BIG + BG_MHID) + (size_t)pos * DFF; const size_t wo = ((size_t)l2 * NE + e) * D * DFF;
            if (up) { const int c = hsh(hh) % DFF; SETBF(hid + c, dsilu(ddot(fs, P.in[I_MOE_W1] + wo + c, DFF, D)) * ddot(fs, P.in[I_MOE_W3] + wo + c, DFF, D)); }
            else { const int c = hsh(hh) % D, mb = t < RL ? t >> 11 : 32; float* hp = (t < RL ? P.out + (size_t)t * D : hctx + (size_t)(t - RL) * D) + c;
                SETF(hp, *hp + modl[(size_t)mb * MODW + 5 * D + c] * ((const float*)(ws + WS_ROUTE + RT_GW))[s * MPAD + pos] * ddot(hid, P.in[I_MOE_W2] + wo + c, D, DFF)); } } }
    if (ph == 20) { const int r = srow(i, RA), c = hh % D, wn = 2 << (c >> 8); int t, L; size_t base; if (r < RL) { t = r & (SEQ - 1); L = SEQ; base = r - t; } else { t = (r - RL) & (CTXL - 1); L = CTXL; base = r - t; }
        const int lo = max(t - wn / 2, 0), hi = min(t + wn / 2 - 1, L - 1); double s = 0; for (int q = lo; q <= hi; ++q) s += bf2f(U[(base + q) * D + c]);
        SETBF((bf16_t*)(ws + WS_BIG + BG_PD) + (size_t)r * D + c, s / (hi - lo + 1) - bf2f(U[(size_t)r * D + c])); }
    if (ph == 21) { const int r = srow(i, RA), c = hh % D, g = c >> 8, mb = r < RL ? r >> 11 : 32; const double dt = ddot((bf16_t*)(ws + WS_BIG + BG_PD) + (size_t)r * D + g * 256, P.in[I_POOL_W] + (size_t)g * 65536 + (c & 255), 256, 256);
        float* hp = (r < RL ? P.out + (size_t)r * D : hctx + (size_t)(r - RL) * D) + c; SETF(hp, *hp + modl[(size_t)mb * MODW + 2 * D + c] * ((dt + P.in[I_POOL_B][c]) * P.in[I_POOL_S][c])); }
    if (ph == 26) { const int r = srow(i, RA), c = hh % 3072; SETBF((bf16_t*)(ws + WS_BIG + BG_QKV) + (size_t)r * 3072 + c, ddot(U + (size_t)r * D, P.in[I_NA_WQKV] + c, 3072, D)); }
    if (ph == 27) { const int r = srow(i, RA), c = hh % 2048, hd = c >> 6; const bf16_t* p = (const bf16_t*)(ws + WS_BIG + BG_QKV) + (size_t)r * 3072 + hd * 64; double ss = 0; for (int k = 0; k < 64; ++k) ss += (double)bf2f(p[k]) * bf2f(p[k]);
        SETBF((bf16_t*)(ws + WS_BIG + BG_QKV) + (size_t)r * 3072 + c, bf2f(p[c & 63]) / sqrt(ss / 64 + 1e-6) * (hd < 16 ? P.in[I_NA_QG][c & 63] * 0.125 : P.in[I_NA_KG][c & 63])); }
    if (ph == 28) { const int r = srow(i, RL), c = hh % D, h = c >> 6, dd = c & 63, b = r >> 11, qr = (r >> 6) & 31, qc = r & 63; const bf16_t* Q = (const bf16_t*)(ws + WS_BIG + BG_QKV);
        const int r0 = min(max(qr - 4, 0), 24), c0 = min(max(qc - 8, 0), 48); double mx = -1e300, l = 0, o = 0;
        for (int pass = 0; pass < 2; ++pass) for (int n = 0; n < 384; ++n) { size_t kr; double s = 0;
            if (n < 128) { const int a = n >> 4, j = n & 15; kr = (size_t)b * SEQ + (size_t)(r0 + a) * 64 + c0 + j; s = P.in[I_NA_RPB][((size_t)h * 15 + (r0 + a - qr + 7)) * 31 + min(max(c0 + j - qc, -15), 15) + 15]; }
            else kr = (size_t)RL + (size_t)b * CTXL + (n - 128);
            for (int k = 0; k < 64; ++k) s += (double)bf2f(Q[(size_t)r * 3072 + h * 64 + k]) * bf2f(Q[kr * 3072 + D + h * 64 + k]);
            if (pass == 0) mx = fmax(mx, s); else { const double pp = exp(s - mx); l += pp; o += pp * bf2f(Q[kr * 3072 + 2 * D + h * 64 + dd]); } }
        SETBF((bf16_t*)(ws + WS_BIG + BG_O) + (size_t)r * D + c, o / l); }
    if (ph == 29) { const int r = srow(i, RL), c = hh % D, mb = r >> 11; const double dt = ddot((bf16_t*)(ws + WS_BIG + BG_O) + (size_t)r * D, P.in[I_NA_WO] + c, D, D); float* hp = P.out + (size_t)r * D + c; SETF(hp, *hp + modl[(size_t)mb * MODW + 2 * D + c] * dt); }
    B->addr[i] = addr; B->val[i] = val; B->kind[i] = kind;
#undef SETBF
#undef SETF
}
__device__ inline void dbg_max(unsigned* w, float e) { atomicMax(w, __float_as_uint(e)); }
__global__ void chk_compare(Params P, int ph) {
    DbgBuf* B = (DbgBuf*)(P.ws + WS_DBG); unsigned* dw = (unsigned*)(P.ws + WS_CTL) + CW_DBG; const int i = blockIdx.x * blockDim.x + threadIdx.x; if (i >= NSAMP) return;
    const int kind = B->kind[i]; float err = 0.f;
    if (kind == 1) { const float got = bf2f(*(const bf16_t*)B->addr[i]); err = fabsf(got - B->val[i]) / (fabsf(B->val[i]) + 0.05f) / 0.03f; if (!(got == got)) err = 1e9f; }
    if (kind == 2) { const float got = *(const float*)B->addr[i]; err = fabsf(got - B->val[i]) / (fabsf(B->val[i]) + 0.05f) / 0.004f; if (!(got == got)) err = 1e9f; }
    if (kind == 3) { err = (*(const int*)B->addr[i] == __float_as_int(B->val[i])) ? 0.f : 1e9f; }
    if (err > 0.f) dbg_max(dw + ph, err);
    if ((ph == 14 || ph == 31) && i < 512) { const int l2 = ph == 14 ? 0 : 1, s = i & 1; unsigned char* ws = P.ws; const unsigned* cnt = (const unsigned*)(ws + WS_CTL) + CW_CNT + 64 * l2 + 8 * s; int total = 0, nvalid = 0; for (int e = 0; e < NE; ++e) { total += ((int)cnt[e] + 255) & ~255; nvalid += (int)cnt[e]; }
        const int nrows = ph == 14 ? RA : RL; if (nvalid != nrows) dbg_max(dw + ph, 7e8f);
        const int pos = (int)(hsh(i * 31u + 5u) % (unsigned)total); const int t = ((const int*)(ws + WS_ROUTE + RT_TOK))[s * MPAD + pos]; const int e = moe_expert_of_pos(cnt, pos);
        int off = 0; for (int k = 0; k < e; ++k) off += ((int)cnt[k] + 255) & ~255; const bool shouldvalid = pos - off < (int)cnt[e];
        if ((t >= 0) != shouldvalid) dbg_max(dw + ph, 6e8f);
        if (t >= 0) { const int ee = ((const int*)(ws + WS_ROUTE + RT_E))[t]; if (((ee >> (8 * s)) & 255) != e || t >= nrows) dbg_max(dw + ph, 5e8f);
            const float gwv = ((const float*)(ws + WS_ROUTE + RT_GW))[s * MPAD + pos], rwv = ((const float*)(ws + WS_ROUTE + RT_W))[2 * t + s]; if (gwv != rwv) dbg_max(dw + ph, 4e8f);
            const int layer = ph == 14 ? 1 : 3; const float* modl = (const float*)(ws + WS_MODV) + (size_t)layer * 33 * MODW; const int c = hsh(i * 77u) % D;
            const double ex = dnorm_elem(P, hrow(P, P.out, (const float*)(ws + WS_HCTX), t), P.in[I_N2G] + layer * D, modl, 1, t, c); const float got = bf2f(((s ? (const bf16_t*)(ws + WS_BIG + BG_FS1) : (const bf16_t*)(ws + WS_U)) + (size_t)pos * D)[c]);
            const float er = fabsf(got - (float)ex) / (fabsf((float)ex) + 0.05f) / 0.03f; if (er > 0.f) dbg_max(dw + ph, er); } }
}
__global__ void dbg_finalize(Params P) {
    const unsigned* dw = (const unsigned*)(P.ws + WS_CTL) + CW_DBG; int bad = -1;
    for (int k = 0; k < NPH; ++k) if (__uint_as_float(dw[k]) > 1.0f) { bad = k; break; }
    if (bad < 0) { const unsigned* bar = (const unsigned*)(P.ws + WS_CTL) + CW_BAR; if (bar[XB_TMO]) bad = 40; }
    if (bad < 0) return;
    const float v = exp2f(4.0f + (float)bad);
    for (size_t i = (size_t)blockIdx.x * blockDim.x + threadIdx.x; i < (size_t)RL * D; i += (size_t)gridDim.x * blockDim.x) P.out[i] = v;
}
#endif

extern "C" void kernel_launch(void* const* d_in, const int* in_sizes, int n_in, void* d_out, int out_size, void* d_ws, size_t ws_size, hipStream_t stream) {
    static int grid = 0;
    if (grid == 0) {
        if (n_in != 40 || out_size != RL * D || ws_size < WS_END + 16 * MiB) { fprintf(stderr, "kernel_launch: unexpected problem (n_in %d out %d ws %zu)\n", n_in, out_size, ws_size); grid = -1; return; }
        int dev = 0, cus = 0;
        if (hipGetDevice(&dev) != hipSuccess || hipDeviceGetAttribute(&cus, hipDeviceAttributeMultiprocessorCount, dev) != hipSuccess) { grid = -1; return; }
        if (hipFuncSetAttribute((const void*)fwd, hipFuncAttributeMaxDynamicSharedMemorySize, LDS_BYTES) != hipSuccess) { fprintf(stderr, "kernel_launch: hipFuncSetAttribute failed\n"); grid = -1; return; }
        int per_cu = 0; (void)hipOccupancyMaxActiveBlocksPerMultiprocessor(&per_cu, (const void*)fwd, NTHR, LDS_BYTES); (void)hipGetLastError();
        if (per_cu < 1) fprintf(stderr, "kernel_launch: occupancy query says %d\n", per_cu);
        grid = cus;
    }
    if (grid < 0) return;
    (void)hipMemsetAsync((char*)d_ws + WS_CTL, 0, CTL_BYTES, stream);
    Params p{};
    for (int i = 0; i < 40; ++i) p.in[i] = (const float*)d_in[i];
    p.out = (float*)d_out; p.ws = (unsigned char*)d_ws;
#if MK_DEBUG || MK_MULTI
    for (int ph = 0; ph < NPH; ++ph) {
#if MK_DEBUG
        hipLaunchKernelGGL(chk_expect, dim3(NSAMP / 256), dim3(256), 0, stream, p, ph);
#endif
        p.ph_lo = ph; p.ph_hi = ph + 1;
        hipLaunchKernelGGL(fwd, dim3(grid), dim3(NTHR), LDS_BYTES, stream, p);
#if MK_DEBUG
        hipLaunchKernelGGL(chk_compare, dim3(NSAMP / 256), dim3(256), 0, stream, p, ph);
#endif
    }
#if MK_DEBUG
    hipLaunchKernelGGL(dbg_finalize, dim3(1024), dim3(256), 0, stream, p);
#endif
#else
    p.ph_lo = 0; p.ph_hi = NPH;
    hipLaunchKernelGGL(fwd, dim3(grid), dim3(NTHR), LDS_BYTES, stream, p);
#endif
}
```

```cpp
#include <hip/hip_runtime.h>
#include <cstdio>
#include <cstdint>

#ifndef PROBE_LO
#define PROBE_LO -1
#define PROBE_HI -1
#endif
#ifndef MK_MULTI
#define MK_MULTI 0
#endif

#define LAS __attribute__((address_space(3)))
typedef unsigned short bf16_t;
typedef short bf16x8 __attribute__((ext_vector_type(8)));
typedef short s16x4 __attribute__((ext_vector_type(4)));
typedef float f32x4 __attribute__((ext_vector_type(4)));
typedef float f32x2 __attribute__((ext_vector_type(2)));
typedef unsigned u32x4 __attribute__((ext_vector_type(4)));
typedef unsigned u32x2 __attribute__((ext_vector_type(2)));

constexpr int D = 1024, NB = 32, SEQ = 2048, CTXL = 256;
constexpr int RL = NB * SEQ, RC = NB * CTXL, RA = RL + RC;
constexpr int DRNN = 1280, LBW = 160, DSGU = 2048, DFF = 3584, NE = 8;
constexpr int MODW = 6 * D;
constexpr int MPAD = 75776;
constexpr float NORM_EPS = 1e-6f;
constexpr int NWAVES = 8, NTHR = 512;

constexpr size_t MiB = 1u << 20;
constexpr size_t WS_CTL = 0, CTL_BYTES = 1 * MiB;
constexpr size_t WS_MODV = 1 * MiB;
constexpr size_t WS_HCTX = 5 * MiB;
constexpr size_t WS_LRU_WIN = 37 * MiB;
constexpr size_t WS_LRU_WA = WS_LRU_WIN + 5 * MiB;
constexpr size_t WS_LRU_WI = WS_LRU_WA + 1 * MiB;
constexpr size_t WS_LRU_WOUT = WS_LRU_WI + 1 * MiB;
constexpr size_t WS_SGU_WIN = WS_LRU_WOUT + 3 * MiB;
constexpr size_t WS_SGU_WS = WS_SGU_WIN + 8 * MiB;
constexpr size_t WS_SGU_WOUT = WS_SGU_WS + 1 * MiB;
constexpr size_t WS_POOL_W = WS_SGU_WOUT + 4 * MiB;
constexpr size_t WS_NA_WQKV = WS_POOL_W + 1 * MiB;
constexpr size_t WS_NA_WO = WS_NA_WQKV + 6 * MiB;
constexpr size_t WS_FFN_W13 = WS_NA_WO + 2 * MiB;
constexpr size_t WS_FFN_W2 = WS_FFN_W13 + 28 * MiB;
constexpr size_t WS_MOE_W13 = WS_FFN_W2 + 14 * MiB;
constexpr size_t WS_MOE_W2 = WS_MOE_W13 + 112 * MiB;
constexpr size_t WS_ROUTE = WS_MOE_W2 + 56 * MiB;
constexpr size_t WS_H = WS_ROUTE + 4 * MiB;
constexpr size_t WS_BIG = WS_H + 148 * MiB;
constexpr size_t WS_END = WS_BIG + 744 * MiB;
constexpr size_t WS_DBG = WS_END;
static_assert(WS_MOE_W13 == 111 * MiB && WS_BIG == 431 * MiB && WS_END == 1175 * MiB, "ws map");
constexpr size_t RT_E = 0;
constexpr size_t RT_W = 512 * 1024;
constexpr size_t RT_TOK = 1280 * 1024;
constexpr size_t RT_GW = 2048 * 1024;
constexpr size_t RT_ST = 2816 * 1024;
constexpr size_t RT_P1 = 3456 * 1024;
static_assert(RT_W >= (size_t)RA * 4 && RT_TOK - RT_W >= (size_t)RA * 8 && RT_GW - RT_TOK >= (size_t)2 * MPAD * 4 && RT_ST - RT_GW >= (size_t)2 * MPAD * 4 && RT_P1 - RT_ST >= (size_t)RA * 8 && 4 * MiB - RT_P1 >= (size_t)RA * 4, "route map");
constexpr size_t BG_XG = 0, BG_Y = 360 * MiB;
constexpr size_t BG_HID = 0;
constexpr size_t BG_Z = 0;
constexpr size_t BG_FS1 = 0, BG_MHID = 0;
constexpr size_t BG_MW2 = 576 * MiB;
constexpr size_t BG_PD = 0;
constexpr size_t BG_QKV = 0, BG_O = 432 * MiB;
static_assert(BG_MHID + (size_t)MPAD * DFF * 2 <= BG_MW2 && BG_O + (size_t)RL * D * 2 <= BG_MW2 && BG_Y + (size_t)RA * DRNN * 2 <= BG_MW2 && BG_MW2 + 168 * MiB <= 744 * MiB, "big map");
constexpr int CW_BAR = 4096;
constexpr int CW_CNT = 16384;
constexpr int CW_CUR = 16384 + 256;
constexpr int CW_DBG = 32768;
constexpr int CW_CVTQ = 20480;

constexpr int LDS_BYTES = 163840;
constexpr int LDS_AUX = 131072;
constexpr int LDS_CTL = LDS_BYTES - 256;

__device__ __forceinline__ float bf2f(unsigned b) { return __uint_as_float(b << 16); }
__device__ __forceinline__ unsigned pk2(float lo, float hi) { unsigned r; asm volatile("v_cvt_pk_bf16_f32 %0, %1, %2" : "=v"(r) : "v"(lo), "v"(hi)); return r; }
__device__ __forceinline__ float lo_bf(unsigned w) { return __uint_as_float(w << 16); }
__device__ __forceinline__ float hi_bf(unsigned w) { return __uint_as_float(w & 0xffff0000u); }
template <int CTRL> __device__ __forceinline__ float dpp_f(float v) { return __int_as_float(__builtin_amdgcn_update_dpp(0, __float_as_int(v), CTRL, 0xf, 0xf, true)); }
__device__ __forceinline__ float wave_sum(float v) {
    v += dpp_f<0xB1>(v);
    v += dpp_f<0x4E>(v);
    v += dpp_f<0x141>(v);
    v += dpp_f<0x140>(v);
    const int iv = __float_as_int(v);
    return (__int_as_float(__builtin_amdgcn_readlane(iv, 0)) + __int_as_float(__builtin_amdgcn_readlane(iv, 16))) + (__int_as_float(__builtin_amdgcn_readlane(iv, 32)) + __int_as_float(__builtin_amdgcn_readlane(iv, 48)));
}
__device__ __forceinline__ float sigmoid_f(float x) { return __builtin_amdgcn_rcpf(1.0f + __builtin_amdgcn_exp2f(-1.4426950408889634f * x)); }
__device__ __forceinline__ float silu_f(float x) { return x * __builtin_amdgcn_rcpf(1.0f + __builtin_amdgcn_exp2f(-1.4426950408889634f * x)); }
__device__ __forceinline__ float gelu_tanh_f(float x) { const float z2 = -2.0f * 1.4426950408889634f * 0.7978845608028654f * (x + 0.044715f * x * x * x); return x * __builtin_amdgcn_rcpf(1.0f + __builtin_amdgcn_exp2f(z2)); }
__device__ __forceinline__ unsigned lds_add(LAS unsigned* p, unsigned v) { return __hip_atomic_fetch_add(p, v, __ATOMIC_RELAXED, __HIP_MEMORY_SCOPE_WORKGROUP); }
#define LDS_WAIT() asm volatile("s_waitcnt lgkmcnt(0)" ::: "memory")
#define VM_WAIT() asm volatile("s_waitcnt vmcnt(0)" ::: "memory")

#define XB_TMO      128
#define XB_XCNT(j)  (256  + 64 * (j))
#define XB_XSUB(j)  (1280 + 64 * (j))
#define XB_XGEN(j)  (2304 + 64 * (j))
#define XB_TOP      3328
#define XB_TOPGEN   3392
#define XCD_BAR_WORDS 3456
#define XB_SPIN_CAP (1u << 18)
__device__ __forceinline__ unsigned xb_ld(unsigned* p)              { return __hip_atomic_load(p, __ATOMIC_RELAXED, __HIP_MEMORY_SCOPE_AGENT); }
__device__ __forceinline__ unsigned xb_add(unsigned* p, unsigned v) { return __hip_atomic_fetch_add(p, v, __ATOMIC_RELAXED, __HIP_MEMORY_SCOPE_AGENT); }
__device__ __forceinline__ unsigned xb_xcc_id() { return (unsigned)__builtin_amdgcn_s_getreg((3 << 11) | 20) & 0xFu; }
#define XB_SPIN(cond, bar) do { unsigned _sp = 0; while (cond) { __builtin_amdgcn_s_sleep(1); \
    if ((++_sp & 255u) == 0u) { if (xb_ld(&(bar)[XB_TMO])) break; if (_sp > XB_SPIN_CAP) { atomicAdd(&(bar)[XB_TMO], 1u); break; } } } } while (0)
struct XcdBarrier { unsigned* bar; unsigned x; volatile LAS unsigned* st; };
__device__ __forceinline__ XcdBarrier xcd_barrier_post(unsigned* bar, volatile LAS unsigned* st) {
    XcdBarrier b; b.bar = bar; b.x = xb_xcc_id(); b.st = st;
    if (threadIdx.x == 0) (void)xb_add(&bar[XB_XCNT(b.x)], 1u);
    return b;
}
__device__ __forceinline__ void xcd_barrier_complete(unsigned* bar, unsigned x, unsigned& nloc, unsigned& nx) {
    const unsigned G = gridDim.x * gridDim.y * gridDim.z;
    unsigned sum, cnt, mine, sp = 0u;
    for (;;) {
        sum = 0u; cnt = 0u; mine = 0u;
#pragma unroll
        for (unsigned j = 0; j < 16; ++j) { const unsigned c = xb_ld(&bar[XB_XCNT(j)]); sum += c; cnt += (c > 0u) ? 1u : 0u; mine = (j == x) ? c : mine; }
        if (sum == G) break;
        __builtin_amdgcn_s_sleep(1);
        if ((++sp & 255u) == 0u) { if (xb_ld(&bar[XB_TMO])) break; if (sp > XB_SPIN_CAP) { atomicAdd(&bar[XB_TMO], 1u); break; } }
    }
    nloc = mine > 0u ? mine : 1u; nx = cnt > 0u ? cnt : 1u;
}
__device__ __forceinline__ void xcd_barrier(const XcdBarrier& b) {
    asm volatile("s_waitcnt vmcnt(0)" ::: "memory");
    __syncthreads();
    if (threadIdx.x == 0) {
        unsigned* bar = b.bar;
        __builtin_amdgcn_s_waitcnt(0);
        unsigned nloc = b.st[0], nx = b.st[1];
        if (nloc == 0u) { xcd_barrier_complete(bar, b.x, nloc, nx); b.st[0] = nloc; b.st[1] = nx; }
        const unsigned old = xb_add(&bar[XB_XSUB(b.x)], 1u);
        const unsigned gen = old / nloc;
        if (old + 1u == (gen + 1u) * nloc) {
            __builtin_amdgcn_fence(__ATOMIC_RELEASE, "agent");
            asm volatile("s_waitcnt vmcnt(0)" ::: "memory");
            const unsigned og = xb_add(&bar[XB_TOP], 1u);
            const unsigned tg = og / nx;
            if (og + 1u == (tg + 1u) * nx) xb_add(&bar[XB_TOPGEN], 1u);
            else XB_SPIN(xb_ld(&bar[XB_TOPGEN]) == tg, bar);
            __builtin_amdgcn_fence(__ATOMIC_ACQUIRE, "agent");
            xb_add(&bar[XB_XGEN(b.x)], 1u);
            asm volatile("s_waitcnt vmcnt(0)" ::: "memory");
        } else {
            XB_SPIN(xb_ld(&bar[XB_XGEN(b.x)]) == gen, bar);
            __builtin_amdgcn_fence(__ATOMIC_ACQUIRE, "agent");
            asm volatile("s_waitcnt vmcnt(0)" ::: "memory");
        }
    }
    __syncthreads();
}

struct Params {
    const float* in[40];
    float* out; unsigned char* ws;
    int ph_lo, ph_hi;
};
enum In { I_X = 0, I_C, I_CTX, I_CCTX, I_MODW, I_MODB, I_N1G, I_N2G, I_LRU_WIN, I_LRU_CW, I_LRU_CB, I_LRU_WA, I_LRU_BA, I_LRU_WI, I_LRU_BI, I_LRU_LAM, I_LRU_WOUT,
          I_SGU_WIN, I_SGU_BIN, I_SGU_LNG, I_SGU_LNB, I_SGU_WS, I_SGU_BS, I_SGU_WOUT, I_POOL_W, I_POOL_B, I_POOL_S, I_NA_WQKV, I_NA_QG, I_NA_KG, I_NA_RPB, I_NA_WO,
          I_FFN_W1, I_FFN_W3, I_FFN_W2, I_MOE_WR, I_MOE_BR, I_MOE_W1, I_MOE_W3, I_MOE_W2 };

namespace pg8 {
constexpr int BM = 256, BK = 64, HALF = 128, HTB = HALF * BK * 2, STAGE_BYTES = 8 * HTB, NXCD = 8, WGM = 8;
__device__ __forceinline__ int lds_byte(int r, int c) { const int st = (r >> 4) * 2 + (c >> 5), rr = r & 15, cc = c & 31, ob = rr * 64 + cc * 2; return st * 1024 + (ob ^ (((ob >> 9) & 1) << 5)); }
__device__ __forceinline__ void stage_rc(int b, int& R, int& C) { const int st = b / 1024, sb = b % 1024, swz = sb ^ (((sb >> 9) & 1) << 5); R = (st >> 1) * 16 + swz / 64; C = (st & 1) * 32 + (swz % 64) / 2; }
__device__ __forceinline__ int perm32(int rho) { const int n = rho >> 4, i = rho & 15; return 8 * (i >> 2) + 4 * n + (i & 3); }

struct Unit { int pm, pn, e; const char* a; const char* b; };
struct Sched {
    int nM, nN, G, c;
    const char* A; size_t a_tile, a_pn;
    const char* B; size_t b_tile, b_e;
    const LAS int* tstart;
    bool rev = false;
    __device__ __forceinline__ bool next(int i, Unit& u) const {
        long L = (long)i * G + c; if (L >= (long)nM * nN) return false;
        if (rev) L = (long)nM * nN - 1 - L;
        int e = 0, t0 = 0, nMe = nM, wgid = (int)L;
        if (tstart) {
#pragma unroll
            for (int k = 1; k < 8; ++k) e += (wgid >= tstart[k] * nN) ? 1 : 0;
            t0 = tstart[e]; nMe = tstart[e + 1] - t0; wgid -= t0 * nN;
        }
        const int nwg = nMe * nN;
        { const int q = nwg / NXCD, r = nwg % NXCD, xcd = wgid % NXCD, off = wgid / NXCD; wgid = (xcd < r ? xcd * (q + 1) : r * (q + 1) + (xcd - r) * q) + off; }
        const int nig = WGM * nN, gid = wgid / nig, fm = gid * WGM, gsz = (nMe - fm) < WGM ? (nMe - fm) : WGM;
        u.pm = t0 + fm + ((wgid % nig) % gsz); u.pn = (wgid % nig) / gsz;
        u.e = e; u.a = A + (size_t)u.pm * a_tile + (size_t)u.pn * a_pn; u.b = B + (size_t)e * b_e + (size_t)u.pn * b_tile;
        return true;
    }
};

template <class Epi, bool GATHER = false>
__device__ __forceinline__ void gemm_phase(LAS unsigned char* lds, const int lda, const int K, const Sched& S, const Epi& E, const int* gidx = nullptr, LAS int* ixt = nullptr) {
    const int tid = threadIdx.x, wid = __builtin_amdgcn_readfirstlane(tid >> 6), lane = tid & 63, wr = wid >> 2, wc = wid & 3, fr = lane & 15, fq = lane >> 4;
    const int nt = K / BK;
    unsigned voffA[2], voffB[2]; int Rl[2]; unsigned cb2[2];
#pragma unroll
    for (int i = 0; i < 2; ++i) { int R, C; stage_rc(tid * 16 + i * 8192, R, C); const int Rb = Epi::PERM ? ((R & ~31) + perm32(R & 31)) : R;
        voffA[i] = (unsigned)(R * lda + C) * 2u; voffB[i] = (unsigned)(Rb * K + C) * 2u; Rl[i] = R; cb2[i] = (unsigned)C * 2u; }
    unsigned cOff[2][2] = {{0u, 0u}, {0u, 0u}}, nOff[2][2] = {{0u, 0u}, {0u, 0u}};
    const size_t kstep = (size_t)(BK * 2);
    const size_t hstepA = (size_t)HALF * lda * 2, hstepB = (size_t)HALF * K * 2;
    const unsigned ldsw = (unsigned)wid * 1024u;
    const int aoff = lds_byte(wr * 64 + fr, fq * 8), boff = lds_byte(wc * 32 + fr, fq * 8);
#define PG8_SA(b, h) (((b) * 2 + (h)) * HTB)
#define PG8_SB(b, h) ((4 + (b) * 2 + (h)) * HTB)
#define PG8_STAGE(bufoff, gbase, voff) do { _Pragma("unroll") for (int _i = 0; _i < 2; ++_i) \
        __builtin_amdgcn_global_load_lds((const unsigned*)((const char*)(gbase) + (voff)[_i]), (LAS unsigned*)(lds + (bufoff) + ldsw + _i * 8192), 16, 0, 0); } while (0)
#define PG8_STAGE_A(bufoff, kptr, h, usenext) do { if constexpr (GATHER) { const unsigned o_[2] = {(usenext) ? nOff[h][0] : cOff[h][0], (usenext) ? nOff[h][1] : cOff[h][1]}; PG8_STAGE(bufoff, kptr, o_); } \
        else PG8_STAGE(bufoff, (kptr) + (h) * hstepA, voffA); } while (0)
#define PG8_LDA(dst, b, h) do { _Pragma("unroll") for (int m = 0; m < 4; ++m) _Pragma("unroll") for (int k = 0; k < 2; ++k) dst[m][k] = *(const LAS bf16x8*)(lds + PG8_SA(b, h) + aoff + m * 2048 + k * 1024); } while (0)
#define PG8_LDB(dst, b, h) do { _Pragma("unroll") for (int n = 0; n < 2; ++n) _Pragma("unroll") for (int k = 0; k < 2; ++k) dst[n][k] = *(const LAS bf16x8*)(lds + PG8_SB(b, h) + boff + n * 2048 + k * 1024); } while (0)
#define PG8_MMA(ai, bj, At, Bt) do { __builtin_amdgcn_s_setprio(1); _Pragma("unroll") for (int m = 0; m < 4; ++m) _Pragma("unroll") for (int n = 0; n < 2; ++n) _Pragma("unroll") for (int k = 0; k < 2; ++k) \
        acc[ai][bj][m][n] = __builtin_amdgcn_mfma_f32_16x16x32_bf16(Bt[n][k], At[m][k], acc[ai][bj][m][n], 0, 0, 0); __builtin_amdgcn_s_setprio(0); } while (0)
#define PG8_WAIT_V(n) asm volatile("s_waitcnt vmcnt(" #n ")" ::: "memory")
#define PG8_WAIT_L(n) asm volatile("s_waitcnt lgkmcnt(" #n ")" ::: "memory")
#define PG8_BAR __builtin_amdgcn_s_barrier()
#define PG8_SCHED __builtin_amdgcn_sched_barrier(0)
    Unit cur, nxt; int ui = 0;
    if (!S.next(0, cur)) return;
    f32x4 acc[2][2][4][2];
#pragma unroll
    for (int a = 0; a < 2; ++a)
#pragma unroll
        for (int b = 0; b < 2; ++b)
#pragma unroll
            for (int m = 0; m < 4; ++m)
#pragma unroll
                for (int n = 0; n < 2; ++n) acc[a][b][m][n] = (f32x4){0.f, 0.f, 0.f, 0.f};
    bf16x8 At[4][2], B0[2][2], B1[2][2];
    const char* cA = cur.a; const char* cB = cur.b;
    if constexpr (GATHER) {
#pragma unroll
        for (int h = 0; h < 2; ++h)
#pragma unroll
            for (int i = 0; i < 2; ++i) { const int ix = gidx[cur.pm * BM + h * HALF + Rl[i]]; cOff[h][i] = (unsigned)(ix < 0 ? 0 : ix) * (unsigned)(lda * 2) + cb2[i]; }
    }
    PG8_STAGE(PG8_SB(0, 0), cB, voffB); PG8_STAGE(PG8_SB(0, 1), cB + hstepB, voffB); PG8_STAGE_A(PG8_SA(0, 0), cA, 0, false); PG8_STAGE_A(PG8_SA(0, 1), cA, 1, false);
    if (wr == 1) PG8_BAR;
    PG8_WAIT_V(2); PG8_BAR;
    PG8_STAGE(PG8_SB(1, 0), cB + kstep, voffB); PG8_STAGE_A(PG8_SA(1, 0), cA + kstep, 0, false); PG8_STAGE(PG8_SB(1, 1), cB + hstepB + kstep, voffB);
    PG8_WAIT_V(6); PG8_BAR;
    for (;;) {
        const bool has_next = S.next(ui + 1, nxt);
        const char* nA = has_next ? nxt.a : cA; const char* nB = has_next ? nxt.b : cB;
        if constexpr (GATHER) { if (has_next && wid == 0) {
#pragma unroll
            for (int k = 0; k < 4; ++k) __builtin_amdgcn_global_load_lds((const unsigned*)(gidx + nxt.pm * BM + k * 64 + lane), (LAS unsigned*)(ixt + ((ui + 1) & 1) * BM + k * 64), 4, 0, 0); } }
        for (int t = 0; t < nt; t += 2) {
            const bool last = (t == nt - 2); const bool un = last && has_next;
            if constexpr (GATHER) { if (un) {
#pragma unroll
                for (int h = 0; h < 2; ++h)
#pragma unroll
                    for (int i = 0; i < 2; ++i) { const int ix = ixt[((ui + 1) & 1) * BM + h * HALF + Rl[i]]; nOff[h][i] = (unsigned)(ix < 0 ? 0 : ix) * (unsigned)(lda * 2) + cb2[i]; } } }
            const char* a1 = cA + (size_t)(t + 1) * kstep;
            const char* a2 = last ? nA : cA + (size_t)(t + 2) * kstep; const char* b2 = last ? nB : cB + (size_t)(t + 2) * kstep;
            const char* a3 = a2 + kstep; const char* b3 = b2 + kstep;
            PG8_LDB(B0, 0, 0); PG8_LDB(B1, 0, 1); PG8_SCHED; PG8_LDA(At, 0, 0); PG8_STAGE_A(PG8_SA(1, 1), a1, 1, false);
            PG8_WAIT_V(8); PG8_WAIT_L(0); PG8_BAR; PG8_MMA(0, 0, At, B0); PG8_MMA(0, 1, At, B1); PG8_BAR; PG8_SCHED;
            PG8_LDA(At, 0, 1); PG8_STAGE(PG8_SB(0, 0), b2, voffB); PG8_STAGE(PG8_SB(0, 1), b2 + hstepB, voffB); PG8_STAGE_A(PG8_SA(0, 0), a2, 0, un);
            PG8_WAIT_V(8); PG8_WAIT_L(0); PG8_BAR; PG8_MMA(1, 0, At, B0); PG8_MMA(1, 1, At, B1); PG8_BAR; PG8_SCHED;
            PG8_LDB(B0, 1, 0); PG8_LDB(B1, 1, 1); PG8_SCHED; PG8_LDA(At, 1, 0); PG8_STAGE_A(PG8_SA(0, 1), a2, 1, un);
            PG8_WAIT_V(8); PG8_WAIT_L(0); PG8_BAR; PG8_MMA(0, 0, At, B0); PG8_MMA(0, 1, At, B1); PG8_BAR; PG8_SCHED;
            PG8_LDA(At, 1, 1); PG8_STAGE(PG8_SB(1, 0), b3, voffB); PG8_STAGE(PG8_SB(1, 1), b3 + hstepB, voffB); PG8_STAGE_A(PG8_SA(1, 0), a3, 0, un);
            PG8_WAIT_V(8); PG8_WAIT_L(0); PG8_BAR; PG8_MMA(1, 0, At, B0); PG8_MMA(1, 1, At, B1); PG8_BAR; PG8_SCHED;
        }
        if (wr == 0) PG8_BAR;
        E(acc, cur, wr, wc, fr, fq);
        if (!has_next) break;
#pragma unroll
        for (int a = 0; a < 2; ++a)
#pragma unroll
            for (int b = 0; b < 2; ++b)
#pragma unroll
                for (int m = 0; m < 4; ++m)
#pragma unroll
                    for (int n = 0; n < 2; ++n) acc[a][b][m][n] = (f32x4){0.f, 0.f, 0.f, 0.f};
        cur = nxt; cA = nA; cB = nB; ++ui;
        if constexpr (GATHER) {
#pragma unroll
            for (int h = 0; h < 2; ++h)
#pragma unroll
                for (int i = 0; i < 2; ++i) cOff[h][i] = nOff[h][i]; }
        if (wr == 1) PG8_BAR;
    }
    PG8_WAIT_V(0);
    PG8_BAR;
#undef PG8_SA
#undef PG8_SB
#undef PG8_STAGE
#undef PG8_LDA
#undef PG8_STAGE_A
#undef PG8_LDB
#undef PG8_MMA
#undef PG8_WAIT_V
#undef PG8_WAIT_L
#undef PG8_BAR
#undef PG8_SCHED
}

template <int ACT> struct EpiBf16 {
    static constexpr bool PERM = true;
    bf16_t* O; int ldc; const float* bias;
    __device__ __forceinline__ void operator()(const f32x4 (&acc)[2][2][4][2], const Unit& u, int wr, int wc, int fr, int fq) const {
        asm volatile("" : "+v"(fr), "+v"(fq));
        const int row0 = u.pm * BM + wr * 64 + fr; const int col0 = u.pn * BM + wc * 32 + 8 * fq;
        f32x4 bv[2][2];
#pragma unroll
        for (int bj = 0; bj < 2; ++bj)
#pragma unroll
            for (int n = 0; n < 2; ++n) bv[bj][n] = bias ? *(const f32x4*)(bias + col0 + bj * HALF + 4 * n) : (f32x4){0.f, 0.f, 0.f, 0.f};
#pragma unroll
        for (int ai = 0; ai < 2; ++ai)
#pragma unroll
            for (int m = 0; m < 4; ++m) { bf16_t* rowp = O + (size_t)(row0 + ai * HALF + m * 16) * ldc + col0;
#pragma unroll
                for (int bj = 0; bj < 2; ++bj) { f32x4 v0 = acc[ai][bj][m][0] + bv[bj][0], v1 = acc[ai][bj][m][1] + bv[bj][1];
                    if (ACT == 1) {
#pragma unroll
                        for (int j = 0; j < 4; ++j) { v0[j] = gelu_tanh_f(v0[j]); v1[j] = gelu_tanh_f(v1[j]); } }
                    u32x4 w; w.x = pk2(v0[0], v0[1]); w.y = pk2(v0[2], v0[3]); w.z = pk2(v1[0], v1[1]); w.w = pk2(v1[2], v1[3]);
                    *(u32x4*)(rowp + bj * HALF) = w; } }
    }
};
struct EpiSwiGLU {
    static constexpr bool PERM = true;
    bf16_t* H; int ldh;
    __device__ __forceinline__ void operator()(const f32x4 (&acc)[2][2][4][2], const Unit& u, int wr, int wc, int fr, int fq) const {
        asm volatile("" : "+v"(fr), "+v"(fq));
        const int row0 = u.pm * BM + wr * 64 + fr; const int col0 = u.pn * HALF + wc * 32 + 8 * fq;
#pragma unroll
        for (int ai = 0; ai < 2; ++ai)
#pragma unroll
            for (int m = 0; m < 4; ++m) { bf16_t* rowp = H + (size_t)(row0 + ai * HALF + m * 16) * ldh + col0;
                f32x4 h0, h1;
#pragma unroll
                for (int j = 0; j < 4; ++j) { h0[j] = silu_f(acc[ai][0][m][0][j]) * acc[ai][1][m][0][j]; h1[j] = silu_f(acc[ai][0][m][1][j]) * acc[ai][1][m][1][j]; }
                u32x4 w; w.x = pk2(h0[0], h0[1]); w.y = pk2(h0[2], h0[3]); w.z = pk2(h1[0], h1[1]); w.w = pk2(h1[2], h1[3]);
                *(u32x4*)rowp = w; }
    }
};
template <bool HAS_BS, bool SRC32> struct EpiResidT {
    static constexpr bool PERM = false;
    const void* src_lat; const void* src_ctx; bf16_t* dst_lat; bf16_t* dst_ctx; const float* gate;
    const float* bias; const float* cscale;
    __device__ __forceinline__ void operator()(const f32x4 (&acc)[2][2][4][2], const Unit& u, int wr, int wc, int fr, int fq) const {
        asm volatile("" : "+v"(fr), "+v"(fq));
        const bool isctx = u.pm >= RL / BM; const int mb = isctx ? 32 : (u.pm >> 3);
        const size_t trow = isctx ? (size_t)(u.pm - RL / BM) * BM : (size_t)u.pm * BM;
        const float* s32 = (const float*)(isctx ? src_ctx : src_lat) + trow * D; const bf16_t* s16 = (const bf16_t*)(isctx ? src_ctx : src_lat) + trow * D;
        bf16_t* dst = (isctx ? dst_ctx : dst_lat) + trow * D;
        const float* g = gate + (size_t)mb * MODW;
        const int col0 = u.pn * BM + wc * 32 + 4 * fq;
        f32x4 gv[2][2], bv[2][2];
#pragma unroll
        for (int bj = 0; bj < 2; ++bj)
#pragma unroll
            for (int n = 0; n < 2; ++n) { const int c = col0 + bj * HALF + n * 16; gv[bj][n] = HAS_BS ? (f32x4){0.f, 0.f, 0.f, 0.f} : *(const f32x4*)(g + c); bv[bj][n] = (f32x4){0.f, 0.f, 0.f, 0.f}; }
        constexpr int MB = HAS_BS ? 1 : 4;
#pragma unroll
        for (int ai = 0; ai < 2; ++ai)
#pragma unroll
            for (int m0 = 0; m0 < 4; m0 += MB) {
                f32x4 rs[MB][2][2];
#pragma unroll
                for (int mi = 0; mi < MB; ++mi) { const unsigned off = (unsigned)((ai * HALF + wr * 64 + (m0 + mi) * 16 + fr) * D + col0);
#pragma unroll
                    for (int bj = 0; bj < 2; ++bj)
#pragma unroll
                        for (int n = 0; n < 2; ++n) { if (SRC32) rs[mi][bj][n] = *(const f32x4*)(s32 + off + bj * HALF + n * 16);
                            else { const u32x2 q = *(const u32x2*)(s16 + off + bj * HALF + n * 16); rs[mi][bj][n] = (f32x4){lo_bf(q.x), hi_bf(q.x), lo_bf(q.y), hi_bf(q.y)}; } } }
#pragma unroll
                for (int mi = 0; mi < MB; ++mi) { const int m = m0 + mi; const unsigned off = (unsigned)((ai * HALF + wr * 64 + m * 16 + fr) * D + col0);
#pragma unroll
                    for (int bj = 0; bj < 2; ++bj)
#pragma unroll
                        for (int n = 0; n < 2; ++n) { f32x4 o;
                            if (HAS_BS) { const int c = col0 + bj * HALF + n * 16;
                                o = rs[mi][bj][n] + (*(const f32x4*)(g + c) * *(const f32x4*)(cscale + c)) * (acc[ai][bj][m][n] + *(const f32x4*)(bias + c)); }
                            else o = rs[mi][bj][n] + gv[bj][n] * acc[ai][bj][m][n];
                            u32x2 w; w.x = pk2(o[0], o[1]); w.y = pk2(o[2], o[3]); *(u32x2*)(dst + off + bj * HALF + n * 16) = w; } }
            }
    }
};
typedef EpiResidT<false, false> EpiResid; typedef EpiResidT<true, false> EpiResidBS; typedef EpiResidT<false, true> EpiResidX;
template <bool OUT32> struct EpiMoeDownT {
    static constexpr bool PERM = false;
    bf16_t* h_lat; bf16_t* h_ctx; float* out32; const float* gate; const int* tok; const float* gw;
    __device__ __forceinline__ void operator()(const f32x4 (&acc)[2][2][4][2], const Unit& u, int wr, int wc, int fr, int fq) const {
        asm volatile("" : "+v"(fr), "+v"(fq));
        const int col0 = u.pn * BM + wc * 32 + 4 * fq;
        int tk[2][4]; float wg[2][4];
#pragma unroll
        for (int ai = 0; ai < 2; ++ai)
#pragma unroll
            for (int m = 0; m < 4; ++m) { const int pos = u.pm * BM + ai * HALF + wr * 64 + m * 16 + fr; tk[ai][m] = tok[pos]; wg[ai][m] = gw[pos]; }
#pragma unroll
        for (int ai = 0; ai < 2; ++ai)
#pragma unroll
            for (int mp = 0; mp < 2; ++mp) {
                u32x2 rs[2][2][2]; f32x4 gg[2][2][2]; size_t ro[2]; bool cx[2];
#pragma unroll
                for (int mi = 0; mi < 2; ++mi) { const int t = tk[ai][2 * mp + mi]; const int tt = t >= 0 ? t : 0; cx[mi] = tt >= RL; const int mb = cx[mi] ? 32 : (tt >> 11);
                    ro[mi] = (size_t)(cx[mi] ? tt - RL : tt) * D + col0; const bf16_t* hp = (cx[mi] ? h_ctx : h_lat) + ro[mi]; const float* g = gate + (size_t)mb * MODW + col0;
#pragma unroll
                    for (int bj = 0; bj < 2; ++bj)
#pragma unroll
                        for (int n = 0; n < 2; ++n) { rs[mi][bj][n] = *(const u32x2*)(hp + bj * HALF + n * 16); gg[mi][bj][n] = *(const f32x4*)(g + bj * HALF + n * 16); } }
#pragma unroll
                for (int mi = 0; mi < 2; ++mi) { const int m = 2 * mp + mi;
                    if (tk[ai][m] >= 0) { const float w = wg[ai][m];
#pragma unroll
                        for (int bj = 0; bj < 2; ++bj)
#pragma unroll
                            for (int n = 0; n < 2; ++n) { const u32x2 q = rs[mi][bj][n]; const f32x4 o = (f32x4){lo_bf(q.x), hi_bf(q.x), lo_bf(q.y), hi_bf(q.y)} + gg[mi][bj][n] * (acc[ai][bj][m][n] * w);
                                if (OUT32) *(f32x4*)(out32 + ro[mi] + bj * HALF + n * 16) = o;
                                else { u32x2 wv; wv.x = pk2(o[0], o[1]); wv.y = pk2(o[2], o[3]); *(u32x2*)((cx[mi] ? h_ctx : h_lat) + ro[mi] + bj * HALF + n * 16) = wv; } } } }
            }
    }
};
typedef EpiMoeDownT<false> EpiMoeDown; typedef EpiMoeDownT<true> EpiMoeDownOut;
}

struct Frame {
    LAS unsigned char* lds;
    int tid, lane, wave, bid, G;
    const Params* p;
    unsigned char* ws; unsigned* ctl;
    float* modv; bf16_t* hlat; bf16_t* hctx; bf16_t* U;
};
#define WSP(T, off) ((T*)(F.ws + (off)))
__device__ __forceinline__ const float* INP(const Frame& F, int i) { return F.p->in[i]; }

__device__ __forceinline__ void cvt_item(const float* W, int K, int N, bf16_t* WT, int mode, LAS float* scr, int item, int lane) {
    const int nblk = N / 32, kb = item / nblk, nb = item % nblk, k0 = 64 * kb, n0 = 32 * nb;
#pragma unroll 8
    for (int i = 0; i < 32; ++i) { const int kk = 2 * i + (lane >> 5); scr[kk * 33 + (lane & 31)] = W[(size_t)(k0 + kk) * N + n0 + (lane & 31)]; }
    LDS_WAIT();
    const int c = lane & 7;
#pragma unroll
    for (int j = 0; j < 4; ++j) { const int n = (lane >> 3) + 8 * j; const LAS float* s = scr + (8 * c) * 33 + n;
        u32x4 o; o.x = pk2(s[0 * 33], s[1 * 33]); o.y = pk2(s[2 * 33], s[3 * 33]); o.z = pk2(s[4 * 33], s[5 * 33]); o.w = pk2(s[6 * 33], s[7 * 33]);
        const int nn = n0 + n; const int drow = mode == 0 ? nn : (256 * (nn >> 7) + (nn & 127) + (mode == 2 ? 128 : 0));
        *(u32x4*)(WT + (size_t)drow * K + k0 + 8 * c) = o; }
    LDS_WAIT();
}
struct CvtJob { const float* src; bf16_t* dst; int K, N, mode; };
__device__ __forceinline__ void cvt_jobs_run(const Frame& F, const CvtJob* jobs, int njobs) {
    (void)jobs; (void)njobs;
}
__device__ __forceinline__ void cvt_run_job(const Frame& F, const CvtJob j, int& base) {
    LAS float* scr = (LAS float*)(F.lds + F.wave * 16384);
    const int gw = F.bid * NWAVES + F.wave, NGW = F.G * NWAVES;
    const int n = (j.K / 64) * (j.N / 32);
    int start = (gw - base) % NGW; if (start < 0) start += NGW;
    for (int it = start; it < n; it += NGW) cvt_item(j.src, j.K, j.N, j.dst, j.mode, scr, it, F.lane);
    base = (base + n) % NGW;
}
__device__ __forceinline__ void phase_cvt_small(const Frame& F) {
    int base = 0;
    cvt_run_job(F, CvtJob{INP(F, I_LRU_WIN), WSP(bf16_t, WS_LRU_WIN), 1024, 2560, 0}, base);
    cvt_run_job(F, CvtJob{INP(F, I_LRU_WOUT), WSP(bf16_t, WS_LRU_WOUT), 1280, 1024, 0}, base);
    cvt_run_job(F, CvtJob{INP(F, I_SGU_WIN), WSP(bf16_t, WS_SGU_WIN), 1024, 4096, 0}, base);
    cvt_run_job(F, CvtJob{INP(F, I_SGU_WOUT), WSP(bf16_t, WS_SGU_WOUT), 2048, 1024, 0}, base);
    for (int g = 0; g < 4; ++g) cvt_run_job(F, CvtJob{INP(F, I_POOL_W) + (size_t)g * 65536, WSP(bf16_t, WS_POOL_W) + (size_t)g * 65536, 256, 256, 0}, base);
    cvt_run_job(F, CvtJob{INP(F, I_NA_WQKV), WSP(bf16_t, WS_NA_WQKV), 1024, 3072, 0}, base);
    cvt_run_job(F, CvtJob{INP(F, I_NA_WO), WSP(bf16_t, WS_NA_WO), 1024, 1024, 0}, base);
    for (int l = 0; l < 2; ++l) {
        cvt_run_job(F, CvtJob{INP(F, I_FFN_W1) + (size_t)l * D * DFF, WSP(bf16_t, WS_FFN_W13) + (size_t)l * 2 * DFF * D, 1024, DFF, 1}, base);
        cvt_run_job(F, CvtJob{INP(F, I_FFN_W3) + (size_t)l * D * DFF, WSP(bf16_t, WS_FFN_W13) + (size_t)l * 2 * DFF * D, 1024, DFF, 2}, base);
        cvt_run_job(F, CvtJob{INP(F, I_FFN_W2) + (size_t)l * D * DFF, WSP(bf16_t, WS_FFN_W2) + (size_t)l * D * DFF, DFF, 1024, 0}, base);
    }
    const size_t gt = (size_t)F.bid * NTHR + F.tid, GT = (size_t)F.G * NTHR;
    { const float* wa = INP(F, I_LRU_WA); const float* wi = INP(F, I_LRU_WI); bf16_t* da = WSP(bf16_t, WS_LRU_WA); bf16_t* di = WSP(bf16_t, WS_LRU_WI);
      for (size_t i = gt; i < (size_t)16 * 160 * 160; i += GT) { const int mat = (int)(i / 25600), rem = (int)(i % 25600), n = rem / 160, k = rem % 160;
          da[i] = (bf16_t)(pk2(wa[(size_t)mat * 25600 + k * 160 + n], 0.f) & 0xffffu); di[i] = (bf16_t)(pk2(wi[(size_t)mat * 25600 + k * 160 + n], 0.f) & 0xffffu); } }
    { const float* w = INP(F, I_SGU_WS); bf16_t* d = WSP(bf16_t, WS_SGU_WS);
      for (size_t i = gt; i < (size_t)8 * 128 * 128; i += GT) d[i] = (bf16_t)(pk2(w[i], 0.f) & 0xffffu); }
}
constexpr int CVT_MOE_ITEMS = 24 * 1792;
__device__ __forceinline__ bf16_t* moe_w13(const Frame& F, int l2) { return l2 ? WSP(bf16_t, WS_BIG + BG_MW2) : WSP(bf16_t, WS_MOE_W13); }
__device__ __forceinline__ bf16_t* moe_w2(const Frame& F, int l2) { return l2 ? WSP(bf16_t, WS_BIG + BG_MW2 + 112 * MiB) : WSP(bf16_t, WS_MOE_W2); }
__device__ __forceinline__ void cvt_moe_item(const Frame& F, int l2, int g, LAS float* scr) {
    const int job = g / 1792, it = g - job * 1792, e = job / 3, which = job - 3 * e; const size_t so = ((size_t)l2 * NE + e) * D * DFF;
    if (which == 0) cvt_item(INP(F, I_MOE_W1) + so, 1024, DFF, moe_w13(F, l2) + (size_t)e * 2 * DFF * D, 1, scr, it, F.lane);
    else if (which == 1) cvt_item(INP(F, I_MOE_W3) + so, 1024, DFF, moe_w13(F, l2) + (size_t)e * 2 * DFF * D, 2, scr, it, F.lane);
    else cvt_item(INP(F, I_MOE_W2) + so, DFF, 1024, moe_w2(F, l2) + (size_t)e * D * DFF, 0, scr, it, F.lane);
}
__device__ __forceinline__ void cvt_moe_queue(const Frame& F, int l2, int g_lo, int g_hi, int qword) {
    LAS float* scr = (LAS float*)(F.lds + F.wave * 16384);
    unsigned* head = F.ctl + CW_CVTQ + 64 * qword; const int n = g_hi - g_lo;
    for (;;) {
        int base = 0; if (F.lane == 0) base = (int)atomicAdd(head, 4u); base = __builtin_amdgcn_readfirstlane(base);
        if (base >= n) break;
        for (int k = 0; k < 4 && base + k < n; ++k) cvt_moe_item(F, l2, g_lo + base + k, scr);
    }
}

__device__ __forceinline__ void phase_mod(const Frame& F) {
    LAS float* sL = (LAS float*)F.lds;
    const float* c = INP(F, I_C); const float* cc = INP(F, I_CCTX);
    for (int unit = F.bid; unit < 4 * 96; unit += F.G) {
        __syncthreads();
        for (int i = F.tid; i < 33 * 1024; i += NTHR) { const int b = i >> 10, k = i & 1023; const float v = b < 32 ? c[b * 1024 + k] : cc[k]; sL[i] = silu_f(v); }
        __syncthreads();
        const int l = unit / 96, col = (unit % 96) * 64 + F.lane, k0 = F.wave * 128;
        const float* w = INP(F, I_MODW) + (size_t)l * 1024 * MODW + col;
        float acc[33];
#pragma unroll
        for (int b = 0; b < 33; ++b) acc[b] = 0.f;
        for (int k = k0; k < k0 + 128; k += 8) {
            float wv[8];
#pragma unroll
            for (int j = 0; j < 8; ++j) wv[j] = w[(size_t)(k + j) * MODW];
#pragma unroll
            for (int b = 0; b < 33; ++b) { const f32x4 s0 = *(const LAS f32x4*)(sL + b * 1024 + k), s1 = *(const LAS f32x4*)(sL + b * 1024 + k + 4);
                acc[b] += (s0[0] * wv[0] + s0[1] * wv[1]) + (s0[2] * wv[2] + s0[3] * wv[3]) + (s1[0] * wv[4] + s1[1] * wv[5]) + (s1[2] * wv[6] + s1[3] * wv[7]); }
        }
        __syncthreads();
#pragma unroll
        for (int b = 0; b < 33; ++b) sL[(F.wave * 33 + b) * 64 + F.lane] = acc[b];
        __syncthreads();
        for (int i = F.tid; i < 33 * 64; i += NTHR) { const int b = i >> 6, cl = i & 63; float t = 0.f;
#pragma unroll
            for (int g = 0; g < 8; ++g) t += sL[(g * 33 + b) * 64 + cl];
            const int cg = (unit % 96) * 64 + cl; F.modv[((size_t)l * 33 + b) * MODW + cg] = t + INP(F, I_MODB)[l * MODW + cg]; }
    }
    __syncthreads();
}

struct NormCtx { const void* src_lat; const void* src_ctx; const float* gain; const float* mod; int which; bool f32src; };
struct NormPar { f32x4 gm[4], sh[4]; };
__device__ __forceinline__ void norm_load_par(const Frame& F, const NormCtx& N, int mb, NormPar& P) {
    const float* sh = N.mod + (size_t)mb * MODW + N.which * 3 * D; const float* sc = sh + D;
#pragma unroll
    for (int j = 0; j < 4; ++j) { const int c = 4 * F.lane + 256 * j; P.gm[j] = *(const f32x4*)(N.gain + c) * (*(const f32x4*)(sc + c) + 1.0f); P.sh[j] = *(const f32x4*)(sh + c); }
}
__device__ __forceinline__ void norm_load_row(const Frame& F, const NormCtx& N, int r, f32x4 (&v)[4]) {
    const size_t ro = (size_t)(r < RL ? r : r - RL) * D; const void* sp = r < RL ? N.src_lat : N.src_ctx;
#pragma unroll
    for (int j = 0; j < 4; ++j) {
        if (N.f32src) v[j] = *(const f32x4*)((const float*)sp + ro + 4 * F.lane + 256 * j);
        else { const u32x2 q = *(const u32x2*)((const bf16_t*)sp + ro + 4 * F.lane + 256 * j); v[j] = (f32x4){lo_bf(q.x), hi_bf(q.x), lo_bf(q.y), hi_bf(q.y)}; } }
}
__device__ __forceinline__ void norm_finish(const NormPar& P, const f32x4 (&v)[4], f32x4 (&y)[4]) {
    float ss = 0.f;
#pragma unroll
    for (int j = 0; j < 4; ++j) ss += (v[j][0] * v[j][0] + v[j][1] * v[j][1]) + (v[j][2] * v[j][2] + v[j][3] * v[j][3]);
    const float rstd = 1.0f / sqrtf(wave_sum(ss) * (1.0f / D) + NORM_EPS);
#pragma unroll
    for (int j = 0; j < 4; ++j) y[j] = (v[j] * rstd) * P.gm[j] + P.sh[j];
}
__device__ __forceinline__ void store_row_bf16(const Frame& F, bf16_t* dst, const f32x4 (&y)[4]) {
#pragma unroll
    for (int j = 0; j < 4; ++j) { u32x2 w; w.x = pk2(y[j][0], y[j][1]); w.y = pk2(y[j][2], y[j][3]); *(u32x2*)(dst + 4 * F.lane + 256 * j) = w; }
}
__device__ __forceinline__ void phase_norm(const Frame& F, const NormCtx& N, int nrows) {
    const int gw = F.bid * NWAVES + F.wave, NGW = F.G * NWAVES, RPW = (nrows + NGW - 1) / NGW, r0 = gw * RPW, r1 = min(nrows, r0 + RPW);
    if (r0 >= r1) return;
    NormPar P; int mbcur = -1; f32x4 v[4], vn[4];
    norm_load_row(F, N, r0, v);
    for (int r = r0; r < r1; ++r) {
        if (r + 1 < r1) norm_load_row(F, N, r + 1, vn);
        const int mb = r < RL ? (r >> 11) : 32; if (mb != mbcur) { norm_load_par(F, N, mb, P); mbcur = mb; }
        f32x4 y[4]; norm_finish(P, v, y); store_row_bf16(F, F.U + (size_t)r * D, y);
#pragma unroll
        for (int j = 0; j < 4; ++j) v[j] = vn[j];
    }
}
__device__ __forceinline__ void route_top2(const Frame& F, float (&lg)[NE], const float* br, int& e0, int& e1, float& w0) {
    const bool h5 = F.lane & 32, h4 = F.lane & 16, h3 = F.lane & 8;
    float a4[4];
#pragma unroll
    for (int k = 0; k < 4; ++k) { const float mine = h5 ? lg[4 + k] : lg[k], send = h5 ? lg[k] : lg[4 + k]; a4[k] = mine + __shfl_xor(send, 32); }
    float a2[2];
#pragma unroll
    for (int k = 0; k < 2; ++k) { const float mine = h4 ? a4[2 + k] : a4[k], send = h4 ? a4[k] : a4[2 + k]; a2[k] = mine + __shfl_xor(send, 16); }
    float a1; { const float mine = h3 ? a2[1] : a2[0], send = h3 ? a2[0] : a2[1]; a1 = mine + __shfl_xor(send, 8); }
    a1 += __shfl_xor(a1, 4); a1 += __shfl_xor(a1, 2); a1 += __shfl_xor(a1, 1);
#pragma unroll
    for (int e = 0; e < NE; ++e) lg[e] = __int_as_float(__builtin_amdgcn_readlane(__float_as_int(a1), ((e >> 2) & 1) * 32 + ((e >> 1) & 1) * 16 + (e & 1) * 8)) + br[e];
    e0 = 0; float v0 = lg[0];
#pragma unroll
    for (int e = 1; e < NE; ++e) if (lg[e] > v0) { v0 = lg[e]; e0 = e; }
    e1 = -1; float v1 = -3.0e38f;
#pragma unroll
    for (int e = 0; e < NE; ++e) if (e != e0 && lg[e] > v1) { v1 = lg[e]; e1 = e; }
    w0 = 1.0f / (1.0f + __expf(v1 - v0));
}
__device__ __forceinline__ void phase_route(const Frame& F, const NormCtx& N, int nrows, int l2) {
    LAS float* wrL = (LAS float*)F.lds;
    LAS unsigned* hist = (LAS unsigned*)(F.lds + 32768);
    __syncthreads();
    const float* wr = INP(F, I_MOE_WR) + (size_t)l2 * D * NE; const float* br = INP(F, I_MOE_BR) + l2 * NE;
    for (int i = F.tid; i < D * NE; i += NTHR) wrL[(i & 7) * D + (i >> 3)] = wr[i];
    if (F.tid < 16) hist[F.tid] = 0u;
    __syncthreads();
    int* re = WSP(int, WS_ROUTE + RT_E); float* rw = WSP(float, WS_ROUTE + RT_W);
    const int gw = F.bid * NWAVES + F.wave, NGW = F.G * NWAVES, RPW = (nrows + NGW - 1) / NGW, r0 = gw * RPW, r1 = min(nrows, r0 + RPW);
    NormPar P; int mbcur = -1; f32x4 va[4], vb[4];
    for (int r = r0; r < r1; r += 2) {
        const bool two = r + 1 < r1; const int rb = two ? r + 1 : r;
        norm_load_row(F, N, r, va); norm_load_row(F, N, rb, vb);
        f32x4 ya[4], yb[4];
        { const int mb = r < RL ? (r >> 11) : 32; if (mb != mbcur) { norm_load_par(F, N, mb, P); mbcur = mb; } norm_finish(P, va, ya); store_row_bf16(F, F.U + (size_t)r * D, ya); }
        { const int mb = rb < RL ? (rb >> 11) : 32; if (mb != mbcur) { norm_load_par(F, N, mb, P); mbcur = mb; } norm_finish(P, vb, yb); if (two) store_row_bf16(F, F.U + (size_t)rb * D, yb); }
        float la[NE], lb[NE];
#pragma unroll
        for (int e = 0; e < NE; ++e) { la[e] = 0.f; lb[e] = 0.f; }
#pragma unroll
        for (int j = 0; j < 4; ++j)
#pragma unroll
            for (int e = 0; e < NE; ++e) { const f32x4 wv = *(const LAS f32x4*)(wrL + e * D + 4 * F.lane + 256 * j);
                la[e] += (ya[j][0] * wv[0] + ya[j][1] * wv[1]) + (ya[j][2] * wv[2] + ya[j][3] * wv[3]); lb[e] += (yb[j][0] * wv[0] + yb[j][1] * wv[1]) + (yb[j][2] * wv[2] + yb[j][3] * wv[3]); }
        int e0, e1; float w0;
        route_top2(F, la, br, e0, e1, w0);
        if (F.lane == 0) { re[r] = e0 | (e1 << 8); rw[2 * r] = w0; rw[2 * r + 1] = 1.0f - w0; lds_add(&hist[e0], 1u); lds_add(&hist[8 + e1], 1u); }
        route_top2(F, lb, br, e0, e1, w0);
        if (F.lane == 0 && two) { re[rb] = e0 | (e1 << 8); rw[2 * rb] = w0; rw[2 * rb + 1] = 1.0f - w0; lds_add(&hist[e0], 1u); lds_add(&hist[8 + e1], 1u); }
    }
    __syncthreads();
    if (F.tid < 16 && hist[F.tid]) atomicAdd(F.ctl + CW_CNT + 64 * l2 + F.tid, hist[F.tid]);
    int* tok = WSP(int, WS_ROUTE + RT_TOK);
    for (size_t i = (size_t)F.bid * NTHR + F.tid; i < (size_t)2 * MPAD; i += (size_t)F.G * NTHR) tok[i] = -1;
    __syncthreads();
}
__device__ __forceinline__ int pad256(int x) { return (x + 255) & ~255; }
__device__ __forceinline__ void phase_assign_scatter0(const Frame& F, int nrows, int l2) {
    LAS unsigned* bcnt = (LAS unsigned*)F.lds;
    LAS unsigned* bbase = (LAS unsigned*)(F.lds + 64);
    __syncthreads();
    if (F.tid < 16) bcnt[F.tid] = 0u;
    __syncthreads();
    const int RPB = (nrows + F.G - 1) / F.G, rb0 = F.bid * RPB, rb1 = min(nrows, rb0 + RPB);
    const int* re = WSP(const int, WS_ROUTE + RT_E); const float* rw = WSP(const float, WS_ROUTE + RT_W);
    int* tok = WSP(int, WS_ROUTE + RT_TOK); float* gwl = WSP(float, WS_ROUTE + RT_GW); int* pos1 = WSP(int, WS_ROUTE + RT_P1);
    const int myr = rb0 + F.wave + 8 * F.lane; const bool have = myr < rb1;
    int e0 = 0, e1 = 0; unsigned li0 = 0, li1 = 0; float w0 = 0.f, w1 = 0.f;
    if (have) { const int ee = re[myr]; e0 = ee & 255; e1 = (ee >> 8) & 255; w0 = rw[2 * myr]; w1 = rw[2 * myr + 1]; li0 = lds_add(&bcnt[e0], 1u); li1 = lds_add(&bcnt[8 + e1], 1u); }
    __syncthreads();
    const unsigned* cnt = F.ctl + CW_CNT + 64 * l2;
    if (F.tid < 16) { const int s = F.tid >> 3, e = F.tid & 7; unsigned off = 0; for (int k = 0; k < e; ++k) off += (unsigned)pad256((int)cnt[s * 8 + k]);
        unsigned b = 0; if (bcnt[F.tid]) b = atomicAdd(F.ctl + CW_CUR + 64 * l2 + F.tid, bcnt[F.tid]); bbase[F.tid] = off + b; }
    __syncthreads();
    const int p0 = (int)(bbase[e0] + li0), p1 = (int)(bbase[8 + e1] + li1);
    if (have) { tok[p0] = myr; gwl[p0] = w0; tok[MPAD + p1] = myr; gwl[MPAD + p1] = w1; pos1[myr] = p1; }
    __syncthreads();
}
__device__ __forceinline__ int moe_tile_table(const Frame& F, int l2, int s, LAS int* tstart) {
    __syncthreads();
    if (F.tid == 0) { const unsigned* cnt = F.ctl + CW_CNT + 64 * l2 + 8 * s; int t = 0; for (int e = 0; e < NE; ++e) { tstart[e] = t; t += pad256((int)cnt[e]) >> 8; } tstart[8] = t; }
    __syncthreads();
    return tstart[8];
}

constexpr int SC_RS = 164;
__device__ __forceinline__ void scan_conv_load(const bf16_t* XG, size_t rowbase, int L, int t0, int ch0, int pt, u32x2 (&xr)[11]) {
    const int q4 = pt % 40, rg = pt / 40, ch = ch0 + 4 * q4, ta = t0 + 8 * rg;
#pragma unroll
    for (int i = 0; i < 11; ++i) { const int tp = ta - 2 + i; xr[i] = (tp >= 0 && tp < L) ? *(const u32x2*)(XG + (rowbase + tp) * 2560 + ch) : (u32x2){0u, 0u}; }
}
__device__ __forceinline__ void scan_conv_math(const float* cw, const float* cb, LAS bf16_t* xc, int ch0, int pt, const u32x2 (&xr)[11]) {
    const int q4 = pt % 40, rg = pt / 40, ch = ch0 + 4 * q4;
    const f32x4 bias = *(const f32x4*)(cb + ch); f32x4 wv[4];
#pragma unroll
    for (int k = 0; k < 4; ++k) wv[k] = *(const f32x4*)(cw + k * DRNN + ch);
#pragma unroll
    for (int i = 0; i < 8; ++i) { f32x4 acc = bias;
#pragma unroll
        for (int k = 0; k < 4; ++k) { const u32x2 x = xr[i + k]; acc[0] += lo_bf(x.x) * wv[k][0]; acc[1] += hi_bf(x.x) * wv[k][1]; acc[2] += lo_bf(x.y) * wv[k][2]; acc[3] += hi_bf(x.y) * wv[k][3]; }
        u32x2 o; o.x = pk2(acc[0], acc[1]); o.y = pk2(acc[2], acc[3]); *(LAS u32x2*)(xc + (8 * rg + i) * 168 + 4 * q4) = o; }
}
__device__ __forceinline__ void phase_scan(const Frame& F, bool need_ctx) {
    LAS bf16_t* xcA0 = (LAS bf16_t*)F.lds;
    LAS float* Ra = (LAS float*)(F.lds + 43008);
    LAS float* Ri = (LAS float*)(F.lds + 43008 + 41984);
    LAS float* tab = (LAS float*)(F.lds + 43008 + 2 * 41984);
    LAS bf16_t* Hb = (LAS bf16_t*)(F.lds + 43008 + 2 * 41984 + 2048);
    const bf16_t* XG = WSP(const bf16_t, WS_BIG + BG_XG); bf16_t* Y = WSP(bf16_t, WS_BIG + BG_Y);
    const float* cw = INP(F, I_LRU_CW); const float* cb = INP(F, I_LRU_CB);
    const int fr = F.lane & 15, fq = F.lane >> 4, w = F.wave;
    const int ntA = w, ntB = 8 + (w & 1), mtB = w >> 1;
    for (int unit = F.bid; unit < NB * 8; unit += F.G) {
        const int b = unit >> 3, kb = unit & 7, ch0 = kb * LBW;
        for (int d = 0; d < 2; ++d) {
            float carry = 0.f;
            bf16x8 Ba[5], Bi[5];
            __syncthreads();
            const bf16_t* wa = WSP(const bf16_t, WS_LRU_WA) + (size_t)(d * 8 + kb) * 25600; const bf16_t* wi = WSP(const bf16_t, WS_LRU_WI) + (size_t)(d * 8 + kb) * 25600;
#pragma unroll
            for (int ks = 0; ks < 5; ++ks) { Ba[ks] = *(const bf16x8*)(wa + (16 * ntA + fr) * 160 + 32 * ks + 8 * fq); Bi[ks] = *(const bf16x8*)(wi + (16 * ntA + fr) * 160 + 32 * ks + 8 * fq); }
            if (F.tid < LBW) { const int c = ch0 + F.tid; tab[F.tid] = INP(F, I_LRU_BA)[d * DRNN + c]; tab[160 + F.tid] = INP(F, I_LRU_BI)[d * DRNN + c];
                const float lam = INP(F, I_LRU_LAM)[d * DRNN + c]; tab[320 + F.tid] = 8.0f * 1.4426950408889634f * (lam > 0.f ? log1pf(expf(-lam)) : (-lam + log1pf(expf(lam)))); }
            if (F.tid >= 192) { u32x2 xr[11]; scan_conv_load(XG, (size_t)RL + (size_t)b * CTXL, CTXL, d ? CTXL - 64 : 0, ch0, F.tid - 192, xr); scan_conv_math(cw, cb, xcA0, ch0, F.tid - 192, xr); }
            __syncthreads();
            for (int cidx = 0; cidx <= 36; ++cidx) {
                const int seg = cidx >= 4, ci = seg ? cidx - 4 : cidx, L = seg ? SEQ : CTXL; const size_t rowbase = seg ? (size_t)b * SEQ : (size_t)RL + (size_t)b * CTXL;
                const int t0 = d ? L - 64 * (ci + 1) : 64 * ci;
                LAS bf16_t* xc = xcA0 + (cidx & 1) * (64 * 168);
                const int pc = cidx - 1; const int pseg = pc >= 4, pci = pseg ? pc - 4 : pc, pL = pseg ? SEQ : CTXL; const size_t prow = pseg ? (size_t)b * SEQ : (size_t)RL + (size_t)b * CTXL;
                const int pt0 = d ? pL - 64 * (pci + 1) : 64 * pci; const bool p_out = pc >= 0 && (pseg == 1 || need_ctx);
                u32x2 pv[5], gv[5];
#pragma unroll
                for (int it = 0; it < 5; ++it) { const int e = F.tid + NTHR * it, tt = e / 40, c4 = e % 40;
                    if (d == 1 && p_out) { const size_t row = prow + pt0 + tt; pv[it] = *(const u32x2*)(Y + row * DRNN + ch0 + 4 * c4); gv[it] = *(const u32x2*)(XG + row * 2560 + DRNN + ch0 + 4 * c4); } else { pv[it] = (u32x2){0u, 0u}; gv[it] = (u32x2){0u, 0u}; } }
                if (cidx < 36) {
                    bf16x8 Xa[5], Xi[5];
#pragma unroll
                    for (int ks = 0; ks < 5; ++ks) { Xa[ks] = *(const bf16x8*)(wa + (16 * ntB + fr) * 160 + 32 * ks + 8 * fq); Xi[ks] = *(const bf16x8*)(wi + (16 * ntB + fr) * 160 + 32 * ks + 8 * fq); }
#pragma unroll 1
                    for (int mt = 0; mt < 4; ++mt) {
                        f32x4 ra = {0.f, 0.f, 0.f, 0.f}, ri = {0.f, 0.f, 0.f, 0.f};
#pragma unroll
                        for (int ks = 0; ks < 5; ++ks) { const bf16x8 a = *(const LAS bf16x8*)(xc + (16 * mt + fr) * 168 + 32 * ks + 8 * fq);
                            ra = __builtin_amdgcn_mfma_f32_16x16x32_bf16(Ba[ks], a, ra, 0, 0, 0); ri = __builtin_amdgcn_mfma_f32_16x16x32_bf16(Bi[ks], a, ri, 0, 0, 0); }
                        const int o = (16 * mt + fr) * SC_RS + 16 * ntA + 4 * fq; *(LAS f32x4*)(Ra + o) = ra; *(LAS f32x4*)(Ri + o) = ri;
                    }
                    {
                        f32x4 ra = {0.f, 0.f, 0.f, 0.f}, ri = {0.f, 0.f, 0.f, 0.f};
#pragma unroll
                        for (int ks = 0; ks < 5; ++ks) { const bf16x8 a = *(const LAS bf16x8*)(xc + (16 * mtB + fr) * 168 + 32 * ks + 8 * fq);
                            ra = __builtin_amdgcn_mfma_f32_16x16x32_bf16(Xa[ks], a, ra, 0, 0, 0); ri = __builtin_amdgcn_mfma_f32_16x16x32_bf16(Xi[ks], a, ri, 0, 0, 0); }
                        const int o = (16 * mtB + fr) * SC_RS + 16 * ntB + 4 * fq; *(LAS f32x4*)(Ra + o) = ra; *(LAS f32x4*)(Ri + o) = ri;
                    }
                }
                if (p_out) {
#pragma unroll
                    for (int it = 0; it < 5; ++it) { const int e = F.tid + NTHR * it, tt = e / 40, c4 = e % 40; const u32x2 hb = *(const LAS u32x2*)(Hb + tt * 168 + 4 * c4);
                        u32x2* yp = (u32x2*)(Y + (prow + pt0 + tt) * DRNN + ch0 + 4 * c4); u32x2 o;
                        if (d == 0) o = hb;
                        else { o.x = pk2((lo_bf(pv[it].x) + lo_bf(hb.x)) * gelu_tanh_f(lo_bf(gv[it].x)), (hi_bf(pv[it].x) + hi_bf(hb.x)) * gelu_tanh_f(hi_bf(gv[it].x)));
                               o.y = pk2((lo_bf(pv[it].y) + lo_bf(hb.y)) * gelu_tanh_f(lo_bf(gv[it].y)), (hi_bf(pv[it].y) + hi_bf(hb.y)) * gelu_tanh_f(hi_bf(gv[it].y))); }
                        *yp = o; }
                }
                if (cidx == 36) break;
                __syncthreads();
                const bool do_conv = F.tid >= 192 && cidx + 1 < 36;
                u32x2 xr[11];
                if (do_conv) { const int nseg = (cidx + 1) >= 4, nci = nseg ? cidx + 1 - 4 : cidx + 1, nL = nseg ? SEQ : CTXL;
                    scan_conv_load(XG, nseg ? (size_t)b * SEQ : (size_t)RL + (size_t)b * CTXL, nL, d ? nL - 64 * (nci + 1) : 64 * nci, ch0, F.tid - 192, xr); }
#pragma unroll 1
                for (int it = 0; it < 5; ++it) { const int e = F.tid + NTHR * it, tt = e / 40, c4 = e % 40; const int o = tt * SC_RS + 4 * c4;
                    const f32x4 va = *(const LAS f32x4*)(Ra + o) + *(const LAS f32x4*)(tab + 4 * c4), vi = *(const LAS f32x4*)(Ri + o) + *(const LAS f32x4*)(tab + 160 + 4 * c4), sp = *(const LAS f32x4*)(tab + 320 + 4 * c4);
                    const u32x2 xv = *(const LAS u32x2*)(xc + tt * 168 + 4 * c4); const float xf[4] = {lo_bf(xv.x), hi_bf(xv.x), lo_bf(xv.y), hi_bf(xv.y)};
                    f32x4 av, bv;
#pragma unroll
                    for (int j = 0; j < 4; ++j) { const float r = __builtin_amdgcn_rcpf(1.0f + __builtin_amdgcn_exp2f(-1.4426950408889634f * va[j])), ig = __builtin_amdgcn_rcpf(1.0f + __builtin_amdgcn_exp2f(-1.4426950408889634f * vi[j]));
                        const float a = __builtin_amdgcn_exp2f(-r * sp[j]); av[j] = a; bv[j] = __builtin_amdgcn_sqrtf(fmaxf(1.0f - a * a, 0.f)) * (ig * xf[j]); }
                    *(LAS f32x4*)(Ra + o) = av; *(LAS f32x4*)(Ri + o) = bv; }
                __syncthreads();
                if (F.tid < LBW) { float h = carry;
#pragma unroll 1
                    for (int s0 = 0; s0 < 64; s0 += 16) {
                        float av[16], bv[16], hv[16];
#pragma unroll
                        for (int k = 0; k < 16; ++k) { const int tt = d ? 63 - (s0 + k) : s0 + k; av[k] = Ra[tt * SC_RS + F.tid]; bv[k] = Ri[tt * SC_RS + F.tid]; }
#pragma unroll
                        for (int k = 0; k < 16; ++k) { h = av[k] * h + bv[k]; hv[k] = h; }
#pragma unroll
                        for (int k = 0; k < 16; ++k) { const int tt = d ? 63 - (s0 + k) : s0 + k; Hb[tt * 168 + F.tid] = (bf16_t)(pk2(hv[k], 0.f) & 0xffffu); }
                    }
                    carry = h; }
                else if (do_conv) scan_conv_math(cw, cb, xcA0 + ((cidx + 1) & 1) * (64 * 168), ch0, F.tid - 192, xr);
                __syncthreads();
            }
        }
    }
}

__device__ __forceinline__ void phase_sgu_stats(const Frame& F) {
    const bf16_t* Z = WSP(const bf16_t, WS_BIG + BG_Z); float* st = WSP(float, WS_ROUTE + RT_ST);
    const int gw = F.bid * NWAVES + F.wave, NGW = F.G * NWAVES, RPW = (RA + NGW - 1) / NGW, r0 = gw * RPW, r1 = min(RA, r0 + RPW);
    if (r0 >= r1) return;
    u32x4 q[4], qn[4];
#pragma unroll
    for (int j = 0; j < 4; ++j) q[j] = *(const u32x4*)(Z + (size_t)r0 * 4096 + DSGU + 8 * F.lane + 512 * j);
    for (int r = r0; r < r1; ++r) {
        if (r + 1 < r1) {
#pragma unroll
            for (int j = 0; j < 4; ++j) qn[j] = *(const u32x4*)(Z + (size_t)(r + 1) * 4096 + DSGU + 8 * F.lane + 512 * j); }
        float x[32]; float s = 0.f;
#pragma unroll
        for (int j = 0; j < 4; ++j) { x[8 * j + 0] = lo_bf(q[j].x); x[8 * j + 1] = hi_bf(q[j].x); x[8 * j + 2] = lo_bf(q[j].y); x[8 * j + 3] = hi_bf(q[j].y); x[8 * j + 4] = lo_bf(q[j].z); x[8 * j + 5] = hi_bf(q[j].z); x[8 * j + 6] = lo_bf(q[j].w); x[8 * j + 7] = hi_bf(q[j].w); }
#pragma unroll
        for (int i = 0; i < 32; ++i) s += x[i];
        const float mean = wave_sum(s) * (1.0f / DSGU); float q2 = 0.f;
#pragma unroll
        for (int i = 0; i < 32; ++i) { const float dlt = x[i] - mean; q2 += dlt * dlt; }
        const float rstd = 1.0f / sqrtf(wave_sum(q2) * (1.0f / DSGU) + NORM_EPS);
        if (F.lane == 0) { st[2 * r] = mean; st[2 * r + 1] = rstd; }
#pragma unroll
        for (int j = 0; j < 4; ++j) q[j] = qn[j];
    }
}
__device__ __forceinline__ size_t sgu_row0(int cu) { return cu < 512 ? (size_t)(cu >> 4) * SEQ + (size_t)(cu & 15) * 128 : (size_t)RL + (size_t)((cu - 512) >> 1) * CTXL + (size_t)((cu - 512) & 1) * 128; }
__device__ __forceinline__ void phase_sgu_spatial(const Frame& F) {
    LAS bf16_t* vT = (LAS bf16_t*)F.lds;
    LAS bf16_t* uT = (LAS bf16_t*)(F.lds + 69632);
    bf16_t* Z = WSP(bf16_t, WS_BIG + BG_Z); const float* st = WSP(const float, WS_ROUTE + RT_ST);
    const bf16_t* wsb = WSP(const bf16_t, WS_SGU_WS);
    const float* lng = INP(F, I_SGU_LNG); const float* lnb = INP(F, I_SGU_LNB); const float* bs = INP(F, I_SGU_BS);
    const int fr = F.lane & 15, fq = F.lane >> 4, w = F.wave;
    const int q8 = F.tid & 15, d8 = F.tid >> 4;
    const int urow = F.tid >> 5, uch = F.tid & 31;
    u32x4 vq[8], uq[8]; f32x2 sq[8];
    int unit = F.bid;
    if (unit < 576 * 8) { const int cu = unit >> 3, g = unit & 7; const size_t row0 = sgu_row0(cu);
#pragma unroll
        for (int i = 0; i < 8; ++i) { const size_t r = row0 + 8 * q8 + i; vq[i] = *(const u32x4*)(Z + r * 4096 + DSGU + 256 * g + 8 * d8); sq[i] = *(const f32x2*)(st + 2 * r);
            uq[i] = *(const u32x4*)(Z + (row0 + urow + 16 * i) * 4096 + 256 * g + 8 * uch); } }
    for (; unit < 576 * 8; unit += F.G) {
        const int cu = unit >> 3, g = unit & 7; const size_t row0 = sgu_row0(cu);
        {
            const int dcol = 256 * g + 8 * d8; float gg[8], bb[8];
#pragma unroll
            for (int j = 0; j < 8; ++j) { gg[j] = lng[dcol + j]; bb[j] = lnb[dcol + j]; }
            float x[8][8];
#pragma unroll
            for (int i = 0; i < 8; ++i) { const u32x4 q = vq[i]; const float mean = sq[i][0], rstd = sq[i][1];
                const float raw[8] = {lo_bf(q.x), hi_bf(q.x), lo_bf(q.y), hi_bf(q.y), lo_bf(q.z), hi_bf(q.z), lo_bf(q.w), hi_bf(q.w)};
#pragma unroll
                for (int j = 0; j < 8; ++j) x[i][j] = (raw[j] - mean) * rstd * gg[j] + bb[j]; }
#pragma unroll
            for (int j = 0; j < 8; ++j) { u32x4 o; o.x = pk2(x[0][j], x[1][j]); o.y = pk2(x[2][j], x[3][j]); o.z = pk2(x[4][j], x[5][j]); o.w = pk2(x[6][j], x[7][j]);
                *(LAS u32x4*)(vT + (8 * d8 + j) * 136 + 8 * q8) = o; }
#pragma unroll
            for (int i = 0; i < 8; ++i) *(LAS u32x4*)(uT + (urow + 16 * i) * 264 + 8 * uch) = uq[i];
        }
        __syncthreads();
        {
            const int nu = unit + F.G;
            if (nu < 576 * 8) { const int ncu = nu >> 3, ng = nu & 7; const size_t nrow0 = sgu_row0(ncu);
#pragma unroll
                for (int i = 0; i < 8; ++i) { const size_t r = nrow0 + 8 * q8 + i; vq[i] = *(const u32x4*)(Z + r * 4096 + DSGU + 256 * ng + 8 * d8); sq[i] = *(const f32x2*)(st + 2 * r);
                    uq[i] = *(const u32x4*)(Z + (nrow0 + urow + 16 * i) * 4096 + 256 * ng + 8 * uch); } }
            const int p = 16 * w + fr; LAS u32x2* urow_l = (LAS u32x2*)(uT + p * 264 + 4 * fq);
            bf16x8 af[4];
#pragma unroll
            for (int ks = 0; ks < 4; ++ks) af[ks] = *(const bf16x8*)(wsb + ((size_t)g * 128 + p) * 128 + 32 * ks + 8 * fq);
            const float bias = bs[g * 128 + p];
#pragma unroll 4
            for (int nt = 0; nt < 16; ++nt) { f32x4 acc = {0.f, 0.f, 0.f, 0.f};
#pragma unroll
                for (int ks = 0; ks < 4; ++ks) { const bf16x8 bfv = *(const LAS bf16x8*)(vT + (16 * nt + fr) * 136 + 32 * ks + 8 * fq); acc = __builtin_amdgcn_mfma_f32_16x16x32_bf16(bfv, af[ks], acc, 0, 0, 0); }
                const u32x2 u2 = urow_l[4 * nt]; u32x2 o; o.x = pk2(lo_bf(u2.x) * (acc[0] + bias), hi_bf(u2.x) * (acc[1] + bias)); o.y = pk2(lo_bf(u2.y) * (acc[2] + bias), hi_bf(u2.y) * (acc[3] + bias)); urow_l[4 * nt] = o; }
        }
        __syncthreads();
#pragma unroll
        for (int i = 0; i < 8; ++i) *(u32x4*)(Z + (row0 + urow + 16 * i) * 4096 + 256 * g + 8 * uch) = *(const LAS u32x4*)(uT + (urow + 16 * i) * 264 + 8 * uch);
        __syncthreads();
    }
}

template <int WN> __device__ __forceinline__ void pool_item(const bf16_t* U, bf16_t* PD, int r, int cg) {
    int t, L; size_t base; if (r < RL) { t = r & (SEQ - 1); L = SEQ; base = (size_t)(r - t); } else { t = (r - RL) & (CTXL - 1); L = CTXL; base = (size_t)(r - t); }
    const int lo = max(t - WN / 2, 0), hi = min(t + WN / 2 - 1, L - 1);
    u32x4 v[WN];
#pragma unroll
    for (int k = 0; k < WN; ++k) { const int q = min(max(t - WN / 2 + k, 0), L - 1); v[k] = *(const u32x4*)(U + (base + q) * D + 8 * cg); }
    float s[8] = {0.f, 0.f, 0.f, 0.f, 0.f, 0.f, 0.f, 0.f};
#pragma unroll
    for (int k = 0; k < WN; ++k) { const int q = t - WN / 2 + k; const float m = (q >= lo && q <= hi) ? 1.f : 0.f;
        s[0] += m * lo_bf(v[k].x); s[1] += m * hi_bf(v[k].x); s[2] += m * lo_bf(v[k].y); s[3] += m * hi_bf(v[k].y); s[4] += m * lo_bf(v[k].z); s[5] += m * hi_bf(v[k].z); s[6] += m * lo_bf(v[k].w); s[7] += m * hi_bf(v[k].w); }
    const u32x4 sv = v[WN / 2];
    const float inv = 1.0f / (float)(hi - lo + 1);
    u32x4 o; o.x = pk2(s[0] * inv - lo_bf(sv.x), s[1] * inv - hi_bf(sv.x)); o.y = pk2(s[2] * inv - lo_bf(sv.y), s[3] * inv - hi_bf(sv.y));
    o.z = pk2(s[4] * inv - lo_bf(sv.z), s[5] * inv - hi_bf(sv.z)); o.w = pk2(s[6] * inv - lo_bf(sv.w), s[7] * inv - hi_bf(sv.w));
    *(u32x4*)(PD + (size_t)r * D + 8 * cg) = o;
}
__device__ __forceinline__ void phase_pool_diff(const Frame& F) {
    bf16_t* PD = WSP(bf16_t, WS_BIG + BG_PD);
    const size_t T0 = (size_t)F.bid * NTHR + F.tid, TS = (size_t)F.G * NTHR, NI = (size_t)RA * 32;
#define POOL_LOOP(g_, WN_, K_) for (size_t i = T0; i < NI; i += K_ * TS) { _Pragma("unroll") for (int k_ = 0; k_ < K_; ++k_) { const size_t ii = i + k_ * TS; if (ii < NI) pool_item<WN_>(F.U, PD, (int)(ii >> 5), 32 * g_ + (int)(ii & 31)); } }
    POOL_LOOP(0, 2, 8) POOL_LOOP(1, 4, 4) POOL_LOOP(2, 8, 2) POOL_LOOP(3, 16, 1)
#undef POOL_LOOP
}

__device__ __forceinline__ void phase_na(const Frame& F) {
    const bf16_t* QKV = WSP(const bf16_t, WS_BIG + BG_QKV); bf16_t* O = WSP(bf16_t, WS_BIG + BG_O); const float* rpb = INP(F, I_NA_RPB);
    const int w = F.wave, rsub = w >> 1, chh = w & 1, fr = F.lane & 15, fq = F.lane >> 4;
    const int skey = F.tid >> 3, sd8 = F.tid & 7;
    LAS float* bt = (LAS float*)(F.lds + 36864);
    const unsigned trl = (unsigned)((fr >> 2) * 144 + (fr & 3) * 8);
    float kgain[8];
#pragma unroll
    for (int j = 0; j < 8; ++j) kgain[j] = INP(F, I_NA_KG)[8 * sd8 + j];
#define NA_KNORM(kr) do { float x_[8] = {lo_bf(kr.x), hi_bf(kr.x), lo_bf(kr.y), hi_bf(kr.y), lo_bf(kr.z), hi_bf(kr.z), lo_bf(kr.w), hi_bf(kr.w)}; float ss_ = 0.f; \
        _Pragma("unroll") for (int j_ = 0; j_ < 8; ++j_) ss_ += x_[j_] * x_[j_]; \
        ss_ += dpp_f<0xB1>(ss_); ss_ += dpp_f<0x4E>(ss_); ss_ += dpp_f<0x141>(ss_); \
        const float rs_ = __builtin_amdgcn_rsqf(ss_ * (1.0f / 64.0f) + NORM_EPS); \
        kr.x = pk2(x_[0] * rs_ * kgain[0], x_[1] * rs_ * kgain[1]); kr.y = pk2(x_[2] * rs_ * kgain[2], x_[3] * rs_ * kgain[3]); \
        kr.z = pk2(x_[4] * rs_ * kgain[4], x_[5] * rs_ * kgain[5]); kr.w = pk2(x_[6] * rs_ * kgain[6], x_[7] * rs_ * kgain[7]); } while (0)
    float gqm = 0.f, gkm = 0.f; for (int i = 0; i < 64; ++i) { gqm = fmaxf(gqm, fabsf(INP(F, I_NA_QG)[i])); gkm = fmaxf(gkm, fabsf(INP(F, I_NA_KG)[i])); }
    const float M0 = 8.0f * gqm * gkm * 1.4426950408889634f;
    for (int unit = F.bid; unit < NB * 16 * 8; unit += F.G) {
        const int rg = unit & 7, h = (unit >> 3) & 15, b = unit >> 7;
        const int r = 4 * rg + rsub, r0 = min(max(r - 4, 0), 24);
        const int ulo = min(max(4 * rg - 4, 0), 24), uhi = min(max(4 * rg - 1, 0), 24) + 8, nnb = uhi - ulo, ntile = nnb + 4;
        bf16x8 qf[2][2]; size_t qrow[2];
#pragma unroll
        for (int qt = 0; qt < 2; ++qt) { qrow[qt] = (size_t)b * SEQ + (size_t)r * 64 + 32 * chh + 16 * qt + fr;
            u32x4 raw[2]; float xv[2][8]; float ss = 0.f;
#pragma unroll
            for (int ks = 0; ks < 2; ++ks) { raw[ks] = *(const u32x4*)(QKV + qrow[qt] * 3072 + h * 64 + 32 * ks + 8 * fq);
                xv[ks][0] = lo_bf(raw[ks].x); xv[ks][1] = hi_bf(raw[ks].x); xv[ks][2] = lo_bf(raw[ks].y); xv[ks][3] = hi_bf(raw[ks].y); xv[ks][4] = lo_bf(raw[ks].z); xv[ks][5] = hi_bf(raw[ks].z); xv[ks][6] = lo_bf(raw[ks].w); xv[ks][7] = hi_bf(raw[ks].w);
#pragma unroll
                for (int j = 0; j < 8; ++j) ss += xv[ks][j] * xv[ks][j]; }
            ss += __shfl_xor(ss, 16); ss += __shfl_xor(ss, 32);
            const float rs = __builtin_amdgcn_rsqf(ss * (1.0f / 64.0f) + NORM_EPS) * (0.125f * 1.4426950408889634f);
#pragma unroll
            for (int ks = 0; ks < 2; ++ks) { const float* gq = INP(F, I_NA_QG) + 32 * ks + 8 * fq; u32x4 pw;
                pw.x = pk2(xv[ks][0] * rs * gq[0], xv[ks][1] * rs * gq[1]); pw.y = pk2(xv[ks][2] * rs * gq[2], xv[ks][3] * rs * gq[3]); pw.z = pk2(xv[ks][4] * rs * gq[4], xv[ks][5] * rs * gq[5]); pw.w = pk2(xv[ks][6] * rs * gq[6], xv[ks][7] * rs * gq[7]);
                qf[qt][ks] = __builtin_bit_cast(bf16x8, pw); } }
        f32x4 o[2][4]; float lrun[2] = {0.f, 0.f};
#pragma unroll
        for (int qt = 0; qt < 2; ++qt)
#pragma unroll
            for (int dt = 0; dt < 4; ++dt) o[qt][dt] = (f32x4){0.f, 0.f, 0.f, 0.f};
        for (int i = F.tid; i < 15 * 31; i += NTHR) bt[i] = rpb[(size_t)h * 465 + i] * 1.4426950408889634f - M0;
        u32x4 kreg, vreg;
        { const size_t krow = (size_t)b * SEQ + (size_t)ulo * 64 + skey; const bf16_t* kp = QKV + krow * 3072 + D + h * 64 + 8 * sd8; kreg = *(const u32x4*)kp; vreg = *(const u32x4*)(kp + D); }
        NA_KNORM(kreg);
        *(LAS u32x4*)(F.lds + skey * 144 + sd8 * 16) = kreg; *(LAS u32x4*)(F.lds + 9216 + skey * 144 + sd8 * 16) = vreg;
        __syncthreads();
        for (int i = 0; i < ntile; ++i) {
            if (i + 1 < ntile) { const size_t krow = (i + 1 < nnb ? (size_t)b * SEQ + (size_t)(ulo + i + 1) * 64 : (size_t)RL + (size_t)b * CTXL + (size_t)(i + 1 - nnb) * 64) + skey;
                const bf16_t* kp = QKV + krow * 3072 + D + h * 64 + 8 * sd8; kreg = *(const u32x4*)kp; vreg = *(const u32x4*)(kp + D); }
            LAS unsigned char* Kb = F.lds + (i & 1) * 18432; LAS unsigned char* Vb = Kb + 9216;
            const bool isnb = i < nnb; const int ra = ulo + i;
            if (!isnb || (ra >= r0 && ra < r0 + 8)) {
                bf16x8 kf[4][2];
#pragma unroll
                for (int kt = 0; kt < 4; ++kt)
#pragma unroll
                    for (int ks = 0; ks < 2; ++ks) kf[kt][ks] = *(const LAS bf16x8*)(Kb + (16 * kt + fr) * 144 + (32 * ks + 8 * fq) * 2);
                s16x4 vA[2][4][2];
#pragma unroll
                for (int s2 = 0; s2 < 2; ++s2)
#pragma unroll
                    for (int dt = 0; dt < 4; ++dt)
#pragma unroll
                        for (int hh = 0; hh < 2; ++hh) vA[s2][dt][hh] = __builtin_amdgcn_ds_read_tr16_b64_v4i16((LAS s16x4*)(Vb + (32 * s2 + 16 * hh + 4 * fq) * 144 + 32 * dt + trl));
                const LAS float* bp = bt + (ra - r + 7) * 31;
#pragma unroll
                for (int qt = 0; qt < 2; ++qt) {
                    const int g4 = 2 * chh + qt; const int klo = isnb ? (g4 <= 1 ? 0 : g4 - 1) : 0, khi = isnb ? (g4 >= 2 ? 3 : g4 + 1) : 3;
                    const int cq = 16 * g4 + fr, cstart = min(max(cq - 8, 0), 48);
                    f32x4 st[4]; float psum = 0.f;
#pragma unroll
                    for (int kt = 0; kt < 4; ++kt) {
                        f32x4 a = {0.f, 0.f, 0.f, 0.f};
                        if (kt >= klo && kt <= khi) {
                            a = __builtin_amdgcn_mfma_f32_16x16x32_bf16(kf[kt][0], qf[qt][0], a, 0, 0, 0); a = __builtin_amdgcn_mfma_f32_16x16x32_bf16(kf[kt][1], qf[qt][1], a, 0, 0, 0);
                            if (isnb) {
#pragma unroll
                                for (int j = 0; j < 4; ++j) { const int ck = 16 * kt + 4 * fq + j; const bool valid = (unsigned)(ck - cstart) < 16u; const int dc = min(max(ck - cq, -15), 15) + 15;
                                    const float pv = __builtin_amdgcn_exp2f(a[j] + bp[dc]); a[j] = valid ? pv : 0.f; } }
                            else {
#pragma unroll
                                for (int j = 0; j < 4; ++j) a[j] = __builtin_amdgcn_exp2f(a[j] - M0); }
                            psum += (a[0] + a[1]) + (a[2] + a[3]);
                        }
                        st[kt] = a;
                    }
                    lrun[qt] += psum;
#pragma unroll
                    for (int s2 = 0; s2 < 2; ++s2) {
                        if (2 * s2 + 1 >= klo && 2 * s2 <= khi) {
                            u32x4 pw; pw.x = pk2(st[2 * s2][0], st[2 * s2][1]); pw.y = pk2(st[2 * s2][2], st[2 * s2][3]); pw.z = pk2(st[2 * s2 + 1][0], st[2 * s2 + 1][1]); pw.w = pk2(st[2 * s2 + 1][2], st[2 * s2 + 1][3]);
                            const bf16x8 pb = __builtin_bit_cast(bf16x8, pw);
#pragma unroll
                            for (int dt = 0; dt < 4; ++dt) { const s16x4 v0 = vA[s2][dt][0], v1 = vA[s2][dt][1]; const bf16x8 va = {v0[0], v0[1], v0[2], v0[3], v1[0], v1[1], v1[2], v1[3]};
                                o[qt][dt] = __builtin_amdgcn_mfma_f32_16x16x32_bf16(va, pb, o[qt][dt], 0, 0, 0); }
                        }
                    }
                }
            }
            if (i + 1 < ntile) { NA_KNORM(kreg); LAS unsigned char* Kn = F.lds + ((i + 1) & 1) * 18432; *(LAS u32x4*)(Kn + skey * 144 + sd8 * 16) = kreg; *(LAS u32x4*)(Kn + 9216 + skey * 144 + sd8 * 16) = vreg; }
            __syncthreads();
        }
#pragma unroll
        for (int qt = 0; qt < 2; ++qt) { float lt = lrun[qt]; lt += __shfl_xor(lt, 16); lt += __shfl_xor(lt, 32); const float inv = 1.0f / lt;
#pragma unroll
            for (int dt = 0; dt < 4; ++dt) { u32x2 w2; w2.x = pk2(o[qt][dt][0] * inv, o[qt][dt][1] * inv); w2.y = pk2(o[qt][dt][2] * inv, o[qt][dt][3] * inv); *(u32x2*)(O + qrow[qt] * D + h * 64 + 16 * dt + 4 * fq) = w2; } }
    }
    __syncthreads();
}

#undef NA_KNORM
constexpr int NPH = 36;
__device__ __forceinline__ pg8::Sched mk_sched(const Frame& F, int nM, int nN, const bf16_t* A, int lda, const bf16_t* B, int K) {
    pg8::Sched S; S.nM = nM; S.nN = nN; S.G = F.G; S.c = F.bid; S.A = (const char*)A; S.a_tile = (size_t)256 * lda * 2; S.a_pn = 0;
    S.B = (const char*)B; S.b_tile = (size_t)256 * K * 2; S.b_e = 0; S.tstart = nullptr; S.rev = false; return S;
}
__global__ void __launch_bounds__(NTHR, 2) fwd(Params P) {
    extern __shared__ __attribute__((aligned(16))) unsigned char lds_raw[];
    Frame F; F.lds = (LAS unsigned char*)lds_raw; F.tid = threadIdx.x; F.lane = F.tid & 63; F.wave = __builtin_amdgcn_readfirstlane(F.tid >> 6); F.bid = blockIdx.x; F.G = gridDim.x;
    F.p = &P; F.ws = P.ws; F.ctl = (unsigned*)(P.ws + WS_CTL); F.modv = (float*)(P.ws + WS_MODV); F.hlat = (bf16_t*)(P.ws + WS_H); F.hctx = F.hlat + (size_t)RL * D; F.U = (bf16_t*)P.out;
    if (F.tid < 64) ((LAS unsigned*)(F.lds + LDS_CTL))[F.tid] = 0u;
    __syncthreads();
    const int lo = P.ph_lo, hi = P.ph_hi;
    XcdBarrier bar; bar.bar = F.ctl + CW_BAR; bar.x = 0; bar.st = (volatile LAS unsigned*)(F.lds + LDS_CTL);
    if (hi - lo > 1) bar = xcd_barrier_post(F.ctl + CW_BAR, (volatile LAS unsigned*)(F.lds + LDS_CTL));
#define IN(k) (lo <= (k) && (k) < hi)
#define SEAM(k) do { if (IN(k) && IN((k) + 1)) xcd_barrier(bar); \
        if (PROBE_LO >= 0 && F.bid == 0 && F.tid == 0) { if ((k) + 1 == PROBE_LO) pr_t[0] = __builtin_amdgcn_s_memrealtime(); if ((k) + 1 == PROBE_HI) pr_t[1] = __builtin_amdgcn_s_memrealtime(); } } while (0)
    volatile LAS unsigned long long* const pr_t = (volatile LAS unsigned long long*)(F.lds + LDS_CTL + 16);
    if (PROBE_LO == 0 && F.bid == 0 && F.tid == 0) pr_t[0] = __builtin_amdgcn_s_memrealtime();
    bf16_t* const out = F.hlat; bf16_t* const hctx = F.hctx;
    const float* const x = INP(F, I_X); const float* const ctx = INP(F, I_CTX);
    LAS unsigned char* const gl = F.lds;
    LAS int* const tstart = (LAS int*)(F.lds + LDS_AUX);
    bf16_t* const BIG = (bf16_t*)(P.ws + WS_BIG);
#define MODL(l) (F.modv + (size_t)(l) * 33 * MODW)
#define LAUNDER do { asm volatile("" : "+v"(F.tid)); F.lane = F.tid & 63; } while (0)

    if (IN(0)) { LAUNDER; phase_cvt_small(F); phase_mod(F); } SEAM(0);
    if (IN(1)) { LAUNDER; NormCtx N{x, ctx, INP(F, I_N1G), MODL(0), 0, true}; phase_norm(F, N, RA); } SEAM(1);
    if (IN(2)) { LAUNDER; pg8::Sched S = mk_sched(F, RA / 256, 10, F.U, D, WSP(bf16_t, WS_LRU_WIN), D); pg8::EpiBf16<0> E{(bf16_t*)(P.ws + WS_BIG + BG_XG), 2560, nullptr}; pg8::gemm_phase(gl, D, D, S, E); } SEAM(2);
    if (IN(3)) { LAUNDER; phase_scan(F, true); } SEAM(3);
    if (IN(4)) { LAUNDER; pg8::Sched S = mk_sched(F, RA / 256, 4, (bf16_t*)(P.ws + WS_BIG + BG_Y), DRNN, WSP(bf16_t, WS_LRU_WOUT), DRNN);
                 pg8::EpiResidX E{x, ctx, out, hctx, MODL(0) + 2 * D, nullptr, nullptr}; pg8::gemm_phase(gl, DRNN, DRNN, S, E); cvt_moe_queue(F, 0, 0, 8192, 0); } SEAM(4);
    if (IN(5)) { LAUNDER; NormCtx N{out, hctx, INP(F, I_N2G), MODL(0), 1, false}; phase_norm(F, N, RA); } SEAM(5);
    if (IN(6)) { LAUNDER; pg8::Sched S = mk_sched(F, RA / 256, 28, F.U, D, WSP(bf16_t, WS_FFN_W13), D); pg8::EpiSwiGLU E{(bf16_t*)(P.ws + WS_BIG + BG_HID), DFF}; pg8::gemm_phase(gl, D, D, S, E); } SEAM(6);
    if (IN(7)) { LAUNDER; pg8::Sched S = mk_sched(F, RA / 256, 4, (bf16_t*)(P.ws + WS_BIG + BG_HID), DFF, WSP(bf16_t, WS_FFN_W2), DFF);
                 S.rev = true; pg8::EpiResid E{out, hctx, out, hctx, MODL(0) + 5 * D, nullptr, nullptr}; pg8::gemm_phase(gl, DFF, DFF, S, E); cvt_moe_queue(F, 0, 8192, 30720, 1); } SEAM(7);
    if (IN(8)) { LAUNDER; NormCtx N{out, hctx, INP(F, I_N1G) + D, MODL(1), 0, false}; phase_norm(F, N, RA); } SEAM(8);
    if (IN(9)) { LAUNDER; pg8::Sched S = mk_sched(F, RA / 256, 16, F.U, D, WSP(bf16_t, WS_SGU_WIN), D); pg8::EpiBf16<1> E{(bf16_t*)(P.ws + WS_BIG + BG_Z), 4096, INP(F, I_SGU_BIN)}; pg8::gemm_phase(gl, D, D, S, E); } SEAM(9);
    if (IN(10)) { LAUNDER; phase_sgu_stats(F); } SEAM(10);
    if (IN(11)) { LAUNDER; phase_sgu_spatial(F); } SEAM(11);
    if (IN(12)) { LAUNDER; pg8::Sched S = mk_sched(F, RA / 256, 4, (bf16_t*)(P.ws + WS_BIG + BG_Z), 4096, WSP(bf16_t, WS_SGU_WOUT), DSGU);
                  pg8::EpiResid E{out, hctx, out, hctx, MODL(1) + 2 * D, nullptr, nullptr}; pg8::gemm_phase(gl, 4096, DSGU, S, E); cvt_moe_queue(F, 0, 30720, CVT_MOE_ITEMS, 2); } SEAM(12);
    if (IN(13)) { LAUNDER; NormCtx N{out, hctx, INP(F, I_N2G) + D, MODL(1), 1, false}; phase_route(F, N, RA, 0); } SEAM(13);
    if (IN(14)) { LAUNDER; phase_assign_scatter0(F, RA, 0); } SEAM(14);
#define MOE_UP(ph, l2, s) if (IN(ph)) { LAUNDER; const int nt_ = moe_tile_table(F, l2, s, tstart); \
        pg8::Sched S = mk_sched(F, nt_, 28, F.U, D, moe_w13(F, l2), D); S.a_tile = 0; S.b_e = (size_t)2 * DFF * D * 2; S.tstart = tstart; \
        pg8::EpiSwiGLU E{(bf16_t*)(P.ws + WS_BIG + BG_MHID), DFF}; pg8::gemm_phase<pg8::EpiSwiGLU, true>(gl, D, D, S, E, WSP(const int, WS_ROUTE + RT_TOK) + (s) * MPAD, (LAS int*)(F.lds + LDS_AUX + 1024)); } SEAM(ph)
#define MOE_DOWN(ph, l2, s, layer, EPI) if (IN(ph)) { LAUNDER; const int nt_ = moe_tile_table(F, l2, s, tstart); \
        pg8::Sched S = mk_sched(F, nt_, 4, (bf16_t*)(P.ws + WS_BIG + BG_MHID), DFF, moe_w2(F, l2), DFF); S.b_e = (size_t)D * DFF * 2; S.tstart = tstart; S.rev = true; \
        EPI E{out, hctx, P.out, MODL(layer) + 5 * D, WSP(const int, WS_ROUTE + RT_TOK) + (s) * MPAD, WSP(const float, WS_ROUTE + RT_GW) + (s) * MPAD}; pg8::gemm_phase(gl, DFF, DFF, S, E); \
        if ((l2) == 0) cvt_moe_queue(F, 1, (s) ? 10752 : 0, (s) ? 21504 : 10752, 3 + (s)); } SEAM(ph)
    MOE_UP(15, 0, 0); MOE_DOWN(16, 0, 0, 1, pg8::EpiMoeDown); MOE_UP(17, 0, 1); MOE_DOWN(18, 0, 1, 1, pg8::EpiMoeDown);
    if (IN(19)) { LAUNDER; NormCtx N{out, hctx, INP(F, I_N1G) + 2 * D, MODL(2), 0, false}; phase_norm(F, N, RA); } SEAM(19);
    if (IN(20)) { LAUNDER; phase_pool_diff(F); } SEAM(20);
    if (IN(21)) { LAUNDER; pg8::Sched S = mk_sched(F, RA / 256, 4, (bf16_t*)(P.ws + WS_BIG + BG_PD), D, WSP(bf16_t, WS_POOL_W), 256); S.a_pn = 512; S.b_tile = (size_t)256 * 256 * 2;
                  pg8::EpiResidBS E{out, hctx, out, hctx, MODL(2) + 2 * D, INP(F, I_POOL_B), INP(F, I_POOL_S)}; pg8::gemm_phase(gl, D, 256, S, E); } SEAM(21);
    if (IN(22)) { LAUNDER; NormCtx N{out, hctx, INP(F, I_N2G) + 2 * D, MODL(2), 1, false}; phase_norm(F, N, RA); } SEAM(22);
    if (IN(23)) { LAUNDER; pg8::Sched S = mk_sched(F, RA / 256, 28, F.U, D, WSP(bf16_t, WS_FFN_W13) + (size_t)2 * DFF * D, D); pg8::EpiSwiGLU E{(bf16_t*)(P.ws + WS_BIG + BG_HID), DFF}; pg8::gemm_phase(gl, D, D, S, E); } SEAM(23);
    if (IN(24)) { LAUNDER; pg8::Sched S = mk_sched(F, RA / 256, 4, (bf16_t*)(P.ws + WS_BIG + BG_HID), DFF, WSP(bf16_t, WS_FFN_W2) + (size_t)D * DFF, DFF);
                  S.rev = true; pg8::EpiResid E{out, hctx, out, hctx, MODL(2) + 5 * D, nullptr, nullptr}; pg8::gemm_phase(gl, DFF, DFF, S, E); cvt_moe_queue(F, 1, 21504, CVT_MOE_ITEMS, 5); } SEAM(24);
    if (IN(25)) { LAUNDER; NormCtx N{out, hctx, INP(F, I_N1G) + 3 * D, MODL(3), 0, false}; phase_norm(F, N, RA); } SEAM(25);
    if (IN(26)) { LAUNDER; pg8::Sched S = mk_sched(F, RA / 256, 12, F.U, D, WSP(bf16_t, WS_NA_WQKV), D); pg8::EpiBf16<0> E{(bf16_t*)(P.ws + WS_BIG + BG_QKV), 3072, nullptr}; pg8::gemm_phase(gl, D, D, S, E); } SEAM(26);
    SEAM(27);
    if (IN(28)) { LAUNDER; phase_na(F); } SEAM(28);
    if (IN(29)) { LAUNDER; pg8::Sched S = mk_sched(F, RL / 256, 4, (bf16_t*)(P.ws + WS_BIG + BG_O), D, WSP(bf16_t, WS_NA_WO), D);
                  pg8::EpiResid E{out, hctx, out, hctx, MODL(3) + 2 * D, nullptr, nullptr}; pg8::gemm_phase(gl, D, D, S, E); } SEAM(29);
    if (IN(30)) { LAUNDER; NormCtx N{out, hctx, INP(F, I_N2G) + 3 * D, MODL(3), 1, false}; phase_route(F, N, RL, 1); } SEAM(30);
    if (IN(31)) { LAUNDER; phase_assign_scatter0(F, RL, 1); } SEAM(31);
    MOE_UP(32, 1, 0); MOE_DOWN(33, 1, 0, 3, pg8::EpiMoeDown); MOE_UP(34, 1, 1); MOE_DOWN(35, 1, 1, 3, pg8::EpiMoeDownOut);
#undef IN
#undef SEAM
    (void)BIG;
    if (PROBE_LO >= 0 && F.bid == 0 && F.tid == 0) { if (PROBE_HI >= NPH) pr_t[1] = __builtin_amdgcn_s_memrealtime();
        const unsigned long long t_end = __builtin_amdgcn_s_memrealtime(), wait = 8ull * (pr_t[1] - pr_t[0]);
        while (__builtin_amdgcn_s_memrealtime() - t_end < wait) __builtin_amdgcn_s_sleep(32); }
}

extern "C" void kernel_launch(void* const* d_in, const int* in_sizes, int n_in, void* d_out, int out_size, void* d_ws, size_t ws_size, hipStream_t stream) {
    static int grid = 0;
    if (grid == 0) {
        if (n_in != 40 || out_size != RL * D || ws_size < WS_END) { fprintf(stderr, "kernel_launch: unexpected problem (n_in %d out %d ws %zu)\n", n_in, out_size, ws_size); grid = -1; return; }
        int dev = 0, cus = 0;
        if (hipGetDevice(&dev) != hipSuccess || hipDeviceGetAttribute(&cus, hipDeviceAttributeMultiprocessorCount, dev) != hipSuccess) { grid = -1; return; }
        if (hipFuncSetAttribute((const void*)fwd, hipFuncAttributeMaxDynamicSharedMemorySize, LDS_BYTES) != hipSuccess) { fprintf(stderr, "kernel_launch: hipFuncSetAttribute failed\n"); grid = -1; return; }
        int per_cu = 0; (void)hipOccupancyMaxActiveBlocksPerMultiprocessor(&per_cu, (const void*)fwd, NTHR, LDS_BYTES); (void)hipGetLastError();
        if (per_cu < 1) fprintf(stderr, "kernel_launch: occupancy query says %d\n", per_cu);
        grid = cus;
    }
    if (grid < 0) return;
    (void)hipMemsetAsync((char*)d_ws + WS_CTL, 0, CTL_BYTES, stream);
    Params p{};
    for (int i = 0; i < 40; ++i) p.in[i] = (const float*)d_in[i];
    p.out = (float*)d_out; p.ws = (unsigned char*)d_ws;
#if MK_MULTI
    for (int ph = 0; ph < NPH; ++ph) { p.ph_lo = ph; p.ph_hi = ph + 1; hipLaunchKernelGGL(fwd, dim3(grid), dim3(NTHR), LDS_BYTES, stream, p); }
#else
    p.ph_lo = 0; p.ph_hi = NPH;
    hipLaunchKernelGGL(fwd, dim3(grid), dim3(NTHR), LDS_BYTES, stream, p);
#endif
}
```

```cpp
#include <hip/hip_runtime.h>
#include <cstdio>
#include <cstdint>

#ifndef PROBE_LO
#define PROBE_LO -1
#define PROBE_HI -1
#endif
#ifndef MK_MULTI
#define MK_MULTI 0
#endif

#define LAS __attribute__((address_space(3)))
typedef unsigned short bf16_t;
typedef short bf16x8 __attribute__((ext_vector_type(8)));
typedef short s16x4 __attribute__((ext_vector_type(4)));
typedef float f32x4 __attribute__((ext_vector_type(4)));
typedef float f32x2 __attribute__((ext_vector_type(2)));
typedef unsigned u32x4 __attribute__((ext_vector_type(4)));
typedef unsigned u32x2 __attribute__((ext_vector_type(2)));

constexpr int D = 1024, NB = 32, SEQ = 2048, CTXL = 256;
constexpr int RL = NB * SEQ, RC = NB * CTXL, RA = RL + RC;
constexpr int DRNN = 1280, LBW = 160, DSGU = 2048, DFF = 3584, NE = 8;
constexpr int MODW = 6 * D;
constexpr int MPAD = 75776;
constexpr float NORM_EPS = 1e-6f;
constexpr int NWAVES = 8, NTHR = 512;

constexpr size_t MiB = 1u << 20;
constexpr size_t WS_CTL = 0, CTL_BYTES = 1 * MiB;
constexpr size_t WS_MODV = 1 * MiB;
constexpr size_t WS_HCTX = 5 * MiB;
constexpr size_t WS_LRU_WIN = 37 * MiB;
constexpr size_t WS_LRU_WA = WS_LRU_WIN + 5 * MiB;
constexpr size_t WS_LRU_WI = WS_LRU_WA + 1 * MiB;
constexpr size_t WS_LRU_WOUT = WS_LRU_WI + 1 * MiB;
constexpr size_t WS_SGU_WIN = WS_LRU_WOUT + 3 * MiB;
constexpr size_t WS_SGU_WS = WS_SGU_WIN + 8 * MiB;
constexpr size_t WS_SGU_WOUT = WS_SGU_WS + 1 * MiB;
constexpr size_t WS_POOL_W = WS_SGU_WOUT + 4 * MiB;
constexpr size_t WS_NA_WQKV = WS_POOL_W + 1 * MiB;
constexpr size_t WS_NA_WO = WS_NA_WQKV + 6 * MiB;
constexpr size_t WS_FFN_W13 = WS_NA_WO + 2 * MiB;
constexpr size_t WS_FFN_W2 = WS_FFN_W13 + 28 * MiB;
constexpr size_t WS_MOE_W13 = WS_FFN_W2 + 14 * MiB;
constexpr size_t WS_MOE_W2 = WS_MOE_W13 + 112 * MiB;
constexpr size_t WS_ROUTE = WS_MOE_W2 + 56 * MiB;
constexpr size_t WS_H = WS_ROUTE + 4 * MiB;
constexpr size_t WS_BIG = WS_H + 148 * MiB;
constexpr size_t WS_END = WS_BIG + 744 * MiB;
constexpr size_t WS_DBG = WS_END;
static_assert(WS_MOE_W13 == 111 * MiB && WS_BIG == 431 * MiB && WS_END == 1175 * MiB, "ws map");
constexpr size_t RT_E = 0;
constexpr size_t RT_W = 512 * 1024;
constexpr size_t RT_TOK = 1280 * 1024;
constexpr size_t RT_GW = 2048 * 1024;
constexpr size_t RT_ST = 2816 * 1024;
constexpr size_t RT_P1 = 3456 * 1024;
static_assert(RT_W >= (size_t)RA * 4 && RT_TOK - RT_W >= (size_t)RA * 8 && RT_GW - RT_TOK >= (size_t)2 * MPAD * 4 && RT_ST - RT_GW >= (size_t)2 * MPAD * 4 && RT_P1 - RT_ST >= (size_t)RA * 8 && 4 * MiB - RT_P1 >= (size_t)RA * 4, "route map");
constexpr size_t BG_XG = 0, BG_Y = 360 * MiB;
constexpr size_t BG_HID = 0;
constexpr size_t BG_Z = 0;
constexpr size_t BG_FS1 = 0, BG_MHID = 0;
constexpr size_t BG_MW2 = 576 * MiB;
constexpr size_t BG_PD = 0;
constexpr size_t BG_QKV = 0, BG_O = 432 * MiB;
static_assert(BG_MHID + (size_t)MPAD * DFF * 2 <= BG_MW2 && BG_O + (size_t)RL * D * 2 <= BG_MW2 && BG_Y + (size_t)RA * DRNN * 2 <= BG_MW2 && BG_MW2 + 168 * MiB <= 744 * MiB, "big map");
constexpr int CW_BAR = 4096;
constexpr int CW_CNT = 16384;
constexpr int CW_CUR = 16384 + 256;
constexpr int CW_DBG = 32768;
constexpr int CW_CVTQ = 20480;

constexpr int LDS_BYTES = 163840;
constexpr int LDS_AUX = 131072;
constexpr int LDS_CTL = LDS_BYTES - 256;

__device__ __forceinline__ float bf2f(unsigned b) { return __uint_as_float(b << 16); }
__device__ __forceinline__ unsigned pk2(float lo, float hi) { unsigned r; asm volatile("v_cvt_pk_bf16_f32 %0, %1, %2" : "=v"(r) : "v"(lo), "v"(hi)); return r; }
__device__ __forceinline__ float lo_bf(unsigned w) { return __uint_as_float(w << 16); }
__device__ __forceinline__ float hi_bf(unsigned w) { return __uint_as_float(w & 0xffff0000u); }
template <int CTRL> __device__ __forceinline__ float dpp_f(float v) { return __int_as_float(__builtin_amdgcn_update_dpp(0, __float_as_int(v), CTRL, 0xf, 0xf, true)); }
__device__ __forceinline__ float wave_sum(float v) {
    v += dpp_f<0xB1>(v);
    v += dpp_f<0x4E>(v);
    v += dpp_f<0x141>(v);
    v += dpp_f<0x140>(v);
    const int iv = __float_as_int(v);
    return (__int_as_float(__builtin_amdgcn_readlane(iv, 0)) + __int_as_float(__builtin_amdgcn_readlane(iv, 16))) + (__int_as_float(__builtin_amdgcn_readlane(iv, 32)) + __int_as_float(__builtin_amdgcn_readlane(iv, 48)));
}
__device__ __forceinline__ float sigmoid_f(float x) { return __builtin_amdgcn_rcpf(1.0f + __builtin_amdgcn_exp2f(-1.4426950408889634f * x)); }
__device__ __forceinline__ float silu_f(float x) { return x * __builtin_amdgcn_rcpf(1.0f + __builtin_amdgcn_exp2f(-1.4426950408889634f * x)); }
__device__ __forceinline__ float gelu_tanh_f(float x) { const float z2 = -2.0f * 1.4426950408889634f * 0.7978845608028654f * (x + 0.044715f * x * x * x); return x * __builtin_amdgcn_rcpf(1.0f + __builtin_amdgcn_exp2f(z2)); }
__device__ __forceinline__ unsigned lds_add(LAS unsigned* p, unsigned v) { return __hip_atomic_fetch_add(p, v, __ATOMIC_RELAXED, __HIP_MEMORY_SCOPE_WORKGROUP); }
#define LDS_WAIT() asm volatile("s_waitcnt lgkmcnt(0)" ::: "memory")
#define VM_WAIT() asm volatile("s_waitcnt vmcnt(0)" ::: "memory")

#define XB_TMO      128
#define XB_XCNT(j)  (256  + 64 * (j))
#define XB_XSUB(j)  (1280 + 64 * (j))
#define XB_XGEN(j)  (2304 + 64 * (j))
#define XB_TOP      3328
#define XB_TOPGEN   3392
#define XCD_BAR_WORDS 3456
#define XB_SPIN_CAP (1u << 18)
__device__ __forceinline__ unsigned xb_ld(unsigned* p)              { return __hip_atomic_load(p, __ATOMIC_RELAXED, __HIP_MEMORY_SCOPE_AGENT); }
__device__ __forceinline__ unsigned xb_add(unsigned* p, unsigned v) { return __hip_atomic_fetch_add(p, v, __ATOMIC_RELAXED, __HIP_MEMORY_SCOPE_AGENT); }
__device__ __forceinline__ unsigned xb_xcc_id() { return (unsigned)__builtin_amdgcn_s_getreg((3 << 11) | 20) & 0xFu; }
#define XB_SPIN(cond, bar) do { unsigned _sp = 0; while (cond) { __builtin_amdgcn_s_sleep(1); \
    if ((++_sp & 255u) == 0u) { if (xb_ld(&(bar)[XB_TMO])) break; if (_sp > XB_SPIN_CAP) { atomicAdd(&(bar)[XB_TMO], 1u); break; } } } } while (0)
struct XcdBarrier { unsigned* bar; unsigned x; volatile LAS unsigned* st; };
__device__ __forceinline__ XcdBarrier xcd_barrier_post(unsigned* bar, volatile LAS unsigned* st) {
    XcdBarrier b; b.bar = bar; b.x = xb_xcc_id(); b.st = st;
    if (threadIdx.x == 0) (void)xb_add(&bar[XB_XCNT(b.x)], 1u);
    return b;
}
__device__ __forceinline__ void xcd_barrier_complete(unsigned* bar, unsigned x, unsigned& nloc, unsigned& nx) {
    const unsigned G = gridDim.x * gridDim.y * gridDim.z;
    unsigned sum, cnt, mine, sp = 0u;
    for (;;) {
        sum = 0u; cnt = 0u; mine = 0u;
#pragma unroll
        for (unsigned j = 0; j < 16; ++j) { const unsigned c = xb_ld(&bar[XB_XCNT(j)]); sum += c; cnt += (c > 0u) ? 1u : 0u; mine = (j == x) ? c : mine; }
        if (sum == G) break;
        __builtin_amdgcn_s_sleep(1);
        if ((++sp & 255u) == 0u) { if (xb_ld(&bar[XB_TMO])) break; if (sp > XB_SPIN_CAP) { atomicAdd(&bar[XB_TMO], 1u); break; } }
    }
    nloc = mine > 0u ? mine : 1u; nx = cnt > 0u ? cnt : 1u;
}
__device__ __forceinline__ void xcd_barrier(const XcdBarrier& b) {
    asm volatile("s_waitcnt vmcnt(0)" ::: "memory");
    __syncthreads();
    if (threadIdx.x == 0) {
        unsigned* bar = b.bar;
        __builtin_amdgcn_s_waitcnt(0);
        unsigned nloc = b.st[0], nx = b.st[1];
        if (nloc == 0u) { xcd_barrier_complete(bar, b.x, nloc, nx); b.st[0] = nloc; b.st[1] = nx; }
        const unsigned old = xb_add(&bar[XB_XSUB(b.x)], 1u);
        const unsigned gen = old / nloc;
        if (old + 1u == (gen + 1u) * nloc) {
            __builtin_amdgcn_fence(__ATOMIC_RELEASE, "agent");
            asm volatile("s_waitcnt vmcnt(0)" ::: "memory");
            const unsigned og = xb_add(&bar[XB_TOP], 1u);
            const unsigned tg = og / nx;
            if (og + 1u == (tg + 1u) * nx) xb_add(&bar[XB_TOPGEN], 1u);
            else XB_SPIN(xb_ld(&bar[XB_TOPGEN]) == tg, bar);
            __builtin_amdgcn_fence(__ATOMIC_ACQUIRE, "agent");
            xb_add(&bar[XB_XGEN(b.x)], 1u);
            asm volatile("s_waitcnt vmcnt(0)" ::: "memory");
        } else {
            XB_SPIN(xb_ld(&bar[XB_XGEN(b.x)]) == gen, bar);
            __builtin_amdgcn_fence(__ATOMIC_ACQUIRE, "agent");
            asm volatile("s_waitcnt vmcnt(0)" ::: "memory");
        }
    }
    __syncthreads();
}

struct Params {
    const float* in[40];
    float* out; unsigned char* ws;
    int ph_lo, ph_hi;
};
enum In { I_X = 0, I_C, I_CTX, I_CCTX, I_MODW, I_MODB, I_N1G, I_N2G, I_LRU_WIN, I_LRU_CW, I_LRU_CB, I_LRU_WA, I_LRU_BA, I_LRU_WI, I_LRU_BI, I_LRU_LAM, I_LRU_WOUT,
          I_SGU_WIN, I_SGU_BIN, I_SGU_LNG, I_SGU_LNB, I_SGU_WS, I_SGU_BS, I_SGU_WOUT, I_POOL_W, I_POOL_B, I_POOL_S, I_NA_WQKV, I_NA_QG, I_NA_KG, I_NA_RPB, I_NA_WO,
          I_FFN_W1, I_FFN_W3, I_FFN_W2, I_MOE_WR, I_MOE_BR, I_MOE_W1, I_MOE_W3, I_MOE_W2 };

namespace pg8 {
constexpr int BM = 256, BK = 64, HALF = 128, HTB = HALF * BK * 2, STAGE_BYTES = 8 * HTB, NXCD = 8, WGM = 8;
__device__ __forceinline__ int lds_byte(int r, int c) { const int st = (r >> 4) * 2 + (c >> 5), rr = r & 15, cc = c & 31, ob = rr * 64 + cc * 2; return st * 1024 + (ob ^ (((ob >> 9) & 1) << 5)); }
__device__ __forceinline__ void stage_rc(int b, int& R, int& C) { const int st = b / 1024, sb = b % 1024, swz = sb ^ (((sb >> 9) & 1) << 5); R = (st >> 1) * 16 + swz / 64; C = (st & 1) * 32 + (swz % 64) / 2; }
__device__ __forceinline__ int perm32(int rho) { const int n = rho >> 4, i = rho & 15; return 8 * (i >> 2) + 4 * n + (i & 3); }

struct Unit { int pm, pn, e; const char* a; const char* b; };
struct Sched {
    int nM, nN, G, c;
    const char* A; size_t a_tile, a_pn;
    const char* B; size_t b_tile, b_e;
    const LAS int* tstart;
    bool rev = false;
    __device__ __forceinline__ bool next(int i, Unit& u) const {
        long L = (long)i * G + c; if (L >= (long)nM * nN) return false;
        if (rev) L = (long)nM * nN - 1 - L;
        int e = 0, t0 = 0, nMe = nM, wgid = (int)L;
        if (tstart) {
#pragma unroll
            for (int k = 1; k < 8; ++k) e += (wgid >= tstart[k] * nN) ? 1 : 0;
            t0 = tstart[e]; nMe = tstart[e + 1] - t0; wgid -= t0 * nN;
        }
        const int nwg = nMe * nN;
        { const int q = nwg / NXCD, r = nwg % NXCD, xcd = wgid % NXCD, off = wgid / NXCD; wgid = (xcd < r ? xcd * (q + 1) : r * (q + 1) + (xcd - r) * q) + off; }
        const int nig = WGM * nN, gid = wgid / nig, fm = gid * WGM, gsz = (nMe - fm) < WGM ? (nMe - fm) : WGM;
        u.pm = t0 + fm + ((wgid % nig) % gsz); u.pn = (wgid % nig) / gsz;
        u.e = e; u.a = A + (size_t)u.pm * a_tile + (size_t)u.pn * a_pn; u.b = B + (size_t)e * b_e + (size_t)u.pn * b_tile;
        return true;
    }
};

template <class Epi, bool GATHER = false>
__device__ __forceinline__ void gemm_phase(LAS unsigned char* lds, const int lda, const int K, const Sched& S, const Epi& E, const int* gidx = nullptr, LAS int* ixt = nullptr) {
    const int tid = threadIdx.x, wid = __builtin_amdgcn_readfirstlane(tid >> 6), lane = tid & 63, wr = wid >> 2, wc = wid & 3, fr = lane & 15, fq = lane >> 4;
    const int nt = K / BK;
    unsigned voffA[2], voffB[2]; int Rl[2]; unsigned cb2[2];
#pragma unroll
    for (int i = 0; i < 2; ++i) { int R, C; stage_rc(tid * 16 + i * 8192, R, C); const int Rb = Epi::PERM ? ((R & ~31) + perm32(R & 31)) : R;
        voffA[i] = (unsigned)(R * lda + C) * 2u; voffB[i] = (unsigned)(Rb * K + C) * 2u; Rl[i] = R; cb2[i] = (unsigned)C * 2u; }
    unsigned cOff[2][2] = {{0u, 0u}, {0u, 0u}}, nOff[2][2] = {{0u, 0u}, {0u, 0u}};
    const size_t kstep = (size_t)(BK * 2);
    const size_t hstepA = (size_t)HALF * lda * 2, hstepB = (size_t)HALF * K * 2;
    const unsigned ldsw = (unsigned)wid * 1024u;
    const int aoff = lds_byte(wr * 64 + fr, fq * 8), boff = lds_byte(wc * 32 + fr, fq * 8);
#define PG8_SA(b, h) (((b) * 2 + (h)) * HTB)
#define PG8_SB(b, h) ((4 + (b) * 2 + (h)) * HTB)
#define PG8_STAGE(bufoff, gbase, voff) do { _Pragma("unroll") for (int _i = 0; _i < 2; ++_i) \
        __builtin_amdgcn_global_load_lds((const unsigned*)((const char*)(gbase) + (voff)[_i]), (LAS unsigned*)(lds + (bufoff) + ldsw + _i * 8192), 16, 0, 0); } while (0)
#define PG8_STAGE_A(bufoff, kptr, h, usenext) do { if constexpr (GATHER) { const unsigned o_[2] = {(usenext) ? nOff[h][0] : cOff[h][0], (usenext) ? nOff[h][1] : cOff[h][1]}; PG8_STAGE(bufoff, kptr, o_); } \
        else PG8_STAGE(bufoff, (kptr) + (h) * hstepA, voffA); } while (0)
#define PG8_LDA(dst, b, h) do { _Pragma("unroll") for (int m = 0; m < 4; ++m) _Pragma("unroll") for (int k = 0; k < 2; ++k) dst[m][k] = *(const LAS bf16x8*)(lds + PG8_SA(b, h) + aoff + m * 2048 + k * 1024); } while (0)
#define PG8_LDB(dst, b, h) do { _Pragma("unroll") for (int n = 0; n < 2; ++n) _Pragma("unroll") for (int k = 0; k < 2; ++k) dst[n][k] = *(const LAS bf16x8*)(lds + PG8_SB(b, h) + boff + n * 2048 + k * 1024); } while (0)
#define PG8_MMA(ai, bj, At, Bt) do { __builtin_amdgcn_s_setprio(1); _Pragma("unroll") for (int m = 0; m < 4; ++m) _Pragma("unroll") for (int n = 0; n < 2; ++n) _Pragma("unroll") for (int k = 0; k < 2; ++k) \
        acc[ai][bj][m][n] = __builtin_amdgcn_mfma_f32_16x16x32_bf16(Bt[n][k], At[m][k], acc[ai][bj][m][n], 0, 0, 0); __builtin_amdgcn_s_setprio(0); } while (0)
#define PG8_WAIT_V(n) asm volatile("s_waitcnt vmcnt(" #n ")" ::: "memory")
#define PG8_WAIT_L(n) asm volatile("s_waitcnt lgkmcnt(" #n ")" ::: "memory")
#define PG8_BAR __builtin_amdgcn_s_barrier()
#define PG8_SCHED __builtin_amdgcn_sched_barrier(0)
    Unit cur, nxt; int ui = 0;
    if (!S.next(0, cur)) return;
    f32x4 acc[2][2][4][2];
#pragma unroll
    for (int a = 0; a < 2; ++a)
#pragma unroll
        for (int b = 0; b < 2; ++b)
#pragma unroll
            for (int m = 0; m < 4; ++m)
#pragma unroll
                for (int n = 0; n < 2; ++n) acc[a][b][m][n] = (f32x4){0.f, 0.f, 0.f, 0.f};
    bf16x8 At[4][2], B0[2][2], B1[2][2];
    const char* cA = cur.a; const char* cB = cur.b;
    if constexpr (GATHER) {
#pragma unroll
        for (int h = 0; h < 2; ++h)
#pragma unroll
            for (int i = 0; i < 2; ++i) { const int ix = gidx[cur.pm * BM + h * HALF + Rl[i]]; cOff[h][i] = (unsigned)(ix < 0 ? 0 : ix) * (unsigned)(lda * 2) + cb2[i]; }
    }
    PG8_STAGE(PG8_SB(0, 0), cB, voffB); PG8_STAGE(PG8_SB(0, 1), cB + hstepB, voffB); PG8_STAGE_A(PG8_SA(0, 0), cA, 0, false); PG8_STAGE_A(PG8_SA(0, 1), cA, 1, false);
    if (wr == 1) PG8_BAR;
    PG8_WAIT_V(2); PG8_BAR;
    PG8_STAGE(PG8_SB(1, 0), cB + kstep, voffB); PG8_STAGE_A(PG8_SA(1, 0), cA + kstep, 0, false); PG8_STAGE(PG8_SB(1, 1), cB + hstepB + kstep, voffB);
    PG8_WAIT_V(6); PG8_BAR;
    for (;;) {
        const bool has_next = S.next(ui + 1, nxt);
        const char* nA = has_next ? nxt.a : cA; const char* nB = has_next ? nxt.b : cB;
        if constexpr (GATHER) { if (has_next && wid == 0) {
#pragma unroll
            for (int k = 0; k < 4; ++k) __builtin_amdgcn_global_load_lds((const unsigned*)(gidx + nxt.pm * BM + k * 64 + lane), (LAS unsigned*)(ixt + ((ui + 1) & 1) * BM + k * 64), 4, 0, 0); } }
        for (int t = 0; t < nt; t += 2) {
            const bool last = (t == nt - 2); const bool un = last && has_next;
            if constexpr (GATHER) { if (un) {
#pragma unroll
                for (int h = 0; h < 2; ++h)
#pragma unroll
                    for (int i = 0; i < 2; ++i) { const int ix = ixt[((ui + 1) & 1) * BM + h * HALF + Rl[i]]; nOff[h][i] = (unsigned)(ix < 0 ? 0 : ix) * (unsigned)(lda * 2) + cb2[i]; } } }
            const char* a1 = cA + (size_t)(t + 1) * kstep;
            const char* a2 = last ? nA : cA + (size_t)(t + 2) * kstep; const char* b2 = last ? nB : cB + (size_t)(t + 2) * kstep;
            const char* a3 = a2 + kstep; const char* b3 = b2 + kstep;
            PG8_LDB(B0, 0, 0); PG8_LDB(B1, 0, 1); PG8_SCHED; PG8_LDA(At, 0, 0); PG8_STAGE_A(PG8_SA(1, 1), a1, 1, false);
            PG8_WAIT_V(8); PG8_WAIT_L(0); PG8_BAR; PG8_MMA(0, 0, At, B0); PG8_MMA(0, 1, At, B1); PG8_BAR; PG8_SCHED;
            PG8_LDA(At, 0, 1); PG8_STAGE(PG8_SB(0, 0), b2, voffB); PG8_STAGE(PG8_SB(0, 1), b2 + hstepB, voffB); PG8_STAGE_A(PG8_SA(0, 0), a2, 0, un);
            PG8_WAIT_V(8); PG8_WAIT_L(0); PG8_BAR; PG8_MMA(1, 0, At, B0); PG8_MMA(1, 1, At, B1); PG8_BAR; PG8_SCHED;
            PG8_LDB(B0, 1, 0); PG8_LDB(B1, 1, 1); PG8_SCHED; PG8_LDA(At, 1, 0); PG8_STAGE_A(PG8_SA(0, 1), a2, 1, un);
            PG8_WAIT_V(8); PG8_WAIT_L(0); PG8_BAR; PG8_MMA(0, 0, At, B0); PG8_MMA(0, 1, At, B1); PG8_BAR; PG8_SCHED;
            PG8_LDA(At, 1, 1); PG8_STAGE(PG8_SB(1, 0), b3, voffB); PG8_STAGE(PG8_SB(1, 1), b3 + hstepB, voffB); PG8_STAGE_A(PG8_SA(1, 0), a3, 0, un);
            PG8_WAIT_V(8); PG8_WAIT_L(0); PG8_BAR; PG8_MMA(1, 0, At, B0); PG8_MMA(1, 1, At, B1); PG8_BAR; PG8_SCHED;
        }
        if (wr == 0) PG8_BAR;
        E(acc, cur, wr, wc, fr, fq);
        if (!has_next) break;
#pragma unroll
        for (int a = 0; a < 2; ++a)
#pragma unroll
            for (int b = 0; b < 2; ++b)
#pragma unroll
                for (int m = 0; m < 4; ++m)
#pragma unroll
                    for (int n = 0; n < 2; ++n) acc[a][b][m][n] = (f32x4){0.f, 0.f, 0.f, 0.f};
        cur = nxt; cA = nA; cB = nB; ++ui;
        if constexpr (GATHER) {
#pragma unroll
            for (int h = 0; h < 2; ++h)
#pragma unroll
                for (int i = 0; i < 2; ++i) cOff[h][i] = nOff[h][i]; }
        if (wr == 1) PG8_BAR;
    }
    PG8_WAIT_V(0);
    PG8_BAR;
#undef PG8_SA
#undef PG8_SB
#undef PG8_STAGE
#undef PG8_LDA
#undef PG8_STAGE_A
#undef PG8_LDB
#undef PG8_MMA
#undef PG8_WAIT_V
#undef PG8_WAIT_L
#undef PG8_BAR
#undef PG8_SCHED
}

template <int ACT> struct EpiBf16 {
    static constexpr bool PERM = true;
    bf16_t* O; int ldc; const float* bias;
    __device__ __forceinline__ void operator()(const f32x4 (&acc)[2][2][4][2], const Unit& u, int wr, int wc, int fr, int fq) const {
        asm volatile("" : "+v"(fr), "+v"(fq));
        const int row0 = u.pm * BM + wr * 64 + fr; const int col0 = u.pn * BM + wc * 32 + 8 * fq;
        f32x4 bv[2][2];
#pragma unroll
        for (int bj = 0; bj < 2; ++bj)
#pragma unroll
            for (int n = 0; n < 2; ++n) bv[bj][n] = bias ? *(const f32x4*)(bias + col0 + bj * HALF + 4 * n) : (f32x4){0.f, 0.f, 0.f, 0.f};
#pragma unroll
        for (int ai = 0; ai < 2; ++ai)
#pragma unroll
            for (int m = 0; m < 4; ++m) { bf16_t* rowp = O + (size_t)(row0 + ai * HALF + m * 16) * ldc + col0;
#pragma unroll
                for (int bj = 0; bj < 2; ++bj) { f32x4 v0 = acc[ai][bj][m][0] + bv[bj][0], v1 = acc[ai][bj][m][1] + bv[bj][1];
                    if (ACT == 1) {
#pragma unroll
                        for (int j = 0; j < 4; ++j) { v0[j] = gelu_tanh_f(v0[j]); v1[j] = gelu_tanh_f(v1[j]); } }
                    u32x4 w; w.x = pk2(v0[0], v0[1]); w.y = pk2(v0[2], v0[3]); w.z = pk2(v1[0], v1[1]); w.w = pk2(v1[2], v1[3]);
                    *(u32x4*)(rowp + bj * HALF) = w; } }
    }
};
struct EpiSwiGLU {
    static constexpr bool PERM = true;
    bf16_t* H; int ldh;
    __device__ __forceinline__ void operator()(const f32x4 (&acc)[2][2][4][2], const Unit& u, int wr, int wc, int fr, int fq) const {
        asm volatile("" : "+v"(fr), "+v"(fq));
        const int row0 = u.pm * BM + wr * 64 + fr; const int col0 = u.pn * HALF + wc * 32 + 8 * fq;
#pragma unroll
        for (int ai = 0; ai < 2; ++ai)
#pragma unroll
            for (int m = 0; m < 4; ++m) { bf16_t* rowp = H + (size_t)(row0 + ai * HALF + m * 16) * ldh + col0;
                f32x4 h0, h1;
#pragma unroll
                for (int j = 0; j < 4; ++j) { h0[j] = silu_f(acc[ai][0][m][0][j]) * acc[ai][1][m][0][j]; h1[j] = silu_f(acc[ai][0][m][1][j]) * acc[ai][1][m][1][j]; }
                u32x4 w; w.x = pk2(h0[0], h0[1]); w.y = pk2(h0[2], h0[3]); w.z = pk2(h1[0], h1[1]); w.w = pk2(h1[2], h1[3]);
                *(u32x4*)rowp = w; }
    }
};
template <bool HAS_BS, bool SRC32> struct EpiResidT {
    static constexpr bool PERM = false;
    const void* src_lat; const void* src_ctx; bf16_t* dst_lat; bf16_t* dst_ctx; const float* gate;
    const float* bias; const float* cscale;
    __device__ __forceinline__ void operator()(const f32x4 (&acc)[2][2][4][2], const Unit& u, int wr, int wc, int fr, int fq) const {
        asm volatile("" : "+v"(fr), "+v"(fq));
        const bool isctx = u.pm >= RL / BM; const int mb = isctx ? 32 : (u.pm >> 3);
        const size_t trow = isctx ? (size_t)(u.pm - RL / BM) * BM : (size_t)u.pm * BM;
        const float* s32 = (const float*)(isctx ? src_ctx : src_lat) + trow * D; const bf16_t* s16 = (const bf16_t*)(isctx ? src_ctx : src_lat) + trow * D;
        bf16_t* dst = (isctx ? dst_ctx : dst_lat) + trow * D;
        const float* g = gate + (size_t)mb * MODW;
        const int col0 = u.pn * BM + wc * 32 + 4 * fq;
        f32x4 gv[2][2], bv[2][2];
#pragma unroll
        for (int bj = 0; bj < 2; ++bj)
#pragma unroll
            for (int n = 0; n < 2; ++n) { const int c = col0 + bj * HALF + n * 16; gv[bj][n] = HAS_BS ? (f32x4){0.f, 0.f, 0.f, 0.f} : *(const f32x4*)(g + c); bv[bj][n] = (f32x4){0.f, 0.f, 0.f, 0.f}; }
        constexpr int MB = HAS_BS ? 1 : 4;
#pragma unroll
        for (int ai = 0; ai < 2; ++ai)
#pragma unroll
            for (int m0 = 0; m0 < 4; m0 += MB) {
                f32x4 rs[MB][2][2];
#pragma unroll
                for (int mi = 0; mi < MB; ++mi) { const unsigned off = (unsigned)((ai * HALF + wr * 64 + (m0 + mi) * 16 + fr) * D + col0);
#pragma unroll
                    for (int bj = 0; bj < 2; ++bj)
#pragma unroll
                        for (int n = 0; n < 2; ++n) { if (SRC32) rs[mi][bj][n] = *(const f32x4*)(s32 + off + bj * HALF + n * 16);
                            else { const u32x2 q = *(const u32x2*)(s16 + off + bj * HALF + n * 16); rs[mi][bj][n] = (f32x4){lo_bf(q.x), hi_bf(q.x), lo_bf(q.y), hi_bf(q.y)}; } } }
#pragma unroll
                for (int mi = 0; mi < MB; ++mi) { const int m = m0 + mi; const unsigned off = (unsigned)((ai * HALF + wr * 64 + m * 16 + fr) * D + col0);
#pragma unroll
                    for (int bj = 0; bj < 2; ++bj)
#pragma unroll
                        for (int n = 0; n < 2; ++n) { f32x4 o;
                            if (HAS_BS) { const int c = col0 + bj * HALF + n * 16;
                                o = rs[mi][bj][n] + (*(const f32x4*)(g + c) * *(const f32x4*)(cscale + c)) * (acc[ai][bj][m][n] + *(const f32x4*)(bias + c)); }
                            else o = rs[mi][bj][n] + gv[bj][n] * acc[ai][bj][m][n];
                            u32x2 w; w.x = pk2(o[0], o[1]); w.y = pk2(o[2], o[3]); *(u32x2*)(dst + off + bj * HALF + n * 16) = w; } }
            }
    }
};
typedef EpiResidT<false, false> EpiResid; typedef EpiResidT<true, false> EpiResidBS; typedef EpiResidT<false, true> EpiResidX;
template <bool OUT32> struct EpiMoeDownT {
    static constexpr bool PERM = false;
    bf16_t* h_lat; bf16_t* h_ctx; float* out32; const float* gate; const int* tok; const float* gw;
    __device__ __forceinline__ void operator()(const f32x4 (&acc)[2][2][4][2], const Unit& u, int wr, int wc, int fr, int fq) const {
        asm volatile("" : "+v"(fr), "+v"(fq));
        const int col0 = u.pn * BM + wc * 32 + 4 * fq;
        int tk[2][4]; float wg[2][4];
#pragma unroll
        for (int ai = 0; ai < 2; ++ai)
#pragma unroll
            for (int m = 0; m < 4; ++m) { const int pos = u.pm * BM + ai * HALF + wr * 64 + m * 16 + fr; tk[ai][m] = tok[pos]; wg[ai][m] = gw[pos]; }
#pragma unroll
        for (int ai = 0; ai < 2; ++ai)
#pragma unroll
            for (int mp = 0; mp < 2; ++mp) {
                u32x2 rs[2][2][2]; f32x4 gg[2][2][2]; size_t ro[2]; bool cx[2];
#pragma unroll
                for (int mi = 0; mi < 2; ++mi) { const int t = tk[ai][2 * mp + mi]; const int tt = t >= 0 ? t : 0; cx[mi] = tt >= RL; const int mb = cx[mi] ? 32 : (tt >> 11);
                    ro[mi] = (size_t)(cx[mi] ? tt - RL : tt) * D + col0; const bf16_t* hp = (cx[mi] ? h_ctx : h_lat) + ro[mi]; const float* g = gate + (size_t)mb * MODW + col0;
#pragma unroll
                    for (int bj = 0; bj < 2; ++bj)
#pragma unroll
                        for (int n = 0; n < 2; ++n) { rs[mi][bj][n] = *(const u32x2*)(hp + bj * HALF + n * 16); gg[mi][bj][n] = *(const f32x4*)(g + bj * HALF + n * 16); } }
#pragma unroll
                for (int mi = 0; mi < 2; ++mi) { const int m = 2 * mp + mi;
                    if (tk[ai][m] >= 0) { const float w = wg[ai][m];
#pragma unroll
                        for (int bj = 0; bj < 2; ++bj)
#pragma unroll
                            for (int n = 0; n < 2; ++n) { const u32x2 q = rs[mi][bj][n]; const f32x4 o = (f32x4){lo_bf(q.x), hi_bf(q.x), lo_bf(q.y), hi_bf(q.y)} + gg[mi][bj][n] * (acc[ai][bj][m][n] * w);
                                if (OUT32) *(f32x4*)(out32 + ro[mi] + bj * HALF + n * 16) = o;
                                else { u32x2 wv; wv.x = pk2(o[0], o[1]); wv.y = pk2(o[2], o[3]); *(u32x2*)((cx[mi] ? h_ctx : h_lat) + ro[mi] + bj * HALF + n * 16) = wv; } } } }
            }
    }
};
typedef EpiMoeDownT<false> EpiMoeDown; typedef EpiMoeDownT<true> EpiMoeDownOut;
}

struct Frame {
    LAS unsigned char* lds;
    int tid, lane, wave, bid, G;
    const Params* p;
    unsigned char* ws; unsigned* ctl;
    float* modv; bf16_t* hlat; bf16_t* hctx; bf16_t* U;
};
#define WSP(T, off) ((T*)(F.ws + (off)))
__device__ __forceinline__ const float* INP(const Frame& F, int i) { return F.p->in[i]; }

__device__ __forceinline__ void cvt_item(const float* W, int K, int N, bf16_t* WT, int mode, LAS float* scr, int item, int lane) {
    const int nblk = N / 32, kb = item / nblk, nb = item % nblk, k0 = 64 * kb, n0 = 32 * nb;
#pragma unroll 8
    for (int i = 0; i < 32; ++i) { const int kk = 2 * i + (lane >> 5); scr[kk * 33 + (lane & 31)] = W[(size_t)(k0 + kk) * N + n0 + (lane & 31)]; }
    LDS_WAIT();
    const int c = lane & 7;
#pragma unroll
    for (int j = 0; j < 4; ++j) { const int n = (lane >> 3) + 8 * j; const LAS float* s = scr + (8 * c) * 33 + n;
        u32x4 o; o.x = pk2(s[0 * 33], s[1 * 33]); o.y = pk2(s[2 * 33], s[3 * 33]); o.z = pk2(s[4 * 33], s[5 * 33]); o.w = pk2(s[6 * 33], s[7 * 33]);
        const int nn = n0 + n; const int drow = mode == 0 ? nn : (256 * (nn >> 7) + (nn & 127) + (mode == 2 ? 128 : 0));
        *(u32x4*)(WT + (size_t)drow * K + k0 + 8 * c) = o; }
    LDS_WAIT();
}
struct CvtJob { const float* src; bf16_t* dst; int K, N, mode; };
__device__ __forceinline__ CvtJob cvt_small_job(const Frame& F, int j) {
    switch (j) {
        case 0: return CvtJob{INP(F, I_LRU_WIN), WSP(bf16_t, WS_LRU_WIN), 1024, 2560, 0};
        case 1: return CvtJob{INP(F, I_LRU_WOUT), WSP(bf16_t, WS_LRU_WOUT), 1280, 1024, 0};
        case 2: return CvtJob{INP(F, I_FFN_W1), WSP(bf16_t, WS_FFN_W13), 1024, DFF, 1};
        case 3: return CvtJob{INP(F, I_FFN_W3), WSP(bf16_t, WS_FFN_W13), 1024, DFF, 2};
        case 4: return CvtJob{INP(F, I_FFN_W2), WSP(bf16_t, WS_FFN_W2), DFF, 1024, 0};
        case 5: return CvtJob{INP(F, I_SGU_WIN), WSP(bf16_t, WS_SGU_WIN), 1024, 4096, 0};
        case 6: return CvtJob{INP(F, I_SGU_WOUT), WSP(bf16_t, WS_SGU_WOUT), 2048, 1024, 0};
        case 7: case 8: case 9: case 10: return CvtJob{INP(F, I_POOL_W) + (size_t)(j - 7) * 65536, WSP(bf16_t, WS_POOL_W) + (size_t)(j - 7) * 65536, 256, 256, 0};
        case 11: return CvtJob{INP(F, I_FFN_W1) + (size_t)D * DFF, WSP(bf16_t, WS_FFN_W13) + (size_t)2 * DFF * D, 1024, DFF, 1};
        case 12: return CvtJob{INP(F, I_FFN_W3) + (size_t)D * DFF, WSP(bf16_t, WS_FFN_W13) + (size_t)2 * DFF * D, 1024, DFF, 2};
        case 13: return CvtJob{INP(F, I_FFN_W2) + (size_t)D * DFF, WSP(bf16_t, WS_FFN_W2) + (size_t)D * DFF, DFF, 1024, 0};
        case 14: return CvtJob{INP(F, I_NA_WQKV), WSP(bf16_t, WS_NA_WQKV), 1024, 3072, 0};
        default: return CvtJob{INP(F, I_NA_WO), WSP(bf16_t, WS_NA_WO), 1024, 1024, 0};
    }
}
__device__ __forceinline__ int cvt_job_items(const CvtJob& j) { return (j.K / 64) * (j.N / 32); }
__device__ __forceinline__ void phase_cvt_small(const Frame& F) {
    const size_t gt = (size_t)F.bid * NTHR + F.tid, GT = (size_t)F.G * NTHR;
    { const float* wa = INP(F, I_LRU_WA); const float* wi = INP(F, I_LRU_WI); bf16_t* da = WSP(bf16_t, WS_LRU_WA); bf16_t* di = WSP(bf16_t, WS_LRU_WI);
      for (size_t i = gt; i < (size_t)16 * 160 * 160; i += GT) { const int mat = (int)(i / 25600), rem = (int)(i % 25600), n = rem / 160, k = rem % 160;
          da[i] = (bf16_t)(pk2(wa[(size_t)mat * 25600 + k * 160 + n], 0.f) & 0xffffu); di[i] = (bf16_t)(pk2(wi[(size_t)mat * 25600 + k * 160 + n], 0.f) & 0xffffu); } }
    { const float* w = INP(F, I_SGU_WS); bf16_t* d = WSP(bf16_t, WS_SGU_WS);
      for (size_t i = gt; i < (size_t)8 * 128 * 128; i += GT) d[i] = (bf16_t)(pk2(w[i], 0.f) & 0xffffu); }
    LAS float* scr = (LAS float*)(F.lds + F.wave * 16384);
    int total = 0; for (int j = 0; j < 16; ++j) total += cvt_job_items(cvt_small_job(F, j));
    unsigned* head = F.ctl + CW_CVTQ + 64 * 6;
    for (;;) {
        int base = 0; if (F.lane == 0) base = (int)atomicAdd(head, 4u); base = __builtin_amdgcn_readfirstlane(base);
        if (base >= total) break;
        int j = 0, off = 0; CvtJob job = cvt_small_job(F, 0);
        for (;;) { const int n = cvt_job_items(job); if (base < off + n) break; off += n; ++j; job = cvt_small_job(F, j); }
        for (int k = 0; k < 4 && base + k < total; ++k) { int it = base + k - off; while (it >= cvt_job_items(job)) { it -= cvt_job_items(job); off += cvt_job_items(job); ++j; job = cvt_small_job(F, j); }
            cvt_item(job.src, job.K, job.N, job.dst, job.mode, scr, it, F.lane); }
    }
}
constexpr int CVT_MOE_ITEMS = 24 * 1792;
__device__ __forceinline__ bf16_t* moe_w13(const Frame& F, int l2) { return l2 ? WSP(bf16_t, WS_BIG + BG_MW2) : WSP(bf16_t, WS_MOE_W13); }
__device__ __forceinline__ bf16_t* moe_w2(const Frame& F, int l2) { return l2 ? WSP(bf16_t, WS_BIG + BG_MW2 + 112 * MiB) : WSP(bf16_t, WS_MOE_W2); }
__device__ __forceinline__ void cvt_moe_item(const Frame& F, int l2, int g, LAS float* scr) {
    const int job = g / 1792, it = g - job * 1792, e = job / 3, which = job - 3 * e; const size_t so = ((size_t)l2 * NE + e) * D * DFF;
    if (which == 0) cvt_item(INP(F, I_MOE_W1) + so, 1024, DFF, moe_w13(F, l2) + (size_t)e * 2 * DFF * D, 1, scr, it, F.lane);
    else if (which == 1) cvt_item(INP(F, I_MOE_W3) + so, 1024, DFF, moe_w13(F, l2) + (size_t)e * 2 * DFF * D, 2, scr, it, F.lane);
    else cvt_item(INP(F, I_MOE_W2) + so, DFF, 1024, moe_w2(F, l2) + (size_t)e * D * DFF, 0, scr, it, F.lane);
}
__device__ __forceinline__ void cvt_moe_queue(const Frame& F, int l2, int g_lo, int g_hi, int qword) {
    LAS float* scr = (LAS float*)(F.lds + F.wave * 16384);
    unsigned* head = F.ctl + CW_CVTQ + 64 * qword; const int n = g_hi - g_lo;
    for (;;) {
        int base = 0; if (F.lane == 0) base = (int)atomicAdd(head, 4u); base = __builtin_amdgcn_readfirstlane(base);
        if (base >= n) break;
        for (int k = 0; k < 4 && base + k < n; ++k) cvt_moe_item(F, l2, g_lo + base + k, scr);
    }
}

__device__ __forceinline__ void phase_mod(const Frame& F) {
    LAS float* sL = (LAS float*)F.lds;
    LAS float* pr = (LAS float*)(F.lds + 135168);
    const float* c = INP(F, I_C); const float* cc = INP(F, I_CCTX);
    __syncthreads();
    if (F.bid < 4 * 96) { for (int i = F.tid; i < 33 * 1024; i += NTHR) { const int b = i >> 10, k = i & 1023; const float v = b < 32 ? c[b * 1024 + k] : cc[k]; sL[i] = silu_f(v); } }
    __syncthreads();
    for (int unit = F.bid; unit < 4 * 96; unit += F.G) {
        const int l = unit / 96, col = (unit % 96) * 64 + F.lane, k0 = F.wave * 128;
        const float* w = INP(F, I_MODW) + (size_t)l * 1024 * MODW + col;
        float acc[33];
#pragma unroll
        for (int b = 0; b < 33; ++b) acc[b] = 0.f;
        for (int k = k0; k < k0 + 128; k += 16) {
            float wv[16];
#pragma unroll
            for (int j = 0; j < 16; ++j) wv[j] = w[(size_t)(k + j) * MODW];
#pragma unroll
            for (int b = 0; b < 33; ++b) {
#pragma unroll
                for (int q = 0; q < 4; ++q) { const f32x4 s0 = *(const LAS f32x4*)(sL + b * 1024 + k + 4 * q); acc[b] += (s0[0] * wv[4 * q] + s0[1] * wv[4 * q + 1]) + (s0[2] * wv[4 * q + 2] + s0[3] * wv[4 * q + 3]); } }
        }
#pragma unroll
        for (int pass = 0; pass < 4; ++pass) {
            __syncthreads();
#pragma unroll
            for (int b = 0; b < 9; ++b) if (pass * 9 + b < 33) pr[(F.wave * 9 + b) * 64 + F.lane] = acc[pass * 9 + b];
            __syncthreads();
            for (int i = F.tid; i < 9 * 64; i += NTHR) { const int b = i >> 6, cl = i & 63, bb = pass * 9 + b;
                if (bb < 33) { float t = 0.f;
#pragma unroll
                    for (int g = 0; g < 8; ++g) t += pr[(g * 9 + b) * 64 + cl];
                    const int cg = (unit % 96) * 64 + cl; F.modv[((size_t)l * 33 + bb) * MODW + cg] = t + INP(F, I_MODB)[l * MODW + cg]; } }
        }
    }
    __syncthreads();
}

struct NormCtx { const void* src_lat; const void* src_ctx; const float* gain; const float* mod; int which; bool f32src; };
struct NormPar { f32x4 gm[4], sh[4]; };
__device__ __forceinline__ void norm_load_par(const Frame& F, const NormCtx& N, int mb, NormPar& P) {
    const float* sh = N.mod + (size_t)mb * MODW + N.which * 3 * D; const float* sc = sh + D;
#pragma unroll
    for (int j = 0; j < 4; ++j) { const int c = 4 * F.lane + 256 * j; P.gm[j] = *(const f32x4*)(N.gain + c) * (*(const f32x4*)(sc + c) + 1.0f); P.sh[j] = *(const f32x4*)(sh + c); }
}
__device__ __forceinline__ void norm_load_row(const Frame& F, const NormCtx& N, int r, f32x4 (&v)[4]) {
    const size_t ro = (size_t)(r < RL ? r : r - RL) * D; const void* sp = r < RL ? N.src_lat : N.src_ctx;
#pragma unroll
    for (int j = 0; j < 4; ++j) {
        if (N.f32src) v[j] = *(const f32x4*)((const float*)sp + ro + 4 * F.lane + 256 * j);
        else { const u32x2 q = *(const u32x2*)((const bf16_t*)sp + ro + 4 * F.lane + 256 * j); v[j] = (f32x4){lo_bf(q.x), hi_bf(q.x), lo_bf(q.y), hi_bf(q.y)}; } }
}
__device__ __forceinline__ void norm_finish(const NormPar& P, const f32x4 (&v)[4], f32x4 (&y)[4]) {
    float ss = 0.f;
#pragma unroll
    for (int j = 0; j < 4; ++j) ss += (v[j][0] * v[j][0] + v[j][1] * v[j][1]) + (v[j][2] * v[j][2] + v[j][3] * v[j][3]);
    const float rstd = 1.0f / sqrtf(wave_sum(ss) * (1.0f / D) + NORM_EPS);
#pragma unroll
    for (int j = 0; j < 4; ++j) y[j] = (v[j] * rstd) * P.gm[j] + P.sh[j];
}
__device__ __forceinline__ void store_row_bf16(const Frame& F, bf16_t* dst, const f32x4 (&y)[4]) {
#pragma unroll
    for (int j = 0; j < 4; ++j) { u32x2 w; w.x = pk2(y[j][0], y[j][1]); w.y = pk2(y[j][2], y[j][3]); *(u32x2*)(dst + 4 * F.lane + 256 * j) = w; }
}
__device__ __forceinline__ void phase_norm(const Frame& F, const NormCtx& N, int nrows) {
    const int gw = F.bid * NWAVES + F.wave, NGW = F.G * NWAVES, RPW = (nrows + NGW - 1) / NGW, r0 = gw * RPW, r1 = min(nrows, r0 + RPW);
    if (r0 >= r1) return;
    NormPar P; int mbcur = -1; f32x4 v[4], vn[4];
    norm_load_row(F, N, r0, v);
    for (int r = r0; r < r1; ++r) {
        if (r + 1 < r1) norm_load_row(F, N, r + 1, vn);
        const int mb = r < RL ? (r >> 11) : 32; if (mb != mbcur) { norm_load_par(F, N, mb, P); mbcur = mb; }
        f32x4 y[4]; norm_finish(P, v, y); store_row_bf16(F, F.U + (size_t)r * D, y);
#pragma unroll
        for (int j = 0; j < 4; ++j) v[j] = vn[j];
    }
}
__device__ __forceinline__ void route_top2(const Frame& F, float (&lg)[NE], const float* br, int& e0, int& e1, float& w0) {
    const bool h5 = F.lane & 32, h4 = F.lane & 16, h3 = F.lane & 8;
    float a4[4];
#pragma unroll
    for (int k = 0; k < 4; ++k) { const float mine = h5 ? lg[4 + k] : lg[k], send = h5 ? lg[k] : lg[4 + k]; a4[k] = mine + __shfl_xor(send, 32); }
    float a2[2];
#pragma unroll
    for (int k = 0; k < 2; ++k) { const float mine = h4 ? a4[2 + k] : a4[k], send = h4 ? a4[k] : a4[2 + k]; a2[k] = mine + __shfl_xor(send, 16); }
    float a1; { const float mine = h3 ? a2[1] : a2[0], send = h3 ? a2[0] : a2[1]; a1 = mine + __shfl_xor(send, 8); }
    a1 += __shfl_xor(a1, 4); a1 += __shfl_xor(a1, 2); a1 += __shfl_xor(a1, 1);
#pragma unroll
    for (int e = 0; e < NE; ++e) lg[e] = __int_as_float(__builtin_amdgcn_readlane(__float_as_int(a1), ((e >> 2) & 1) * 32 + ((e >> 1) & 1) * 16 + (e & 1) * 8)) + br[e];
    e0 = 0; float v0 = lg[0];
#pragma unroll
    for (int e = 1; e < NE; ++e) if (lg[e] > v0) { v0 = lg[e]; e0 = e; }
    e1 = -1; float v1 = -3.0e38f;
#pragma unroll
    for (int e = 0; e < NE; ++e) if (e != e0 && lg[e] > v1) { v1 = lg[e]; e1 = e; }
    w0 = 1.0f / (1.0f + __expf(v1 - v0));
}
__device__ __forceinline__ void phase_route(const Frame& F, const NormCtx& N, int nrows, int l2) {
    LAS float* wrL = (LAS float*)F.lds;
    LAS unsigned* hist = (LAS unsigned*)(F.lds + 32768);
    __syncthreads();
    const float* wr = INP(F, I_MOE_WR) + (size_t)l2 * D * NE; const float* br = INP(F, I_MOE_BR) + l2 * NE;
    for (int i = F.tid; i < D * NE; i += NTHR) wrL[(i & 7) * D + (i >> 3)] = wr[i];
    if (F.tid < 16) hist[F.tid] = 0u;
    __syncthreads();
    int* re = WSP(int, WS_ROUTE + RT_E); float* rw = WSP(float, WS_ROUTE + RT_W);
    const int gw = F.bid * NWAVES + F.wave, NGW = F.G * NWAVES, RPW = (nrows + NGW - 1) / NGW, r0 = gw * RPW, r1 = min(nrows, r0 + RPW);
    NormPar P; int mbcur = -1; f32x4 va[4], vb[4];
    for (int r = r0; r < r1; r += 2) {
        const bool two = r + 1 < r1; const int rb = two ? r + 1 : r;
        norm_load_row(F, N, r, va); norm_load_row(F, N, rb, vb);
        f32x4 ya[4], yb[4];
        { const int mb = r < RL ? (r >> 11) : 32; if (mb != mbcur) { norm_load_par(F, N, mb, P); mbcur = mb; } norm_finish(P, va, ya); store_row_bf16(F, F.U + (size_t)r * D, ya); }
        { const int mb = rb < RL ? (rb >> 11) : 32; if (mb != mbcur) { norm_load_par(F, N, mb, P); mbcur = mb; } norm_finish(P, vb, yb); if (two) store_row_bf16(F, F.U + (size_t)rb * D, yb); }
        float la[NE], lb[NE];
#pragma unroll
        for (int e = 0; e < NE; ++e) { la[e] = 0.f; lb[e] = 0.f; }
#pragma unroll
        for (int j = 0; j < 4; ++j)
#pragma unroll
            for (int e = 0; e < NE; ++e) { const f32x4 wv = *(const LAS f32x4*)(wrL + e * D + 4 * F.lane + 256 * j);
                la[e] += (ya[j][0] * wv[0] + ya[j][1] * wv[1]) + (ya[j][2] * wv[2] + ya[j][3] * wv[3]); lb[e] += (yb[j][0] * wv[0] + yb[j][1] * wv[1]) + (yb[j][2] * wv[2] + yb[j][3] * wv[3]); }
        int e0, e1; float w0;
        route_top2(F, la, br, e0, e1, w0);
        if (F.lane == 0) { re[r] = e0 | (e1 << 8); rw[2 * r] = w0; rw[2 * r + 1] = 1.0f - w0; lds_add(&hist[e0], 1u); lds_add(&hist[8 + e1], 1u); }
        route_top2(F, lb, br, e0, e1, w0);
        if (F.lane == 0 && two) { re[rb] = e0 | (e1 << 8); rw[2 * rb] = w0; rw[2 * rb + 1] = 1.0f - w0; lds_add(&hist[e0], 1u); lds_add(&hist[8 + e1], 1u); }
    }
    __syncthreads();
    if (F.tid < 16 && hist[F.tid]) atomicAdd(F.ctl + CW_CNT + 64 * l2 + F.tid, hist[F.tid]);
    int* tok = WSP(int, WS_ROUTE + RT_TOK);
    for (size_t i = (size_t)F.bid * NTHR + F.tid; i < (size_t)2 * MPAD; i += (size_t)F.G * NTHR) tok[i] = -1;
    __syncthreads();
}
__device__ __forceinline__ int pad256(int x) { return (x + 255) & ~255; }
__device__ __forceinline__ void phase_assign_scatter0(const Frame& F, int nrows, int l2) {
    LAS unsigned* bcnt = (LAS unsigned*)F.lds;
    LAS unsigned* bbase = (LAS unsigned*)(F.lds + 64);
    __syncthreads();
    if (F.tid < 16) bcnt[F.tid] = 0u;
    __syncthreads();
    const int RPB = (nrows + F.G - 1) / F.G, rb0 = F.bid * RPB, rb1 = min(nrows, rb0 + RPB);
    const int* re = WSP(const int, WS_ROUTE + RT_E); const float* rw = WSP(const float, WS_ROUTE + RT_W);
    int* tok = WSP(int, WS_ROUTE + RT_TOK); float* gwl = WSP(float, WS_ROUTE + RT_GW); int* pos1 = WSP(int, WS_ROUTE + RT_P1);
    const int myr = rb0 + F.wave + 8 * F.lane; const bool have = myr < rb1;
    int e0 = 0, e1 = 0; unsigned li0 = 0, li1 = 0; float w0 = 0.f, w1 = 0.f;
    if (have) { const int ee = re[myr]; e0 = ee & 255; e1 = (ee >> 8) & 255; w0 = rw[2 * myr]; w1 = rw[2 * myr + 1]; li0 = lds_add(&bcnt[e0], 1u); li1 = lds_add(&bcnt[8 + e1], 1u); }
    __syncthreads();
    const unsigned* cnt = F.ctl + CW_CNT + 64 * l2;
    if (F.tid < 16) { const int s = F.tid >> 3, e = F.tid & 7; unsigned off = 0; for (int k = 0; k < e; ++k) off += (unsigned)pad256((int)cnt[s * 8 + k]);
        unsigned b = 0; if (bcnt[F.tid]) b = atomicAdd(F.ctl + CW_CUR + 64 * l2 + F.tid, bcnt[F.tid]); bbase[F.tid] = off + b; }
    __syncthreads();
    const int p0 = (int)(bbase[e0] + li0), p1 = (int)(bbase[8 + e1] + li1);
    if (have) { tok[p0] = myr; gwl[p0] = w0; tok[MPAD + p1] = myr; gwl[MPAD + p1] = w1; pos1[myr] = p1; }
    __syncthreads();
}
__device__ __forceinline__ int moe_tile_table(const Frame& F, int l2, int s, LAS int* tstart) {
    __syncthreads();
    if (F.tid == 0) { const unsigned* cnt = F.ctl + CW_CNT + 64 * l2 + 8 * s; int t = 0; for (int e = 0; e < NE; ++e) { tstart[e] = t; t += pad256((int)cnt[e]) >> 8; } tstart[8] = t; }
    __syncthreads();
    return tstart[8];
}

constexpr int SC_RS = 164;
__device__ __forceinline__ void scan_conv_load(const bf16_t* XG, size_t rowbase, int L, int t0, int ch0, int pt, u32x2 (&xr)[11]) {
    const int q4 = pt % 40, rg = pt / 40, ch = ch0 + 4 * q4, ta = t0 + 8 * rg;
#pragma unroll
    for (int i = 0; i < 11; ++i) { const int tp = ta - 2 + i; xr[i] = (tp >= 0 && tp < L) ? *(const u32x2*)(XG + (rowbase + tp) * 2560 + ch) : (u32x2){0u, 0u}; }
}
__device__ __forceinline__ void scan_conv_math(const float* cw, const float* cb, LAS bf16_t* xc, int ch0, int pt, const u32x2 (&xr)[11]) {
    const int q4 = pt % 40, rg = pt / 40, ch = ch0 + 4 * q4;
    const f32x4 bias = *(const f32x4*)(cb + ch); f32x4 wv[4];
#pragma unroll
    for (int k = 0; k < 4; ++k) wv[k] = *(const f32x4*)(cw + k * DRNN + ch);
#pragma unroll
    for (int i = 0; i < 8; ++i) { f32x4 acc = bias;
#pragma unroll
        for (int k = 0; k < 4; ++k) { const u32x2 x = xr[i + k]; acc[0] += lo_bf(x.x) * wv[k][0]; acc[1] += hi_bf(x.x) * wv[k][1]; acc[2] += lo_bf(x.y) * wv[k][2]; acc[3] += hi_bf(x.y) * wv[k][3]; }
        u32x2 o; o.x = pk2(acc[0], acc[1]); o.y = pk2(acc[2], acc[3]); *(LAS u32x2*)(xc + (8 * rg + i) * 168 + 4 * q4) = o; }
}
__device__ __forceinline__ void phase_scan(const Frame& F, bool need_ctx) {
    LAS bf16_t* xcA0 = (LAS bf16_t*)F.lds;
    LAS float* Ra = (LAS float*)(F.lds + 43008);
    LAS float* Ri = (LAS float*)(F.lds + 43008 + 41984);
    LAS float* tab = (LAS float*)(F.lds + 43008 + 2 * 41984);
    LAS bf16_t* Hb = (LAS bf16_t*)(F.lds + 43008 + 2 * 41984 + 2048);
    const bf16_t* XG = WSP(const bf16_t, WS_BIG + BG_XG); bf16_t* Y = WSP(bf16_t, WS_BIG + BG_Y);
    const float* cw = INP(F, I_LRU_CW); const float* cb = INP(F, I_LRU_CB);
    const int fr = F.lane & 15, fq = F.lane >> 4, w = F.wave;
    const int ntA = w, ntB = 8 + (w & 1), mtB = w >> 1;
    for (int unit = F.bid; unit < NB * 8; unit += F.G) {
        const int b = unit >> 3, kb = unit & 7, ch0 = kb * LBW;
        for (int d = 0; d < 2; ++d) {
            float carry = 0.f;
            bf16x8 Ba[5], Bi[5];
            __syncthreads();
            const bf16_t* wa = WSP(const bf16_t, WS_LRU_WA) + (size_t)(d * 8 + kb) * 25600; const bf16_t* wi = WSP(const bf16_t, WS_LRU_WI) + (size_t)(d * 8 + kb) * 25600;
#pragma unroll
            for (int ks = 0; ks < 5; ++ks) { Ba[ks] = *(const bf16x8*)(wa + (16 * ntA + fr) * 160 + 32 * ks + 8 * fq); Bi[ks] = *(const bf16x8*)(wi + (16 * ntA + fr) * 160 + 32 * ks + 8 * fq); }
            if (F.tid < LBW) { const int c = ch0 + F.tid; tab[F.tid] = INP(F, I_LRU_BA)[d * DRNN + c]; tab[160 + F.tid] = INP(F, I_LRU_BI)[d * DRNN + c];
                const float lam = INP(F, I_LRU_LAM)[d * DRNN + c]; tab[320 + F.tid] = 8.0f * 1.4426950408889634f * (lam > 0.f ? log1pf(expf(-lam)) : (-lam + log1pf(expf(lam)))); }
            if (F.tid >= 192) { u32x2 xr[11]; scan_conv_load(XG, (size_t)RL + (size_t)b * CTXL, CTXL, d ? CTXL - 64 : 0, ch0, F.tid - 192, xr); scan_conv_math(cw, cb, xcA0, ch0, F.tid - 192, xr); }
            __syncthreads();
            for (int cidx = 0; cidx <= 36; ++cidx) {
                const int seg = cidx >= 4, ci = seg ? cidx - 4 : cidx, L = seg ? SEQ : CTXL; const size_t rowbase = seg ? (size_t)b * SEQ : (size_t)RL + (size_t)b * CTXL;
                const int t0 = d ? L - 64 * (ci + 1) : 64 * ci;
                LAS bf16_t* xc = xcA0 + (cidx & 1) * (64 * 168);
                const int pc = cidx - 1; const int pseg = pc >= 4, pci = pseg ? pc - 4 : pc, pL = pseg ? SEQ : CTXL; const size_t prow = pseg ? (size_t)b * SEQ : (size_t)RL + (size_t)b * CTXL;
                const int pt0 = d ? pL - 64 * (pci + 1) : 64 * pci; const bool p_out = pc >= 0 && (pseg == 1 || need_ctx);
                u32x2 pv[5], gv[5];
#pragma unroll
                for (int it = 0; it < 5; ++it) { const int e = F.tid + NTHR * it, tt = e / 40, c4 = e % 40;
                    if (d == 1 && p_out) { const size_t row = prow + pt0 + tt; pv[it] = *(const u32x2*)(Y + row * DRNN + ch0 + 4 * c4); gv[it] = *(const u32x2*)(XG + row * 2560 + DRNN + ch0 + 4 * c4); } else { pv[it] = (u32x2){0u, 0u}; gv[it] = (u32x2){0u, 0u}; } }
                if (cidx < 36) {
                    bf16x8 Xa[5], Xi[5];
#pragma unroll
                    for (int ks = 0; ks < 5; ++ks) { Xa[ks] = *(const bf16x8*)(wa + (16 * ntB + fr) * 160 + 32 * ks + 8 * fq); Xi[ks] = *(const bf16x8*)(wi + (16 * ntB + fr) * 160 + 32 * ks + 8 * fq); }
#pragma unroll 1
                    for (int mt = 0; mt < 4; ++mt) {
                        f32x4 ra = {0.f, 0.f, 0.f, 0.f}, ri = {0.f, 0.f, 0.f, 0.f};
#pragma unroll
                        for (int ks = 0; ks < 5; ++ks) { const bf16x8 a = *(const LAS bf16x8*)(xc + (16 * mt + fr) * 168 + 32 * ks + 8 * fq);
                            ra = __builtin_amdgcn_mfma_f32_16x16x32_bf16(Ba[ks], a, ra, 0, 0, 0); ri = __builtin_amdgcn_mfma_f32_16x16x32_bf16(Bi[ks], a, ri, 0, 0, 0); }
                        const int o = (16 * mt + fr) * SC_RS + 16 * ntA + 4 * fq; *(LAS f32x4*)(Ra + o) = ra; *(LAS f32x4*)(Ri + o) = ri;
                    }
                    {
                        f32x4 ra = {0.f, 0.f, 0.f, 0.f}, ri = {0.f, 0.f, 0.f, 0.f};
#pragma unroll
                        for (int ks = 0; ks < 5; ++ks) { const bf16x8 a = *(const LAS bf16x8*)(xc + (16 * mtB + fr) * 168 + 32 * ks + 8 * fq);
                            ra = __builtin_amdgcn_mfma_f32_16x16x32_bf16(Xa[ks], a, ra, 0, 0, 0); ri = __builtin_amdgcn_mfma_f32_16x16x32_bf16(Xi[ks], a, ri, 0, 0, 0); }
                        const int o = (16 * mtB + fr) * SC_RS + 16 * ntB + 4 * fq; *(LAS f32x4*)(Ra + o) = ra; *(LAS f32x4*)(Ri + o) = ri;
                    }
                }
                if (p_out) {
#pragma unroll
                    for (int it = 0; it < 5; ++it) { const int e = F.tid + NTHR * it, tt = e / 40, c4 = e % 40; const u32x2 hb = *(const LAS u32x2*)(Hb + tt * 168 + 4 * c4);
                        u32x2* yp = (u32x2*)(Y + (prow + pt0 + tt) * DRNN + ch0 + 4 * c4); u32x2 o;
                        if (d == 0) o = hb;
                        else { o.x = pk2((lo_bf(pv[it].x) + lo_bf(hb.x)) * gelu_tanh_f(lo_bf(gv[it].x)), (hi_bf(pv[it].x) + hi_bf(hb.x)) * gelu_tanh_f(hi_bf(gv[it].x)));
                               o.y = pk2((lo_bf(pv[it].y) + lo_bf(hb.y)) * gelu_tanh_f(lo_bf(gv[it].y)), (hi_bf(pv[it].y) + hi_bf(hb.y)) * gelu_tanh_f(hi_bf(gv[it].y))); }
                        *yp = o; }
                }
                if (cidx == 36) break;
                __syncthreads();
                const bool do_conv = F.tid >= 192 && cidx + 1 < 36;
                u32x2 xr[11];
                if (do_conv) { const int nseg = (cidx + 1) >= 4, nci = nseg ? cidx + 1 - 4 : cidx + 1, nL = nseg ? SEQ : CTXL;
                    scan_conv_load(XG, nseg ? (size_t)b * SEQ : (size_t)RL + (size_t)b * CTXL, nL, d ? nL - 64 * (nci + 1) : 64 * nci, ch0, F.tid - 192, xr); }
#pragma unroll 1
                for (int it = 0; it < 5; ++it) { const int e = F.tid + NTHR * it, tt = e / 40, c4 = e % 40; const int o = tt * SC_RS + 4 * c4;
                    const f32x4 va = *(const LAS f32x4*)(Ra + o) + *(const LAS f32x4*)(tab + 4 * c4), vi = *(const LAS f32x4*)(Ri + o) + *(const LAS f32x4*)(tab + 160 + 4 * c4), sp = *(const LAS f32x4*)(tab + 320 + 4 * c4);
                    const u32x2 xv = *(const LAS u32x2*)(xc + tt * 168 + 4 * c4); const float xf[4] = {lo_bf(xv.x), hi_bf(xv.x), lo_bf(xv.y), hi_bf(xv.y)};
                    f32x4 av, bv;
#pragma unroll
                    for (int j = 0; j < 4; ++j) { const float r = __builtin_amdgcn_rcpf(1.0f + __builtin_amdgcn_exp2f(-1.4426950408889634f * va[j])), ig = __builtin_amdgcn_rcpf(1.0f + __builtin_amdgcn_exp2f(-1.4426950408889634f * vi[j]));
                        const float a = __builtin_amdgcn_exp2f(-r * sp[j]); av[j] = a; bv[j] = __builtin_amdgcn_sqrtf(fmaxf(1.0f - a * a, 0.f)) * (ig * xf[j]); }
                    *(LAS f32x4*)(Ra + o) = av; *(LAS f32x4*)(Ri + o) = bv; }
                __syncthreads();
                if (F.tid < LBW) { float h = carry;
#pragma unroll 1
                    for (int s0 = 0; s0 < 64; s0 += 16) {
                        float av[16], bv[16], hv[16];
#pragma unroll
                        for (int k = 0; k < 16; ++k) { const int tt = d ? 63 - (s0 + k) : s0 + k; av[k] = Ra[tt * SC_RS + F.tid]; bv[k] = Ri[tt * SC_RS + F.tid]; }
#pragma unroll
                        for (int k = 0; k < 16; ++k) { h = av[k] * h + bv[k]; hv[k] = h; }
#pragma unroll
                        for (int k = 0; k < 16; ++k) { const int tt = d ? 63 - (s0 + k) : s0 + k; Hb[tt * 168 + F.tid] = (bf16_t)(pk2(hv[k], 0.f) & 0xffffu); }
                    }
                    carry = h; }
                else if (do_conv) scan_conv_math(cw, cb, xcA0 + ((cidx + 1) & 1) * (64 * 168), ch0, F.tid - 192, xr);
                __syncthreads();
            }
        }
    }
}

__device__ __forceinline__ void phase_sgu_stats(const Frame& F) {
    const bf16_t* Z = WSP(const bf16_t, WS_BIG + BG_Z); float* st = WSP(float, WS_ROUTE + RT_ST);
    const int gw = F.bid * NWAVES + F.wave, NGW = F.G * NWAVES, RPW = (RA + NGW - 1) / NGW, r0 = gw * RPW, r1 = min(RA, r0 + RPW);
    if (r0 >= r1) return;
    u32x4 q[4], qn[4];
#pragma unroll
    for (int j = 0; j < 4; ++j) q[j] = *(const u32x4*)(Z + (size_t)r0 * 4096 + DSGU + 8 * F.lane + 512 * j);
    for (int r = r0; r < r1; ++r) {
        if (r + 1 < r1) {
#pragma unroll
            for (int j = 0; j < 4; ++j) qn[j] = *(const u32x4*)(Z + (size_t)(r + 1) * 4096 + DSGU + 8 * F.lane + 512 * j); }
        float x[32]; float s = 0.f;
#pragma unroll
        for (int j = 0; j < 4; ++j) { x[8 * j + 0] = lo_bf(q[j].x); x[8 * j + 1] = hi_bf(q[j].x); x[8 * j + 2] = lo_bf(q[j].y); x[8 * j + 3] = hi_bf(q[j].y); x[8 * j + 4] = lo_bf(q[j].z); x[8 * j + 5] = hi_bf(q[j].z); x[8 * j + 6] = lo_bf(q[j].w); x[8 * j + 7] = hi_bf(q[j].w); }
#pragma unroll
        for (int i = 0; i < 32; ++i) s += x[i];
        const float mean = wave_sum(s) * (1.0f / DSGU); float q2 = 0.f;
#pragma unroll
        for (int i = 0; i < 32; ++i) { const float dlt = x[i] - mean; q2 += dlt * dlt; }
        const float rstd = 1.0f / sqrtf(wave_sum(q2) * (1.0f / DSGU) + NORM_EPS);
        if (F.lane == 0) { st[2 * r] = mean; st[2 * r + 1] = rstd; }
#pragma unroll
        for (int j = 0; j < 4; ++j) q[j] = qn[j];
    }
}
__device__ __forceinline__ size_t sgu_row0(int cu) { return cu < 512 ? (size_t)(cu >> 4) * SEQ + (size_t)(cu & 15) * 128 : (size_t)RL + (size_t)((cu - 512) >> 1) * CTXL + (size_t)((cu - 512) & 1) * 128; }
__device__ __forceinline__ void phase_sgu_spatial(const Frame& F) {
    LAS bf16_t* vT = (LAS bf16_t*)F.lds;
    LAS bf16_t* uT = (LAS bf16_t*)(F.lds + 69632);
    bf16_t* Z = WSP(bf16_t, WS_BIG + BG_Z); const float* st = WSP(const float, WS_ROUTE + RT_ST);
    const bf16_t* wsb = WSP(const bf16_t, WS_SGU_WS);
    const float* lng = INP(F, I_SGU_LNG); const float* lnb = INP(F, I_SGU_LNB); const float* bs = INP(F, I_SGU_BS);
    const int fr = F.lane & 15, fq = F.lane >> 4, w = F.wave;
    const int q8 = F.tid & 15, d8 = F.tid >> 4;
    const int urow = F.tid >> 5, uch = F.tid & 31;
    u32x4 vq[8], uq[8]; f32x2 sq[8];
    int unit = F.bid;
    if (unit < 576 * 8) { const int cu = unit >> 3, g = unit & 7; const size_t row0 = sgu_row0(cu);
#pragma unroll
        for (int i = 0; i < 8; ++i) { const size_t r = row0 + 8 * q8 + i; vq[i] = *(const u32x4*)(Z + r * 4096 + DSGU + 256 * g + 8 * d8); sq[i] = *(const f32x2*)(st + 2 * r);
            uq[i] = *(const u32x4*)(Z + (row0 + urow + 16 * i) * 4096 + 256 * g + 8 * uch); } }
    for (; unit < 576 * 8; unit += F.G) {
        const int cu = unit >> 3, g = unit & 7; const size_t row0 = sgu_row0(cu);
        {
            const int dcol = 256 * g + 8 * d8; float gg[8], bb[8];
#pragma unroll
            for (int j = 0; j < 8; ++j) { gg[j] = lng[dcol + j]; bb[j] = lnb[dcol + j]; }
            float x[8][8];
#pragma unroll
            for (int i = 0; i < 8; ++i) { const u32x4 q = vq[i]; const float mean = sq[i][0], rstd = sq[i][1];
                const float raw[8] = {lo_bf(q.x), hi_bf(q.x), lo_bf(q.y), hi_bf(q.y), lo_bf(q.z), hi_bf(q.z), lo_bf(q.w), hi_bf(q.w)};
#pragma unroll
                for (int j = 0; j < 8; ++j) x[i][j] = (raw[j] - mean) * rstd * gg[j] + bb[j]; }
#pragma unroll
            for (int j = 0; j < 8; ++j) { u32x4 o; o.x = pk2(x[0][j], x[1][j]); o.y = pk2(x[2][j], x[3][j]); o.z = pk2(x[4][j], x[5][j]); o.w = pk2(x[6][j], x[7][j]);
                *(LAS u32x4*)(vT + (8 * d8 + j) * 136 + 8 * q8) = o; }
#pragma unroll
            for (int i = 0; i < 8; ++i) *(LAS u32x4*)(uT + (urow + 16 * i) * 264 + 8 * uch) = uq[i];
        }
        __syncthreads();
        {
            const int nu = unit + F.G;
            if (nu < 576 * 8) { const int ncu = nu >> 3, ng = nu & 7; const size_t nrow0 = sgu_row0(ncu);
#pragma unroll
                for (int i = 0; i < 8; ++i) { const size_t r = nrow0 + 8 * q8 + i; vq[i] = *(const u32x4*)(Z + r * 4096 + DSGU + 256 * ng + 8 * d8); sq[i] = *(const f32x2*)(st + 2 * r);
                    uq[i] = *(const u32x4*)(Z + (nrow0 + urow + 16 * i) * 4096 + 256 * ng + 8 * uch); } }
            const int p = 16 * w + fr; LAS u32x2* urow_l = (LAS u32x2*)(uT + p * 264 + 4 * fq);
            bf16x8 af[4];
#pragma unroll
            for (int ks = 0; ks < 4; ++ks) af[ks] = *(const bf16x8*)(wsb + ((size_t)g * 128 + p) * 128 + 32 * ks + 8 * fq);
            const float bias = bs[g * 128 + p];
#pragma unroll 4
            for (int nt = 0; nt < 16; ++nt) { f32x4 acc = {0.f, 0.f, 0.f, 0.f};
#pragma unroll
                for (int ks = 0; ks < 4; ++ks) { const bf16x8 bfv = *(const LAS bf16x8*)(vT + (16 * nt + fr) * 136 + 32 * ks + 8 * fq); acc = __builtin_amdgcn_mfma_f32_16x16x32_bf16(bfv, af[ks], acc, 0, 0, 0); }
                const u32x2 u2 = urow_l[4 * nt]; u32x2 o; o.x = pk2(lo_bf(u2.x) * (acc[0] + bias), hi_bf(u2.x) * (acc[1] + bias)); o.y = pk2(lo_bf(u2.y) * (acc[2] + bias), hi_bf(u2.y) * (acc[3] + bias)); urow_l[4 * nt] = o; }
        }
        __syncthreads();
#pragma unroll
        for (int i = 0; i < 8; ++i) *(u32x4*)(Z + (row0 + urow + 16 * i) * 4096 + 256 * g + 8 * uch) = *(const LAS u32x4*)(uT + (urow + 16 * i) * 264 + 8 * uch);
        __syncthreads();
    }
}

template <int WN> __device__ __forceinline__ void pool_item(const bf16_t* U, bf16_t* PD, int r, int cg) {
    int t, L; size_t base; if (r < RL) { t = r & (SEQ - 1); L = SEQ; base = (size_t)(r - t); } else { t = (r - RL) & (CTXL - 1); L = CTXL; base = (size_t)(r - t); }
    const int lo = max(t - WN / 2, 0), hi = min(t + WN / 2 - 1, L - 1);
    u32x4 v[WN];
#pragma unroll
    for (int k = 0; k < WN; ++k) { const int q = min(max(t - WN / 2 + k, 0), L - 1); v[k] = *(const u32x4*)(U + (base + q) * D + 8 * cg); }
    float s[8] = {0.f, 0.f, 0.f, 0.f, 0.f, 0.f, 0.f, 0.f};
#pragma unroll
    for (int k = 0; k < WN; ++k) { const int q = t - WN / 2 + k; const float m = (q >= lo && q <= hi) ? 1.f : 0.f;
        s[0] += m * lo_bf(v[k].x); s[1] += m * hi_bf(v[k].x); s[2] += m * lo_bf(v[k].y); s[3] += m * hi_bf(v[k].y); s[4] += m * lo_bf(v[k].z); s[5] += m * hi_bf(v[k].z); s[6] += m * lo_bf(v[k].w); s[7] += m * hi_bf(v[k].w); }
    const u32x4 sv = v[WN / 2];
    const float inv = 1.0f / (float)(hi - lo + 1);
    u32x4 o; o.x = pk2(s[0] * inv - lo_bf(sv.x), s[1] * inv - hi_bf(sv.x)); o.y = pk2(s[2] * inv - lo_bf(sv.y), s[3] * inv - hi_bf(sv.y));
    o.z = pk2(s[4] * inv - lo_bf(sv.z), s[5] * inv - hi_bf(sv.z)); o.w = pk2(s[6] * inv - lo_bf(sv.w), s[7] * inv - hi_bf(sv.w));
    *(u32x4*)(PD + (size_t)r * D + 8 * cg) = o;
}
__device__ __forceinline__ void phase_pool_diff(const Frame& F) {
    bf16_t* PD = WSP(bf16_t, WS_BIG + BG_PD);
    const size_t T0 = (size_t)F.bid * NTHR + F.tid, TS = (size_t)F.G * NTHR, NI = (size_t)RA * 32;
#define POOL_LOOP(g_, WN_, K_) for (size_t i = T0; i < NI; i += K_ * TS) { _Pragma("unroll") for (int k_ = 0; k_ < K_; ++k_) { const size_t ii = i + k_ * TS; if (ii < NI) pool_item<WN_>(F.U, PD, (int)(ii >> 5), 32 * g_ + (int)(ii & 31)); } }
    POOL_LOOP(0, 2, 8) POOL_LOOP(1, 4, 4) POOL_LOOP(2, 8, 2) POOL_LOOP(3, 16, 1)
#undef POOL_LOOP
}

__device__ __forceinline__ void phase_na(const Frame& F) {
    const bf16_t* QKV = WSP(const bf16_t, WS_BIG + BG_QKV); bf16_t* O = WSP(bf16_t, WS_BIG + BG_O); const float* rpb = INP(F, I_NA_RPB);
    const int w = F.wave, rsub = w >> 1, chh = w & 1, fr = F.lane & 15, fq = F.lane >> 4;
    const int skey = F.tid >> 3, sd8 = F.tid & 7;
    LAS float* bt = (LAS float*)(F.lds + 36864);
    const unsigned trl = (unsigned)((fr >> 2) * 144 + (fr & 3) * 8);
    float kgain[8];
#pragma unroll
    for (int j = 0; j < 8; ++j) kgain[j] = INP(F, I_NA_KG)[8 * sd8 + j];
#define NA_KNORM(kr) do { float x_[8] = {lo_bf(kr.x), hi_bf(kr.x), lo_bf(kr.y), hi_bf(kr.y), lo_bf(kr.z), hi_bf(kr.z), lo_bf(kr.w), hi_bf(kr.w)}; float ss_ = 0.f; \
        _Pragma("unroll") for (int j_ = 0; j_ < 8; ++j_) ss_ += x_[j_] * x_[j_]; \
        ss_ += dpp_f<0xB1>(ss_); ss_ += dpp_f<0x4E>(ss_); ss_ += dpp_f<0x141>(ss_); \
        const float rs_ = __builtin_amdgcn_rsqf(ss_ * (1.0f / 64.0f) + NORM_EPS); \
        kr.x = pk2(x_[0] * rs_ * kgain[0], x_[1] * rs_ * kgain[1]); kr.y = pk2(x_[2] * rs_ * kgain[2], x_[3] * rs_ * kgain[3]); \
        kr.z = pk2(x_[4] * rs_ * kgain[4], x_[5] * rs_ * kgain[5]); kr.w = pk2(x_[6] * rs_ * kgain[6], x_[7] * rs_ * kgain[7]); } while (0)
    float gqm = 0.f, gkm = 0.f; for (int i = 0; i < 64; ++i) { gqm = fmaxf(gqm, fabsf(INP(F, I_NA_QG)[i])); gkm = fmaxf(gkm, fabsf(INP(F, I_NA_KG)[i])); }
    const float M0 = 8.0f * gqm * gkm * 1.4426950408889634f;
    for (int unit = F.bid; unit < NB * 16 * 8; unit += F.G) {
        const int rg = unit & 7, h = (unit >> 3) & 15, b = unit >> 7;
        const int r = 4 * rg + rsub, r0 = min(max(r - 4, 0), 24);
        const int ulo = min(max(4 * rg - 4, 0), 24), uhi = min(max(4 * rg - 1, 0), 24) + 8, nnb = uhi - ulo, ntile = nnb + 4;
        bf16x8 qf[2][2]; size_t qrow[2];
#pragma unroll
        for (int qt = 0; qt < 2; ++qt) { qrow[qt] = (size_t)b * SEQ + (size_t)r * 64 + 32 * chh + 16 * qt + fr;
            u32x4 raw[2]; float xv[2][8]; float ss = 0.f;
#pragma unroll
            for (int ks = 0; ks < 2; ++ks) { raw[ks] = *(const u32x4*)(QKV + qrow[qt] * 3072 + h * 64 + 32 * ks + 8 * fq);
                xv[ks][0] = lo_bf(raw[ks].x); xv[ks][1] = hi_bf(raw[ks].x); xv[ks][2] = lo_bf(raw[ks].y); xv[ks][3] = hi_bf(raw[ks].y); xv[ks][4] = lo_bf(raw[ks].z); xv[ks][5] = hi_bf(raw[ks].z); xv[ks][6] = lo_bf(raw[ks].w); xv[ks][7] = hi_bf(raw[ks].w);
#pragma unroll
                for (int j = 0; j < 8; ++j) ss += xv[ks][j] * xv[ks][j]; }
            ss += __shfl_xor(ss, 16); ss += __shfl_xor(ss, 32);
            const float rs = __builtin_amdgcn_rsqf(ss * (1.0f / 64.0f) + NORM_EPS) * (0.125f * 1.4426950408889634f);
#pragma unroll
            for (int ks = 0; ks < 2; ++ks) { const float* gq = INP(F, I_NA_QG) + 32 * ks + 8 * fq; u32x4 pw;
                pw.x = pk2(xv[ks][0] * rs * gq[0], xv[ks][1] * rs * gq[1]); pw.y = pk2(xv[ks][2] * rs * gq[2], xv[ks][3] * rs * gq[3]); pw.z = pk2(xv[ks][4] * rs * gq[4], xv[ks][5] * rs * gq[5]); pw.w = pk2(xv[ks][6] * rs * gq[6], xv[ks][7] * rs * gq[7]);
                qf[qt][ks] = __builtin_bit_cast(bf16x8, pw); } }
        f32x4 o[2][4]; float lrun[2] = {0.f, 0.f};
#pragma unroll
        for (int qt = 0; qt < 2; ++qt)
#pragma unroll
            for (int dt = 0; dt < 4; ++dt) o[qt][dt] = (f32x4){0.f, 0.f, 0.f, 0.f};
        for (int i = F.tid; i < 15 * 31; i += NTHR) bt[i] = rpb[(size_t)h * 465 + i] * 1.4426950408889634f - M0;
        u32x4 kreg, vreg;
        { const size_t krow = (size_t)b * SEQ + (size_t)ulo * 64 + skey; const bf16_t* kp = QKV + krow * 3072 + D + h * 64 + 8 * sd8; kreg = *(const u32x4*)kp; vreg = *(const u32x4*)(kp + D); }
        NA_KNORM(kreg);
        *(LAS u32x4*)(F.lds + skey * 144 + sd8 * 16) = kreg; *(LAS u32x4*)(F.lds + 9216 + skey * 144 + sd8 * 16) = vreg;
        __syncthreads();
        for (int i = 0; i < ntile; ++i) {
            if (i + 1 < ntile) { const size_t krow = (i + 1 < nnb ? (size_t)b * SEQ + (size_t)(ulo + i + 1) * 64 : (size_t)RL + (size_t)b * CTXL + (size_t)(i + 1 - nnb) * 64) + skey;
                const bf16_t* kp = QKV + krow * 3072 + D + h * 64 + 8 * sd8; kreg = *(const u32x4*)kp; vreg = *(const u32x4*)(kp + D); }
            LAS unsigned char* Kb = F.lds + (i & 1) * 18432; LAS unsigned char* Vb = Kb + 9216;
            const bool isnb = i < nnb; const int ra = ulo + i;
            if (!isnb || (ra >= r0 && ra < r0 + 8)) {
                bf16x8 kf[4][2];
#pragma unroll
                for (int kt = 0; kt < 4; ++kt)
#pragma unroll
                    for (int ks = 0; ks < 2; ++ks) kf[kt][ks] = *(const LAS bf16x8*)(Kb + (16 * kt + fr) * 144 + (32 * ks + 8 * fq) * 2);
                s16x4 vA[2][4][2];
#pragma unroll
                for (int s2 = 0; s2 < 2; ++s2)
#pragma unroll
                    for (int dt = 0; dt < 4; ++dt)
#pragma unroll
                        for (int hh = 0; hh < 2; ++hh) vA[s2][dt][hh] = __builtin_amdgcn_ds_read_tr16_b64_v4i16((LAS s16x4*)(Vb + (32 * s2 + 16 * hh + 4 * fq) * 144 + 32 * dt + trl));
                const LAS float* bp = bt + (ra - r + 7) * 31;
#pragma unroll
                for (int qt = 0; qt < 2; ++qt) {
                    const int g4 = 2 * chh + qt; const int klo = isnb ? (g4 <= 1 ? 0 : g4 - 1) : 0, khi = isnb ? (g4 >= 2 ? 3 : g4 + 1) : 3;
                    const int cq = 16 * g4 + fr, cstart = min(max(cq - 8, 0), 48);
                    f32x4 st[4]; float psum = 0.f;
#pragma unroll
                    for (int kt = 0; kt < 4; ++kt) {
                        f32x4 a = {0.f, 0.f, 0.f, 0.f};
                        if (kt >= klo && kt <= khi) {
                            a = __builtin_amdgcn_mfma_f32_16x16x32_bf16(kf[kt][0], qf[qt][0], a, 0, 0, 0); a = __builtin_amdgcn_mfma_f32_16x16x32_bf16(kf[kt][1], qf[qt][1], a, 0, 0, 0);
                            if (isnb) {
#pragma unroll
                                for (int j = 0; j < 4; ++j) { const int ck = 16 * kt + 4 * fq + j; const bool valid = (unsigned)(ck - cstart) < 16u; const int dc = min(max(ck - cq, -15), 15) + 15;
                                    const float pv = __builtin_amdgcn_exp2f(a[j] + bp[dc]); a[j] = valid ? pv : 0.f; } }
                            else {
#pragma unroll
                                for (int j = 0; j < 4; ++j) a[j] = __builtin_amdgcn_exp2f(a[j] - M0); }
                            psum += (a[0] + a[1]) + (a[2] + a[3]);
                        }
                        st[kt] = a;
                    }
                    lrun[qt] += psum;
#pragma unroll
                    for (int s2 = 0; s2 < 2; ++s2) {
                        if (2 * s2 + 1 >= klo && 2 * s2 <= khi) {
                            u32x4 pw; pw.x = pk2(st[2 * s2][0], st[2 * s2][1]); pw.y = pk2(st[2 * s2][2], st[2 * s2][3]); pw.z = pk2(st[2 * s2 + 1][0], st[2 * s2 + 1][1]); pw.w = pk2(st[2 * s2 + 1][2], st[2 * s2 + 1][3]);
                            const bf16x8 pb = __builtin_bit_cast(bf16x8, pw);
#pragma unroll
                            for (int dt = 0; dt < 4; ++dt) { const s16x4 v0 = vA[s2][dt][0], v1 = vA[s2][dt][1]; const bf16x8 va = {v0[0], v0[1], v0[2], v0[3], v1[0], v1[1], v1[2], v1[3]};
                                o[qt][dt] = __builtin_amdgcn_mfma_f32_16x16x32_bf16(va, pb, o[qt][dt], 0, 0, 0); }
                        }
                    }
                }
            }
            if (i + 1 < ntile) { NA_KNORM(kreg); LAS unsigned char* Kn = F.lds + ((i + 1) & 1) * 18432; *(LAS u32x4*)(Kn + skey * 144 + sd8 * 16) = kreg; *(LAS u32x4*)(Kn + 9216 + skey * 144 + sd8 * 16) = vreg; }
            __syncthreads();
        }
#pragma unroll
        for (int qt = 0; qt < 2; ++qt) { float lt = lrun[qt]; lt += __shfl_xor(lt, 16); lt += __shfl_xor(lt, 32); const float inv = 1.0f / lt;
#pragma unroll
            for (int dt = 0; dt < 4; ++dt) { u32x2 w2; w2.x = pk2(o[qt][dt][0] * inv, o[qt][dt][1] * inv); w2.y = pk2(o[qt][dt][2] * inv, o[qt][dt][3] * inv); *(u32x2*)(O + qrow[qt] * D + h * 64 + 16 * dt + 4 * fq) = w2; } }
    }
    __syncthreads();
}

#undef NA_KNORM
constexpr int NPH = 36;
__device__ __forceinline__ pg8::Sched mk_sched(const Frame& F, int nM, int nN, const bf16_t* A, int lda, const bf16_t* B, int K) {
    pg8::Sched S; S.nM = nM; S.nN = nN; S.G = F.G; S.c = F.bid; S.A = (const char*)A; S.a_tile = (size_t)256 * lda * 2; S.a_pn = 0;
    S.B = (const char*)B; S.b_tile = (size_t)256 * K * 2; S.b_e = 0; S.tstart = nullptr; S.rev = false; return S;
}
__global__ void __launch_bounds__(NTHR, 2) fwd(Params P) {
    extern __shared__ __attribute__((aligned(16))) unsigned char lds_raw[];
    Frame F; F.lds = (LAS unsigned char*)lds_raw; F.tid = threadIdx.x; F.lane = F.tid & 63; F.wave = __builtin_amdgcn_readfirstlane(F.tid >> 6); F.bid = blockIdx.x; F.G = gridDim.x;
    F.p = &P; F.ws = P.ws; F.ctl = (unsigned*)(P.ws + WS_CTL); F.modv = (float*)(P.ws + WS_MODV); F.hlat = (bf16_t*)(P.ws + WS_H); F.hctx = F.hlat + (size_t)RL * D; F.U = (bf16_t*)P.out;
    if (F.tid < 64) ((LAS unsigned*)(F.lds + LDS_CTL))[F.tid] = 0u;
    __syncthreads();
    const int lo = P.ph_lo, hi = P.ph_hi;
    XcdBarrier bar; bar.bar = F.ctl + CW_BAR; bar.x = 0; bar.st = (volatile LAS unsigned*)(F.lds + LDS_CTL);
    if (hi - lo > 1) bar = xcd_barrier_post(F.ctl + CW_BAR, (volatile LAS unsigned*)(F.lds + LDS_CTL));
#define IN(k) (lo <= (k) && (k) < hi)
#define SEAM(k) do { if (IN(k) && IN((k) + 1)) xcd_barrier(bar); \
        if (PROBE_LO >= 0 && F.bid == 0 && F.tid == 0) { if ((k) + 1 == PROBE_LO) pr_t[0] = __builtin_amdgcn_s_memrealtime(); if ((k) + 1 == PROBE_HI) pr_t[1] = __builtin_amdgcn_s_memrealtime(); } } while (0)
    volatile LAS unsigned long long* const pr_t = (volatile LAS unsigned long long*)(F.lds + LDS_CTL + 16);
    if (PROBE_LO == 0 && F.bid == 0 && F.tid == 0) pr_t[0] = __builtin_amdgcn_s_memrealtime();
    bf16_t* const out = F.hlat; bf16_t* const hctx = F.hctx;
    const float* const x = INP(F, I_X); const float* const ctx = INP(F, I_CTX);
    LAS unsigned char* const gl = F.lds;
    LAS int* const tstart = (LAS int*)(F.lds + LDS_AUX);
    bf16_t* const BIG = (bf16_t*)(P.ws + WS_BIG);
#define MODL(l) (F.modv + (size_t)(l) * 33 * MODW)
#define LAUNDER do { asm volatile("" : "+v"(F.tid)); F.lane = F.tid & 63; } while (0)

    if (IN(0)) { LAUNDER; phase_mod(F); phase_cvt_small(F); } SEAM(0);
    if (IN(1)) { LAUNDER; NormCtx N{x, ctx, INP(F, I_N1G), MODL(0), 0, true}; phase_norm(F, N, RA); } SEAM(1);
    if (IN(2)) { LAUNDER; pg8::Sched S = mk_sched(F, RA / 256, 10, F.U, D, WSP(bf16_t, WS_LRU_WIN), D); pg8::EpiBf16<0> E{(bf16_t*)(P.ws + WS_BIG + BG_XG), 2560, nullptr}; pg8::gemm_phase(gl, D, D, S, E); } SEAM(2);
    if (IN(3)) { LAUNDER; phase_scan(F, true); } SEAM(3);
    if (IN(4)) { LAUNDER; pg8::Sched S = mk_sched(F, RA / 256, 4, (bf16_t*)(P.ws + WS_BIG + BG_Y), DRNN, WSP(bf16_t, WS_LRU_WOUT), DRNN);
                 pg8::EpiResidX E{x, ctx, out, hctx, MODL(0) + 2 * D, nullptr, nullptr}; pg8::gemm_phase(gl, DRNN, DRNN, S, E); cvt_moe_queue(F, 0, 0, 8192, 0); } SEAM(4);
    if (IN(5)) { LAUNDER; NormCtx N{out, hctx, INP(F, I_N2G), MODL(0), 1, false}; phase_norm(F, N, RA); } SEAM(5);
    if (IN(6)) { LAUNDER; pg8::Sched S = mk_sched(F, RA / 256, 28, F.U, D, WSP(bf16_t, WS_FFN_W13), D); pg8::EpiSwiGLU E{(bf16_t*)(P.ws + WS_BIG + BG_HID), DFF}; pg8::gemm_phase(gl, D, D, S, E); } SEAM(6);
    if (IN(7)) { LAUNDER; pg8::Sched S = mk_sched(F, RA / 256, 4, (bf16_t*)(P.ws + WS_BIG + BG_HID), DFF, WSP(bf16_t, WS_FFN_W2), DFF);
                 S.rev = true; pg8::EpiResid E{out, hctx, out, hctx, MODL(0) + 5 * D, nullptr, nullptr}; pg8::gemm_phase(gl, DFF, DFF, S, E); cvt_moe_queue(F, 0, 8192, 30720, 1); } SEAM(7);
    if (IN(8)) { LAUNDER; NormCtx N{out, hctx, INP(F, I_N1G) + D, MODL(1), 0, false}; phase_norm(F, N, RA); } SEAM(8);
    if (IN(9)) { LAUNDER; pg8::Sched S = mk_sched(F, RA / 256, 16, F.U, D, WSP(bf16_t, WS_SGU_WIN), D); pg8::EpiBf16<1> E{(bf16_t*)(P.ws + WS_BIG + BG_Z), 4096, INP(F, I_SGU_BIN)}; pg8::gemm_phase(gl, D, D, S, E); } SEAM(9);
    if (IN(10)) { LAUNDER; phase_sgu_stats(F); } SEAM(10);
    if (IN(11)) { LAUNDER; phase_sgu_spatial(F); } SEAM(11);
    if (IN(12)) { LAUNDER; pg8::Sched S = mk_sched(F, RA / 256, 4, (bf16_t*)(P.ws + WS_BIG + BG_Z), 4096, WSP(bf16_t, WS_SGU_WOUT), DSGU);
                  pg8::EpiResid E{out, hctx, out, hctx, MODL(1) + 2 * D, nullptr, nullptr}; pg8::gemm_phase(gl, 4096, DSGU, S, E); cvt_moe_queue(F, 0, 30720, CVT_MOE_ITEMS, 2); } SEAM(12);
    if (IN(13)) { LAUNDER; NormCtx N{out, hctx, INP(F, I_N2G) + D, MODL(1), 1, false}; phase_route(F, N, RA, 0); } SEAM(13);
    if (IN(14)) { LAUNDER; phase_assign_scatter0(F, RA, 0); } SEAM(14);
#define MOE_UP(ph, l2, s) if (IN(ph)) { LAUNDER; const int nt_ = moe_tile_table(F, l2, s, tstart); \
        pg8::Sched S = mk_sched(F, nt_, 28, F.U, D, moe_w13(F, l2), D); S.a_tile = 0; S.b_e = (size_t)2 * DFF * D * 2; S.tstart = tstart; \
        pg8::EpiSwiGLU E{(bf16_t*)(P.ws + WS_BIG + BG_MHID), DFF}; pg8::gemm_phase<pg8::EpiSwiGLU, true>(gl, D, D, S, E, WSP(const int, WS_ROUTE + RT_TOK) + (s) * MPAD, (LAS int*)(F.lds + LDS_AUX + 1024)); } SEAM(ph)
#define MOE_DOWN(ph, l2, s, layer, EPI) if (IN(ph)) { LAUNDER; const int nt_ = moe_tile_table(F, l2, s, tstart); \
        pg8::Sched S = mk_sched(F, nt_, 4, (bf16_t*)(P.ws + WS_BIG + BG_MHID), DFF, moe_w2(F, l2), DFF); S.b_e = (size_t)D * DFF * 2; S.tstart = tstart; S.rev = true; \
        EPI E{out, hctx, P.out, MODL(layer) + 5 * D, WSP(const int, WS_ROUTE + RT_TOK) + (s) * MPAD, WSP(const float, WS_ROUTE + RT_GW) + (s) * MPAD}; pg8::gemm_phase(gl, DFF, DFF, S, E); \
        if ((l2) == 0) cvt_moe_queue(F, 1, (s) ? 10752 : 0, (s) ? 21504 : 10752, 3 + (s)); } SEAM(ph)
    MOE_UP(15, 0, 0); MOE_DOWN(16, 0, 0, 1, pg8::EpiMoeDown); MOE_UP(17, 0, 1); MOE_DOWN(18, 0, 1, 1, pg8::EpiMoeDown);
    if (IN(19)) { LAUNDER; NormCtx N{out, hctx, INP(F, I_N1G) + 2 * D, MODL(2), 0, false}; phase_norm(F, N, RA); } SEAM(19);
    if (IN(20)) { LAUNDER; phase_pool_diff(F); } SEAM(20);
    if (IN(21)) { LAUNDER; pg8::Sched S = mk_sched(F, RA / 256, 4, (bf16_t*)(P.ws + WS_BIG + BG_PD), D, WSP(bf16_t, WS_POOL_W), 256); S.a_pn = 512; S.b_tile = (size_t)256 * 256 * 2;
                  pg8::EpiResidBS E{out, hctx, out, hctx, MODL(2) + 2 * D, INP(F, I_POOL_B), INP(F, I_POOL_S)}; pg8::gemm_phase(gl, D, 256, S, E); } SEAM(21);
    if (IN(22)) { LAUNDER; NormCtx N{out, hctx, INP(F, I_N2G) + 2 * D, MODL(2), 1, false}; phase_norm(F, N, RA); } SEAM(22);
    if (IN(23)) { LAUNDER; pg8::Sched S = mk_sched(F, RA / 256, 28, F.U, D, WSP(bf16_t, WS_FFN_W13) + (size_t)2 * DFF * D, D); pg8::EpiSwiGLU E{(bf16_t*)(P.ws + WS_BIG + BG_HID), DFF}; pg8::gemm_phase(gl, D, D, S, E); } SEAM(23);
    if (IN(24)) { LAUNDER; pg8::Sched S = mk_sched(F, RA / 256, 4, (bf16_t*)(P.ws + WS_BIG + BG_HID), DFF, WSP(bf16_t, WS_FFN_W2) + (size_t)D * DFF, DFF);
                  S.rev = true; pg8::EpiResid E{out, hctx, out, hctx, MODL(2) + 5 * D, nullptr, nullptr}; pg8::gemm_phase(gl, DFF, DFF, S, E); cvt_moe_queue(F, 1, 21504, CVT_MOE_ITEMS, 5); } SEAM(24);
    if (IN(25)) { LAUNDER; NormCtx N{out, hctx, INP(F, I_N1G) + 3 * D, MODL(3), 0, false}; phase_norm(F, N, RA); } SEAM(25);
    if (IN(26)) { LAUNDER; pg8::Sched S = mk_sched(F, RA / 256, 12, F.U, D, WSP(bf16_t, WS_NA_WQKV), D); pg8::EpiBf16<0> E{(bf16_t*)(P.ws + WS_BIG + BG_QKV), 3072, nullptr}; pg8::gemm_phase(gl, D, D, S, E); } SEAM(26);
    SEAM(27);
    if (IN(28)) { LAUNDER; phase_na(F); } SEAM(28);
    if (IN(29)) { LAUNDER; pg8::Sched S = mk_sched(F, RL / 256, 4, (bf16_t*)(P.ws + WS_BIG + BG_O), D, WSP(bf16_t, WS_NA_WO), D);
                  pg8::EpiResid E{out, hctx, out, hctx, MODL(3) + 2 * D, nullptr, nullptr}; pg8::gemm_phase(gl, D, D, S, E); } SEAM(29);
    if (IN(30)) { LAUNDER; NormCtx N{out, hctx, INP(F, I_N2G) + 3 * D, MODL(3), 1, false}; phase_route(F, N, RL, 1); } SEAM(30);
    if (IN(31)) { LAUNDER; phase_assign_scatter0(F, RL, 1); } SEAM(31);
    MOE_UP(32, 1, 0); MOE_DOWN(33, 1, 0, 3, pg8::EpiMoeDown); MOE_UP(34, 1, 1); MOE_DOWN(35, 1, 1, 3, pg8::EpiMoeDownOut);
#undef IN
#undef SEAM
    (void)BIG;
    if (PROBE_LO >= 0 && F.bid == 0 && F.tid == 0) { if (PROBE_HI >= NPH) pr_t[1] = __builtin_amdgcn_s_memrealtime();
        const unsigned long long t_end = __builtin_amdgcn_s_memrealtime(), wait = 8ull * (pr_t[1] - pr_t[0]);
        while (__builtin_amdgcn_s_memrealtime() - t_end < wait) __builtin_amdgcn_s_sleep(32); }
}

extern "C" void kernel_launch(void* const* d_in, const int* in_sizes, int n_in, void* d_out, int out_size, void* d_ws, size_t ws_size, hipStream_t stream) {
    static int grid = 0;
    if (grid == 0) {
        if (n_in != 40 || out_size != RL * D || ws_size < WS_END) { fprintf(stderr, "kernel_launch: unexpected problem (n_in %d out %d ws %zu)\n", n_in, out_size, ws_size); grid = -1; return; }
        int dev = 0, cus = 0;
        if (hipGetDevice(&dev) != hipSuccess || hipDeviceGetAttribute(&cus, hipDeviceAttributeMultiprocessorCount, dev) != hipSuccess) { grid = -1; return; }
        if (hipFuncSetAttribute((const void*)fwd, hipFuncAttributeMaxDynamicSharedMemorySize, LDS_BYTES) != hipSuccess) { fprintf(stderr, "kernel_launch: hipFuncSetAttribute failed\n"); grid = -1; return; }
        int per_cu = 0; (void)hipOccupancyMaxActiveBlocksPerMultiprocessor(&per_cu, (const void*)fwd, NTHR, LDS_BYTES); (void)hipGetLastError();
        if (per_cu < 1) fprintf(stderr, "kernel_launch: occupancy query says %d\n", per_cu);
        grid = cus;
    }
    if (grid < 0) return;
    (void)hipMemsetAsync((char*)d_ws + WS_CTL, 0, CTL_BYTES, stream);
    Params p{};
    for (int i = 0; i < 40; ++i) p.in[i] = (const float*)d_in[i];
    p.out = (float*)d_out; p.ws = (unsigned char*)d_ws;
#if MK_MULTI
    for (int ph = 0; ph < NPH; ++ph) { p.ph_lo = ph; p.ph_hi = ph + 1; hipLaunchKernelGGL(fwd, dim3(grid), dim3(NTHR), LDS_BYTES, stream, p); }
#else
    p.ph_lo = 0; p.ph_hi = NPH;
    hipLaunchKernelGGL(fwd, dim3(grid), dim3(NTHR), LDS_BYTES, stream, p);
#endif
}
```

```cpp
#include <hip/hip_runtime.h>
#include <cstdio>
#include <cstdint>

#ifndef PROBE_LO
#define PROBE_LO -1
#define PROBE_HI -1
#endif
#ifndef WGM_WIDE
#define WGM_WIDE 4
#define WGM_NARROW 4
#endif
#ifndef MK_MULTI
#define MK_MULTI 0
#endif

#define LAS __attribute__((address_space(3)))
typedef unsigned short bf16_t;
typedef short bf16x8 __attribute__((ext_vector_type(8)));
typedef short s16x4 __attribute__((ext_vector_type(4)));
typedef float f32x4 __attribute__((ext_vector_type(4)));
typedef float f32x2 __attribute__((ext_vector_type(2)));
typedef unsigned u32x4 __attribute__((ext_vector_type(4)));
typedef unsigned u32x2 __attribute__((ext_vector_type(2)));

constexpr int D = 1024, NB = 32, SEQ = 2048, CTXL = 256;
constexpr int RL = NB * SEQ, RC = NB * CTXL, RA = RL + RC;
constexpr int DRNN = 1280, LBW = 160, DSGU = 2048, DFF = 3584, NE = 8;
constexpr int MODW = 6 * D;
constexpr int MPAD = 75776;
constexpr float NORM_EPS = 1e-6f;
constexpr int NWAVES = 8, NTHR = 512;

constexpr size_t MiB = 1u << 20;
constexpr size_t WS_CTL = 0, CTL_BYTES = 1 * MiB;
constexpr size_t WS_MODV = 1 * MiB;
constexpr size_t WS_HCTX = 5 * MiB;
constexpr size_t WS_LRU_WIN = 37 * MiB;
constexpr size_t WS_LRU_WA = WS_LRU_WIN + 5 * MiB;
constexpr size_t WS_LRU_WI = WS_LRU_WA + 1 * MiB;
constexpr size_t WS_LRU_WOUT = WS_LRU_WI + 1 * MiB;
constexpr size_t WS_SGU_WIN = WS_LRU_WOUT + 3 * MiB;
constexpr size_t WS_SGU_WS = WS_SGU_WIN + 8 * MiB;
constexpr size_t WS_SGU_WOUT = WS_SGU_WS + 1 * MiB;
constexpr size_t WS_POOL_W = WS_SGU_WOUT + 4 * MiB;
constexpr size_t WS_NA_WQKV = WS_POOL_W + 1 * MiB;
constexpr size_t WS_NA_WO = WS_NA_WQKV + 6 * MiB;
constexpr size_t WS_FFN_W13 = WS_NA_WO + 2 * MiB;
constexpr size_t WS_FFN_W2 = WS_FFN_W13 + 28 * MiB;
constexpr size_t WS_MOE_W13 = WS_FFN_W2 + 14 * MiB;
constexpr size_t WS_MOE_W2 = WS_MOE_W13 + 112 * MiB;
constexpr size_t WS_ROUTE = WS_MOE_W2 + 56 * MiB;
constexpr size_t WS_H = WS_ROUTE + 4 * MiB;
constexpr size_t WS_BIG = WS_H + 148 * MiB;
constexpr size_t WS_END = WS_BIG + 744 * MiB;
constexpr size_t WS_DBG = WS_END;
static_assert(WS_MOE_W13 == 111 * MiB && WS_BIG == 431 * MiB && WS_END == 1175 * MiB, "ws map");
constexpr size_t RT_E = 0;
constexpr size_t RT_W = 512 * 1024;
constexpr size_t RT_TOK = 1280 * 1024;
constexpr size_t RT_GW = 2048 * 1024;
constexpr size_t RT_ST = 2816 * 1024;
constexpr size_t RT_P1 = 3456 * 1024;
static_assert(RT_W >= (size_t)RA * 4 && RT_TOK - RT_W >= (size_t)RA * 8 && RT_GW - RT_TOK >= (size_t)2 * MPAD * 4 && RT_ST - RT_GW >= (size_t)2 * MPAD * 4 && RT_P1 - RT_ST >= (size_t)RA * 8 && 4 * MiB - RT_P1 >= (size_t)RA * 4, "route map");
constexpr size_t BG_XG = 0, BG_Y = 360 * MiB;
constexpr size_t BG_HID = 0;
constexpr size_t BG_Z = 0;
constexpr size_t BG_FS1 = 0, BG_MHID = 0;
constexpr size_t BG_MW2 = 576 * MiB;
constexpr size_t BG_PD = 0;
constexpr size_t BG_QKV = 0, BG_O = 432 * MiB;
static_assert(BG_MHID + (size_t)MPAD * DFF * 2 <= BG_MW2 && BG_O + (size_t)RL * D * 2 <= BG_MW2 && BG_Y + (size_t)RA * DRNN * 2 <= BG_MW2 && BG_MW2 + 168 * MiB <= 744 * MiB, "big map");
constexpr int CW_BAR = 4096;
constexpr int CW_CNT = 16384;
constexpr int CW_CUR = 16384 + 256;
constexpr int CW_DBG = 32768;
constexpr int CW_CVTQ = 20480;

constexpr int LDS_BYTES = 163840;
constexpr int LDS_AUX = 131072;
constexpr int LDS_CTL = LDS_BYTES - 256;

__device__ __forceinline__ float bf2f(unsigned b) { return __uint_as_float(b << 16); }
__device__ __forceinline__ unsigned pk2(float lo, float hi) { unsigned r; asm volatile("v_cvt_pk_bf16_f32 %0, %1, %2" : "=v"(r) : "v"(lo), "v"(hi)); return r; }
__device__ __forceinline__ float lo_bf(unsigned w) { return __uint_as_float(w << 16); }
__device__ __forceinline__ float hi_bf(unsigned w) { return __uint_as_float(w & 0xffff0000u); }
template <int CTRL> __device__ __forceinline__ float dpp_f(float v) { return __int_as_float(__builtin_amdgcn_update_dpp(0, __float_as_int(v), CTRL, 0xf, 0xf, true)); }
__device__ __forceinline__ float wave_sum(float v) {
    v += dpp_f<0xB1>(v);
    v += dpp_f<0x4E>(v);
    v += dpp_f<0x141>(v);
    v += dpp_f<0x140>(v);
    const int iv = __float_as_int(v);
    return (__int_as_float(__builtin_amdgcn_readlane(iv, 0)) + __int_as_float(__builtin_amdgcn_readlane(iv, 16))) + (__int_as_float(__builtin_amdgcn_readlane(iv, 32)) + __int_as_float(__builtin_amdgcn_readlane(iv, 48)));
}
__device__ __forceinline__ float sigmoid_f(float x) { return __builtin_amdgcn_rcpf(1.0f + __builtin_amdgcn_exp2f(-1.4426950408889634f * x)); }
__device__ __forceinline__ float silu_f(float x) { return x * __builtin_amdgcn_rcpf(1.0f + __builtin_amdgcn_exp2f(-1.4426950408889634f * x)); }
__device__ __forceinline__ float gelu_tanh_f(float x) { const float z2 = -2.0f * 1.4426950408889634f * 0.7978845608028654f * (x + 0.044715f * x * x * x); return x * __builtin_amdgcn_rcpf(1.0f + __builtin_amdgcn_exp2f(z2)); }
__device__ __forceinline__ unsigned lds_add(LAS unsigned* p, unsigned v) { return __hip_atomic_fetch_add(p, v, __ATOMIC_RELAXED, __HIP_MEMORY_SCOPE_WORKGROUP); }
#define LDS_WAIT() asm volatile("s_waitcnt lgkmcnt(0)" ::: "memory")
#define VM_WAIT() asm volatile("s_waitcnt vmcnt(0)" ::: "memory")

#define XB_TMO      128
#define XB_XCNT(j)  (256  + 64 * (j))
#define XB_XSUB(j)  (1280 + 64 * (j))
#define XB_XGEN(j)  (2304 + 64 * (j))
#define XB_TOP      3328
#define XB_TOPGEN   3392
#define XCD_BAR_WORDS 3456
#define XB_SPIN_CAP (1u << 18)
__device__ __forceinline__ unsigned xb_ld(unsigned* p)              { return __hip_atomic_load(p, __ATOMIC_RELAXED, __HIP_MEMORY_SCOPE_AGENT); }
__device__ __forceinline__ unsigned xb_add(unsigned* p, unsigned v) { return __hip_atomic_fetch_add(p, v, __ATOMIC_RELAXED, __HIP_MEMORY_SCOPE_AGENT); }
__device__ __forceinline__ unsigned xb_xcc_id() { return (unsigned)__builtin_amdgcn_s_getreg((3 << 11) | 20) & 0xFu; }
#define XB_SPIN(cond, bar) do { unsigned _sp = 0; while (cond) { __builtin_amdgcn_s_sleep(1); \
    if ((++_sp & 255u) == 0u) { if (xb_ld(&(bar)[XB_TMO])) break; if (_sp > XB_SPIN_CAP) { atomicAdd(&(bar)[XB_TMO], 1u); break; } } } } while (0)
struct XcdBarrier { unsigned* bar; unsigned x; volatile LAS unsigned* st; };
__device__ __forceinline__ XcdBarrier xcd_barrier_post(unsigned* bar, volatile LAS unsigned* st) {
    XcdBarrier b; b.bar = bar; b.x = xb_xcc_id(); b.st = st;
    if (threadIdx.x == 0) (void)xb_add(&bar[XB_XCNT(b.x)], 1u);
    return b;
}
__device__ __forceinline__ void xcd_barrier_complete(unsigned* bar, unsigned x, unsigned& nloc, unsigned& nx) {
    const unsigned G = gridDim.x * gridDim.y * gridDim.z;
    unsigned sum, cnt, mine, sp = 0u;
    for (;;) {
        sum = 0u; cnt = 0u; mine = 0u;
#pragma unroll
        for (unsigned j = 0; j < 16; ++j) { const unsigned c = xb_ld(&bar[XB_XCNT(j)]); sum += c; cnt += (c > 0u) ? 1u : 0u; mine = (j == x) ? c : mine; }
        if (sum == G) break;
        __builtin_amdgcn_s_sleep(1);
        if ((++sp & 255u) == 0u) { if (xb_ld(&bar[XB_TMO])) break; if (sp > XB_SPIN_CAP) { atomicAdd(&bar[XB_TMO], 1u); break; } }
    }
    nloc = mine > 0u ? mine : 1u; nx = cnt > 0u ? cnt : 1u;
}
__device__ __forceinline__ void xcd_barrier(const XcdBarrier& b) {
    asm volatile("s_waitcnt vmcnt(0)" ::: "memory");
    __syncthreads();
    if (threadIdx.x == 0) {
        unsigned* bar = b.bar;
        __builtin_amdgcn_s_waitcnt(0);
        unsigned nloc = b.st[0], nx = b.st[1];
        if (nloc == 0u) { xcd_barrier_complete(bar, b.x, nloc, nx); b.st[0] = nloc; b.st[1] = nx; }
        const unsigned old = xb_add(&bar[XB_XSUB(b.x)], 1u);
        const unsigned gen = old / nloc;
        if (old + 1u == (gen + 1u) * nloc) {
            __builtin_amdgcn_fence(__ATOMIC_RELEASE, "agent");
            asm volatile("s_waitcnt vmcnt(0)" ::: "memory");
            const unsigned og = xb_add(&bar[XB_TOP], 1u);
            const unsigned tg = og / nx;
            if (og + 1u == (tg + 1u) * nx) xb_add(&bar[XB_TOPGEN], 1u);
            else XB_SPIN(xb_ld(&bar[XB_TOPGEN]) == tg, bar);
            __builtin_amdgcn_fence(__ATOMIC_ACQUIRE, "agent");
            xb_add(&bar[XB_XGEN(b.x)], 1u);
            asm volatile("s_waitcnt vmcnt(0)" ::: "memory");
        } else {
            XB_SPIN(xb_ld(&bar[XB_XGEN(b.x)]) == gen, bar);
            __builtin_amdgcn_fence(__ATOMIC_ACQUIRE, "agent");
            asm volatile("s_waitcnt vmcnt(0)" ::: "memory");
        }
    }
    __syncthreads();
}

struct Params {
    const float* in[40];
    float* out; unsigned char* ws;
    int ph_lo, ph_hi;
};
enum In { I_X = 0, I_C, I_CTX, I_CCTX, I_MODW, I_MODB, I_N1G, I_N2G, I_LRU_WIN, I_LRU_CW, I_LRU_CB, I_LRU_WA, I_LRU_BA, I_LRU_WI, I_LRU_BI, I_LRU_LAM, I_LRU_WOUT,
          I_SGU_WIN, I_SGU_BIN, I_SGU_LNG, I_SGU_LNB, I_SGU_WS, I_SGU_BS, I_SGU_WOUT, I_POOL_W, I_POOL_B, I_POOL_S, I_NA_WQKV, I_NA_QG, I_NA_KG, I_NA_RPB, I_NA_WO,
          I_FFN_W1, I_FFN_W3, I_FFN_W2, I_MOE_WR, I_MOE_BR, I_MOE_W1, I_MOE_W3, I_MOE_W2 };

namespace pg8 {
constexpr int BM = 256, BK = 64, HALF = 128, HTB = HALF * BK * 2, STAGE_BYTES = 8 * HTB, NXCD = 8, WGM = 4;
__device__ __forceinline__ int lds_byte(int r, int c) { const int st = (r >> 4) * 2 + (c >> 5), rr = r & 15, cc = c & 31, ob = rr * 64 + cc * 2; return st * 1024 + (ob ^ (((ob >> 9) & 1) << 5)); }
__device__ __forceinline__ void stage_rc(int b, int& R, int& C) { const int st = b / 1024, sb = b % 1024, swz = sb ^ (((sb >> 9) & 1) << 5); R = (st >> 1) * 16 + swz / 64; C = (st & 1) * 32 + (swz % 64) / 2; }
__device__ __forceinline__ int perm32(int rho) { const int n = rho >> 4, i = rho & 15; return 8 * (i >> 2) + 4 * n + (i & 3); }

struct Unit { int pm, pn, e; const char* a; const char* b; };
struct Sched {
    int nM, nN, G, c;
    const char* A; size_t a_tile, a_pn;
    const char* B; size_t b_tile, b_e;
    const LAS int* tstart;
    int wgm = WGM;
    bool rev = false;
    __device__ __forceinline__ bool next(int i, Unit& u) const {
        long L = (long)i * G + c; if (L >= (long)nM * nN) return false;
        if (rev) L = (long)nM * nN - 1 - L;
        int e = 0, t0 = 0, nMe = nM, wgid = (int)L;
        if (tstart) {
#pragma unroll
            for (int k = 1; k < 8; ++k) e += (wgid >= tstart[k] * nN) ? 1 : 0;
            t0 = tstart[e]; nMe = tstart[e + 1] - t0; wgid -= t0 * nN;
        }
        const int nwg = nMe * nN;
        { const int q = nwg / NXCD, r = nwg % NXCD, xcd = wgid % NXCD, off = wgid / NXCD; wgid = (xcd < r ? xcd * (q + 1) : r * (q + 1) + (xcd - r) * q) + off; }
        const int nig = wgm * nN, gid = wgid / nig, fm = gid * wgm, gsz = (nMe - fm) < wgm ? (nMe - fm) : wgm;
        u.pm = t0 + fm + ((wgid % nig) % gsz); u.pn = (wgid % nig) / gsz;
        u.e = e; u.a = A + (size_t)u.pm * a_tile + (size_t)u.pn * a_pn; u.b = B + (size_t)e * b_e + (size_t)u.pn * b_tile;
        return true;
    }
};

template <class Epi, bool GATHER = false>
__device__ __forceinline__ void gemm_phase(LAS unsigned char* lds, const int lda, const int K, const Sched& S, const Epi& E, const int* gidx = nullptr, LAS int* ixt = nullptr) {
    const int tid = threadIdx.x, wid = __builtin_amdgcn_readfirstlane(tid >> 6), lane = tid & 63, wr = wid >> 2, wc = wid & 3, fr = lane & 15, fq = lane >> 4;
    const int nt = K / BK;
    unsigned voffA[2], voffB[2]; int Rl[2]; unsigned cb2[2];
#pragma unroll
    for (int i = 0; i < 2; ++i) { int R, C; stage_rc(tid * 16 + i * 8192, R, C); const int Rb = Epi::PERM ? ((R & ~31) + perm32(R & 31)) : R;
        voffA[i] = (unsigned)(R * lda + C) * 2u; voffB[i] = (unsigned)(Rb * K + C) * 2u; Rl[i] = R; cb2[i] = (unsigned)C * 2u; }
    unsigned cOff[2][2] = {{0u, 0u}, {0u, 0u}}, nOff[2][2] = {{0u, 0u}, {0u, 0u}};
    const size_t kstep = (size_t)(BK * 2);
    const size_t hstepA = (size_t)HALF * lda * 2, hstepB = (size_t)HALF * K * 2;
    const unsigned ldsw = (unsigned)wid * 1024u;
    const int aoff = lds_byte(wr * 64 + fr, fq * 8), boff = lds_byte(wc * 32 + fr, fq * 8);
#define PG8_SA(b, h) (((b) * 2 + (h)) * HTB)
#define PG8_SB(b, h) ((4 + (b) * 2 + (h)) * HTB)
#define PG8_STAGE(bufoff, gbase, voff) do { _Pragma("unroll") for (int _i = 0; _i < 2; ++_i) \
        __builtin_amdgcn_global_load_lds((const unsigned*)((const char*)(gbase) + (voff)[_i]), (LAS unsigned*)(lds + (bufoff) + ldsw + _i * 8192), 16, 0, 0); } while (0)
#define PG8_STAGE_A(bufoff, kptr, h, usenext) do { if constexpr (GATHER) { const unsigned o_[2] = {(usenext) ? nOff[h][0] : cOff[h][0], (usenext) ? nOff[h][1] : cOff[h][1]}; PG8_STAGE(bufoff, kptr, o_); } \
        else PG8_STAGE(bufoff, (kptr) + (h) * hstepA, voffA); } while (0)
#define PG8_LDA(dst, b, h) do { _Pragma("unroll") for (int m = 0; m < 4; ++m) _Pragma("unroll") for (int k = 0; k < 2; ++k) dst[m][k] = *(const LAS bf16x8*)(lds + PG8_SA(b, h) + aoff + m * 2048 + k * 1024); } while (0)
#define PG8_LDB(dst, b, h) do { _Pragma("unroll") for (int n = 0; n < 2; ++n) _Pragma("unroll") for (int k = 0; k < 2; ++k) dst[n][k] = *(const LAS bf16x8*)(lds + PG8_SB(b, h) + boff + n * 2048 + k * 1024); } while (0)
#define PG8_MMA(ai, bj, At, Bt) do { __builtin_amdgcn_s_setprio(1); _Pragma("unroll") for (int m = 0; m < 4; ++m) _Pragma("unroll") for (int n = 0; n < 2; ++n) _Pragma("unroll") for (int k = 0; k < 2; ++k) \
        acc[ai][bj][m][n] = __builtin_amdgcn_mfma_f32_16x16x32_bf16(Bt[n][k], At[m][k], acc[ai][bj][m][n], 0, 0, 0); __builtin_amdgcn_s_setprio(0); } while (0)
#define PG8_WAIT_V(n) asm volatile("s_waitcnt vmcnt(" #n ")" ::: "memory")
#define PG8_WAIT_L(n) asm volatile("s_waitcnt lgkmcnt(" #n ")" ::: "memory")
#define PG8_BAR __builtin_amdgcn_s_barrier()
#define PG8_SCHED __builtin_amdgcn_sched_barrier(0)
    Unit cur, nxt; int ui = 0;
    if (!S.next(0, cur)) return;
    f32x4 acc[2][2][4][2];
#pragma unroll
    for (int a = 0; a < 2; ++a)
#pragma unroll
        for (int b = 0; b < 2; ++b)
#pragma unroll
            for (int m = 0; m < 4; ++m)
#pragma unroll
                for (int n = 0; n < 2; ++n) acc[a][b][m][n] = (f32x4){0.f, 0.f, 0.f, 0.f};
    bf16x8 At[4][2], B0[2][2], B1[2][2];
    const char* cA = cur.a; const char* cB = cur.b;
    if constexpr (GATHER) {
#pragma unroll
        for (int h = 0; h < 2; ++h)
#pragma unroll
            for (int i = 0; i < 2; ++i) { const int ix = gidx[cur.pm * BM + h * HALF + Rl[i]]; cOff[h][i] = (unsigned)(ix < 0 ? 0 : ix) * (unsigned)(lda * 2) + cb2[i]; }
    }
    PG8_STAGE(PG8_SB(0, 0), cB, voffB); PG8_STAGE(PG8_SB(0, 1), cB + hstepB, voffB); PG8_STAGE_A(PG8_SA(0, 0), cA, 0, false); PG8_STAGE_A(PG8_SA(0, 1), cA, 1, false);
    if (wr == 1) PG8_BAR;
    PG8_WAIT_V(2); PG8_BAR;
    PG8_STAGE(PG8_SB(1, 0), cB + kstep, voffB); PG8_STAGE_A(PG8_SA(1, 0), cA + kstep, 0, false); PG8_STAGE(PG8_SB(1, 1), cB + hstepB + kstep, voffB);
    PG8_WAIT_V(6); PG8_BAR;
    for (;;) {
        const bool has_next = S.next(ui + 1, nxt);
        const char* nA = has_next ? nxt.a : cA; const char* nB = has_next ? nxt.b : cB;
        if constexpr (GATHER) { if (has_next && wid == 0) {
#pragma unroll
            for (int k = 0; k < 4; ++k) __builtin_amdgcn_global_load_lds((const unsigned*)(gidx + nxt.pm * BM + k * 64 + lane), (LAS unsigned*)(ixt + ((ui + 1) & 1) * BM + k * 64), 4, 0, 0); } }
        for (int t = 0; t < nt; t += 2) {
            const bool last = (t == nt - 2); const bool un = last && has_next;
            if constexpr (GATHER) { if (un) {
#pragma unroll
                for (int h = 0; h < 2; ++h)
#pragma unroll
                    for (int i = 0; i < 2; ++i) { const int ix = ixt[((ui + 1) & 1) * BM + h * HALF + Rl[i]]; nOff[h][i] = (unsigned)(ix < 0 ? 0 : ix) * (unsigned)(lda * 2) + cb2[i]; } } }
            const char* a1 = cA + (size_t)(t + 1) * kstep;
            const char* a2 = last ? nA : cA + (size_t)(t + 2) * kstep; const char* b2 = last ? nB : cB + (size_t)(t + 2) * kstep;
            const char* a3 = a2 + kstep; const char* b3 = b2 + kstep;
            PG8_LDB(B0, 0, 0); PG8_LDB(B1, 0, 1); PG8_SCHED; PG8_LDA(At, 0, 0); PG8_STAGE_A(PG8_SA(1, 1), a1, 1, false);
            PG8_WAIT_V(8); PG8_WAIT_L(0); PG8_BAR; PG8_MMA(0, 0, At, B0); PG8_MMA(0, 1, At, B1); PG8_BAR; PG8_SCHED;
            PG8_LDA(At, 0, 1); PG8_STAGE(PG8_SB(0, 0), b2, voffB); PG8_STAGE(PG8_SB(0, 1), b2 + hstepB, voffB); PG8_STAGE_A(PG8_SA(0, 0), a2, 0, un);
            PG8_WAIT_V(8); PG8_WAIT_L(0); PG8_BAR; PG8_MMA(1, 0, At, B0); PG8_MMA(1, 1, At, B1); PG8_BAR; PG8_SCHED;
            PG8_LDB(B0, 1, 0); PG8_LDB(B1, 1, 1); PG8_SCHED; PG8_LDA(At, 1, 0); PG8_STAGE_A(PG8_SA(0, 1), a2, 1, un);
            PG8_WAIT_V(8); PG8_WAIT_L(0); PG8_BAR; PG8_MMA(0, 0, At, B0); PG8_MMA(0, 1, At, B1); PG8_BAR; PG8_SCHED;
            PG8_LDA(At, 1, 1); PG8_STAGE(PG8_SB(1, 0), b3, voffB); PG8_STAGE(PG8_SB(1, 1), b3 + hstepB, voffB); PG8_STAGE_A(PG8_SA(1, 0), a3, 0, un);
            PG8_WAIT_V(8); PG8_WAIT_L(0); PG8_BAR; PG8_MMA(1, 0, At, B0); PG8_MMA(1, 1, At, B1); PG8_BAR; PG8_SCHED;
        }
        if (wr == 0) PG8_BAR;
        E(acc, cur, wr, wc, fr, fq);
        if (!has_next) break;
#pragma unroll
        for (int a = 0; a < 2; ++a)
#pragma unroll
            for (int b = 0; b < 2; ++b)
#pragma unroll
                for (int m = 0; m < 4; ++m)
#pragma unroll
                    for (int n = 0; n < 2; ++n) acc[a][b][m][n] = (f32x4){0.f, 0.f, 0.f, 0.f};
        cur = nxt; cA = nA; cB = nB; ++ui;
        if constexpr (GATHER) {
#pragma unroll
            for (int h = 0; h < 2; ++h)
#pragma unroll
                for (int i = 0; i < 2; ++i) cOff[h][i] = nOff[h][i]; }
        if (wr == 1) PG8_BAR;
    }
    PG8_WAIT_V(0);
    PG8_BAR;
#undef PG8_SA
#undef PG8_SB
#undef PG8_STAGE
#undef PG8_LDA
#undef PG8_STAGE_A
#undef PG8_LDB
#undef PG8_MMA
#undef PG8_WAIT_V
#undef PG8_WAIT_L
#undef PG8_BAR
#undef PG8_SCHED
}

template <int ACT> struct EpiBf16 {
    static constexpr bool PERM = true;
    bf16_t* O; int ldc; const float* bias;
    __device__ __forceinline__ void operator()(const f32x4 (&acc)[2][2][4][2], const Unit& u, int wr, int wc, int fr, int fq) const {
        asm volatile("" : "+v"(fr), "+v"(fq));
        const int row0 = u.pm * BM + wr * 64 + fr; const int col0 = u.pn * BM + wc * 32 + 8 * fq;
        f32x4 bv[2][2];
#pragma unroll
        for (int bj = 0; bj < 2; ++bj)
#pragma unroll
            for (int n = 0; n < 2; ++n) bv[bj][n] = bias ? *(const f32x4*)(bias + col0 + bj * HALF + 4 * n) : (f32x4){0.f, 0.f, 0.f, 0.f};
#pragma unroll
        for (int ai = 0; ai < 2; ++ai)
#pragma unroll
            for (int m = 0; m < 4; ++m) { bf16_t* rowp = O + (size_t)(row0 + ai * HALF + m * 16) * ldc + col0;
#pragma unroll
                for (int bj = 0; bj < 2; ++bj) { f32x4 v0 = acc[ai][bj][m][0] + bv[bj][0], v1 = acc[ai][bj][m][1] + bv[bj][1];
                    if (ACT == 1) {
#pragma unroll
                        for (int j = 0; j < 4; ++j) { v0[j] = gelu_tanh_f(v0[j]); v1[j] = gelu_tanh_f(v1[j]); } }
                    u32x4 w; w.x = pk2(v0[0], v0[1]); w.y = pk2(v0[2], v0[3]); w.z = pk2(v1[0], v1[1]); w.w = pk2(v1[2], v1[3]);
                    *(u32x4*)(rowp + bj * HALF) = w; } }
    }
};
struct EpiSwiGLU {
    static constexpr bool PERM = true;
    bf16_t* H; int ldh;
    __device__ __forceinline__ void operator()(const f32x4 (&acc)[2][2][4][2], const Unit& u, int wr, int wc, int fr, int fq) const {
        asm volatile("" : "+v"(fr), "+v"(fq));
        const int row0 = u.pm * BM + wr * 64 + fr; const int col0 = u.pn * HALF + wc * 32 + 8 * fq;
#pragma unroll
        for (int ai = 0; ai < 2; ++ai)
#pragma unroll
            for (int m = 0; m < 4; ++m) { bf16_t* rowp = H + (size_t)(row0 + ai * HALF + m * 16) * ldh + col0;
                f32x4 h0, h1;
#pragma unroll
                for (int j = 0; j < 4; ++j) { h0[j] = silu_f(acc[ai][0][m][0][j]) * acc[ai][1][m][0][j]; h1[j] = silu_f(acc[ai][0][m][1][j]) * acc[ai][1][m][1][j]; }
                u32x4 w; w.x = pk2(h0[0], h0[1]); w.y = pk2(h0[2], h0[3]); w.z = pk2(h1[0], h1[1]); w.w = pk2(h1[2], h1[3]);
                *(u32x4*)rowp = w; }
    }
};
template <bool HAS_BS, bool SRC32> struct EpiResidT {
    static constexpr bool PERM = false;
    const void* src_lat; const void* src_ctx; bf16_t* dst_lat; bf16_t* dst_ctx; const float* gate;
    const float* bias; const float* cscale;
    __device__ __forceinline__ void operator()(const f32x4 (&acc)[2][2][4][2], const Unit& u, int wr, int wc, int fr, int fq) const {
        asm volatile("" : "+v"(fr), "+v"(fq));
        const bool isctx = u.pm >= RL / BM; const int mb = isctx ? 32 : (u.pm >> 3);
        const size_t trow = isctx ? (size_t)(u.pm - RL / BM) * BM : (size_t)u.pm * BM;
        const float* s32 = (const float*)(isctx ? src_ctx : src_lat) + trow * D; const bf16_t* s16 = (const bf16_t*)(isctx ? src_ctx : src_lat) + trow * D;
        bf16_t* dst = (isctx ? dst_ctx : dst_lat) + trow * D;
        const float* g = gate + (size_t)mb * MODW;
        const int col0 = u.pn * BM + wc * 32 + 4 * fq;
        f32x4 gv[2][2], bv[2][2];
#pragma unroll
        for (int bj = 0; bj < 2; ++bj)
#pragma unroll
            for (int n = 0; n < 2; ++n) { const int c = col0 + bj * HALF + n * 16; gv[bj][n] = HAS_BS ? (f32x4){0.f, 0.f, 0.f, 0.f} : *(const f32x4*)(g + c); bv[bj][n] = (f32x4){0.f, 0.f, 0.f, 0.f}; }
        constexpr int MB = HAS_BS ? 1 : 4;
#pragma unroll
        for (int ai = 0; ai < 2; ++ai)
#pragma unroll
            for (int m0 = 0; m0 < 4; m0 += MB) {
                f32x4 rs[MB][2][2];
#pragma unroll
                for (int mi = 0; mi < MB; ++mi) { const unsigned off = (unsigned)((ai * HALF + wr * 64 + (m0 + mi) * 16 + fr) * D + col0);
#pragma unroll
                    for (int bj = 0; bj < 2; ++bj)
#pragma unroll
                        for (int n = 0; n < 2; ++n) { if (SRC32) rs[mi][bj][n] = *(const f32x4*)(s32 + off + bj * HALF + n * 16);
                            else { const u32x2 q = *(const u32x2*)(s16 + off + bj * HALF + n * 16); rs[mi][bj][n] = (f32x4){lo_bf(q.x), hi_bf(q.x), lo_bf(q.y), hi_bf(q.y)}; } } }
#pragma unroll
                for (int mi = 0; mi < MB; ++mi) { const int m = m0 + mi; const unsigned off = (unsigned)((ai * HALF + wr * 64 + m * 16 + fr) * D + col0);
#pragma unroll
                    for (int bj = 0; bj < 2; ++bj)
#pragma unroll
                        for (int n = 0; n < 2; ++n) { f32x4 o;
                            if (HAS_BS) { const int c = col0 + bj * HALF + n * 16;
                                o = rs[mi][bj][n] + (*(const f32x4*)(g + c) * *(const f32x4*)(cscale + c)) * (acc[ai][bj][m][n] + *(const f32x4*)(bias + c)); }
                            else o = rs[mi][bj][n] + gv[bj][n] * acc[ai][bj][m][n];
                            u32x2 w; w.x = pk2(o[0], o[1]); w.y = pk2(o[2], o[3]); *(u32x2*)(dst + off + bj * HALF + n * 16) = w; } }
            }
    }
};
typedef EpiResidT<false, false> EpiResid; typedef EpiResidT<true, false> EpiResidBS; typedef EpiResidT<false, true> EpiResidX;
template <bool OUT32> struct EpiMoeDownT {
    static constexpr bool PERM = false;
    bf16_t* h_lat; bf16_t* h_ctx; float* out32; const float* gate; const int* tok; const float* gw;
    __device__ __forceinline__ void operator()(const f32x4 (&acc)[2][2][4][2], const Unit& u, int wr, int wc, int fr, int fq) const {
        asm volatile("" : "+v"(fr), "+v"(fq));
        const int col0 = u.pn * BM + wc * 32 + 4 * fq;
        int tk[2][4]; float wg[2][4];
#pragma unroll
        for (int ai = 0; ai < 2; ++ai)
#pragma unroll
            for (int m = 0; m < 4; ++m) { const int pos = u.pm * BM + ai * HALF + wr * 64 + m * 16 + fr; tk[ai][m] = tok[pos]; wg[ai][m] = gw[pos]; }
#pragma unroll
        for (int ai = 0; ai < 2; ++ai)
#pragma unroll
            for (int mp = 0; mp < 2; ++mp) {
                u32x2 rs[2][2][2]; f32x4 gg[2][2][2]; size_t ro[2]; bool cx[2];
#pragma unroll
                for (int mi = 0; mi < 2; ++mi) { const int t = tk[ai][2 * mp + mi]; const int tt = t >= 0 ? t : 0; cx[mi] = tt >= RL; const int mb = cx[mi] ? 32 : (tt >> 11);
                    ro[mi] = (size_t)(cx[mi] ? tt - RL : tt) * D + col0; const bf16_t* hp = (cx[mi] ? h_ctx : h_lat) + ro[mi]; const float* g = gate + (size_t)mb * MODW + col0;
#pragma unroll
                    for (int bj = 0; bj < 2; ++bj)
#pragma unroll
                        for (int n = 0; n < 2; ++n) { rs[mi][bj][n] = *(const u32x2*)(hp + bj * HALF + n * 16); gg[mi][bj][n] = *(const f32x4*)(g + bj * HALF + n * 16); } }
#pragma unroll
                for (int mi = 0; mi < 2; ++mi) { const int m = 2 * mp + mi;
                    if (tk[ai][m] >= 0) { const float w = wg[ai][m];
#pragma unroll
                        for (int bj = 0; bj < 2; ++bj)
#pragma unroll
                            for (int n = 0; n < 2; ++n) { const u32x2 q = rs[mi][bj][n]; const f32x4 o = (f32x4){lo_bf(q.x), hi_bf(q.x), lo_bf(q.y), hi_bf(q.y)} + gg[mi][bj][n] * (acc[ai][bj][m][n] * w);
                                if (OUT32) *(f32x4*)(out32 + ro[mi] + bj * HALF + n * 16) = o;
                                else { u32x2 wv; wv.x = pk2(o[0], o[1]); wv.y = pk2(o[2], o[3]); *(u32x2*)((cx[mi] ? h_ctx : h_lat) + ro[mi] + bj * HALF + n * 16) = wv; } } } }
            }
    }
};
typedef EpiMoeDownT<false> EpiMoeDown; typedef EpiMoeDownT<true> EpiMoeDownOut;
}

struct Frame {
    LAS unsigned char* lds;
    int tid, lane, wave, bid, G;
    const Params* p;
    unsigned char* ws; unsigned* ctl;
    float* modv; bf16_t* hlat; bf16_t* hctx; bf16_t* U;
};
#define WSP(T, off) ((T*)(F.ws + (off)))
__device__ __forceinline__ const float* INP(const Frame& F, int i) { return F.p->in[i]; }

__device__ __forceinline__ void cvt_item(const float* W, int K, int N, bf16_t* WT, int mode, LAS float* scr, int item, int lane) {
    const int nblk = N / 32, kb = item / nblk, nb = item % nblk, k0 = 64 * kb, n0 = 32 * nb;
#pragma unroll 8
    for (int i = 0; i < 32; ++i) { const int kk = 2 * i + (lane >> 5); scr[kk * 33 + (lane & 31)] = W[(size_t)(k0 + kk) * N + n0 + (lane & 31)]; }
    LDS_WAIT();
    const int c = lane & 7;
#pragma unroll
    for (int j = 0; j < 4; ++j) { const int n = (lane >> 3) + 8 * j; const LAS float* s = scr + (8 * c) * 33 + n;
        u32x4 o; o.x = pk2(s[0 * 33], s[1 * 33]); o.y = pk2(s[2 * 33], s[3 * 33]); o.z = pk2(s[4 * 33], s[5 * 33]); o.w = pk2(s[6 * 33], s[7 * 33]);
        const int nn = n0 + n; const int drow = mode == 0 ? nn : (256 * (nn >> 7) + (nn & 127) + (mode == 2 ? 128 : 0));
        *(u32x4*)(WT + (size_t)drow * K + k0 + 8 * c) = o; }
    LDS_WAIT();
}
struct CvtJob { const float* src; bf16_t* dst; int K, N, mode; };
__device__ __forceinline__ CvtJob cvt_small_job(const Frame& F, int j) {
    switch (j) {
        case 0: return CvtJob{INP(F, I_LRU_WIN), WSP(bf16_t, WS_LRU_WIN), 1024, 2560, 0};
        case 1: return CvtJob{INP(F, I_LRU_WOUT), WSP(bf16_t, WS_LRU_WOUT), 1280, 1024, 0};
        case 2: return CvtJob{INP(F, I_FFN_W1), WSP(bf16_t, WS_FFN_W13), 1024, DFF, 1};
        case 3: return CvtJob{INP(F, I_FFN_W3), WSP(bf16_t, WS_FFN_W13), 1024, DFF, 2};
        case 4: return CvtJob{INP(F, I_FFN_W2), WSP(bf16_t, WS_FFN_W2), DFF, 1024, 0};
        case 5: return CvtJob{INP(F, I_SGU_WIN), WSP(bf16_t, WS_SGU_WIN), 1024, 4096, 0};
        case 6: return CvtJob{INP(F, I_SGU_WOUT), WSP(bf16_t, WS_SGU_WOUT), 2048, 1024, 0};
        case 7: case 8: case 9: case 10: return CvtJob{INP(F, I_POOL_W) + (size_t)(j - 7) * 65536, WSP(bf16_t, WS_POOL_W) + (size_t)(j - 7) * 65536, 256, 256, 0};
        case 11: return CvtJob{INP(F, I_FFN_W1) + (size_t)D * DFF, WSP(bf16_t, WS_FFN_W13) + (size_t)2 * DFF * D, 1024, DFF, 1};
        case 12: return CvtJob{INP(F, I_FFN_W3) + (size_t)D * DFF, WSP(bf16_t, WS_FFN_W13) + (size_t)2 * DFF * D, 1024, DFF, 2};
        case 13: return CvtJob{INP(F, I_FFN_W2) + (size_t)D * DFF, WSP(bf16_t, WS_FFN_W2) + (size_t)D * DFF, DFF, 1024, 0};
        case 14: return CvtJob{INP(F, I_NA_WQKV), WSP(bf16_t, WS_NA_WQKV), 1024, 3072, 0};
        default: return CvtJob{INP(F, I_NA_WO), WSP(bf16_t, WS_NA_WO), 1024, 1024, 0};
    }
}
__device__ __forceinline__ int cvt_job_items(const CvtJob& j) { return (j.K / 64) * (j.N / 32); }
__device__ __forceinline__ void phase_cvt_small(const Frame& F) {
    const size_t gt = (size_t)F.bid * NTHR + F.tid, GT = (size_t)F.G * NTHR;
    { const float* wa = INP(F, I_LRU_WA); const float* wi = INP(F, I_LRU_WI); bf16_t* da = WSP(bf16_t, WS_LRU_WA); bf16_t* di = WSP(bf16_t, WS_LRU_WI);
      for (size_t i = gt; i < (size_t)16 * 160 * 160; i += GT) { const int mat = (int)(i / 25600), rem = (int)(i % 25600), n = rem / 160, k = rem % 160;
          da[i] = (bf16_t)(pk2(wa[(size_t)mat * 25600 + k * 160 + n], 0.f) & 0xffffu); di[i] = (bf16_t)(pk2(wi[(size_t)mat * 25600 + k * 160 + n], 0.f) & 0xffffu); } }
    { const float* w = INP(F, I_SGU_WS); bf16_t* d = WSP(bf16_t, WS_SGU_WS);
      for (size_t i = gt; i < (size_t)8 * 128 * 128; i += GT) d[i] = (bf16_t)(pk2(w[i], 0.f) & 0xffffu); }
    LAS float* scr = (LAS float*)(F.lds + F.wave * 16384);
    int total = 0; for (int j = 0; j < 16; ++j) total += cvt_job_items(cvt_small_job(F, j));
    unsigned* head = F.ctl + CW_CVTQ + 64 * 6;
    for (;;) {
        int base = 0; if (F.lane == 0) base = (int)atomicAdd(head, 4u); base = __builtin_amdgcn_readfirstlane(base);
        if (base >= total) break;
        int j = 0, off = 0; CvtJob job = cvt_small_job(F, 0);
        for (;;) { const int n = cvt_job_items(job); if (base < off + n) break; off += n; ++j; job = cvt_small_job(F, j); }
        for (int k = 0; k < 4 && base + k < total; ++k) { int it = base + k - off; while (it >= cvt_job_items(job)) { it -= cvt_job_items(job); off += cvt_job_items(job); ++j; job = cvt_small_job(F, j); }
            cvt_item(job.src, job.K, job.N, job.dst, job.mode, scr, it, F.lane); }
    }
}
constexpr int CVT_MOE_ITEMS = 24 * 1792;
__device__ __forceinline__ bf16_t* moe_w13(const Frame& F, int l2) { return l2 ? WSP(bf16_t, WS_BIG + BG_MW2) : WSP(bf16_t, WS_MOE_W13); }
__device__ __forceinline__ bf16_t* moe_w2(const Frame& F, int l2) { return l2 ? WSP(bf16_t, WS_BIG + BG_MW2 + 112 * MiB) : WSP(bf16_t, WS_MOE_W2); }
__device__ __forceinline__ void cvt_moe_item(const Frame& F, int l2, int g, LAS float* scr) {
    const int job = g / 1792, it = g - job * 1792, e = job / 3, which = job - 3 * e; const size_t so = ((size_t)l2 * NE + e) * D * DFF;
    if (which == 0) cvt_item(INP(F, I_MOE_W1) + so, 1024, DFF, moe_w13(F, l2) + (size_t)e * 2 * DFF * D, 1, scr, it, F.lane);
    else if (which == 1) cvt_item(INP(F, I_MOE_W3) + so, 1024, DFF, moe_w13(F, l2) + (size_t)e * 2 * DFF * D, 2, scr, it, F.lane);
    else cvt_item(INP(F, I_MOE_W2) + so, DFF, 1024, moe_w2(F, l2) + (size_t)e * D * DFF, 0, scr, it, F.lane);
}
__device__ __forceinline__ void cvt_moe_queue(const Frame& F, int l2, int g_lo, int g_hi, int qword) {
    LAS float* scr = (LAS float*)(F.lds + F.wave * 16384);
    unsigned* head = F.ctl + CW_CVTQ + 64 * qword; const int n = g_hi - g_lo;
    for (;;) {
        int base = 0; if (F.lane == 0) base = (int)atomicAdd(head, 4u); base = __builtin_amdgcn_readfirstlane(base);
        if (base >= n) break;
        for (int k = 0; k < 4 && base + k < n; ++k) cvt_moe_item(F, l2, g_lo + base + k, scr);
    }
}

__device__ __forceinline__ void phase_mod(const Frame& F) {
    LAS float* sL = (LAS float*)F.lds;
    LAS float* pr = (LAS float*)(F.lds + 135168);
    const float* c = INP(F, I_C); const float* cc = INP(F, I_CCTX);
    __syncthreads();
    if (F.bid < 4 * 96) { for (int i = F.tid; i < 33 * 1024; i += NTHR) { const int b = i >> 10, k = i & 1023; const float v = b < 32 ? c[b * 1024 + k] : cc[k]; sL[i] = silu_f(v); } }
    __syncthreads();
    for (int unit = F.bid; unit < 4 * 96; unit += F.G) {
        const int l = unit / 96, col = (unit % 96) * 64 + F.lane, k0 = F.wave * 128;
        const float* w = INP(F, I_MODW) + (size_t)l * 1024 * MODW + col;
        float acc[33];
#pragma unroll
        for (int b = 0; b < 33; ++b) acc[b] = 0.f;
        for (int k = k0; k < k0 + 128; k += 16) {
            float wv[16];
#pragma unroll
            for (int j = 0; j < 16; ++j) wv[j] = w[(size_t)(k + j) * MODW];
#pragma unroll
            for (int b = 0; b < 33; ++b) {
#pragma unroll
                for (int q = 0; q < 4; ++q) { const f32x4 s0 = *(const LAS f32x4*)(sL + b * 1024 + k + 4 * q); acc[b] += (s0[0] * wv[4 * q] + s0[1] * wv[4 * q + 1]) + (s0[2] * wv[4 * q + 2] + s0[3] * wv[4 * q + 3]); } }
        }
#pragma unroll
        for (int pass = 0; pass < 4; ++pass) {
            __syncthreads();
#pragma unroll
            for (int b = 0; b < 9; ++b) if (pass * 9 + b < 33) pr[(F.wave * 9 + b) * 64 + F.lane] = acc[pass * 9 + b];
            __syncthreads();
            for (int i = F.tid; i < 9 * 64; i += NTHR) { const int b = i >> 6, cl = i & 63, bb = pass * 9 + b;
                if (bb < 33) { float t = 0.f;
#pragma unroll
                    for (int g = 0; g < 8; ++g) t += pr[(g * 9 + b) * 64 + cl];
                    const int cg = (unit % 96) * 64 + cl; F.modv[((size_t)l * 33 + bb) * MODW + cg] = t + INP(F, I_MODB)[l * MODW + cg]; } }
        }
    }
    __syncthreads();
}

struct NormCtx { const void* src_lat; const void* src_ctx; const float* gain; const float* mod; int which; bool f32src; };
struct NormPar { f32x4 gm[4], sh[4]; };
__device__ __forceinline__ void norm_load_par(const Frame& F, const NormCtx& N, int mb, NormPar& P) {
    const float* sh = N.mod + (size_t)mb * MODW + N.which * 3 * D; const float* sc = sh + D;
#pragma unroll
    for (int j = 0; j < 4; ++j) { const int c = 4 * F.lane + 256 * j; P.gm[j] = *(const f32x4*)(N.gain + c) * (*(const f32x4*)(sc + c) + 1.0f); P.sh[j] = *(const f32x4*)(sh + c); }
}
__device__ __forceinline__ void norm_load_row(const Frame& F, const NormCtx& N, int r, f32x4 (&v)[4]) {
    const size_t ro = (size_t)(r < RL ? r : r - RL) * D; const void* sp = r < RL ? N.src_lat : N.src_ctx;
#pragma unroll
    for (int j = 0; j < 4; ++j) {
        if (N.f32src) v[j] = *(const f32x4*)((const float*)sp + ro + 4 * F.lane + 256 * j);
        else { const u32x2 q = *(const u32x2*)((const bf16_t*)sp + ro + 4 * F.lane + 256 * j); v[j] = (f32x4){lo_bf(q.x), hi_bf(q.x), lo_bf(q.y), hi_bf(q.y)}; } }
}
__device__ __forceinline__ void norm_finish(const NormPar& P, const f32x4 (&v)[4], f32x4 (&y)[4]) {
    float ss = 0.f;
#pragma unroll
    for (int j = 0; j < 4; ++j) ss += (v[j][0] * v[j][0] + v[j][1] * v[j][1]) + (v[j][2] * v[j][2] + v[j][3] * v[j][3]);
    const float rstd = 1.0f / sqrtf(wave_sum(ss) * (1.0f / D) + NORM_EPS);
#pragma unroll
    for (int j = 0; j < 4; ++j) y[j] = (v[j] * rstd) * P.gm[j] + P.sh[j];
}
__device__ __forceinline__ void store_row_bf16(const Frame& F, bf16_t* dst, const f32x4 (&y)[4]) {
#pragma unroll
    for (int j = 0; j < 4; ++j) { u32x2 w; w.x = pk2(y[j][0], y[j][1]); w.y = pk2(y[j][2], y[j][3]); *(u32x2*)(dst + 4 * F.lane + 256 * j) = w; }
}
__device__ __forceinline__ void phase_norm(const Frame& F, const NormCtx& N, int nrows) {
    const int gw = F.bid * NWAVES + F.wave, NGW = F.G * NWAVES, RPW = (nrows + NGW - 1) / NGW, r0 = gw * RPW, r1 = min(nrows, r0 + RPW);
    if (r0 >= r1) return;
    NormPar P; int mbcur = -1; f32x4 v[4], vn[4];
    norm_load_row(F, N, r0, v);
    for (int r = r0; r < r1; ++r) {
        if (r + 1 < r1) norm_load_row(F, N, r + 1, vn);
        const int mb = r < RL ? (r >> 11) : 32; if (mb != mbcur) { norm_load_par(F, N, mb, P); mbcur = mb; }
        f32x4 y[4]; norm_finish(P, v, y); store_row_bf16(F, F.U + (size_t)r * D, y);
#pragma unroll
        for (int j = 0; j < 4; ++j) v[j] = vn[j];
    }
}
__device__ __forceinline__ void route_top2(const Frame& F, float (&lg)[NE], const float* br, int& e0, int& e1, float& w0) {
    const bool h5 = F.lane & 32, h4 = F.lane & 16, h3 = F.lane & 8;
    float a4[4];
#pragma unroll
    for (int k = 0; k < 4; ++k) { const float mine = h5 ? lg[4 + k] : lg[k], send = h5 ? lg[k] : lg[4 + k]; a4[k] = mine + __shfl_xor(send, 32); }
    float a2[2];
#pragma unroll
    for (int k = 0; k < 2; ++k) { const float mine = h4 ? a4[2 + k] : a4[k], send = h4 ? a4[k] : a4[2 + k]; a2[k] = mine + __shfl_xor(send, 16); }
    float a1; { const float mine = h3 ? a2[1] : a2[0], send = h3 ? a2[0] : a2[1]; a1 = mine + __shfl_xor(send, 8); }
    a1 += __shfl_xor(a1, 4); a1 += __shfl_xor(a1, 2); a1 += __shfl_xor(a1, 1);
#pragma unroll
    for (int e = 0; e < NE; ++e) lg[e] = __int_as_float(__builtin_amdgcn_readlane(__float_as_int(a1), ((e >> 2) & 1) * 32 + ((e >> 1) & 1) * 16 + (e & 1) * 8)) + br[e];
    e0 = 0; float v0 = lg[0];
#pragma unroll
    for (int e = 1; e < NE; ++e) if (lg[e] > v0) { v0 = lg[e]; e0 = e; }
    e1 = -1; float v1 = -3.0e38f;
#pragma unroll
    for (int e = 0; e < NE; ++e) if (e != e0 && lg[e] > v1) { v1 = lg[e]; e1 = e; }
    w0 = 1.0f / (1.0f + __expf(v1 - v0));
}
__device__ __forceinline__ void phase_route(const Frame& F, const NormCtx& N, int nrows, int l2) {
    LAS float* wrL = (LAS float*)F.lds;
    LAS unsigned* hist = (LAS unsigned*)(F.lds + 32768);
    __syncthreads();
    const float* wr = INP(F, I_MOE_WR) + (size_t)l2 * D * NE; const float* br = INP(F, I_MOE_BR) + l2 * NE;
    for (int i = F.tid; i < D * NE; i += NTHR) wrL[(i & 7) * D + (i >> 3)] = wr[i];
    if (F.tid < 16) hist[F.tid] = 0u;
    __syncthreads();
    int* re = WSP(int, WS_ROUTE + RT_E); float* rw = WSP(float, WS_ROUTE + RT_W);
    const int gw = F.bid * NWAVES + F.wave, NGW = F.G * NWAVES, RPW = (nrows + NGW - 1) / NGW, r0 = gw * RPW, r1 = min(nrows, r0 + RPW);
    NormPar P; int mbcur = -1; f32x4 va[4], vb[4];
    for (int r = r0; r < r1; r += 2) {
        const bool two = r + 1 < r1; const int rb = two ? r + 1 : r;
        norm_load_row(F, N, r, va); norm_load_row(F, N, rb, vb);
        f32x4 ya[4], yb[4];
        { const int mb = r < RL ? (r >> 11) : 32; if (mb != mbcur) { norm_load_par(F, N, mb, P); mbcur = mb; } norm_finish(P, va, ya); store_row_bf16(F, F.U + (size_t)r * D, ya); }
        { const int mb = rb < RL ? (rb >> 11) : 32; if (mb != mbcur) { norm_load_par(F, N, mb, P); mbcur = mb; } norm_finish(P, vb, yb); if (two) store_row_bf16(F, F.U + (size_t)rb * D, yb); }
        float la[NE], lb[NE];
#pragma unroll
        for (int e = 0; e < NE; ++e) { la[e] = 0.f; lb[e] = 0.f; }
#pragma unroll
        for (int j = 0; j < 4; ++j)
#pragma unroll
            for (int e = 0; e < NE; ++e) { const f32x4 wv = *(const LAS f32x4*)(wrL + e * D + 4 * F.lane + 256 * j);
                la[e] += (ya[j][0] * wv[0] + ya[j][1] * wv[1]) + (ya[j][2] * wv[2] + ya[j][3] * wv[3]); lb[e] += (yb[j][0] * wv[0] + yb[j][1] * wv[1]) + (yb[j][2] * wv[2] + yb[j][3] * wv[3]); }
        int e0, e1; float w0;
        route_top2(F, la, br, e0, e1, w0);
        if (F.lane == 0) { re[r] = e0 | (e1 << 8); rw[2 * r] = w0; rw[2 * r + 1] = 1.0f - w0; lds_add(&hist[e0], 1u); lds_add(&hist[8 + e1], 1u); }
        route_top2(F, lb, br, e0, e1, w0);
        if (F.lane == 0 && two) { re[rb] = e0 | (e1 << 8); rw[2 * rb] = w0; rw[2 * rb + 1] = 1.0f - w0; lds_add(&hist[e0], 1u); lds_add(&hist[8 + e1], 1u); }
    }
    __syncthreads();
    if (F.tid < 16 && hist[F.tid]) atomicAdd(F.ctl + CW_CNT + 64 * l2 + F.tid, hist[F.tid]);
    int* tok = WSP(int, WS_ROUTE + RT_TOK);
    for (size_t i = (size_t)F.bid * NTHR + F.tid; i < (size_t)2 * MPAD; i += (size_t)F.G * NTHR) tok[i] = -1;
    __syncthreads();
}
__device__ __forceinline__ int pad256(int x) { return (x + 255) & ~255; }
__device__ __forceinline__ void phase_assign_scatter0(const Frame& F, int nrows, int l2) {
    LAS unsigned* bcnt = (LAS unsigned*)F.lds;
    LAS unsigned* bbase = (LAS unsigned*)(F.lds + 64);
    __syncthreads();
    if (F.tid < 16) bcnt[F.tid] = 0u;
    __syncthreads();
    const int RPB = (nrows + F.G - 1) / F.G, rb0 = F.bid * RPB, rb1 = min(nrows, rb0 + RPB);
    const int* re = WSP(const int, WS_ROUTE + RT_E); const float* rw = WSP(const float, WS_ROUTE + RT_W);
    int* tok = WSP(int, WS_ROUTE + RT_TOK); float* gwl = WSP(float, WS_ROUTE + RT_GW); int* pos1 = WSP(int, WS_ROUTE + RT_P1);
    const int myr = rb0 + F.wave + 8 * F.lane; const bool have = myr < rb1;
    int e0 = 0, e1 = 0; unsigned li0 = 0, li1 = 0; float w0 = 0.f, w1 = 0.f;
    if (have) { const int ee = re[myr]; e0 = ee & 255; e1 = (ee >> 8) & 255; w0 = rw[2 * myr]; w1 = rw[2 * myr + 1]; li0 = lds_add(&bcnt[e0], 1u); li1 = lds_add(&bcnt[8 + e1], 1u); }
    __syncthreads();
    const unsigned* cnt = F.ctl + CW_CNT + 64 * l2;
    if (F.tid < 16) { const int s = F.tid >> 3, e = F.tid & 7; unsigned off = 0; for (int k = 0; k < e; ++k) off += (unsigned)pad256((int)cnt[s * 8 + k]);
        unsigned b = 0; if (bcnt[F.tid]) b = atomicAdd(F.ctl + CW_CUR + 64 * l2 + F.tid, bcnt[F.tid]); bbase[F.tid] = off + b; }
    __syncthreads();
    const int p0 = (int)(bbase[e0] + li0), p1 = (int)(bbase[8 + e1] + li1);
    if (have) { tok[p0] = myr; gwl[p0] = w0; tok[MPAD + p1] = myr; gwl[MPAD + p1] = w1; pos1[myr] = p1; }
    __syncthreads();
}
__device__ __forceinline__ int moe_tile_table(const Frame& F, int l2, int s, LAS int* tstart) {
    __syncthreads();
    if (F.tid == 0) { const unsigned* cnt = F.ctl + CW_CNT + 64 * l2 + 8 * s; int t = 0; for (int e = 0; e < NE; ++e) { tstart[e] = t; t += pad256((int)cnt[e]) >> 8; } tstart[8] = t; }
    __syncthreads();
    return tstart[8];
}

constexpr int SC_RS = 164;
__device__ __forceinline__ void scan_conv_load(const bf16_t* XG, size_t rowbase, int L, int t0, int ch0, int pt, u32x2 (&xr)[11]) {
    const int q4 = pt % 40, rg = pt / 40, ch = ch0 + 4 * q4, ta = t0 + 8 * rg;
#pragma unroll
    for (int i = 0; i < 11; ++i) { const int tp = ta - 2 + i; xr[i] = (tp >= 0 && tp < L) ? *(const u32x2*)(XG + (rowbase + tp) * 2560 + ch) : (u32x2){0u, 0u}; }
}
__device__ __forceinline__ void scan_conv_math(const float* cw, const float* cb, LAS bf16_t* xc, int ch0, int pt, const u32x2 (&xr)[11]) {
    const int q4 = pt % 40, rg = pt / 40, ch = ch0 + 4 * q4;
    const f32x4 bias = *(const f32x4*)(cb + ch); f32x4 wv[4];
#pragma unroll
    for (int k = 0; k < 4; ++k) wv[k] = *(const f32x4*)(cw + k * DRNN + ch);
#pragma unroll
    for (int i = 0; i < 8; ++i) { f32x4 acc = bias;
#pragma unroll
        for (int k = 0; k < 4; ++k) { const u32x2 x = xr[i + k]; acc[0] += lo_bf(x.x) * wv[k][0]; acc[1] += hi_bf(x.x) * wv[k][1]; acc[2] += lo_bf(x.y) * wv[k][2]; acc[3] += hi_bf(x.y) * wv[k][3]; }
        u32x2 o; o.x = pk2(acc[0], acc[1]); o.y = pk2(acc[2], acc[3]); *(LAS u32x2*)(xc + (8 * rg + i) * 168 + 4 * q4) = o; }
}
__device__ __forceinline__ void phase_scan(const Frame& F, bool need_ctx) {
    LAS bf16_t* xcA0 = (LAS bf16_t*)F.lds;
    LAS float* Ra = (LAS float*)(F.lds + 43008);
    LAS float* Ri = (LAS float*)(F.lds + 43008 + 41984);
    LAS float* tab = (LAS float*)(F.lds + 43008 + 2 * 41984);
    LAS bf16_t* Hb = (LAS bf16_t*)(F.lds + 43008 + 2 * 41984 + 2048);
    const bf16_t* XG = WSP(const bf16_t, WS_BIG + BG_XG); bf16_t* Y = WSP(bf16_t, WS_BIG + BG_Y);
    const float* cw = INP(F, I_LRU_CW); const float* cb = INP(F, I_LRU_CB);
    const int fr = F.lane & 15, fq = F.lane >> 4, w = F.wave;
    const int ntA = w, ntB = 8 + (w & 1), mtB = w >> 1;
    for (int unit = F.bid; unit < NB * 8; unit += F.G) {
        const int b = unit >> 3, kb = unit & 7, ch0 = kb * LBW;
        for (int d = 0; d < 2; ++d) {
            float carry = 0.f;
            bf16x8 Ba[5], Bi[5];
            __syncthreads();
            const bf16_t* wa = WSP(const bf16_t, WS_LRU_WA) + (size_t)(d * 8 + kb) * 25600; const bf16_t* wi = WSP(const bf16_t, WS_LRU_WI) + (size_t)(d * 8 + kb) * 25600;
#pragma unroll
            for (int ks = 0; ks < 5; ++ks) { Ba[ks] = *(const bf16x8*)(wa + (16 * ntA + fr) * 160 + 32 * ks + 8 * fq); Bi[ks] = *(const bf16x8*)(wi + (16 * ntA + fr) * 160 + 32 * ks + 8 * fq); }
            if (F.tid < LBW) { const int c = ch0 + F.tid; tab[F.tid] = INP(F, I_LRU_BA)[d * DRNN + c]; tab[160 + F.tid] = INP(F, I_LRU_BI)[d * DRNN + c];
                const float lam = INP(F, I_LRU_LAM)[d * DRNN + c]; tab[320 + F.tid] = 8.0f * 1.4426950408889634f * (lam > 0.f ? log1pf(expf(-lam)) : (-lam + log1pf(expf(lam)))); }
            if (F.tid >= 192) { u32x2 xr[11]; scan_conv_load(XG, (size_t)RL + (size_t)b * CTXL, CTXL, d ? CTXL - 64 : 0, ch0, F.tid - 192, xr); scan_conv_math(cw, cb, xcA0, ch0, F.tid - 192, xr); }
            __syncthreads();
            for (int cidx = 0; cidx <= 36; ++cidx) {
                const int seg = cidx >= 4, ci = seg ? cidx - 4 : cidx, L = seg ? SEQ : CTXL; const size_t rowbase = seg ? (size_t)b * SEQ : (size_t)RL + (size_t)b * CTXL;
                const int t0 = d ? L - 64 * (ci + 1) : 64 * ci;
                LAS bf16_t* xc = xcA0 + (cidx & 1) * (64 * 168);
                const int pc = cidx - 1; const int pseg = pc >= 4, pci = pseg ? pc - 4 : pc, pL = pseg ? SEQ : CTXL; const size_t prow = pseg ? (size_t)b * SEQ : (size_t)RL + (size_t)b * CTXL;
                const int pt0 = d ? pL - 64 * (pci + 1) : 64 * pci; const bool p_out = pc >= 0 && (pseg == 1 || need_ctx);
                u32x2 pv[5], gv[5];
#pragma unroll
                for (int it = 0; it < 5; ++it) { const int e = F.tid + NTHR * it, tt = e / 40, c4 = e % 40;
                    if (d == 1 && p_out) { const size_t row = prow + pt0 + tt; pv[it] = *(const u32x2*)(Y + row * DRNN + ch0 + 4 * c4); gv[it] = *(const u32x2*)(XG + row * 2560 + DRNN + ch0 + 4 * c4); } else { pv[it] = (u32x2){0u, 0u}; gv[it] = (u32x2){0u, 0u}; } }
                if (cidx < 36) {
                    bf16x8 Xa[5], Xi[5];
#pragma unroll
                    for (int ks = 0; ks < 5; ++ks) { Xa[ks] = *(const bf16x8*)(wa + (16 * ntB + fr) * 160 + 32 * ks + 8 * fq); Xi[ks] = *(const bf16x8*)(wi + (16 * ntB + fr) * 160 + 32 * ks + 8 * fq); }
#pragma unroll 1
                    for (int mt = 0; mt < 4; ++mt) {
                        f32x4 ra = {0.f, 0.f, 0.f, 0.f}, ri = {0.f, 0.f, 0.f, 0.f};
#pragma unroll
                        for (int ks = 0; ks < 5; ++ks) { const bf16x8 a = *(const LAS bf16x8*)(xc + (16 * mt + fr) * 168 + 32 * ks + 8 * fq);
                            ra = __builtin_amdgcn_mfma_f32_16x16x32_bf16(Ba[ks], a, ra, 0, 0, 0); ri = __builtin_amdgcn_mfma_f32_16x16x32_bf16(Bi[ks], a, ri, 0, 0, 0); }
                        const int o = (16 * mt + fr) * SC_RS + 16 * ntA + 4 * fq; *(LAS f32x4*)(Ra + o) = ra; *(LAS f32x4*)(Ri + o) = ri;
                    }
                    {
                        f32x4 ra = {0.f, 0.f, 0.f, 0.f}, ri = {0.f, 0.f, 0.f, 0.f};
#pragma unroll
                        for (int ks = 0; ks < 5; ++ks) { const bf16x8 a = *(const LAS bf16x8*)(xc + (16 * mtB + fr) * 168 + 32 * ks + 8 * fq);
                            ra = __builtin_amdgcn_mfma_f32_16x16x32_bf16(Xa[ks], a, ra, 0, 0, 0); ri = __builtin_amdgcn_mfma_f32_16x16x32_bf16(Xi[ks], a, ri, 0, 0, 0); }
                        const int o = (16 * mtB + fr) * SC_RS + 16 * ntB + 4 * fq; *(LAS f32x4*)(Ra + o) = ra; *(LAS f32x4*)(Ri + o) = ri;
                    }
                }
                if (p_out) {
#pragma unroll
                    for (int it = 0; it < 5; ++it) { const int e = F.tid + NTHR * it, tt = e / 40, c4 = e % 40; const u32x2 hb = *(const LAS u32x2*)(Hb + tt * 168 + 4 * c4);
                        u32x2* yp = (u32x2*)(Y + (prow + pt0 + tt) * DRNN + ch0 + 4 * c4); u32x2 o;
                        if (d == 0) o = hb;
                        else { o.x = pk2((lo_bf(pv[it].x) + lo_bf(hb.x)) * gelu_tanh_f(lo_bf(gv[it].x)), (hi_bf(pv[it].x) + hi_bf(hb.x)) * gelu_tanh_f(hi_bf(gv[it].x)));
                               o.y = pk2((lo_bf(pv[it].y) + lo_bf(hb.y)) * gelu_tanh_f(lo_bf(gv[it].y)), (hi_bf(pv[it].y) + hi_bf(hb.y)) * gelu_tanh_f(hi_bf(gv[it].y))); }
                        *yp = o; }
                }
                if (cidx == 36) break;
                __syncthreads();
                const bool do_conv = F.tid >= 192 && cidx + 1 < 36;
                u32x2 xr[11];
                if (do_conv) { const int nseg = (cidx + 1) >= 4, nci = nseg ? cidx + 1 - 4 : cidx + 1, nL = nseg ? SEQ : CTXL;
                    scan_conv_load(XG, nseg ? (size_t)b * SEQ : (size_t)RL + (size_t)b * CTXL, nL, d ? nL - 64 * (nci + 1) : 64 * nci, ch0, F.tid - 192, xr); }
#pragma unroll 1
                for (int it = 0; it < 5; ++it) { const int e = F.tid + NTHR * it, tt = e / 40, c4 = e % 40; const int o = tt * SC_RS + 4 * c4;
                    const f32x4 va = *(const LAS f32x4*)(Ra + o) + *(const LAS f32x4*)(tab + 4 * c4), vi = *(const LAS f32x4*)(Ri + o) + *(const LAS f32x4*)(tab + 160 + 4 * c4), sp = *(const LAS f32x4*)(tab + 320 + 4 * c4);
                    const u32x2 xv = *(const LAS u32x2*)(xc + tt * 168 + 4 * c4); const float xf[4] = {lo_bf(xv.x), hi_bf(xv.x), lo_bf(xv.y), hi_bf(xv.y)};
                    f32x4 av, bv;
#pragma unroll
                    for (int j = 0; j < 4; ++j) { const float r = __builtin_amdgcn_rcpf(1.0f + __builtin_amdgcn_exp2f(-1.4426950408889634f * va[j])), ig = __builtin_amdgcn_rcpf(1.0f + __builtin_amdgcn_exp2f(-1.4426950408889634f * vi[j]));
                        const float a = __builtin_amdgcn_exp2f(-r * sp[j]); av[j] = a; bv[j] = __builtin_amdgcn_sqrtf(fmaxf(1.0f - a * a, 0.f)) * (ig * xf[j]); }
                    *(LAS f32x4*)(Ra + o) = av; *(LAS f32x4*)(Ri + o) = bv; }
                __syncthreads();
                if (F.tid < LBW) { float h = carry;
#pragma unroll 1
                    for (int s0 = 0; s0 < 64; s0 += 16) {
                        float av[16], bv[16], hv[16];
#pragma unroll
                        for (int k = 0; k < 16; ++k) { const int tt = d ? 63 - (s0 + k) : s0 + k; av[k] = Ra[tt * SC_RS + F.tid]; bv[k] = Ri[tt * SC_RS + F.tid]; }
#pragma unroll
                        for (int k = 0; k < 16; ++k) { h = av[k] * h + bv[k]; hv[k] = h; }
#pragma unroll
                        for (int k = 0; k < 16; ++k) { const int tt = d ? 63 - (s0 + k) : s0 + k; Hb[tt * 168 + F.tid] = (bf16_t)(pk2(hv[k], 0.f) & 0xffffu); }
                    }
                    carry = h; }
                else if (do_conv) scan_conv_math(cw, cb, xcA0 + ((cidx + 1) & 1) * (64 * 168), ch0, F.tid - 192, xr);
                __syncthreads();
            }
        }
    }
}

__device__ __forceinline__ void phase_sgu_stats(const Frame& F) {
    const bf16_t* Z = WSP(const bf16_t, WS_BIG + BG_Z); float* st = WSP(float, WS_ROUTE + RT_ST);
    const int gw = F.bid * NWAVES + F.wave, NGW = F.G * NWAVES, RPW = (RA + NGW - 1) / NGW, r0 = gw * RPW, r1 = min(RA, r0 + RPW);
    if (r0 >= r1) return;
    u32x4 q[4], qn[4];
#pragma unroll
    for (int j = 0; j < 4; ++j) q[j] = *(const u32x4*)(Z + (size_t)r0 * 4096 + DSGU + 8 * F.lane + 512 * j);
    for (int r = r0; r < r1; ++r) {
        if (r + 1 < r1) {
#pragma unroll
            for (int j = 0; j < 4; ++j) qn[j] = *(const u32x4*)(Z + (size_t)(r + 1) * 4096 + DSGU + 8 * F.lane + 512 * j); }
        float x[32]; float s = 0.f;
#pragma unroll
        for (int j = 0; j < 4; ++j) { x[8 * j + 0] = lo_bf(q[j].x); x[8 * j + 1] = hi_bf(q[j].x); x[8 * j + 2] = lo_bf(q[j].y); x[8 * j + 3] = hi_bf(q[j].y); x[8 * j + 4] = lo_bf(q[j].z); x[8 * j + 5] = hi_bf(q[j].z); x[8 * j + 6] = lo_bf(q[j].w); x[8 * j + 7] = hi_bf(q[j].w); }
#pragma unroll
        for (int i = 0; i < 32; ++i) s += x[i];
        const float mean = wave_sum(s) * (1.0f / DSGU); float q2 = 0.f;
#pragma unroll
        for (int i = 0; i < 32; ++i) { const float dlt = x[i] - mean; q2 += dlt * dlt; }
        const float rstd = 1.0f / sqrtf(wave_sum(q2) * (1.0f / DSGU) + NORM_EPS);
        if (F.lane == 0) { st[2 * r] = mean; st[2 * r + 1] = rstd; }
#pragma unroll
        for (int j = 0; j < 4; ++j) q[j] = qn[j];
    }
}
__device__ __forceinline__ size_t sgu_row0(int cu) { return cu < 512 ? (size_t)(cu >> 4) * SEQ + (size_t)(cu & 15) * 128 : (size_t)RL + (size_t)((cu - 512) >> 1) * CTXL + (size_t)((cu - 512) & 1) * 128; }
__device__ __forceinline__ void phase_sgu_spatial(const Frame& F) {
    LAS bf16_t* vT = (LAS bf16_t*)F.lds;
    LAS bf16_t* uT = (LAS bf16_t*)(F.lds + 69632);
    bf16_t* Z = WSP(bf16_t, WS_BIG + BG_Z); const float* st = WSP(const float, WS_ROUTE + RT_ST);
    const bf16_t* wsb = WSP(const bf16_t, WS_SGU_WS);
    const float* lng = INP(F, I_SGU_LNG); const float* lnb = INP(F, I_SGU_LNB); const float* bs = INP(F, I_SGU_BS);
    const int fr = F.lane & 15, fq = F.lane >> 4, w = F.wave;
    const int q8 = F.tid >> 5, d8 = F.tid & 31;
    const int urow = F.tid >> 5, uch = F.tid & 31;
    u32x4 vq[8], uq[8]; f32x2 sq[8];
    int unit = F.bid;
    if (unit < 576 * 8) { const int cu = unit >> 3, g = unit & 7; const size_t row0 = sgu_row0(cu);
#pragma unroll
        for (int i = 0; i < 8; ++i) { const size_t r = row0 + 8 * q8 + i; vq[i] = *(const u32x4*)(Z + r * 4096 + DSGU + 256 * g + 8 * d8); sq[i] = *(const f32x2*)(st + 2 * r);
            uq[i] = *(const u32x4*)(Z + (row0 + urow + 16 * i) * 4096 + 256 * g + 8 * uch); } }
    for (; unit < 576 * 8; unit += F.G) {
        const int cu = unit >> 3, g = unit & 7; const size_t row0 = sgu_row0(cu);
        {
            const int dcol = 256 * g + 8 * d8; float gg[8], bb[8];
#pragma unroll
            for (int j = 0; j < 8; ++j) { gg[j] = lng[dcol + j]; bb[j] = lnb[dcol + j]; }
            float x[8][8];
#pragma unroll
            for (int i = 0; i < 8; ++i) { const u32x4 q = vq[i]; const float mean = sq[i][0], rstd = sq[i][1];
                const float raw[8] = {lo_bf(q.x), hi_bf(q.x), lo_bf(q.y), hi_bf(q.y), lo_bf(q.z), hi_bf(q.z), lo_bf(q.w), hi_bf(q.w)};
#pragma unroll
                for (int j = 0; j < 8; ++j) x[i][j] = (raw[j] - mean) * rstd * gg[j] + bb[j]; }
#pragma unroll
            for (int j = 0; j < 8; ++j) { u32x4 o; o.x = pk2(x[0][j], x[1][j]); o.y = pk2(x[2][j], x[3][j]); o.z = pk2(x[4][j], x[5][j]); o.w = pk2(x[6][j], x[7][j]);
                *(LAS u32x4*)(vT + (8 * d8 + j) * 136 + 8 * (q8 ^ (d8 & 15))) = o; }
#pragma unroll
            for (int i = 0; i < 8; ++i) *(LAS u32x4*)(uT + (urow + 16 * i) * 264 + 8 * uch) = uq[i];
        }
        __syncthreads();
        {
            const int nu = unit + F.G;
            if (nu < 576 * 8) { const int ncu = nu >> 3, ng = nu & 7; const size_t nrow0 = sgu_row0(ncu);
#pragma unroll
                for (int i = 0; i < 8; ++i) { const size_t r = nrow0 + 8 * q8 + i; vq[i] = *(const u32x4*)(Z + r * 4096 + DSGU + 256 * ng + 8 * d8); sq[i] = *(const f32x2*)(st + 2 * r);
                    uq[i] = *(const u32x4*)(Z + (nrow0 + urow + 16 * i) * 4096 + 256 * ng + 8 * uch); } }
            const int p = 16 * w + fr; LAS u32x2* urow_l = (LAS u32x2*)(uT + p * 264 + 4 * fq);
            bf16x8 af[4];
#pragma unroll
            for (int ks = 0; ks < 4; ++ks) af[ks] = *(const bf16x8*)(wsb + ((size_t)g * 128 + p) * 128 + 32 * ks + 8 * fq);
            const float bias = bs[g * 128 + p];
#pragma unroll 4
            for (int nt = 0; nt < 16; ++nt) { f32x4 acc = {0.f, 0.f, 0.f, 0.f};
#pragma unroll
                for (int ks = 0; ks < 4; ++ks) { const bf16x8 bfv = *(const LAS bf16x8*)(vT + (16 * nt + fr) * 136 + 8 * ((4 * ks + fq) ^ ((2 * nt + (fr >> 3)) & 15))); acc = __builtin_amdgcn_mfma_f32_16x16x32_bf16(bfv, af[ks], acc, 0, 0, 0); }
                const u32x2 u2 = urow_l[4 * nt]; u32x2 o; o.x = pk2(lo_bf(u2.x) * (acc[0] + bias), hi_bf(u2.x) * (acc[1] + bias)); o.y = pk2(lo_bf(u2.y) * (acc[2] + bias), hi_bf(u2.y) * (acc[3] + bias)); urow_l[4 * nt] = o; }
        }
        __syncthreads();
#pragma unroll
        for (int i = 0; i < 8; ++i) *(u32x4*)(Z + (row0 + urow + 16 * i) * 4096 + 256 * g + 8 * uch) = *(const LAS u32x4*)(uT + (urow + 16 * i) * 264 + 8 * uch);
        __syncthreads();
    }
}

template <int WN> __device__ __forceinline__ void pool_item(const bf16_t* U, bf16_t* PD, int r, int cg) {
    int t, L; size_t base; if (r < RL) { t = r & (SEQ - 1); L = SEQ; base = (size_t)(r - t); } else { t = (r - RL) & (CTXL - 1); L = CTXL; base = (size_t)(r - t); }
    const int lo = max(t - WN / 2, 0), hi = min(t + WN / 2 - 1, L - 1);
    u32x4 v[WN];
#pragma unroll
    for (int k = 0; k < WN; ++k) { const int q = min(max(t - WN / 2 + k, 0), L - 1); v[k] = *(const u32x4*)(U + (base + q) * D + 8 * cg); }
    float s[8] = {0.f, 0.f, 0.f, 0.f, 0.f, 0.f, 0.f, 0.f};
#pragma unroll
    for (int k = 0; k < WN; ++k) { const int q = t - WN / 2 + k; const float m = (q >= lo && q <= hi) ? 1.f : 0.f;
        s[0] += m * lo_bf(v[k].x); s[1] += m * hi_bf(v[k].x); s[2] += m * lo_bf(v[k].y); s[3] += m * hi_bf(v[k].y); s[4] += m * lo_bf(v[k].z); s[5] += m * hi_bf(v[k].z); s[6] += m * lo_bf(v[k].w); s[7] += m * hi_bf(v[k].w); }
    const u32x4 sv = v[WN / 2];
    const float inv = 1.0f / (float)(hi - lo + 1);
    u32x4 o; o.x = pk2(s[0] * inv - lo_bf(sv.x), s[1] * inv - hi_bf(sv.x)); o.y = pk2(s[2] * inv - lo_bf(sv.y), s[3] * inv - hi_bf(sv.y));
    o.z = pk2(s[4] * inv - lo_bf(sv.z), s[5] * inv - hi_bf(sv.z)); o.w = pk2(s[6] * inv - lo_bf(sv.w), s[7] * inv - hi_bf(sv.w));
    *(u32x4*)(PD + (size_t)r * D + 8 * cg) = o;
}
__device__ __forceinline__ void phase_pool_diff(const Frame& F) {
    bf16_t* PD = WSP(bf16_t, WS_BIG + BG_PD);
    const size_t T0 = (size_t)F.bid * NTHR + F.tid, TS = (size_t)F.G * NTHR, NI = (size_t)RA * 32;
#define POOL_LOOP(g_, WN_, K_) for (size_t i = T0; i < NI; i += K_ * TS) { _Pragma("unroll") for (int k_ = 0; k_ < K_; ++k_) { const size_t ii = i + k_ * TS; if (ii < NI) pool_item<WN_>(F.U, PD, (int)(ii >> 5), 32 * g_ + (int)(ii & 31)); } }
    POOL_LOOP(0, 2, 8) POOL_LOOP(1, 4, 4) POOL_LOOP(2, 8, 2) POOL_LOOP(3, 16, 1)
#undef POOL_LOOP
}

__device__ __forceinline__ void phase_na(const Frame& F) {
    const bf16_t* QKV = WSP(const bf16_t, WS_BIG + BG_QKV); bf16_t* O = WSP(bf16_t, WS_BIG + BG_O); const float* rpb = INP(F, I_NA_RPB);
    const int w = F.wave, rsub = w >> 1, chh = w & 1, fr = F.lane & 15, fq = F.lane >> 4;
    const int skey = F.tid >> 3, sd8 = F.tid & 7;
    LAS float* bt = (LAS float*)(F.lds + 36864);
    const unsigned trl = (unsigned)((fr >> 2) * 144 + (fr & 3) * 8);
    float kgain[8];
#pragma unroll
    for (int j = 0; j < 8; ++j) kgain[j] = INP(F, I_NA_KG)[8 * sd8 + j];
#define NA_KNORM(kr) do { float x_[8] = {lo_bf(kr.x), hi_bf(kr.x), lo_bf(kr.y), hi_bf(kr.y), lo_bf(kr.z), hi_bf(kr.z), lo_bf(kr.w), hi_bf(kr.w)}; float ss_ = 0.f; \
        _Pragma("unroll") for (int j_ = 0; j_ < 8; ++j_) ss_ += x_[j_] * x_[j_]; \
        ss_ += dpp_f<0xB1>(ss_); ss_ += dpp_f<0x4E>(ss_); ss_ += dpp_f<0x141>(ss_); \
        const float rs_ = __builtin_amdgcn_rsqf(ss_ * (1.0f / 64.0f) + NORM_EPS); \
        kr.x = pk2(x_[0] * rs_ * kgain[0], x_[1] * rs_ * kgain[1]); kr.y = pk2(x_[2] * rs_ * kgain[2], x_[3] * rs_ * kgain[3]); \
        kr.z = pk2(x_[4] * rs_ * kgain[4], x_[5] * rs_ * kgain[5]); kr.w = pk2(x_[6] * rs_ * kgain[6], x_[7] * rs_ * kgain[7]); } while (0)
    float gqm = 0.f, gkm = 0.f; for (int i = 0; i < 64; ++i) { gqm = fmaxf(gqm, fabsf(INP(F, I_NA_QG)[i])); gkm = fmaxf(gkm, fabsf(INP(F, I_NA_KG)[i])); }
    const float M0 = 8.0f * gqm * gkm * 1.4426950408889634f;
    for (int unit = F.bid; unit < NB * 16 * 8; unit += F.G) {
        const int rg = unit & 7, h = (unit >> 3) & 15, b = unit >> 7;
        const int r = 4 * rg + rsub, r0 = min(max(r - 4, 0), 24);
        const int ulo = min(max(4 * rg - 4, 0), 24), uhi = min(max(4 * rg - 1, 0), 24) + 8, nnb = uhi - ulo, ntile = nnb + 4;
        bf16x8 qf[2][2]; size_t qrow[2];
#pragma unroll
        for (int qt = 0; qt < 2; ++qt) { qrow[qt] = (size_t)b * SEQ + (size_t)r * 64 + 32 * chh + 16 * qt + fr;
            u32x4 raw[2]; float xv[2][8]; float ss = 0.f;
#pragma unroll
            for (int ks = 0; ks < 2; ++ks) { raw[ks] = *(const u32x4*)(QKV + qrow[qt] * 3072 + h * 64 + 32 * ks + 8 * fq);
                xv[ks][0] = lo_bf(raw[ks].x); xv[ks][1] = hi_bf(raw[ks].x); xv[ks][2] = lo_bf(raw[ks].y); xv[ks][3] = hi_bf(raw[ks].y); xv[ks][4] = lo_bf(raw[ks].z); xv[ks][5] = hi_bf(raw[ks].z); xv[ks][6] = lo_bf(raw[ks].w); xv[ks][7] = hi_bf(raw[ks].w);
#pragma unroll
                for (int j = 0; j < 8; ++j) ss += xv[ks][j] * xv[ks][j]; }
            ss += __shfl_xor(ss, 16); ss += __shfl_xor(ss, 32);
            const float rs = __builtin_amdgcn_rsqf(ss * (1.0f / 64.0f) + NORM_EPS) * (0.125f * 1.4426950408889634f);
#pragma unroll
            for (int ks = 0; ks < 2; ++ks) { const float* gq = INP(F, I_NA_QG) + 32 * ks + 8 * fq; u32x4 pw;
                pw.x = pk2(xv[ks][0] * rs * gq[0], xv[ks][1] * rs * gq[1]); pw.y = pk2(xv[ks][2] * rs * gq[2], xv[ks][3] * rs * gq[3]); pw.z = pk2(xv[ks][4] * rs * gq[4], xv[ks][5] * rs * gq[5]); pw.w = pk2(xv[ks][6] * rs * gq[6], xv[ks][7] * rs * gq[7]);
                qf[qt][ks] = __builtin_bit_cast(bf16x8, pw); } }
        f32x4 o[2][4]; float lrun[2] = {0.f, 0.f};
#pragma unroll
        for (int qt = 0; qt < 2; ++qt)
#pragma unroll
            for (int dt = 0; dt < 4; ++dt) o[qt][dt] = (f32x4){0.f, 0.f, 0.f, 0.f};
        for (int i = F.tid; i < 15 * 31; i += NTHR) bt[i] = rpb[(size_t)h * 465 + i] * 1.4426950408889634f - M0;
        u32x4 kreg, vreg;
        { const size_t krow = (size_t)b * SEQ + (size_t)ulo * 64 + skey; const bf16_t* kp = QKV + krow * 3072 + D + h * 64 + 8 * sd8; kreg = *(const u32x4*)kp; vreg = *(const u32x4*)(kp + D); }
        NA_KNORM(kreg);
        *(LAS u32x4*)(F.lds + skey * 144 + sd8 * 16) = kreg; *(LAS u32x4*)(F.lds + 9216 + skey * 144 + sd8 * 16) = vreg;
        __syncthreads();
        for (int i = 0; i < ntile; ++i) {
            if (i + 1 < ntile) { const size_t krow = (i + 1 < nnb ? (size_t)b * SEQ + (size_t)(ulo + i + 1) * 64 : (size_t)RL + (size_t)b * CTXL + (size_t)(i + 1 - nnb) * 64) + skey;
                const bf16_t* kp = QKV + krow * 3072 + D + h * 64 + 8 * sd8; kreg = *(const u32x4*)kp; vreg = *(const u32x4*)(kp + D); }
            LAS unsigned char* Kb = F.lds + (i & 1) * 18432; LAS unsigned char* Vb = Kb + 9216;
            const bool isnb = i < nnb; const int ra = ulo + i;
            if (!isnb || (ra >= r0 && ra < r0 + 8)) {
                bf16x8 kf[4][2];
#pragma unroll
                for (int kt = 0; kt < 4; ++kt)
#pragma unroll
                    for (int ks = 0; ks < 2; ++ks) kf[kt][ks] = *(const LAS bf16x8*)(Kb + (16 * kt + fr) * 144 + (32 * ks + 8 * fq) * 2);
                s16x4 vA[2][4][2];
#pragma unroll
                for (int s2 = 0; s2 < 2; ++s2)
#pragma unroll
                    for (int dt = 0; dt < 4; ++dt)
#pragma unroll
                        for (int hh = 0; hh < 2; ++hh) vA[s2][dt][hh] = __builtin_amdgcn_ds_read_tr16_b64_v4i16((LAS s16x4*)(Vb + (32 * s2 + 16 * hh + 4 * fq) * 144 + 32 * dt + trl));
                const LAS float* bp = bt + (ra - r + 7) * 31;
#pragma unroll
                for (int qt = 0; qt < 2; ++qt) {
                    const int g4 = 2 * chh + qt; const int klo = isnb ? (g4 <= 1 ? 0 : g4 - 1) : 0, khi = isnb ? (g4 >= 2 ? 3 : g4 + 1) : 3;
                    const int cq = 16 * g4 + fr, cstart = min(max(cq - 8, 0), 48);
                    f32x4 st[4]; float psum = 0.f;
#pragma unroll
                    for (int kt = 0; kt < 4; ++kt) {
                        f32x4 a = {0.f, 0.f, 0.f, 0.f};
                        if (kt >= klo && kt <= khi) {
                            a = __builtin_amdgcn_mfma_f32_16x16x32_bf16(kf[kt][0], qf[qt][0], a, 0, 0, 0); a = __builtin_amdgcn_mfma_f32_16x16x32_bf16(kf[kt][1], qf[qt][1], a, 0, 0, 0);
                            if (isnb) {
#pragma unroll
                                for (int j = 0; j < 4; ++j) { const int ck = 16 * kt + 4 * fq + j; const bool valid = (unsigned)(ck - cstart) < 16u; const int dc = min(max(ck - cq, -15), 15) + 15;
                                    const float pv = __builtin_amdgcn_exp2f(a[j] + bp[dc]); a[j] = valid ? pv : 0.f; } }
                            else {
#pragma unroll
                                for (int j = 0; j < 4; ++j) a[j] = __builtin_amdgcn_exp2f(a[j] - M0); }
                            psum += (a[0] + a[1]) + (a[2] + a[3]);
                        }
                        st[kt] = a;
                    }
                    lrun[qt] += psum;
#pragma unroll
                    for (int s2 = 0; s2 < 2; ++s2) {
                        if (2 * s2 + 1 >= klo && 2 * s2 <= khi) {
                            u32x4 pw; pw.x = pk2(st[2 * s2][0], st[2 * s2][1]); pw.y = pk2(st[2 * s2][2], st[2 * s2][3]); pw.z = pk2(st[2 * s2 + 1][0], st[2 * s2 + 1][1]); pw.w = pk2(st[2 * s2 + 1][2], st[2 * s2 + 1][3]);
                            const bf16x8 pb = __builtin_bit_cast(bf16x8, pw);
#pragma unroll
                            for (int dt = 0; dt < 4; ++dt) { const s16x4 v0 = vA[s2][dt][0], v1 = vA[s2][dt][1]; const bf16x8 va = {v0[0], v0[1], v0[2], v0[3], v1[0], v1[1], v1[2], v1[3]};
                                o[qt][dt] = __builtin_amdgcn_mfma_f32_16x16x32_bf16(va, pb, o[qt][dt], 0, 0, 0); }
                        }
                    }
                }
            }
            if (i + 1 < ntile) { NA_KNORM(kreg); LAS unsigned char* Kn = F.lds + ((i + 1) & 1) * 18432; *(LAS u32x4*)(Kn + skey * 144 + sd8 * 16) = kreg; *(LAS u32x4*)(Kn + 9216 + skey * 144 + sd8 * 16) = vreg; }
            __syncthreads();
        }
#pragma unroll
        for (int qt = 0; qt < 2; ++qt) { float lt = lrun[qt]; lt += __shfl_xor(lt, 16); lt += __shfl_xor(lt, 32); const float inv = 1.0f / lt;
#pragma unroll
            for (int dt = 0; dt < 4; ++dt) { u32x2 w2; w2.x = pk2(o[qt][dt][0] * inv, o[qt][dt][1] * inv); w2.y = pk2(o[qt][dt][2] * inv, o[qt][dt][3] * inv); *(u32x2*)(O + qrow[qt] * D + h * 64 + 16 * dt + 4 * fq) = w2; } }
    }
    __syncthreads();
}

#undef NA_KNORM
constexpr int NPH = 36;
__device__ __forceinline__ pg8::Sched mk_sched(const Frame& F, int nM, int nN, const bf16_t* A, int lda, const bf16_t* B, int K) {
    pg8::Sched S; S.nM = nM; S.nN = nN; S.G = F.G; S.c = F.bid; S.A = (const char*)A; S.a_tile = (size_t)256 * lda * 2; S.a_pn = 0;
    S.B = (const char*)B; S.b_tile = (size_t)256 * K * 2; S.b_e = 0; S.tstart = nullptr; S.rev = false; S.wgm = nN >= 8 ? WGM_WIDE : WGM_NARROW; return S;
}
__global__ void __launch_bounds__(NTHR, 2) fwd(Params P) {
    extern __shared__ __attribute__((aligned(16))) unsigned char lds_raw[];
    Frame F; F.lds = (LAS unsigned char*)lds_raw; F.tid = threadIdx.x; F.lane = F.tid & 63; F.wave = __builtin_amdgcn_readfirstlane(F.tid >> 6); F.bid = blockIdx.x; F.G = gridDim.x;
    F.p = &P; F.ws = P.ws; F.ctl = (unsigned*)(P.ws + WS_CTL); F.modv = (float*)(P.ws + WS_MODV); F.hlat = (bf16_t*)(P.ws + WS_H); F.hctx = F.hlat + (size_t)RL * D; F.U = (bf16_t*)P.out;
    if (F.tid < 64) ((LAS unsigned*)(F.lds + LDS_CTL))[F.tid] = 0u;
    __syncthreads();
    const int lo = P.ph_lo, hi = P.ph_hi;
    XcdBarrier bar; bar.bar = F.ctl + CW_BAR; bar.x = 0; bar.st = (volatile LAS unsigned*)(F.lds + LDS_CTL);
    if (hi - lo > 1) bar = xcd_barrier_post(F.ctl + CW_BAR, (volatile LAS unsigned*)(F.lds + LDS_CTL));
#define IN(k) (lo <= (k) && (k) < hi)
#define SEAM(k) do { if (IN(k) && IN((k) + 1)) xcd_barrier(bar); \
        if (PROBE_LO >= 0 && F.bid == 0 && F.tid == 0) { if ((k) + 1 == PROBE_LO) pr_t[0] = __builtin_amdgcn_s_memrealtime(); if ((k) + 1 == PROBE_HI) pr_t[1] = __builtin_amdgcn_s_memrealtime(); } } while (0)
    volatile LAS unsigned long long* const pr_t = (volatile LAS unsigned long long*)(F.lds + LDS_CTL + 16);
    if (PROBE_LO == 0 && F.bid == 0 && F.tid == 0) pr_t[0] = __builtin_amdgcn_s_memrealtime();
    bf16_t* const out = F.hlat; bf16_t* const hctx = F.hctx;
    const float* const x = INP(F, I_X); const float* const ctx = INP(F, I_CTX);
    LAS unsigned char* const gl = F.lds;
    LAS int* const tstart = (LAS int*)(F.lds + LDS_AUX);
    bf16_t* const BIG = (bf16_t*)(P.ws + WS_BIG);
#define MODL(l) (F.modv + (size_t)(l) * 33 * MODW)
#define LAUNDER do { asm volatile("" : "+v"(F.tid)); F.lane = F.tid & 63; } while (0)

    if (IN(0)) { LAUNDER; phase_mod(F); phase_cvt_small(F); } SEAM(0);
    if (IN(1)) { LAUNDER; NormCtx N{x, ctx, INP(F, I_N1G), MODL(0), 0, true}; phase_norm(F, N, RA); } SEAM(1);
    if (IN(2)) { LAUNDER; pg8::Sched S = mk_sched(F, RA / 256, 10, F.U, D, WSP(bf16_t, WS_LRU_WIN), D); pg8::EpiBf16<0> E{(bf16_t*)(P.ws + WS_BIG + BG_XG), 2560, nullptr}; pg8::gemm_phase(gl, D, D, S, E); } SEAM(2);
    if (IN(3)) { LAUNDER; phase_scan(F, true); } SEAM(3);
    if (IN(4)) { LAUNDER; pg8::Sched S = mk_sched(F, RA / 256, 4, (bf16_t*)(P.ws + WS_BIG + BG_Y), DRNN, WSP(bf16_t, WS_LRU_WOUT), DRNN);
                 pg8::EpiResidX E{x, ctx, out, hctx, MODL(0) + 2 * D, nullptr, nullptr}; pg8::gemm_phase(gl, DRNN, DRNN, S, E); cvt_moe_queue(F, 0, 0, 8192, 0); } SEAM(4);
    if (IN(5)) { LAUNDER; NormCtx N{out, hctx, INP(F, I_N2G), MODL(0), 1, false}; phase_norm(F, N, RA); } SEAM(5);
    if (IN(6)) { LAUNDER; pg8::Sched S = mk_sched(F, RA / 256, 28, F.U, D, WSP(bf16_t, WS_FFN_W13), D); pg8::EpiSwiGLU E{(bf16_t*)(P.ws + WS_BIG + BG_HID), DFF}; pg8::gemm_phase(gl, D, D, S, E); } SEAM(6);
    if (IN(7)) { LAUNDER; pg8::Sched S = mk_sched(F, RA / 256, 4, (bf16_t*)(P.ws + WS_BIG + BG_HID), DFF, WSP(bf16_t, WS_FFN_W2), DFF);
                 S.rev = true; pg8::EpiResid E{out, hctx, out, hctx, MODL(0) + 5 * D, nullptr, nullptr}; pg8::gemm_phase(gl, DFF, DFF, S, E); cvt_moe_queue(F, 0, 8192, 30720, 1); } SEAM(7);
    if (IN(8)) { LAUNDER; NormCtx N{out, hctx, INP(F, I_N1G) + D, MODL(1), 0, false}; phase_norm(F, N, RA); } SEAM(8);
    if (IN(9)) { LAUNDER; pg8::Sched S = mk_sched(F, RA / 256, 16, F.U, D, WSP(bf16_t, WS_SGU_WIN), D); pg8::EpiBf16<1> E{(bf16_t*)(P.ws + WS_BIG + BG_Z), 4096, INP(F, I_SGU_BIN)}; pg8::gemm_phase(gl, D, D, S, E); } SEAM(9);
    if (IN(10)) { LAUNDER; phase_sgu_stats(F); } SEAM(10);
    if (IN(11)) { LAUNDER; phase_sgu_spatial(F); } SEAM(11);
    if (IN(12)) { LAUNDER; pg8::Sched S = mk_sched(F, RA / 256, 4, (bf16_t*)(P.ws + WS_BIG + BG_Z), 4096, WSP(bf16_t, WS_SGU_WOUT), DSGU);
                  pg8::EpiResid E{out, hctx, out, hctx, MODL(1) + 2 * D, nullptr, nullptr}; pg8::gemm_phase(gl, 4096, DSGU, S, E); cvt_moe_queue(F, 0, 30720, CVT_MOE_ITEMS, 2); } SEAM(12);
    if (IN(13)) { LAUNDER; NormCtx N{out, hctx, INP(F, I_N2G) + D, MODL(1), 1, false}; phase_route(F, N, RA, 0); } SEAM(13);
    if (IN(14)) { LAUNDER; phase_assign_scatter0(F, RA, 0); } SEAM(14);
#define MOE_UP(ph, l2, s) if (IN(ph)) { LAUNDER; const int nt_ = moe_tile_table(F, l2, s, tstart); \
        pg8::Sched S = mk_sched(F, nt_, 28, F.U, D, moe_w13(F, l2), D); S.a_tile = 0; S.b_e = (size_t)2 * DFF * D * 2; S.tstart = tstart; \
        pg8::EpiSwiGLU E{(bf16_t*)(P.ws + WS_BIG + BG_MHID), DFF}; pg8::gemm_phase<pg8::EpiSwiGLU, true>(gl, D, D, S, E, WSP(const int, WS_ROUTE + RT_TOK) + (s) * MPAD, (LAS int*)(F.lds + LDS_AUX + 1024)); } SEAM(ph)
#define MOE_DOWN(ph, l2, s, layer, EPI) if (IN(ph)) { LAUNDER; const int nt_ = moe_tile_table(F, l2, s, tstart); \
        pg8::Sched S = mk_sched(F, nt_, 4, (bf16_t*)(P.ws + WS_BIG + BG_MHID), DFF, moe_w2(F, l2), DFF); S.b_e = (size_t)D * DFF * 2; S.tstart = tstart; S.rev = true; \
        EPI E{out, hctx, P.out, MODL(layer) + 5 * D, WSP(const int, WS_ROUTE + RT_TOK) + (s) * MPAD, WSP(const float, WS_ROUTE + RT_GW) + (s) * MPAD}; pg8::gemm_phase(gl, DFF, DFF, S, E); \
        if ((l2) == 0) cvt_moe_queue(F, 1, (s) ? 10752 : 0, (s) ? 21504 : 10752, 3 + (s)); } SEAM(ph)
    MOE_UP(15, 0, 0); MOE_DOWN(16, 0, 0, 1, pg8::EpiMoeDown); MOE_UP(17, 0, 1); MOE_DOWN(18, 0, 1, 1, pg8::EpiMoeDown);
    if (IN(19)) { LAUNDER; NormCtx N{out, hctx, INP(F, I_N1G) + 2 * D, MODL(2), 0, false}; phase_norm(F, N, RA); } SEAM(19);
    if (IN(20)) { LAUNDER; phase_pool_diff(F); } SEAM(20);
    if (IN(21)) { LAUNDER; pg8::Sched S = mk_sched(F, RA / 256, 4, (bf16_t*)(P.ws + WS_BIG + BG_PD), D, WSP(bf16_t, WS_POOL_W), 256); S.a_pn = 512; S.b_tile = (size_t)256 * 256 * 2;
                  pg8::EpiResidBS E{out, hctx, out, hctx, MODL(2) + 2 * D, INP(F, I_POOL_B), INP(F, I_POOL_S)}; pg8::gemm_phase(gl, D, 256, S, E); } SEAM(21);
    if (IN(22)) { LAUNDER; NormCtx N{out, hctx, INP(F, I_N2G) + 2 * D, MODL(2), 1, false}; phase_norm(F, N, RA); } SEAM(22);
    if (IN(23)) { LAUNDER; pg8::Sched S = mk_sched(F, RA / 256, 28, F.U, D, WSP(bf16_t, WS_FFN_W13) + (size_t)2 * DFF * D, D); pg8::EpiSwiGLU E{(bf16_t*)(P.ws + WS_BIG + BG_HID), DFF}; pg8::gemm_phase(gl, D, D, S, E); } SEAM(23);
    if (IN(24)) { LAUNDER; pg8::Sched S = mk_sched(F, RA / 256, 4, (bf16_t*)(P.ws + WS_BIG + BG_HID), DFF, WSP(bf16_t, WS_FFN_W2) + (size_t)D * DFF, DFF);
                  S.rev = true; pg8::EpiResid E{out, hctx, out, hctx, MODL(2) + 5 * D, nullptr, nullptr}; pg8::gemm_phase(gl, DFF, DFF, S, E); cvt_moe_queue(F, 1, 21504, CVT_MOE_ITEMS, 5); } SEAM(24);
    if (IN(25)) { LAUNDER; NormCtx N{out, hctx, INP(F, I_N1G) + 3 * D, MODL(3), 0, false}; phase_norm(F, N, RA); } SEAM(25);
    if (IN(26)) { LAUNDER; pg8::Sched S = mk_sched(F, RA / 256, 12, F.U, D, WSP(bf16_t, WS_NA_WQKV), D); pg8::EpiBf16<0> E{(bf16_t*)(P.ws + WS_BIG + BG_QKV), 3072, nullptr}; pg8::gemm_phase(gl, D, D, S, E); } SEAM(26);
    SEAM(27);
    if (IN(28)) { LAUNDER; phase_na(F); } SEAM(28);
    if (IN(29)) { LAUNDER; pg8::Sched S = mk_sched(F, RL / 256, 4, (bf16_t*)(P.ws + WS_BIG + BG_O), D, WSP(bf16_t, WS_NA_WO), D);
                  pg8::EpiResid E{out, hctx, out, hctx, MODL(3) + 2 * D, nullptr, nullptr}; pg8::gemm_phase(gl, D, D, S, E); } SEAM(29);
    if (IN(30)) { LAUNDER; NormCtx N{out, hctx, INP(F, I_N2G) + 3 * D, MODL(3), 1, false}; phase_route(F, N, RL, 1); } SEAM(30);
    if (IN(31)) { LAUNDER; phase_assign_scatter0(F, RL, 1); } SEAM(31);
    MOE_UP(32, 1, 0); MOE_DOWN(33, 1, 0, 3, pg8::EpiMoeDown); MOE_UP(34, 1, 1); MOE_DOWN(35, 1, 1, 3, pg8::EpiMoeDownOut);
#undef IN
#undef SEAM
    (void)BIG;
    if (PROBE_LO >= 0 && F.bid == 0 && F.tid == 0) { if (PROBE_HI >= NPH) pr_t[1] = __builtin_amdgcn_s_memrealtime();
        const unsigned long long t_end = __builtin_amdgcn_s_memrealtime(), wait = 8ull * (pr_t[1] - pr_t[0]);
        while (__builtin_amdgcn_s_memrealtime() - t_end < wait) __builtin_amdgcn_s_sleep(32); }
}

extern "C" void kernel_launch(void* const* d_in, const int* in_sizes, int n_in, void* d_out, int out_size, void* d_ws, size_t ws_size, hipStream_t stream) {
    static int grid = 0;
    if (grid == 0) {
        if (n_in != 40 || out_size != RL * D || ws_size < WS_END) { fprintf(stderr, "kernel_launch: unexpected problem (n_in %d out %d ws %zu)\n", n_in, out_size, ws_size); grid = -1; return; }
        int dev = 0, cus = 0;
        if (hipGetDevice(&dev) != hipSuccess || hipDeviceGetAttribute(&cus, hipDeviceAttributeMultiprocessorCount, dev) != hipSuccess) { grid = -1; return; }
        if (hipFuncSetAttribute((const void*)fwd, hipFuncAttributeMaxDynamicSharedMemorySize, LDS_BYTES) != hipSuccess) { fprintf(stderr, "kernel_launch: hipFuncSetAttribute failed\n"); grid = -1; return; }
        int per_cu = 0; (void)hipOccupancyMaxActiveBlocksPerMultiprocessor(&per_cu, (const void*)fwd, NTHR, LDS_BYTES); (void)hipGetLastError();
        if (per_cu < 1) fprintf(stderr, "kernel_launch: occupancy query says %d\n", per_cu);
        grid = cus;
    }
    if (grid < 0) return;
    (void)hipMemsetAsync((char*)d_ws + WS_CTL, 0, CTL_BYTES, stream);
    Params p{};
    for (int i = 0; i < 40; ++i) p.in[i] = (const float*)d_in[i];
    p.out = (float*)d_out; p.ws = (unsigned char*)d_ws;
#if MK_MULTI
    for (int ph = 0; ph < NPH; ++ph) { p.ph_lo = ph; p.ph_hi = ph + 1; hipLaunchKernelGGL(fwd, dim3(grid), dim3(NTHR), LDS_BYTES, stream, p); }
#else
    p.ph_lo = 0; p.ph_hi = NPH;
    hipLaunchKernelGGL(fwd, dim3(grid), dim3(NTHR), LDS_BYTES, stream, p);
#endif
}
```

```cpp
#include <hip/hip_runtime.h>
#include <cstdio>
#include <cstdint>

#ifndef PROBE_CLK
#define PROBE_CLK 0
#endif
#ifndef PROBE_LO
#define PROBE_LO -1
#define PROBE_HI -1
#endif
#ifndef WGM_WIDE
#define WGM_WIDE 4
#define WGM_NARROW 4
#endif
#ifndef MK_MULTI
#define MK_MULTI 0
#endif

#define LAS __attribute__((address_space(3)))
typedef unsigned short bf16_t;
typedef short bf16x8 __attribute__((ext_vector_type(8)));
typedef short s16x4 __attribute__((ext_vector_type(4)));
typedef float f32x4 __attribute__((ext_vector_type(4)));
typedef float f32x2 __attribute__((ext_vector_type(2)));
typedef unsigned u32x4 __attribute__((ext_vector_type(4)));
typedef unsigned u32x2 __attribute__((ext_vector_type(2)));

constexpr int D = 1024, NB = 32, SEQ = 2048, CTXL = 256;
constexpr int RL = NB * SEQ, RC = NB * CTXL, RA = RL + RC;
constexpr int DRNN = 1280, LBW = 160, DSGU = 2048, DFF = 3584, NE = 8;
constexpr int MODW = 6 * D;
constexpr int MPAD = 75776;
constexpr float NORM_EPS = 1e-6f;
constexpr int NWAVES = 8, NTHR = 512;

constexpr size_t MiB = 1u << 20;
constexpr size_t WS_CTL = 0, CTL_BYTES = 1 * MiB;
constexpr size_t WS_MODV = 1 * MiB;
constexpr size_t WS_HCTX = 5 * MiB;
constexpr size_t WS_LRU_WIN = 37 * MiB;
constexpr size_t WS_LRU_WA = WS_LRU_WIN + 5 * MiB;
constexpr size_t WS_LRU_WI = WS_LRU_WA + 1 * MiB;
constexpr size_t WS_LRU_WOUT = WS_LRU_WI + 1 * MiB;
constexpr size_t WS_SGU_WIN = WS_LRU_WOUT + 3 * MiB;
constexpr size_t WS_SGU_WS = WS_SGU_WIN + 8 * MiB;
constexpr size_t WS_SGU_WOUT = WS_SGU_WS + 1 * MiB;
constexpr size_t WS_POOL_W = WS_SGU_WOUT + 4 * MiB;
constexpr size_t WS_NA_WQKV = WS_POOL_W + 1 * MiB;
constexpr size_t WS_NA_WO = WS_NA_WQKV + 6 * MiB;
constexpr size_t WS_FFN_W13 = WS_NA_WO + 2 * MiB;
constexpr size_t WS_FFN_W2 = WS_FFN_W13 + 28 * MiB;
constexpr size_t WS_MOE_W13 = WS_FFN_W2 + 14 * MiB;
constexpr size_t WS_MOE_W2 = WS_MOE_W13 + 112 * MiB;
constexpr size_t WS_ROUTE = WS_MOE_W2 + 56 * MiB;
constexpr size_t WS_H = WS_ROUTE + 4 * MiB;
constexpr size_t WS_BIG = WS_H + 148 * MiB;
constexpr size_t WS_END = WS_BIG + 744 * MiB;
constexpr size_t WS_DBG = WS_END;
static_assert(WS_MOE_W13 == 111 * MiB && WS_BIG == 431 * MiB && WS_END == 1175 * MiB, "ws map");
constexpr size_t RT_E = 0;
constexpr size_t RT_W = 512 * 1024;
constexpr size_t RT_TOK = 1280 * 1024;
constexpr size_t RT_GW = 2048 * 1024;
constexpr size_t RT_ST = 2816 * 1024;
constexpr size_t RT_P1 = 3456 * 1024;
static_assert(RT_W >= (size_t)RA * 4 && RT_TOK - RT_W >= (size_t)RA * 8 && RT_GW - RT_TOK >= (size_t)2 * MPAD * 4 && RT_ST - RT_GW >= (size_t)2 * MPAD * 4 && RT_P1 - RT_ST >= (size_t)RA * 8 && 4 * MiB - RT_P1 >= (size_t)RA * 4, "route map");
constexpr size_t BG_XG = 0, BG_Y = 360 * MiB;
constexpr size_t BG_HID = 0;
constexpr size_t BG_Z = 0;
constexpr size_t BG_FS1 = 0, BG_MHID = 0;
constexpr size_t BG_MW2 = 576 * MiB;
constexpr size_t BG_PD = 0;
constexpr size_t BG_QKV = 0, BG_O = 432 * MiB;
static_assert(BG_MHID + (size_t)MPAD * DFF * 2 <= BG_MW2 && BG_O + (size_t)RL * D * 2 <= BG_MW2 && BG_Y + (size_t)RA * DRNN * 2 <= BG_MW2 && BG_MW2 + 168 * MiB <= 744 * MiB, "big map");
constexpr int CW_BAR = 4096;
constexpr int CW_CNT = 16384;
constexpr int CW_CUR = 16384 + 256;
constexpr int CW_DBG = 32768;
constexpr int CW_CVTQ = 20480;

constexpr int LDS_BYTES = 163840;
constexpr int LDS_AUX = 131072;
constexpr int LDS_CTL = LDS_BYTES - 256;

__device__ __forceinline__ float bf2f(unsigned b) { return __uint_as_float(b << 16); }
__device__ __forceinline__ unsigned pk2(float lo, float hi) { unsigned r; asm volatile("v_cvt_pk_bf16_f32 %0, %1, %2" : "=v"(r) : "v"(lo), "v"(hi)); return r; }
__device__ __forceinline__ float lo_bf(unsigned w) { return __uint_as_float(w << 16); }
__device__ __forceinline__ float hi_bf(unsigned w) { return __uint_as_float(w & 0xffff0000u); }
template <int CTRL> __device__ __forceinline__ float dpp_f(float v) { return __int_as_float(__builtin_amdgcn_update_dpp(0, __float_as_int(v), CTRL, 0xf, 0xf, true)); }
__device__ __forceinline__ float wave_sum(float v) {
    v += dpp_f<0xB1>(v);
    v += dpp_f<0x4E>(v);
    v += dpp_f<0x141>(v);
    v += dpp_f<0x140>(v);
    const int iv = __float_as_int(v);
    return (__int_as_float(__builtin_amdgcn_readlane(iv, 0)) + __int_as_float(__builtin_amdgcn_readlane(iv, 16))) + (__int_as_float(__builtin_amdgcn_readlane(iv, 32)) + __int_as_float(__builtin_amdgcn_readlane(iv, 48)));
}
__device__ __forceinline__ float sigmoid_f(float x) { return __builtin_amdgcn_rcpf(1.0f + __builtin_amdgcn_exp2f(-1.4426950408889634f * x)); }
__device__ __forceinline__ float silu_f(float x) { return x * __builtin_amdgcn_rcpf(1.0f + __builtin_amdgcn_exp2f(-1.4426950408889634f * x)); }
__device__ __forceinline__ float gelu_tanh_f(float x) { const float z2 = -2.0f * 1.4426950408889634f * 0.7978845608028654f * (x + 0.044715f * x * x * x); return x * __builtin_amdgcn_rcpf(1.0f + __builtin_amdgcn_exp2f(z2)); }
__device__ __forceinline__ unsigned lds_add(LAS unsigned* p, unsigned v) { return __hip_atomic_fetch_add(p, v, __ATOMIC_RELAXED, __HIP_MEMORY_SCOPE_WORKGROUP); }
#define LDS_WAIT() asm volatile("s_waitcnt lgkmcnt(0)" ::: "memory")
#define VM_WAIT() asm volatile("s_waitcnt vmcnt(0)" ::: "memory")

#define XB_TMO      128
#define XB_XCNT(j)  (256  + 64 * (j))
#define XB_XSUB(j)  (1280 + 64 * (j))
#define XB_XGEN(j)  (2304 + 64 * (j))
#define XB_TOP      3328
#define XB_TOPGEN   3392
#define XCD_BAR_WORDS 3456
#define XB_SPIN_CAP (1u << 18)
__device__ __forceinline__ unsigned xb_ld(unsigned* p)              { return __hip_atomic_load(p, __ATOMIC_RELAXED, __HIP_MEMORY_SCOPE_AGENT); }
__device__ __forceinline__ unsigned xb_add(unsigned* p, unsigned v) { return __hip_atomic_fetch_add(p, v, __ATOMIC_RELAXED, __HIP_MEMORY_SCOPE_AGENT); }
__device__ __forceinline__ unsigned xb_xcc_id() { return (unsigned)__builtin_amdgcn_s_getreg((3 << 11) | 20) & 0xFu; }
#define XB_SPIN(cond, bar) do { unsigned _sp = 0; while (cond) { __builtin_amdgcn_s_sleep(1); \
    if ((++_sp & 255u) == 0u) { if (xb_ld(&(bar)[XB_TMO])) break; if (_sp > XB_SPIN_CAP) { atomicAdd(&(bar)[XB_TMO], 1u); break; } } } } while (0)
struct XcdBarrier { unsigned* bar; unsigned x; volatile LAS unsigned* st; };
__device__ __forceinline__ XcdBarrier xcd_barrier_post(unsigned* bar, volatile LAS unsigned* st) {
    XcdBarrier b; b.bar = bar; b.x = xb_xcc_id(); b.st = st;
    if (threadIdx.x == 0) (void)xb_add(&bar[XB_XCNT(b.x)], 1u);
    return b;
}
__device__ __forceinline__ void xcd_barrier_complete(unsigned* bar, unsigned x, unsigned& nloc, unsigned& nx) {
    const unsigned G = gridDim.x * gridDim.y * gridDim.z;
    unsigned sum, cnt, mine, sp = 0u;
    for (;;) {
        sum = 0u; cnt = 0u; mine = 0u;
#pragma unroll
        for (unsigned j = 0; j < 16; ++j) { const unsigned c = xb_ld(&bar[XB_XCNT(j)]); sum += c; cnt += (c > 0u) ? 1u : 0u; mine = (j == x) ? c : mine; }
        if (sum == G) break;
        __builtin_amdgcn_s_sleep(1);
        if ((++sp & 255u) == 0u) { if (xb_ld(&bar[XB_TMO])) break; if (sp > XB_SPIN_CAP) { atomicAdd(&bar[XB_TMO], 1u); break; } }
    }
    nloc = mine > 0u ? mine : 1u; nx = cnt > 0u ? cnt : 1u;
}
__device__ __forceinline__ void xcd_barrier(const XcdBarrier& b) {
    asm volatile("s_waitcnt vmcnt(0)" ::: "memory");
    __syncthreads();
    if (threadIdx.x == 0) {
        unsigned* bar = b.bar;
        __builtin_amdgcn_s_waitcnt(0);
        unsigned nloc = b.st[0], nx = b.st[1];
        if (nloc == 0u) { xcd_barrier_complete(bar, b.x, nloc, nx); b.st[0] = nloc; b.st[1] = nx; }
        const unsigned old = xb_add(&bar[XB_XSUB(b.x)], 1u);
        const unsigned gen = old / nloc;
        if (old + 1u == (gen + 1u) * nloc) {
            __builtin_amdgcn_fence(__ATOMIC_RELEASE, "agent");
            asm volatile("s_waitcnt vmcnt(0)" ::: "memory");
            const unsigned og = xb_add(&bar[XB_TOP], 1u);
            const unsigned tg = og / nx;
            if (og + 1u == (tg + 1u) * nx) xb_add(&bar[XB_TOPGEN], 1u);
            else XB_SPIN(xb_ld(&bar[XB_TOPGEN]) == tg, bar);
            __builtin_amdgcn_fence(__ATOMIC_ACQUIRE, "agent");
            xb_add(&bar[XB_XGEN(b.x)], 1u);
            asm volatile("s_waitcnt vmcnt(0)" ::: "memory");
        } else {
            XB_SPIN(xb_ld(&bar[XB_XGEN(b.x)]) == gen, bar);
            __builtin_amdgcn_fence(__ATOMIC_ACQUIRE, "agent");
            asm volatile("s_waitcnt vmcnt(0)" ::: "memory");
        }
    }
    __syncthreads();
}

struct Params {
    const float* in[40];
    float* out; unsigned char* ws;
    int ph_lo, ph_hi;
};
enum In { I_X = 0, I_C, I_CTX, I_CCTX, I_MODW, I_MODB, I_N1G, I_N2G, I_LRU_WIN, I_LRU_CW, I_LRU_CB, I_LRU_WA, I_LRU_BA, I_LRU_WI, I_LRU_BI, I_LRU_LAM, I_LRU_WOUT,
          I_SGU_WIN, I_SGU_BIN, I_SGU_LNG, I_SGU_LNB, I_SGU_WS, I_SGU_BS, I_SGU_WOUT, I_POOL_W, I_POOL_B, I_POOL_S, I_NA_WQKV, I_NA_QG, I_NA_KG, I_NA_RPB, I_NA_WO,
          I_FFN_W1, I_FFN_W3, I_FFN_W2, I_MOE_WR, I_MOE_BR, I_MOE_W1, I_MOE_W3, I_MOE_W2 };

namespace pg8 {
constexpr int BM = 256, BK = 64, HALF = 128, HTB = HALF * BK * 2, STAGE_BYTES = 8 * HTB, NXCD = 8, WGM = 4;
__device__ __forceinline__ int lds_byte(int r, int c) { const int st = (r >> 4) * 2 + (c >> 5), rr = r & 15, cc = c & 31, ob = rr * 64 + cc * 2; return st * 1024 + (ob ^ (((ob >> 9) & 1) << 5)); }
__device__ __forceinline__ void stage_rc(int b, int& R, int& C) { const int st = b / 1024, sb = b % 1024, swz = sb ^ (((sb >> 9) & 1) << 5); R = (st >> 1) * 16 + swz / 64; C = (st & 1) * 32 + (swz % 64) / 2; }
__device__ __forceinline__ int perm32(int rho) { const int n = rho >> 4, i = rho & 15; return 8 * (i >> 2) + 4 * n + (i & 3); }

struct Unit { int pm, pn, e; const char* a; const char* b; };
struct Sched {
    int nM, nN, G, c;
    const char* A; size_t a_tile, a_pn;
    const char* B; size_t b_tile, b_e;
    const LAS int* tstart;
    int wgm = WGM;
    bool rev = false;
    __device__ __forceinline__ bool next(int i, Unit& u) const {
        long L = (long)i * G + c; if (L >= (long)nM * nN) return false;
        if (rev) L = (long)nM * nN - 1 - L;
        int e = 0, t0 = 0, nMe = nM, wgid = (int)L;
        if (tstart) {
#pragma unroll
            for (int k = 1; k < 8; ++k) e += (wgid >= tstart[k] * nN) ? 1 : 0;
            t0 = tstart[e]; nMe = tstart[e + 1] - t0; wgid -= t0 * nN;
        }
        const int nwg = nMe * nN;
        { const int q = nwg / NXCD, r = nwg % NXCD, xcd = wgid % NXCD, off = wgid / NXCD; wgid = (xcd < r ? xcd * (q + 1) : r * (q + 1) + (xcd - r) * q) + off; }
        const int nig = wgm * nN, gid = wgid / nig, fm = gid * wgm, gsz = (nMe - fm) < wgm ? (nMe - fm) : wgm;
        u.pm = t0 + fm + ((wgid % nig) % gsz); u.pn = (wgid % nig) / gsz;
        u.e = e; u.a = A + (size_t)u.pm * a_tile + (size_t)u.pn * a_pn; u.b = B + (size_t)e * b_e + (size_t)u.pn * b_tile;
        return true;
    }
};

template <class Epi, bool GATHER = false>
__device__ __forceinline__ void gemm_phase(LAS unsigned char* lds, const int lda, const int K, const Sched& S, const Epi& E, const int* gidx = nullptr, LAS int* ixt = nullptr) {
    const int tid = threadIdx.x, wid = __builtin_amdgcn_readfirstlane(tid >> 6), lane = tid & 63, wr = wid >> 2, wc = wid & 3, fr = lane & 15, fq = lane >> 4;
    const int nt = K / BK;
    unsigned voffA[2], voffB[2]; int Rl[2]; unsigned cb2[2];
#pragma unroll
    for (int i = 0; i < 2; ++i) { int R, C; stage_rc(tid * 16 + i * 8192, R, C); const int Rb = Epi::PERM ? ((R & ~31) + perm32(R & 31)) : R;
        voffA[i] = (unsigned)(R * lda + C) * 2u; voffB[i] = (unsigned)(Rb * K + C) * 2u; Rl[i] = R; cb2[i] = (unsigned)C * 2u; }
    unsigned cOff[2][2] = {{0u, 0u}, {0u, 0u}}, nOff[2][2] = {{0u, 0u}, {0u, 0u}};
    const size_t kstep = (size_t)(BK * 2);
    const size_t hstepA = (size_t)HALF * lda * 2, hstepB = (size_t)HALF * K * 2;
    const unsigned ldsw = (unsigned)wid * 1024u;
    const int aoff = lds_byte(wr * 64 + fr, fq * 8), boff = lds_byte(wc * 32 + fr, fq * 8);
#define PG8_SA(b, h) (((b) * 2 + (h)) * HTB)
#define PG8_SB(b, h) ((4 + (b) * 2 + (h)) * HTB)
#define PG8_STAGE(bufoff, gbase, voff) do { _Pragma("unroll") for (int _i = 0; _i < 2; ++_i) \
        __builtin_amdgcn_global_load_lds((const unsigned*)((const char*)(gbase) + (voff)[_i]), (LAS unsigned*)(lds + (bufoff) + ldsw + _i * 8192), 16, 0, 0); } while (0)
#define PG8_STAGE_A(bufoff, kptr, h, usenext) do { if constexpr (GATHER) { const unsigned o_[2] = {(usenext) ? nOff[h][0] : cOff[h][0], (usenext) ? nOff[h][1] : cOff[h][1]}; PG8_STAGE(bufoff, kptr, o_); } \
        else PG8_STAGE(bufoff, (kptr) + (h) * hstepA, voffA); } while (0)
#define PG8_LDA(dst, b, h) do { _Pragma("unroll") for (int m = 0; m < 4; ++m) _Pragma("unroll") for (int k = 0; k < 2; ++k) dst[m][k] = *(const LAS bf16x8*)(lds + PG8_SA(b, h) + aoff + m * 2048 + k * 1024); } while (0)
#define PG8_LDB(dst, b, h) do { _Pragma("unroll") for (int n = 0; n < 2; ++n) _Pragma("unroll") for (int k = 0; k < 2; ++k) dst[n][k] = *(const LAS bf16x8*)(lds + PG8_SB(b, h) + boff + n * 2048 + k * 1024); } while (0)
#define PG8_MMA(ai, bj, At, Bt) do { __builtin_amdgcn_s_setprio(1); _Pragma("unroll") for (int m = 0; m < 4; ++m) _Pragma("unroll") for (int n = 0; n < 2; ++n) _Pragma("unroll") for (int k = 0; k < 2; ++k) \
        acc[ai][bj][m][n] = __builtin_amdgcn_mfma_f32_16x16x32_bf16(Bt[n][k], At[m][k], acc[ai][bj][m][n], 0, 0, 0); __builtin_amdgcn_s_setprio(0); } while (0)
#define PG8_WAIT_V(n) asm volatile("s_waitcnt vmcnt(" #n ")" ::: "memory")
#define PG8_WAIT_L(n) asm volatile("s_waitcnt lgkmcnt(" #n ")" ::: "memory")
#define PG8_BAR __builtin_amdgcn_s_barrier()
#define PG8_SCHED __builtin_amdgcn_sched_barrier(0)
    Unit cur, nxt; int ui = 0;
    if (!S.next(0, cur)) return;
    f32x4 acc[2][2][4][2];
#pragma unroll
    for (int a = 0; a < 2; ++a)
#pragma unroll
        for (int b = 0; b < 2; ++b)
#pragma unroll
            for (int m = 0; m < 4; ++m)
#pragma unroll
                for (int n = 0; n < 2; ++n) acc[a][b][m][n] = (f32x4){0.f, 0.f, 0.f, 0.f};
    bf16x8 At[4][2], B0[2][2], B1[2][2];
    const char* cA = cur.a; const char* cB = cur.b;
    if constexpr (GATHER) {
#pragma unroll
        for (int h = 0; h < 2; ++h)
#pragma unroll
            for (int i = 0; i < 2; ++i) { const int ix = gidx[cur.pm * BM + h * HALF + Rl[i]]; cOff[h][i] = (unsigned)(ix < 0 ? 0 : ix) * (unsigned)(lda * 2) + cb2[i]; }
    }
    PG8_STAGE(PG8_SB(0, 0), cB, voffB); PG8_STAGE(PG8_SB(0, 1), cB + hstepB, voffB); PG8_STAGE_A(PG8_SA(0, 0), cA, 0, false); PG8_STAGE_A(PG8_SA(0, 1), cA, 1, false);
    if (wr == 1) PG8_BAR;
    PG8_WAIT_V(2); PG8_BAR;
    PG8_STAGE(PG8_SB(1, 0), cB + kstep, voffB); PG8_STAGE_A(PG8_SA(1, 0), cA + kstep, 0, false); PG8_STAGE(PG8_SB(1, 1), cB + hstepB + kstep, voffB);
    PG8_WAIT_V(6); PG8_BAR;
    for (;;) {
        const bool has_next = S.next(ui + 1, nxt);
        const char* nA = has_next ? nxt.a : cA; const char* nB = has_next ? nxt.b : cB;
        if constexpr (GATHER) { if (has_next && wid == 0) {
#pragma unroll
            for (int k = 0; k < 4; ++k) __builtin_amdgcn_global_load_lds((const unsigned*)(gidx + nxt.pm * BM + k * 64 + lane), (LAS unsigned*)(ixt + ((ui + 1) & 1) * BM + k * 64), 4, 0, 0); } }
        for (int t = 0; t < nt; t += 2) {
            const bool last = (t == nt - 2); const bool un = last && has_next;
            if constexpr (GATHER) { if (un) {
#pragma unroll
                for (int h = 0; h < 2; ++h)
#pragma unroll
                    for (int i = 0; i < 2; ++i) { const int ix = ixt[((ui + 1) & 1) * BM + h * HALF + Rl[i]]; nOff[h][i] = (unsigned)(ix < 0 ? 0 : ix) * (unsigned)(lda * 2) + cb2[i]; } } }
            const char* a1 = cA + (size_t)(t + 1) * kstep;
            const char* a2 = last ? nA : cA + (size_t)(t + 2) * kstep; const char* b2 = last ? nB : cB + (size_t)(t + 2) * kstep;
            const char* a3 = a2 + kstep; const char* b3 = b2 + kstep;
            PG8_LDB(B0, 0, 0); PG8_LDB(B1, 0, 1); PG8_SCHED; PG8_LDA(At, 0, 0); PG8_STAGE_A(PG8_SA(1, 1), a1, 1, false);
            PG8_WAIT_V(8); PG8_WAIT_L(0); PG8_BAR; PG8_MMA(0, 0, At, B0); PG8_MMA(0, 1, At, B1); PG8_BAR; PG8_SCHED;
            PG8_LDA(At, 0, 1); PG8_STAGE(PG8_SB(0, 0), b2, voffB); PG8_STAGE(PG8_SB(0, 1), b2 + hstepB, voffB); PG8_STAGE_A(PG8_SA(0, 0), a2, 0, un);
            PG8_WAIT_V(8); PG8_WAIT_L(0); PG8_BAR; PG8_MMA(1, 0, At, B0); PG8_MMA(1, 1, At, B1); PG8_BAR; PG8_SCHED;
            PG8_LDB(B0, 1, 0); PG8_LDB(B1, 1, 1); PG8_SCHED; PG8_LDA(At, 1, 0); PG8_STAGE_A(PG8_SA(0, 1), a2, 1, un);
            PG8_WAIT_V(8); PG8_WAIT_L(0); PG8_BAR; PG8_MMA(0, 0, At, B0); PG8_MMA(0, 1, At, B1); PG8_BAR; PG8_SCHED;
            PG8_LDA(At, 1, 1); PG8_STAGE(PG8_SB(1, 0), b3, voffB); PG8_STAGE(PG8_SB(1, 1), b3 + hstepB, voffB); PG8_STAGE_A(PG8_SA(1, 0), a3, 0, un);
            PG8_WAIT_V(8); PG8_WAIT_L(0); PG8_BAR; PG8_MMA(1, 0, At, B0); PG8_MMA(1, 1, At, B1); PG8_BAR; PG8_SCHED;
        }
        if (wr == 0) PG8_BAR;
        E(acc, cur, wr, wc, fr, fq);
        if (!has_next) break;
#pragma unroll
        for (int a = 0; a < 2; ++a)
#pragma unroll
            for (int b = 0; b < 2; ++b)
#pragma unroll
                for (int m = 0; m < 4; ++m)
#pragma unroll
                    for (int n = 0; n < 2; ++n) acc[a][b][m][n] = (f32x4){0.f, 0.f, 0.f, 0.f};
        cur = nxt; cA = nA; cB = nB; ++ui;
        if constexpr (GATHER) {
#pragma unroll
            for (int h = 0; h < 2; ++h)
#pragma unroll
                for (int i = 0; i < 2; ++i) cOff[h][i] = nOff[h][i]; }
        if (wr == 1) PG8_BAR;
    }
    PG8_WAIT_V(0);
    PG8_BAR;
#undef PG8_SA
#undef PG8_SB
#undef PG8_STAGE
#undef PG8_LDA
#undef PG8_STAGE_A
#undef PG8_LDB
#undef PG8_MMA
#undef PG8_WAIT_V
#undef PG8_WAIT_L
#undef PG8_BAR
#undef PG8_SCHED
}

template <int ACT> struct EpiBf16 {
    static constexpr bool PERM = true;
    bf16_t* O; int ldc; const float* bias;
    __device__ __forceinline__ void operator()(const f32x4 (&acc)[2][2][4][2], const Unit& u, int wr, int wc, int fr, int fq) const {
        asm volatile("" : "+v"(fr), "+v"(fq));
        const int row0 = u.pm * BM + wr * 64 + fr; const int col0 = u.pn * BM + wc * 32 + 8 * fq;
        f32x4 bv[2][2];
#pragma unroll
        for (int bj = 0; bj < 2; ++bj)
#pragma unroll
            for (int n = 0; n < 2; ++n) bv[bj][n] = bias ? *(const f32x4*)(bias + col0 + bj * HALF + 4 * n) : (f32x4){0.f, 0.f, 0.f, 0.f};
#pragma unroll
        for (int ai = 0; ai < 2; ++ai)
#pragma unroll
            for (int m = 0; m < 4; ++m) { bf16_t* rowp = O + (size_t)(row0 + ai * HALF + m * 16) * ldc + col0;
#pragma unroll
                for (int bj = 0; bj < 2; ++bj) { f32x4 v0 = acc[ai][bj][m][0] + bv[bj][0], v1 = acc[ai][bj][m][1] + bv[bj][1];
                    if (ACT == 1) {
#pragma unroll
                        for (int j = 0; j < 4; ++j) { v0[j] = gelu_tanh_f(v0[j]); v1[j] = gelu_tanh_f(v1[j]); } }
                    u32x4 w; w.x = pk2(v0[0], v0[1]); w.y = pk2(v0[2], v0[3]); w.z = pk2(v1[0], v1[1]); w.w = pk2(v1[2], v1[3]);
                    *(u32x4*)(rowp + bj * HALF) = w; } }
    }
};
struct EpiSwiGLU {
    static constexpr bool PERM = true;
    bf16_t* H; int ldh;
    __device__ __forceinline__ void operator()(const f32x4 (&acc)[2][2][4][2], const Unit& u, int wr, int wc, int fr, int fq) const {
        asm volatile("" : "+v"(fr), "+v"(fq));
        const int row0 = u.pm * BM + wr * 64 + fr; const int col0 = u.pn * HALF + wc * 32 + 8 * fq;
#pragma unroll
        for (int ai = 0; ai < 2; ++ai)
#pragma unroll
            for (int m = 0; m < 4; ++m) { bf16_t* rowp = H + (size_t)(row0 + ai * HALF + m * 16) * ldh + col0;
                f32x4 h0, h1;
#pragma unroll
                for (int j = 0; j < 4; ++j) { h0[j] = silu_f(acc[ai][0][m][0][j]) * acc[ai][1][m][0][j]; h1[j] = silu_f(acc[ai][0][m][1][j]) * acc[ai][1][m][1][j]; }
                u32x4 w; w.x = pk2(h0[0], h0[1]); w.y = pk2(h0[2], h0[3]); w.z = pk2(h1[0], h1[1]); w.w = pk2(h1[2], h1[3]);
                *(u32x4*)rowp = w; }
    }
};
template <bool HAS_BS, bool SRC32> struct EpiResidT {
    static constexpr bool PERM = false;
    const void* src_lat; const void* src_ctx; bf16_t* dst_lat; bf16_t* dst_ctx; const float* gate;
    const float* bias; const float* cscale;
    __device__ __forceinline__ void operator()(const f32x4 (&acc)[2][2][4][2], const Unit& u, int wr, int wc, int fr, int fq) const {
        asm volatile("" : "+v"(fr), "+v"(fq));
        const bool isctx = u.pm >= RL / BM; const int mb = isctx ? 32 : (u.pm >> 3);
        const size_t trow = isctx ? (size_t)(u.pm - RL / BM) * BM : (size_t)u.pm * BM;
        const float* s32 = (const float*)(isctx ? src_ctx : src_lat) + trow * D; const bf16_t* s16 = (const bf16_t*)(isctx ? src_ctx : src_lat) + trow * D;
        bf16_t* dst = (isctx ? dst_ctx : dst_lat) + trow * D;
        const float* g = gate + (size_t)mb * MODW;
        const int col0 = u.pn * BM + wc * 32 + 4 * fq;
        f32x4 gv[2][2], bv[2][2];
#pragma unroll
        for (int bj = 0; bj < 2; ++bj)
#pragma unroll
            for (int n = 0; n < 2; ++n) { const int c = col0 + bj * HALF + n * 16; gv[bj][n] = HAS_BS ? (f32x4){0.f, 0.f, 0.f, 0.f} : *(const f32x4*)(g + c); bv[bj][n] = (f32x4){0.f, 0.f, 0.f, 0.f}; }
        constexpr int MB = HAS_BS ? 1 : 4;
#pragma unroll
        for (int ai = 0; ai < 2; ++ai)
#pragma unroll
            for (int m0 = 0; m0 < 4; m0 += MB) {
                f32x4 rs[MB][2][2];
#pragma unroll
                for (int mi = 0; mi < MB; ++mi) { const unsigned off = (unsigned)((ai * HALF + wr * 64 + (m0 + mi) * 16 + fr) * D + col0);
#pragma unroll
                    for (int bj = 0; bj < 2; ++bj)
#pragma unroll
                        for (int n = 0; n < 2; ++n) { if (SRC32) rs[mi][bj][n] = *(const f32x4*)(s32 + off + bj * HALF + n * 16);
                            else { const u32x2 q = *(const u32x2*)(s16 + off + bj * HALF + n * 16); rs[mi][bj][n] = (f32x4){lo_bf(q.x), hi_bf(q.x), lo_bf(q.y), hi_bf(q.y)}; } } }
#pragma unroll
                for (int mi = 0; mi < MB; ++mi) { const int m = m0 + mi; const unsigned off = (unsigned)((ai * HALF + wr * 64 + m * 16 + fr) * D + col0);
#pragma unroll
                    for (int bj = 0; bj < 2; ++bj)
#pragma unroll
                        for (int n = 0; n < 2; ++n) { f32x4 o;
                            if (HAS_BS) { const int c = col0 + bj * HALF + n * 16;
                                o = rs[mi][bj][n] + (*(const f32x4*)(g + c) * *(const f32x4*)(cscale + c)) * (acc[ai][bj][m][n] + *(const f32x4*)(bias + c)); }
                            else o = rs[mi][bj][n] + gv[bj][n] * acc[ai][bj][m][n];
                            u32x2 w; w.x = pk2(o[0], o[1]); w.y = pk2(o[2], o[3]); *(u32x2*)(dst + off + bj * HALF + n * 16) = w; } }
            }
    }
};
typedef EpiResidT<false, false> EpiResid; typedef EpiResidT<true, false> EpiResidBS; typedef EpiResidT<false, true> EpiResidX;
template <bool OUT32> struct EpiMoeDownT {
    static constexpr bool PERM = false;
    bf16_t* h_lat; bf16_t* h_ctx; float* out32; const float* gate; const int* tok; const float* gw;
    __device__ __forceinline__ void operator()(const f32x4 (&acc)[2][2][4][2], const Unit& u, int wr, int wc, int fr, int fq) const {
        asm volatile("" : "+v"(fr), "+v"(fq));
        const int col0 = u.pn * BM + wc * 32 + 4 * fq;
        int tk[2][4]; float wg[2][4];
#pragma unroll
        for (int ai = 0; ai < 2; ++ai)
#pragma unroll
            for (int m = 0; m < 4; ++m) { const int pos = u.pm * BM + ai * HALF + wr * 64 + m * 16 + fr; tk[ai][m] = tok[pos]; wg[ai][m] = gw[pos]; }
#pragma unroll
        for (int ai = 0; ai < 2; ++ai)
#pragma unroll
            for (int mp = 0; mp < 2; ++mp) {
                u32x2 rs[2][2][2]; f32x4 gg[2][2][2]; size_t ro[2]; bool cx[2];
#pragma unroll
                for (int mi = 0; mi < 2; ++mi) { const int t = tk[ai][2 * mp + mi]; const int tt = t >= 0 ? t : 0; cx[mi] = tt >= RL; const int mb = cx[mi] ? 32 : (tt >> 11);
                    ro[mi] = (size_t)(cx[mi] ? tt - RL : tt) * D + col0; const bf16_t* hp = (cx[mi] ? h_ctx : h_lat) + ro[mi]; const float* g = gate + (size_t)mb * MODW + col0;
#pragma unroll
                    for (int bj = 0; bj < 2; ++bj)
#pragma unroll
                        for (int n = 0; n < 2; ++n) { rs[mi][bj][n] = *(const u32x2*)(hp + bj * HALF + n * 16); gg[mi][bj][n] = *(const f32x4*)(g + bj * HALF + n * 16); } }
#pragma unroll
                for (int mi = 0; mi < 2; ++mi) { const int m = 2 * mp + mi;
                    if (tk[ai][m] >= 0) { const float w = wg[ai][m];
#pragma unroll
                        for (int bj = 0; bj < 2; ++bj)
#pragma unroll
                            for (int n = 0; n < 2; ++n) { const u32x2 q = rs[mi][bj][n]; const f32x4 o = (f32x4){lo_bf(q.x), hi_bf(q.x), lo_bf(q.y), hi_bf(q.y)} + gg[mi][bj][n] * (acc[ai][bj][m][n] * w);
                                if (OUT32) *(f32x4*)(out32 + ro[mi] + bj * HALF + n * 16) = o;
                                else { u32x2 wv; wv.x = pk2(o[0], o[1]); wv.y = pk2(o[2], o[3]); *(u32x2*)((cx[mi] ? h_ctx : h_lat) + ro[mi] + bj * HALF + n * 16) = wv; } } } }
            }
    }
};
typedef EpiMoeDownT<false> EpiMoeDown; typedef EpiMoeDownT<true> EpiMoeDownOut;
}

struct Frame {
    LAS unsigned char* lds;
    int tid, lane, wave, bid, G;
    const Params* p;
    unsigned char* ws; unsigned* ctl;
    float* modv; bf16_t* hlat; bf16_t* hctx; bf16_t* U;
};
#define WSP(T, off) ((T*)(F.ws + (off)))
__device__ __forceinline__ const float* INP(const Frame& F, int i) { return F.p->in[i]; }

__device__ __forceinline__ void cvt_item(const float* W, int K, int N, bf16_t* WT, int mode, LAS float* scr, int item, int lane) {
    const int nblk = N / 32, kb = item / nblk, nb = item % nblk, k0 = 64 * kb, n0 = 32 * nb;
#pragma unroll 8
    for (int i = 0; i < 32; ++i) { const int kk = 2 * i + (lane >> 5); scr[kk * 33 + (lane & 31)] = W[(size_t)(k0 + kk) * N + n0 + (lane & 31)]; }
    LDS_WAIT();
    const int c = lane & 7;
#pragma unroll
    for (int j = 0; j < 4; ++j) { const int n = (lane >> 3) + 8 * j; const LAS float* s = scr + (8 * c) * 33 + n;
        u32x4 o; o.x = pk2(s[0 * 33], s[1 * 33]); o.y = pk2(s[2 * 33], s[3 * 33]); o.z = pk2(s[4 * 33], s[5 * 33]); o.w = pk2(s[6 * 33], s[7 * 33]);
        const int nn = n0 + n; const int drow = mode == 0 ? nn : (256 * (nn >> 7) + (nn & 127) + (mode == 2 ? 128 : 0));
        *(u32x4*)(WT + (size_t)drow * K + k0 + 8 * c) = o; }
    LDS_WAIT();
}
struct CvtJob { const float* src; bf16_t* dst; int K, N, mode; };
__device__ __forceinline__ CvtJob cvt_small_job(const Frame& F, int j) {
    switch (j) {
        case 0: return CvtJob{INP(F, I_LRU_WIN), WSP(bf16_t, WS_LRU_WIN), 1024, 2560, 0};
        case 1: return CvtJob{INP(F, I_LRU_WOUT), WSP(bf16_t, WS_LRU_WOUT), 1280, 1024, 0};
        case 2: return CvtJob{INP(F, I_FFN_W1), WSP(bf16_t, WS_FFN_W13), 1024, DFF, 1};
        case 3: return CvtJob{INP(F, I_FFN_W3), WSP(bf16_t, WS_FFN_W13), 1024, DFF, 2};
        case 4: return CvtJob{INP(F, I_FFN_W2), WSP(bf16_t, WS_FFN_W2), DFF, 1024, 0};
        case 5: return CvtJob{INP(F, I_SGU_WIN), WSP(bf16_t, WS_SGU_WIN), 1024, 4096, 0};
        case 6: return CvtJob{INP(F, I_SGU_WOUT), WSP(bf16_t, WS_SGU_WOUT), 2048, 1024, 0};
        case 7: case 8: case 9: case 10: return CvtJob{INP(F, I_POOL_W) + (size_t)(j - 7) * 65536, WSP(bf16_t, WS_POOL_W) + (size_t)(j - 7) * 65536, 256, 256, 0};
        case 11: return CvtJob{INP(F, I_FFN_W1) + (size_t)D * DFF, WSP(bf16_t, WS_FFN_W13) + (size_t)2 * DFF * D, 1024, DFF, 1};
        case 12: return CvtJob{INP(F, I_FFN_W3) + (size_t)D * DFF, WSP(bf16_t, WS_FFN_W13) + (size_t)2 * DFF * D, 1024, DFF, 2};
        case 13: return CvtJob{INP(F, I_FFN_W2) + (size_t)D * DFF, WSP(bf16_t, WS_FFN_W2) + (size_t)D * DFF, DFF, 1024, 0};
        case 14: return CvtJob{INP(F, I_NA_WQKV), WSP(bf16_t, WS_NA_WQKV), 1024, 3072, 0};
        default: return CvtJob{INP(F, I_NA_WO), WSP(bf16_t, WS_NA_WO), 1024, 1024, 0};
    }
}
__device__ __forceinline__ int cvt_job_items(const CvtJob& j) { return (j.K / 64) * (j.N / 32); }
__device__ __forceinline__ void cvt_small_queue(const Frame& F, int j_lo, int j_hi, int qword) {
    LAS float* scr = (LAS float*)(F.lds + F.wave * 16384);
    int total = 0; for (int j = j_lo; j < j_hi; ++j) total += cvt_job_items(cvt_small_job(F, j));
    unsigned* head = F.ctl + CW_CVTQ + 64 * qword;
    for (;;) {
        int base = 0; if (F.lane == 0) base = (int)atomicAdd(head, 4u); base = __builtin_amdgcn_readfirstlane(base);
        if (base >= total) break;
        int j = j_lo, off = 0; CvtJob job = cvt_small_job(F, j);
        for (;;) { const int n = cvt_job_items(job); if (base < off + n) break; off += n; ++j; job = cvt_small_job(F, j); }
        for (int k = 0; k < 4 && base + k < total; ++k) { int it = base + k - off; while (it >= cvt_job_items(job)) { it -= cvt_job_items(job); off += cvt_job_items(job); ++j; job = cvt_small_job(F, j); }
            cvt_item(job.src, job.K, job.N, job.dst, job.mode, scr, it, F.lane); }
    }
}
__device__ __forceinline__ void phase_cvt_small(const Frame& F) {
    const size_t gt = (size_t)F.bid * NTHR + F.tid, GT = (size_t)F.G * NTHR;
    { const float* wa = INP(F, I_LRU_WA); const float* wi = INP(F, I_LRU_WI); bf16_t* da = WSP(bf16_t, WS_LRU_WA); bf16_t* di = WSP(bf16_t, WS_LRU_WI);
      for (size_t i = gt; i < (size_t)16 * 160 * 160; i += GT) { const int mat = (int)(i / 25600), rem = (int)(i % 25600), n = rem / 160, k = rem % 160;
          da[i] = (bf16_t)(pk2(wa[(size_t)mat * 25600 + k * 160 + n], 0.f) & 0xffffu); di[i] = (bf16_t)(pk2(wi[(size_t)mat * 25600 + k * 160 + n], 0.f) & 0xffffu); } }
    { const float* w = INP(F, I_SGU_WS); bf16_t* d = WSP(bf16_t, WS_SGU_WS);
      for (size_t i = gt; i < (size_t)8 * 128 * 128; i += GT) d[i] = (bf16_t)(pk2(w[i], 0.f) & 0xffffu); }
    cvt_small_queue(F, 0, 16, 6);
}
constexpr int CVT_MOE_ITEMS = 24 * 1792;
__device__ __forceinline__ bf16_t* moe_w13(const Frame& F, int l2) { return l2 ? WSP(bf16_t, WS_BIG + BG_MW2) : WSP(bf16_t, WS_MOE_W13); }
__device__ __forceinline__ bf16_t* moe_w2(const Frame& F, int l2) { return l2 ? WSP(bf16_t, WS_BIG + BG_MW2 + 112 * MiB) : WSP(bf16_t, WS_MOE_W2); }
__device__ __forceinline__ void cvt_moe_item(const Frame& F, int l2, int g, LAS float* scr) {
    const int job = g / 1792, it = g - job * 1792, e = job / 3, which = job - 3 * e; const size_t so = ((size_t)l2 * NE + e) * D * DFF;
    if (which == 0) cvt_item(INP(F, I_MOE_W1) + so, 1024, DFF, moe_w13(F, l2) + (size_t)e * 2 * DFF * D, 1, scr, it, F.lane);
    else if (which == 1) cvt_item(INP(F, I_MOE_W3) + so, 1024, DFF, moe_w13(F, l2) + (size_t)e * 2 * DFF * D, 2, scr, it, F.lane);
    else cvt_item(INP(F, I_MOE_W2) + so, DFF, 1024, moe_w2(F, l2) + (size_t)e * D * DFF, 0, scr, it, F.lane);
}
__device__ __forceinline__ void cvt_moe_queue(const Frame& F, int l2, int g_lo, int g_hi, int qword) {
    LAS float* scr = (LAS float*)(F.lds + F.wave * 16384);
    unsigned* head = F.ctl + CW_CVTQ + 64 * qword; const int n = g_hi - g_lo;
    for (;;) {
        int base = 0; if (F.lane == 0) base = (int)atomicAdd(head, 4u); base = __builtin_amdgcn_readfirstlane(base);
        if (base >= n) break;
        for (int k = 0; k < 4 && base + k < n; ++k) cvt_moe_item(F, l2, g_lo + base + k, scr);
    }
}

__device__ __forceinline__ void phase_mod(const Frame& F) {
    LAS float* sL = (LAS float*)F.lds;
    LAS float* pr = (LAS float*)(F.lds + 135168);
    const float* c = INP(F, I_C); const float* cc = INP(F, I_CCTX);
    __syncthreads();
    if (F.bid < 4 * 192) { for (int i = F.tid; i < 33 * 1024; i += NTHR) { const int b = i >> 10, k = i & 1023; const float v = b < 32 ? c[b * 1024 + k] : cc[k]; sL[i] = silu_f(v); } }
    __syncthreads();
    const int cl0 = F.lane & 31, kg = 2 * F.wave + (F.lane >> 5), k0 = 64 * kg;
    for (int unit = F.bid; unit < 4 * 192; unit += F.G) {
        const int l = unit / 192, col = (unit % 192) * 32 + cl0;
        const float* w = INP(F, I_MODW) + (size_t)l * 1024 * MODW + col;
        float acc[33];
#pragma unroll
        for (int b = 0; b < 33; ++b) acc[b] = 0.f;
        for (int k = k0; k < k0 + 64; k += 16) {
            float wv[16];
#pragma unroll
            for (int j = 0; j < 16; ++j) wv[j] = w[(size_t)(k + j) * MODW];
#pragma unroll
            for (int b = 0; b < 33; ++b) {
#pragma unroll
                for (int q = 0; q < 4; ++q) { const f32x4 s0 = *(const LAS f32x4*)(sL + b * 1024 + k + 4 * q); acc[b] += (s0[0] * wv[4 * q] + s0[1] * wv[4 * q + 1]) + (s0[2] * wv[4 * q + 2] + s0[3] * wv[4 * q + 3]); } }
        }
#pragma unroll
        for (int pass = 0; pass < 4; ++pass) {
            __syncthreads();
#pragma unroll
            for (int b = 0; b < 9; ++b) if (pass * 9 + b < 33) pr[(kg * 9 + b) * 32 + cl0] = acc[pass * 9 + b];
            __syncthreads();
            for (int i = F.tid; i < 9 * 32; i += NTHR) { const int b = i >> 5, cl = i & 31, bb = pass * 9 + b;
                if (bb < 33) { float t = 0.f;
#pragma unroll
                    for (int g = 0; g < 16; ++g) t += pr[(g * 9 + b) * 32 + cl];
                    const int cg = (unit % 192) * 32 + cl; F.modv[((size_t)l * 33 + bb) * MODW + cg] = t + INP(F, I_MODB)[l * MODW + cg]; } }
        }
    }
    __syncthreads();
}

struct NormCtx { const void* src_lat; const void* src_ctx; const float* gain; const float* mod; int which; bool f32src; };
struct NormPar { f32x4 gm[4], sh[4]; };
__device__ __forceinline__ void norm_load_par(const Frame& F, const NormCtx& N, int mb, NormPar& P) {
    const float* sh = N.mod + (size_t)mb * MODW + N.which * 3 * D; const float* sc = sh + D;
#pragma unroll
    for (int j = 0; j < 4; ++j) { const int c = 4 * F.lane + 256 * j; P.gm[j] = *(const f32x4*)(N.gain + c) * (*(const f32x4*)(sc + c) + 1.0f); P.sh[j] = *(const f32x4*)(sh + c); }
}
__device__ __forceinline__ void norm_load_row(const Frame& F, const NormCtx& N, int r, f32x4 (&v)[4]) {
    const size_t ro = (size_t)(r < RL ? r : r - RL) * D; const void* sp = r < RL ? N.src_lat : N.src_ctx;
#pragma unroll
    for (int j = 0; j < 4; ++j) {
        if (N.f32src) v[j] = *(const f32x4*)((const float*)sp + ro + 4 * F.lane + 256 * j);
        else { const u32x2 q = *(const u32x2*)((const bf16_t*)sp + ro + 4 * F.lane + 256 * j); v[j] = (f32x4){lo_bf(q.x), hi_bf(q.x), lo_bf(q.y), hi_bf(q.y)}; } }
}
__device__ __forceinline__ void norm_finish(const NormPar& P, const f32x4 (&v)[4], f32x4 (&y)[4]) {
    float ss = 0.f;
#pragma unroll
    for (int j = 0; j < 4; ++j) ss += (v[j][0] * v[j][0] + v[j][1] * v[j][1]) + (v[j][2] * v[j][2] + v[j][3] * v[j][3]);
    const float rstd = 1.0f / sqrtf(wave_sum(ss) * (1.0f / D) + NORM_EPS);
#pragma unroll
    for (int j = 0; j < 4; ++j) y[j] = (v[j] * rstd) * P.gm[j] + P.sh[j];
}
__device__ __forceinline__ void store_row_bf16(const Frame& F, bf16_t* dst, const f32x4 (&y)[4]) {
#pragma unroll
    for (int j = 0; j < 4; ++j) { u32x2 w; w.x = pk2(y[j][0], y[j][1]); w.y = pk2(y[j][2], y[j][3]); *(u32x2*)(dst + 4 * F.lane + 256 * j) = w; }
}
__device__ __forceinline__ void phase_norm(const Frame& F, const NormCtx& N, int nrows) {
    const int gw = F.bid * NWAVES + F.wave, NGW = F.G * NWAVES, RPW = (nrows + NGW - 1) / NGW, r0 = gw * RPW, r1 = min(nrows, r0 + RPW);
    if (r0 >= r1) return;
    NormPar P; int mbcur = -1; f32x4 v[4], vn[4];
    norm_load_row(F, N, r0, v);
    for (int r = r0; r < r1; ++r) {
        if (r + 1 < r1) norm_load_row(F, N, r + 1, vn);
        const int mb = r < RL ? (r >> 11) : 32; if (mb != mbcur) { norm_load_par(F, N, mb, P); mbcur = mb; }
        f32x4 y[4]; norm_finish(P, v, y); store_row_bf16(F, F.U + (size_t)r * D, y);
#pragma unroll
        for (int j = 0; j < 4; ++j) v[j] = vn[j];
    }
}
__device__ __forceinline__ void route_top2(const Frame& F, float (&lg)[NE], const float* br, int& e0, int& e1, float& w0) {
    const bool h5 = F.lane & 32, h4 = F.lane & 16, h3 = F.lane & 8;
    float a4[4];
#pragma unroll
    for (int k = 0; k < 4; ++k) { const float mine = h5 ? lg[4 + k] : lg[k], send = h5 ? lg[k] : lg[4 + k]; a4[k] = mine + __shfl_xor(send, 32); }
    float a2[2];
#pragma unroll
    for (int k = 0; k < 2; ++k) { const float mine = h4 ? a4[2 + k] : a4[k], send = h4 ? a4[k] : a4[2 + k]; a2[k] = mine + __shfl_xor(send, 16); }
    float a1; { const float mine = h3 ? a2[1] : a2[0], send = h3 ? a2[0] : a2[1]; a1 = mine + __shfl_xor(send, 8); }
    a1 += __shfl_xor(a1, 4); a1 += __shfl_xor(a1, 2); a1 += __shfl_xor(a1, 1);
#pragma unroll
    for (int e = 0; e < NE; ++e) lg[e] = __int_as_float(__builtin_amdgcn_readlane(__float_as_int(a1), ((e >> 2) & 1) * 32 + ((e >> 1) & 1) * 16 + (e & 1) * 8)) + br[e];
    e0 = 0; float v0 = lg[0];
#pragma unroll
    for (int e = 1; e < NE; ++e) if (lg[e] > v0) { v0 = lg[e]; e0 = e; }
    e1 = -1; float v1 = -3.0e38f;
#pragma unroll
    for (int e = 0; e < NE; ++e) if (e != e0 && lg[e] > v1) { v1 = lg[e]; e1 = e; }
    w0 = 1.0f / (1.0f + __expf(v1 - v0));
}
__device__ __forceinline__ void phase_route(const Frame& F, const NormCtx& N, int nrows, int l2) {
    LAS float* wrL = (LAS float*)F.lds;
    LAS unsigned* hist = (LAS unsigned*)(F.lds + 32768);
    __syncthreads();
    const float* wr = INP(F, I_MOE_WR) + (size_t)l2 * D * NE; const float* br = INP(F, I_MOE_BR) + l2 * NE;
    for (int i = F.tid; i < D * NE; i += NTHR) wrL[(i & 7) * D + (i >> 3)] = wr[i];
    if (F.tid < 16) hist[F.tid] = 0u;
    __syncthreads();
    int* re = WSP(int, WS_ROUTE + RT_E); float* rw = WSP(float, WS_ROUTE + RT_W);
    const int gw = F.bid * NWAVES + F.wave, NGW = F.G * NWAVES, RPW = (nrows + NGW - 1) / NGW, r0 = gw * RPW, r1 = min(nrows, r0 + RPW);
    NormPar P; int mbcur = -1; f32x4 va[4], vb[4];
    for (int r = r0; r < r1; r += 2) {
        const bool two = r + 1 < r1; const int rb = two ? r + 1 : r;
        norm_load_row(F, N, r, va); norm_load_row(F, N, rb, vb);
        f32x4 ya[4], yb[4];
        { const int mb = r < RL ? (r >> 11) : 32; if (mb != mbcur) { norm_load_par(F, N, mb, P); mbcur = mb; } norm_finish(P, va, ya); store_row_bf16(F, F.U + (size_t)r * D, ya); }
        { const int mb = rb < RL ? (rb >> 11) : 32; if (mb != mbcur) { norm_load_par(F, N, mb, P); mbcur = mb; } norm_finish(P, vb, yb); if (two) store_row_bf16(F, F.U + (size_t)rb * D, yb); }
        float la[NE], lb[NE];
#pragma unroll
        for (int e = 0; e < NE; ++e) { la[e] = 0.f; lb[e] = 0.f; }
#pragma unroll
        for (int j = 0; j < 4; ++j)
#pragma unroll
            for (int e = 0; e < NE; ++e) { const f32x4 wv = *(const LAS f32x4*)(wrL + e * D + 4 * F.lane + 256 * j);
                la[e] += (ya[j][0] * wv[0] + ya[j][1] * wv[1]) + (ya[j][2] * wv[2] + ya[j][3] * wv[3]); lb[e] += (yb[j][0] * wv[0] + yb[j][1] * wv[1]) + (yb[j][2] * wv[2] + yb[j][3] * wv[3]); }
        int e0, e1; float w0;
        route_top2(F, la, br, e0, e1, w0);
        if (F.lane == 0) { re[r] = e0 | (e1 << 8); rw[2 * r] = w0; rw[2 * r + 1] = 1.0f - w0; lds_add(&hist[e0], 1u); lds_add(&hist[8 + e1], 1u); }
        route_top2(F, lb, br, e0, e1, w0);
        if (F.lane == 0 && two) { re[rb] = e0 | (e1 << 8); rw[2 * rb] = w0; rw[2 * rb + 1] = 1.0f - w0; lds_add(&hist[e0], 1u); lds_add(&hist[8 + e1], 1u); }
    }
    __syncthreads();
    if (F.tid < 16 && hist[F.tid]) atomicAdd(F.ctl + CW_CNT + 64 * l2 + F.tid, hist[F.tid]);
    int* tok = WSP(int, WS_ROUTE + RT_TOK);
    for (size_t i = (size_t)F.bid * NTHR + F.tid; i < (size_t)2 * MPAD; i += (size_t)F.G * NTHR) tok[i] = -1;
    __syncthreads();
}
__device__ __forceinline__ int pad256(int x) { return (x + 255) & ~255; }
__device__ __forceinline__ void phase_assign_scatter0(const Frame& F, int nrows, int l2) {
    LAS unsigned* bcnt = (LAS unsigned*)F.lds;
    LAS unsigned* bbase = (LAS unsigned*)(F.lds + 64);
    __syncthreads();
    if (F.tid < 16) bcnt[F.tid] = 0u;
    __syncthreads();
    const int RPB = (nrows + F.G - 1) / F.G, rb0 = F.bid * RPB, rb1 = min(nrows, rb0 + RPB);
    const int* re = WSP(const int, WS_ROUTE + RT_E); const float* rw = WSP(const float, WS_ROUTE + RT_W);
    int* tok = WSP(int, WS_ROUTE + RT_TOK); float* gwl = WSP(float, WS_ROUTE + RT_GW); int* pos1 = WSP(int, WS_ROUTE + RT_P1);
    const int myr = rb0 + F.wave + 8 * F.lane; const bool have = myr < rb1;
    int e0 = 0, e1 = 0; unsigned li0 = 0, li1 = 0; float w0 = 0.f, w1 = 0.f;
    if (have) { const int ee = re[myr]; e0 = ee & 255; e1 = (ee >> 8) & 255; w0 = rw[2 * myr]; w1 = rw[2 * myr + 1]; li0 = lds_add(&bcnt[e0], 1u); li1 = lds_add(&bcnt[8 + e1], 1u); }
    __syncthreads();
    const unsigned* cnt = F.ctl + CW_CNT + 64 * l2;
    if (F.tid < 16) { const int s = F.tid >> 3, e = F.tid & 7; unsigned off = 0; for (int k = 0; k < e; ++k) off += (unsigned)pad256((int)cnt[s * 8 + k]);
        unsigned b = 0; if (bcnt[F.tid]) b = atomicAdd(F.ctl + CW_CUR + 64 * l2 + F.tid, bcnt[F.tid]); bbase[F.tid] = off + b; }
    __syncthreads();
    const int p0 = (int)(bbase[e0] + li0), p1 = (int)(bbase[8 + e1] + li1);
    if (have) { tok[p0] = myr; gwl[p0] = w0; tok[MPAD + p1] = myr; gwl[MPAD + p1] = w1; pos1[myr] = p1; }
    __syncthreads();
}
__device__ __forceinline__ int moe_tile_table(const Frame& F, int l2, int s, LAS int* tstart) {
    __syncthreads();
    if (F.tid == 0) { const unsigned* cnt = F.ctl + CW_CNT + 64 * l2 + 8 * s; int t = 0; for (int e = 0; e < NE; ++e) { tstart[e] = t; t += pad256((int)cnt[e]) >> 8; } tstart[8] = t; }
    __syncthreads();
    return tstart[8];
}

constexpr int SC_RS = 164;
__device__ __forceinline__ void scan_conv_load(const bf16_t* XG, size_t rowbase, int L, int t0, int ch0, int pt, u32x2 (&xr)[11]) {
    const int q4 = pt % 40, rg = pt / 40, ch = ch0 + 4 * q4, ta = t0 + 8 * rg;
#pragma unroll
    for (int i = 0; i < 11; ++i) { const int tp = ta - 2 + i; xr[i] = (tp >= 0 && tp < L) ? *(const u32x2*)(XG + (rowbase + tp) * 2560 + ch) : (u32x2){0u, 0u}; }
}
__device__ __forceinline__ void scan_conv_math(const float* cw, const float* cb, LAS bf16_t* xc, int ch0, int pt, const u32x2 (&xr)[11]) {
    const int q4 = pt % 40, rg = pt / 40, ch = ch0 + 4 * q4;
    const f32x4 bias = *(const f32x4*)(cb + ch); f32x4 wv[4];
#pragma unroll
    for (int k = 0; k < 4; ++k) wv[k] = *(const f32x4*)(cw + k * DRNN + ch);
#pragma unroll
    for (int i = 0; i < 8; ++i) { f32x4 acc = bias;
#pragma unroll
        for (int k = 0; k < 4; ++k) { const u32x2 x = xr[i + k]; acc[0] += lo_bf(x.x) * wv[k][0]; acc[1] += hi_bf(x.x) * wv[k][1]; acc[2] += lo_bf(x.y) * wv[k][2]; acc[3] += hi_bf(x.y) * wv[k][3]; }
        u32x2 o; o.x = pk2(acc[0], acc[1]); o.y = pk2(acc[2], acc[3]); *(LAS u32x2*)(xc + (8 * rg + i) * 168 + 4 * q4) = o; }
}
__device__ __forceinline__ void phase_scan(const Frame& F, bool need_ctx) {
    LAS bf16_t* xcA0 = (LAS bf16_t*)F.lds;
    LAS float* Ra = (LAS float*)(F.lds + 43008);
    LAS float* Ri = (LAS float*)(F.lds + 43008 + 41984);
    LAS float* tab = (LAS float*)(F.lds + 43008 + 2 * 41984);
    LAS bf16_t* Hb = (LAS bf16_t*)(F.lds + 43008 + 2 * 41984 + 2048);
    const bf16_t* XG = WSP(const bf16_t, WS_BIG + BG_XG); bf16_t* Y = WSP(bf16_t, WS_BIG + BG_Y);
    const float* cw = INP(F, I_LRU_CW); const float* cb = INP(F, I_LRU_CB);
    const int fr = F.lane & 15, fq = F.lane >> 4, w = F.wave;
    const int ntA = w, ntB = 8 + (w & 1), mtB = w >> 1;
    for (int unit = F.bid; unit < NB * 8; unit += F.G) {
        const int b = unit >> 3, kb = unit & 7, ch0 = kb * LBW;
        for (int d = 0; d < 2; ++d) {
            float carry = 0.f;
            bf16x8 Ba[5], Bi[5];
            __syncthreads();
            const bf16_t* wa = WSP(const bf16_t, WS_LRU_WA) + (size_t)(d * 8 + kb) * 25600; const bf16_t* wi = WSP(const bf16_t, WS_LRU_WI) + (size_t)(d * 8 + kb) * 25600;
#pragma unroll
            for (int ks = 0; ks < 5; ++ks) { Ba[ks] = *(const bf16x8*)(wa + (16 * ntA + fr) * 160 + 32 * ks + 8 * fq); Bi[ks] = *(const bf16x8*)(wi + (16 * ntA + fr) * 160 + 32 * ks + 8 * fq); }
            if (F.tid < LBW) { const int c = ch0 + F.tid; tab[F.tid] = INP(F, I_LRU_BA)[d * DRNN + c]; tab[160 + F.tid] = INP(F, I_LRU_BI)[d * DRNN + c];
                const float lam = INP(F, I_LRU_LAM)[d * DRNN + c]; tab[320 + F.tid] = 8.0f * 1.4426950408889634f * (lam > 0.f ? log1pf(expf(-lam)) : (-lam + log1pf(expf(lam)))); }
            if (F.tid >= 192) { u32x2 xr[11]; scan_conv_load(XG, (size_t)RL + (size_t)b * CTXL, CTXL, d ? CTXL - 64 : 0, ch0, F.tid - 192, xr); scan_conv_math(cw, cb, xcA0, ch0, F.tid - 192, xr); }
            __syncthreads();
            for (int cidx = 0; cidx <= 36; ++cidx) {
                const int seg = cidx >= 4, ci = seg ? cidx - 4 : cidx, L = seg ? SEQ : CTXL; const size_t rowbase = seg ? (size_t)b * SEQ : (size_t)RL + (size_t)b * CTXL;
                const int t0 = d ? L - 64 * (ci + 1) : 64 * ci;
                LAS bf16_t* xc = xcA0 + (cidx & 1) * (64 * 168);
                const int pc = cidx - 1; const int pseg = pc >= 4, pci = pseg ? pc - 4 : pc, pL = pseg ? SEQ : CTXL; const size_t prow = pseg ? (size_t)b * SEQ : (size_t)RL + (size_t)b * CTXL;
                const int pt0 = d ? pL - 64 * (pci + 1) : 64 * pci; const bool p_out = pc >= 0 && (pseg == 1 || need_ctx);
                u32x2 pv[5], gv[5];
#pragma unroll
                for (int it = 0; it < 5; ++it) { const int e = F.tid + NTHR * it, tt = e / 40, c4 = e % 40;
                    if (d == 1 && p_out) { const size_t row = prow + pt0 + tt; pv[it] = *(const u32x2*)(Y + row * DRNN + ch0 + 4 * c4); gv[it] = *(const u32x2*)(XG + row * 2560 + DRNN + ch0 + 4 * c4); } else { pv[it] = (u32x2){0u, 0u}; gv[it] = (u32x2){0u, 0u}; } }
                if (cidx < 36) {
                    bf16x8 Xa[5], Xi[5];
#pragma unroll
                    for (int ks = 0; ks < 5; ++ks) { Xa[ks] = *(const bf16x8*)(wa + (16 * ntB + fr) * 160 + 32 * ks + 8 * fq); Xi[ks] = *(const bf16x8*)(wi + (16 * ntB + fr) * 160 + 32 * ks + 8 * fq); }
#pragma unroll 1
                    for (int mt = 0; mt < 4; ++mt) {
                        f32x4 ra = {0.f, 0.f, 0.f, 0.f}, ri = {0.f, 0.f, 0.f, 0.f};
#pragma unroll
                        for (int ks = 0; ks < 5; ++ks) { const bf16x8 a = *(const LAS bf16x8*)(xc + (16 * mt + fr) * 168 + 32 * ks + 8 * fq);
                            ra = __builtin_amdgcn_mfma_f32_16x16x32_bf16(Ba[ks], a, ra, 0, 0, 0); ri = __builtin_amdgcn_mfma_f32_16x16x32_bf16(Bi[ks], a, ri, 0, 0, 0); }
                        const int o = (16 * mt + fr) * SC_RS + 16 * ntA + 4 * fq; *(LAS f32x4*)(Ra + o) = ra; *(LAS f32x4*)(Ri + o) = ri;
                    }
                    {
                        f32x4 ra = {0.f, 0.f, 0.f, 0.f}, ri = {0.f, 0.f, 0.f, 0.f};
#pragma unroll
                        for (int ks = 0; ks < 5; ++ks) { const bf16x8 a = *(const LAS bf16x8*)(xc + (16 * mtB + fr) * 168 + 32 * ks + 8 * fq);
                            ra = __builtin_amdgcn_mfma_f32_16x16x32_bf16(Xa[ks], a, ra, 0, 0, 0); ri = __builtin_amdgcn_mfma_f32_16x16x32_bf16(Xi[ks], a, ri, 0, 0, 0); }
                        const int o = (16 * mtB + fr) * SC_RS + 16 * ntB + 4 * fq; *(LAS f32x4*)(Ra + o) = ra; *(LAS f32x4*)(Ri + o) = ri;
                    }
                }
                if (p_out) {
#pragma unroll
                    for (int it = 0; it < 5; ++it) { const int e = F.tid + NTHR * it, tt = e / 40, c4 = e % 40; const u32x2 hb = *(const LAS u32x2*)(Hb + tt * 168 + 4 * c4);
                        u32x2* yp = (u32x2*)(Y + (prow + pt0 + tt) * DRNN + ch0 + 4 * c4); u32x2 o;
                        if (d == 0) o = hb;
                        else { o.x = pk2((lo_bf(pv[it].x) + lo_bf(hb.x)) * gelu_tanh_f(lo_bf(gv[it].x)), (hi_bf(pv[it].x) + hi_bf(hb.x)) * gelu_tanh_f(hi_bf(gv[it].x)));
                               o.y = pk2((lo_bf(pv[it].y) + lo_bf(hb.y)) * gelu_tanh_f(lo_bf(gv[it].y)), (hi_bf(pv[it].y) + hi_bf(hb.y)) * gelu_tanh_f(hi_bf(gv[it].y))); }
                        *yp = o; }
                }
                if (cidx == 36) break;
                __syncthreads();
                const bool do_conv = F.tid >= 192 && cidx + 1 < 36;
                u32x2 xr[11];
                if (do_conv) { const int nseg = (cidx + 1) >= 4, nci = nseg ? cidx + 1 - 4 : cidx + 1, nL = nseg ? SEQ : CTXL;
                    scan_conv_load(XG, nseg ? (size_t)b * SEQ : (size_t)RL + (size_t)b * CTXL, nL, d ? nL - 64 * (nci + 1) : 64 * nci, ch0, F.tid - 192, xr); }
#pragma unroll 1
                for (int it = 0; it < 5; ++it) { const int e = F.tid + NTHR * it, tt = e / 40, c4 = e % 40; const int o = tt * SC_RS + 4 * c4;
                    const f32x4 va = *(const LAS f32x4*)(Ra + o) + *(const LAS f32x4*)(tab + 4 * c4), vi = *(const LAS f32x4*)(Ri + o) + *(const LAS f32x4*)(tab + 160 + 4 * c4), sp = *(const LAS f32x4*)(tab + 320 + 4 * c4);
                    const u32x2 xv = *(const LAS u32x2*)(xc + tt * 168 + 4 * c4); const float xf[4] = {lo_bf(xv.x), hi_bf(xv.x), lo_bf(xv.y), hi_bf(xv.y)};
                    f32x4 av, bv;
#pragma unroll
                    for (int j = 0; j < 4; ++j) { const float r = __builtin_amdgcn_rcpf(1.0f + __builtin_amdgcn_exp2f(-1.4426950408889634f * va[j])), ig = __builtin_amdgcn_rcpf(1.0f + __builtin_amdgcn_exp2f(-1.4426950408889634f * vi[j]));
                        const float a = __builtin_amdgcn_exp2f(-r * sp[j]); av[j] = a; bv[j] = __builtin_amdgcn_sqrtf(fmaxf(1.0f - a * a, 0.f)) * (ig * xf[j]); }
                    *(LAS f32x4*)(Ra + o) = av; *(LAS f32x4*)(Ri + o) = bv; }
                __syncthreads();
                if (F.tid < LBW) { float h = carry;
#pragma unroll 1
                    for (int s0 = 0; s0 < 64; s0 += 16) {
                        float av[16], bv[16], hv[16];
#pragma unroll
                        for (int k = 0; k < 16; ++k) { const int tt = d ? 63 - (s0 + k) : s0 + k; av[k] = Ra[tt * SC_RS + F.tid]; bv[k] = Ri[tt * SC_RS + F.tid]; }
#pragma unroll
                        for (int k = 0; k < 16; ++k) { h = av[k] * h + bv[k]; hv[k] = h; }
#pragma unroll
                        for (int k = 0; k < 16; ++k) { const int tt = d ? 63 - (s0 + k) : s0 + k; Hb[tt * 168 + F.tid] = (bf16_t)(pk2(hv[k], 0.f) & 0xffffu); }
                    }
                    carry = h; }
                else if (do_conv) scan_conv_math(cw, cb, xcA0 + ((cidx + 1) & 1) * (64 * 168), ch0, F.tid - 192, xr);
                __syncthreads();
            }
        }
    }
}

__device__ __forceinline__ void phase_sgu_stats(const Frame& F) {
    const bf16_t* Z = WSP(const bf16_t, WS_BIG + BG_Z); float* st = WSP(float, WS_ROUTE + RT_ST);
    const int gw = F.bid * NWAVES + F.wave, NGW = F.G * NWAVES, RPW = (RA + NGW - 1) / NGW, r0 = gw * RPW, r1 = min(RA, r0 + RPW);
    if (r0 >= r1) return;
    u32x4 q[4], qn[4];
#pragma unroll
    for (int j = 0; j < 4; ++j) q[j] = *(const u32x4*)(Z + (size_t)r0 * 4096 + DSGU + 8 * F.lane + 512 * j);
    for (int r = r0; r < r1; ++r) {
        if (r + 1 < r1) {
#pragma unroll
            for (int j = 0; j < 4; ++j) qn[j] = *(const u32x4*)(Z + (size_t)(r + 1) * 4096 + DSGU + 8 * F.lane + 512 * j); }
        float x[32]; float s = 0.f;
#pragma unroll
        for (int j = 0; j < 4; ++j) { x[8 * j + 0] = lo_bf(q[j].x); x[8 * j + 1] = hi_bf(q[j].x); x[8 * j + 2] = lo_bf(q[j].y); x[8 * j + 3] = hi_bf(q[j].y); x[8 * j + 4] = lo_bf(q[j].z); x[8 * j + 5] = hi_bf(q[j].z); x[8 * j + 6] = lo_bf(q[j].w); x[8 * j + 7] = hi_bf(q[j].w); }
#pragma unroll
        for (int i = 0; i < 32; ++i) s += x[i];
        const float mean = wave_sum(s) * (1.0f / DSGU); float q2 = 0.f;
#pragma unroll
        for (int i = 0; i < 32; ++i) { const float dlt = x[i] - mean; q2 += dlt * dlt; }
        const float rstd = 1.0f / sqrtf(wave_sum(q2) * (1.0f / DSGU) + NORM_EPS);
        if (F.lane == 0) { st[2 * r] = mean; st[2 * r + 1] = rstd; }
#pragma unroll
        for (int j = 0; j < 4; ++j) q[j] = qn[j];
    }
}
__device__ __forceinline__ size_t sgu_row0(int cu) { return cu < 512 ? (size_t)(cu >> 4) * SEQ + (size_t)(cu & 15) * 128 : (size_t)RL + (size_t)((cu - 512) >> 1) * CTXL + (size_t)((cu - 512) & 1) * 128; }
__device__ __forceinline__ void phase_sgu_spatial(const Frame& F) {
    LAS bf16_t* vT = (LAS bf16_t*)F.lds;
    LAS bf16_t* uT = (LAS bf16_t*)(F.lds + 69632);
    bf16_t* Z = WSP(bf16_t, WS_BIG + BG_Z); const float* st = WSP(const float, WS_ROUTE + RT_ST);
    const bf16_t* wsb = WSP(const bf16_t, WS_SGU_WS);
    const float* lng = INP(F, I_SGU_LNG); const float* lnb = INP(F, I_SGU_LNB); const float* bs = INP(F, I_SGU_BS);
    const int fr = F.lane & 15, fq = F.lane >> 4, w = F.wave;
    const int q8 = F.tid >> 5, d8 = F.tid & 31;
    const int urow = F.tid >> 5, uch = F.tid & 31;
    u32x4 vq[8], uq[8]; f32x2 sq[8];
    int unit = F.bid;
    if (unit < 576 * 8) { const int cu = unit >> 3, g = unit & 7; const size_t row0 = sgu_row0(cu);
#pragma unroll
        for (int i = 0; i < 8; ++i) { const size_t r = row0 + 8 * q8 + i; vq[i] = *(const u32x4*)(Z + r * 4096 + DSGU + 256 * g + 8 * d8); sq[i] = *(const f32x2*)(st + 2 * r);
            uq[i] = *(const u32x4*)(Z + (row0 + urow + 16 * i) * 4096 + 256 * g + 8 * uch); } }
    for (; unit < 576 * 8; unit += F.G) {
        const int cu = unit >> 3, g = unit & 7; const size_t row0 = sgu_row0(cu);
        {
            const int dcol = 256 * g + 8 * d8; float gg[8], bb[8];
#pragma unroll
            for (int j = 0; j < 8; ++j) { gg[j] = lng[dcol + j]; bb[j] = lnb[dcol + j]; }
            float x[8][8];
#pragma unroll
            for (int i = 0; i < 8; ++i) { const u32x4 q = vq[i]; const float mean = sq[i][0], rstd = sq[i][1];
                const float raw[8] = {lo_bf(q.x), hi_bf(q.x), lo_bf(q.y), hi_bf(q.y), lo_bf(q.z), hi_bf(q.z), lo_bf(q.w), hi_bf(q.w)};
#pragma unroll
                for (int j = 0; j < 8; ++j) x[i][j] = (raw[j] - mean) * rstd * gg[j] + bb[j]; }
#pragma unroll
            for (int j = 0; j < 8; ++j) { u32x4 o; o.x = pk2(x[0][j], x[1][j]); o.y = pk2(x[2][j], x[3][j]); o.z = pk2(x[4][j], x[5][j]); o.w = pk2(x[6][j], x[7][j]);
                *(LAS u32x4*)(vT + (8 * d8 + j) * 136 + 8 * (q8 ^ (d8 & 15))) = o; }
#pragma unroll
            for (int i = 0; i < 8; ++i) *(LAS u32x4*)(uT + (urow + 16 * i) * 264 + 8 * uch) = uq[i];
        }
        __syncthreads();
        {
            const int nu = unit + F.G;
            if (nu < 576 * 8) { const int ncu = nu >> 3, ng = nu & 7; const size_t nrow0 = sgu_row0(ncu);
#pragma unroll
                for (int i = 0; i < 8; ++i) { const size_t r = nrow0 + 8 * q8 + i; vq[i] = *(const u32x4*)(Z + r * 4096 + DSGU + 256 * ng + 8 * d8); sq[i] = *(const f32x2*)(st + 2 * r);
                    uq[i] = *(const u32x4*)(Z + (nrow0 + urow + 16 * i) * 4096 + 256 * ng + 8 * uch); } }
            const int p = 16 * w + fr; LAS u32x2* urow_l = (LAS u32x2*)(uT + p * 264 + 4 * fq);
            bf16x8 af[4];
#pragma unroll
            for (int ks = 0; ks < 4; ++ks) af[ks] = *(const bf16x8*)(wsb + ((size_t)g * 128 + p) * 128 + 32 * ks + 8 * fq);
            const float bias = bs[g * 128 + p];
#pragma unroll 4
            for (int nt = 0; nt < 16; ++nt) { f32x4 acc = {0.f, 0.f, 0.f, 0.f};
#pragma unroll
                for (int ks = 0; ks < 4; ++ks) { const bf16x8 bfv = *(const LAS bf16x8*)(vT + (16 * nt + fr) * 136 + 8 * ((4 * ks + fq) ^ ((2 * nt + (fr >> 3)) & 15))); acc = __builtin_amdgcn_mfma_f32_16x16x32_bf16(bfv, af[ks], acc, 0, 0, 0); }
                const u32x2 u2 = urow_l[4 * nt]; u32x2 o; o.x = pk2(lo_bf(u2.x) * (acc[0] + bias), hi_bf(u2.x) * (acc[1] + bias)); o.y = pk2(lo_bf(u2.y) * (acc[2] + bias), hi_bf(u2.y) * (acc[3] + bias)); urow_l[4 * nt] = o; }
        }
        __syncthreads();
#pragma unroll
        for (int i = 0; i < 8; ++i) *(u32x4*)(Z + (row0 + urow + 16 * i) * 4096 + 256 * g + 8 * uch) = *(const LAS u32x4*)(uT + (urow + 16 * i) * 264 + 8 * uch);
        __syncthreads();
    }
}

template <int WN> __device__ __forceinline__ void pool_item(const bf16_t* U, bf16_t* PD, int r, int cg) {
    int t, L; size_t base; if (r < RL) { t = r & (SEQ - 1); L = SEQ; base = (size_t)(r - t); } else { t = (r - RL) & (CTXL - 1); L = CTXL; base = (size_t)(r - t); }
    const int lo = max(t - WN / 2, 0), hi = min(t + WN / 2 - 1, L - 1);
    u32x4 v[WN];
#pragma unroll
    for (int k = 0; k < WN; ++k) { const int q = min(max(t - WN / 2 + k, 0), L - 1); v[k] = *(const u32x4*)(U + (base + q) * D + 8 * cg); }
    float s[8] = {0.f, 0.f, 0.f, 0.f, 0.f, 0.f, 0.f, 0.f};
#pragma unroll
    for (int k = 0; k < WN; ++k) { const int q = t - WN / 2 + k; const float m = (q >= lo && q <= hi) ? 1.f : 0.f;
        s[0] += m * lo_bf(v[k].x); s[1] += m * hi_bf(v[k].x); s[2] += m * lo_bf(v[k].y); s[3] += m * hi_bf(v[k].y); s[4] += m * lo_bf(v[k].z); s[5] += m * hi_bf(v[k].z); s[6] += m * lo_bf(v[k].w); s[7] += m * hi_bf(v[k].w); }
    const u32x4 sv = v[WN / 2];
    const float inv = 1.0f / (float)(hi - lo + 1);
    u32x4 o; o.x = pk2(s[0] * inv - lo_bf(sv.x), s[1] * inv - hi_bf(sv.x)); o.y = pk2(s[2] * inv - lo_bf(sv.y), s[3] * inv - hi_bf(sv.y));
    o.z = pk2(s[4] * inv - lo_bf(sv.z), s[5] * inv - hi_bf(sv.z)); o.w = pk2(s[6] * inv - lo_bf(sv.w), s[7] * inv - hi_bf(sv.w));
    *(u32x4*)(PD + (size_t)r * D + 8 * cg) = o;
}
__device__ __forceinline__ void phase_pool_diff(const Frame& F) {
    bf16_t* PD = WSP(bf16_t, WS_BIG + BG_PD);
    const size_t T0 = (size_t)F.bid * NTHR + F.tid, TS = (size_t)F.G * NTHR, NI = (size_t)RA * 32;
#define POOL_LOOP(g_, WN_, K_) for (size_t i = T0; i < NI; i += K_ * TS) { _Pragma("unroll") for (int k_ = 0; k_ < K_; ++k_) { const size_t ii = i + k_ * TS; if (ii < NI) pool_item<WN_>(F.U, PD, (int)(ii >> 5), 32 * g_ + (int)(ii & 31)); } }
    POOL_LOOP(0, 2, 8) POOL_LOOP(1, 4, 4) POOL_LOOP(2, 8, 2) POOL_LOOP(3, 16, 1)
#undef POOL_LOOP
}

__device__ __forceinline__ void phase_na(const Frame& F) {
    const bf16_t* QKV = WSP(const bf16_t, WS_BIG + BG_QKV); bf16_t* O = WSP(bf16_t, WS_BIG + BG_O); const float* rpb = INP(F, I_NA_RPB);
    const int w = F.wave, rsub = w >> 1, chh = w & 1, fr = F.lane & 15, fq = F.lane >> 4;
    const int skey = F.tid >> 3, sd8 = F.tid & 7;
    LAS float* bt = (LAS float*)(F.lds + 36864);
    const unsigned trl = (unsigned)((fr >> 2) * 144 + (fr & 3) * 8);
    float kgain[8];
#pragma unroll
    for (int j = 0; j < 8; ++j) kgain[j] = INP(F, I_NA_KG)[8 * sd8 + j];
#define NA_KNORM(kr) do { float x_[8] = {lo_bf(kr.x), hi_bf(kr.x), lo_bf(kr.y), hi_bf(kr.y), lo_bf(kr.z), hi_bf(kr.z), lo_bf(kr.w), hi_bf(kr.w)}; float ss_ = 0.f; \
        _Pragma("unroll") for (int j_ = 0; j_ < 8; ++j_) ss_ += x_[j_] * x_[j_]; \
        ss_ += dpp_f<0xB1>(ss_); ss_ += dpp_f<0x4E>(ss_); ss_ += dpp_f<0x141>(ss_); \
        const float rs_ = __builtin_amdgcn_rsqf(ss_ * (1.0f / 64.0f) + NORM_EPS); \
        kr.x = pk2(x_[0] * rs_ * kgain[0], x_[1] * rs_ * kgain[1]); kr.y = pk2(x_[2] * rs_ * kgain[2], x_[3] * rs_ * kgain[3]); \
        kr.z = pk2(x_[4] * rs_ * kgain[4], x_[5] * rs_ * kgain[5]); kr.w = pk2(x_[6] * rs_ * kgain[6], x_[7] * rs_ * kgain[7]); } while (0)
    float gqm = 0.f, gkm = 0.f; for (int i = 0; i < 64; ++i) { gqm = fmaxf(gqm, fabsf(INP(F, I_NA_QG)[i])); gkm = fmaxf(gkm, fabsf(INP(F, I_NA_KG)[i])); }
    const float M0 = 8.0f * gqm * gkm * 1.4426950408889634f;
    for (int unit = F.bid; unit < NB * 16 * 8; unit += F.G) {
        const int rg = unit & 7, h = (unit >> 3) & 15, b = unit >> 7;
        const int r = 4 * rg + rsub, r0 = min(max(r - 4, 0), 24);
        const int ulo = min(max(4 * rg - 4, 0), 24), uhi = min(max(4 * rg - 1, 0), 24) + 8, nnb = uhi - ulo, ntile = nnb + 4;
        bf16x8 qf[2][2]; size_t qrow[2];
#pragma unroll
        for (int qt = 0; qt < 2; ++qt) { qrow[qt] = (size_t)b * SEQ + (size_t)r * 64 + 32 * chh + 16 * qt + fr;
            u32x4 raw[2]; float xv[2][8]; float ss = 0.f;
#pragma unroll
            for (int ks = 0; ks < 2; ++ks) { raw[ks] = *(const u32x4*)(QKV + qrow[qt] * 3072 + h * 64 + 32 * ks + 8 * fq);
                xv[ks][0] = lo_bf(raw[ks].x); xv[ks][1] = hi_bf(raw[ks].x); xv[ks][2] = lo_bf(raw[ks].y); xv[ks][3] = hi_bf(raw[ks].y); xv[ks][4] = lo_bf(raw[ks].z); xv[ks][5] = hi_bf(raw[ks].z); xv[ks][6] = lo_bf(raw[ks].w); xv[ks][7] = hi_bf(raw[ks].w);
#pragma unroll
                for (int j = 0; j < 8; ++j) ss += xv[ks][j] * xv[ks][j]; }
            ss += __shfl_xor(ss, 16); ss += __shfl_xor(ss, 32);
            const float rs = __builtin_amdgcn_rsqf(ss * (1.0f / 64.0f) + NORM_EPS) * (0.125f * 1.4426950408889634f);
#pragma unroll
            for (int ks = 0; ks < 2; ++ks) { const float* gq = INP(F, I_NA_QG) + 32 * ks + 8 * fq; u32x4 pw;
                pw.x = pk2(xv[ks][0] * rs * gq[0], xv[ks][1] * rs * gq[1]); pw.y = pk2(xv[ks][2] * rs * gq[2], xv[ks][3] * rs * gq[3]); pw.z = pk2(xv[ks][4] * rs * gq[4], xv[ks][5] * rs * gq[5]); pw.w = pk2(xv[ks][6] * rs * gq[6], xv[ks][7] * rs * gq[7]);
                qf[qt][ks] = __builtin_bit_cast(bf16x8, pw); } }
        f32x4 o[2][4]; float lrun[2] = {0.f, 0.f};
#pragma unroll
        for (int qt = 0; qt < 2; ++qt)
#pragma unroll
            for (int dt = 0; dt < 4; ++dt) o[qt][dt] = (f32x4){0.f, 0.f, 0.f, 0.f};
        for (int i = F.tid; i < 15 * 31; i += NTHR) bt[i] = rpb[(size_t)h * 465 + i] * 1.4426950408889634f - M0;
        u32x4 kreg, vreg;
        { const size_t krow = (size_t)b * SEQ + (size_t)ulo * 64 + skey; const bf16_t* kp = QKV + krow * 3072 + D + h * 64 + 8 * sd8; kreg = *(const u32x4*)kp; vreg = *(const u32x4*)(kp + D); }
        NA_KNORM(kreg);
        *(LAS u32x4*)(F.lds + skey * 144 + sd8 * 16) = kreg; *(LAS u32x4*)(F.lds + 9216 + skey * 144 + sd8 * 16) = vreg;
        __syncthreads();
        for (int i = 0; i < ntile; ++i) {
            if (i + 1 < ntile) { const size_t krow = (i + 1 < nnb ? (size_t)b * SEQ + (size_t)(ulo + i + 1) * 64 : (size_t)RL + (size_t)b * CTXL + (size_t)(i + 1 - nnb) * 64) + skey;
                const bf16_t* kp = QKV + krow * 3072 + D + h * 64 + 8 * sd8; kreg = *(const u32x4*)kp; vreg = *(const u32x4*)(kp + D); }
            LAS unsigned char* Kb = F.lds + (i & 1) * 18432; LAS unsigned char* Vb = Kb + 9216;
            const bool isnb = i < nnb; const int ra = ulo + i;
            if (!isnb || (ra >= r0 && ra < r0 + 8)) {
                bf16x8 kf[4][2];
#pragma unroll
                for (int kt = 0; kt < 4; ++kt)
#pragma unroll
                    for (int ks = 0; ks < 2; ++ks) kf[kt][ks] = *(const LAS bf16x8*)(Kb + (16 * kt + fr) * 144 + (32 * ks + 8 * fq) * 2);
                s16x4 vA[2][4][2];
#pragma unroll
                for (int s2 = 0; s2 < 2; ++s2)
#pragma unroll
                    for (int dt = 0; dt < 4; ++dt)
#pragma unroll
                        for (int hh = 0; hh < 2; ++hh) vA[s2][dt][hh] = __builtin_amdgcn_ds_read_tr16_b64_v4i16((LAS s16x4*)(Vb + (32 * s2 + 16 * hh + 4 * fq) * 144 + 32 * dt + trl));
                const LAS float* bp = bt + (ra - r + 7) * 31;
#pragma unroll
                for (int qt = 0; qt < 2; ++qt) {
                    const int g4 = 2 * chh + qt; const int klo = isnb ? (g4 <= 1 ? 0 : g4 - 1) : 0, khi = isnb ? (g4 >= 2 ? 3 : g4 + 1) : 3;
                    const int cq = 16 * g4 + fr, cstart = min(max(cq - 8, 0), 48);
                    f32x4 st[4]; float psum = 0.f;
#pragma unroll
                    for (int kt = 0; kt < 4; ++kt) {
                        f32x4 a = {0.f, 0.f, 0.f, 0.f};
                        if (kt >= klo && kt <= khi) {
                            a = __builtin_amdgcn_mfma_f32_16x16x32_bf16(kf[kt][0], qf[qt][0], a, 0, 0, 0); a = __builtin_amdgcn_mfma_f32_16x16x32_bf16(kf[kt][1], qf[qt][1], a, 0, 0, 0);
                            if (isnb) {
#pragma unroll
                                for (int j = 0; j < 4; ++j) { const int ck = 16 * kt + 4 * fq + j; const bool valid = (unsigned)(ck - cstart) < 16u; const int dc = min(max(ck - cq, -15), 15) + 15;
                                    const float pv = __builtin_amdgcn_exp2f(a[j] + bp[dc]); a[j] = valid ? pv : 0.f; } }
                            else {
#pragma unroll
                                for (int j = 0; j < 4; ++j) a[j] = __builtin_amdgcn_exp2f(a[j] - M0); }
                            psum += (a[0] + a[1]) + (a[2] + a[3]);
                        }
                        st[kt] = a;
                    }
                    lrun[qt] += psum;
#pragma unroll
                    for (int s2 = 0; s2 < 2; ++s2) {
                        if (2 * s2 + 1 >= klo && 2 * s2 <= khi) {
                            u32x4 pw; pw.x = pk2(st[2 * s2][0], st[2 * s2][1]); pw.y = pk2(st[2 * s2][2], st[2 * s2][3]); pw.z = pk2(st[2 * s2 + 1][0], st[2 * s2 + 1][1]); pw.w = pk2(st[2 * s2 + 1][2], st[2 * s2 + 1][3]);
                            const bf16x8 pb = __builtin_bit_cast(bf16x8, pw);
#pragma unroll
                            for (int dt = 0; dt < 4; ++dt) { const s16x4 v0 = vA[s2][dt][0], v1 = vA[s2][dt][1]; const bf16x8 va = {v0[0], v0[1], v0[2], v0[3], v1[0], v1[1], v1[2], v1[3]};
                                o[qt][dt] = __builtin_amdgcn_mfma_f32_16x16x32_bf16(va, pb, o[qt][dt], 0, 0, 0); }
                        }
                    }
                }
            }
            if (i + 1 < ntile) { NA_KNORM(kreg); LAS unsigned char* Kn = F.lds + ((i + 1) & 1) * 18432; *(LAS u32x4*)(Kn + skey * 144 + sd8 * 16) = kreg; *(LAS u32x4*)(Kn + 9216 + skey * 144 + sd8 * 16) = vreg; }
            __syncthreads();
        }
#pragma unroll
        for (int qt = 0; qt < 2; ++qt) { float lt = lrun[qt]; lt += __shfl_xor(lt, 16); lt += __shfl_xor(lt, 32); const float inv = 1.0f / lt;
#pragma unroll
            for (int dt = 0; dt < 4; ++dt) { u32x2 w2; w2.x = pk2(o[qt][dt][0] * inv, o[qt][dt][1] * inv); w2.y = pk2(o[qt][dt][2] * inv, o[qt][dt][3] * inv); *(u32x2*)(O + qrow[qt] * D + h * 64 + 16 * dt + 4 * fq) = w2; } }
    }
    __syncthreads();
}

#undef NA_KNORM
constexpr int NPH = 36;
__device__ __forceinline__ pg8::Sched mk_sched(const Frame& F, int nM, int nN, const bf16_t* A, int lda, const bf16_t* B, int K) {
    pg8::Sched S; S.nM = nM; S.nN = nN; S.G = F.G; S.c = F.bid; S.A = (const char*)A; S.a_tile = (size_t)256 * lda * 2; S.a_pn = 0;
    S.B = (const char*)B; S.b_tile = (size_t)256 * K * 2; S.b_e = 0; S.tstart = nullptr; S.rev = false; S.wgm = nN >= 8 ? WGM_WIDE : WGM_NARROW; return S;
}
__global__ void __launch_bounds__(NTHR, 2) fwd(Params P) {
    extern __shared__ __attribute__((aligned(16))) unsigned char lds_raw[];
    Frame F; F.lds = (LAS unsigned char*)lds_raw; F.tid = threadIdx.x; F.lane = F.tid & 63; F.wave = __builtin_amdgcn_readfirstlane(F.tid >> 6); F.bid = blockIdx.x; F.G = gridDim.x;
    F.p = &P; F.ws = P.ws; F.ctl = (unsigned*)(P.ws + WS_CTL); F.modv = (float*)(P.ws + WS_MODV); F.hlat = (bf16_t*)(P.ws + WS_H); F.hctx = F.hlat + (size_t)RL * D; F.U = (bf16_t*)P.out;
    if (F.tid < 64) ((LAS unsigned*)(F.lds + LDS_CTL))[F.tid] = 0u;
    __syncthreads();
    const int lo = P.ph_lo, hi = P.ph_hi;
    XcdBarrier bar; bar.bar = F.ctl + CW_BAR; bar.x = 0; bar.st = (volatile LAS unsigned*)(F.lds + LDS_CTL);
    if (hi - lo > 1) bar = xcd_barrier_post(F.ctl + CW_BAR, (volatile LAS unsigned*)(F.lds + LDS_CTL));
#define IN(k) (lo <= (k) && (k) < hi)
#define SEAM(k) do { if (IN(k) && IN((k) + 1)) xcd_barrier(bar); \
        if (PROBE_LO >= 0 && F.bid == 0 && F.tid == 0) { if ((k) + 1 == PROBE_LO) pr_t[0] = PROBE_CLK ? (unsigned long long)clock64() : __builtin_amdgcn_s_memrealtime(); if ((k) + 1 == PROBE_HI) pr_t[1] = PROBE_CLK ? (unsigned long long)clock64() : __builtin_amdgcn_s_memrealtime(); } } while (0)
    volatile LAS unsigned long long* const pr_t = (volatile LAS unsigned long long*)(F.lds + LDS_CTL + 16);
    if (PROBE_LO == 0 && F.bid == 0 && F.tid == 0) pr_t[0] = PROBE_CLK ? (unsigned long long)clock64() : __builtin_amdgcn_s_memrealtime();
    bf16_t* const out = F.hlat; bf16_t* const hctx = F.hctx;
    const float* const x = INP(F, I_X); const float* const ctx = INP(F, I_CTX);
    LAS unsigned char* const gl = F.lds;
    LAS int* const tstart = (LAS int*)(F.lds + LDS_AUX);
    bf16_t* const BIG = (bf16_t*)(P.ws + WS_BIG);
#define MODL(l) (F.modv + (size_t)(l) * 33 * MODW)
#define LAUNDER do { asm volatile("" : "+v"(F.tid)); F.lane = F.tid & 63; } while (0)

    if (IN(0)) { LAUNDER; phase_mod(F); phase_cvt_small(F); } SEAM(0);
    if (IN(1)) { LAUNDER; NormCtx N{x, ctx, INP(F, I_N1G), MODL(0), 0, true}; phase_norm(F, N, RA); } SEAM(1);
    if (IN(2)) { LAUNDER; pg8::Sched S = mk_sched(F, RA / 256, 10, F.U, D, WSP(bf16_t, WS_LRU_WIN), D); pg8::EpiBf16<0> E{(bf16_t*)(P.ws + WS_BIG + BG_XG), 2560, nullptr}; pg8::gemm_phase(gl, D, D, S, E); } SEAM(2);
    if (IN(3)) { LAUNDER; phase_scan(F, true); } SEAM(3);
    if (IN(4)) { LAUNDER; pg8::Sched S = mk_sched(F, RA / 256, 4, (bf16_t*)(P.ws + WS_BIG + BG_Y), DRNN, WSP(bf16_t, WS_LRU_WOUT), DRNN);
                 pg8::EpiResidX E{x, ctx, out, hctx, MODL(0) + 2 * D, nullptr, nullptr}; pg8::gemm_phase(gl, DRNN, DRNN, S, E); cvt_moe_queue(F, 0, 0, 8192, 0); } SEAM(4);
    if (IN(5)) { LAUNDER; NormCtx N{out, hctx, INP(F, I_N2G), MODL(0), 1, false}; phase_norm(F, N, RA); } SEAM(5);
    if (IN(6)) { LAUNDER; pg8::Sched S = mk_sched(F, RA / 256, 28, F.U, D, WSP(bf16_t, WS_FFN_W13), D); pg8::EpiSwiGLU E{(bf16_t*)(P.ws + WS_BIG + BG_HID), DFF}; pg8::gemm_phase(gl, D, D, S, E); } SEAM(6);
    if (IN(7)) { LAUNDER; pg8::Sched S = mk_sched(F, RA / 256, 4, (bf16_t*)(P.ws + WS_BIG + BG_HID), DFF, WSP(bf16_t, WS_FFN_W2), DFF);
                 S.rev = true; pg8::EpiResid E{out, hctx, out, hctx, MODL(0) + 5 * D, nullptr, nullptr}; pg8::gemm_phase(gl, DFF, DFF, S, E); cvt_moe_queue(F, 0, 8192, 30720, 1); } SEAM(7);
    if (IN(8)) { LAUNDER; NormCtx N{out, hctx, INP(F, I_N1G) + D, MODL(1), 0, false}; phase_norm(F, N, RA); } SEAM(8);
    if (IN(9)) { LAUNDER; pg8::Sched S = mk_sched(F, RA / 256, 16, F.U, D, WSP(bf16_t, WS_SGU_WIN), D); pg8::EpiBf16<1> E{(bf16_t*)(P.ws + WS_BIG + BG_Z), 4096, INP(F, I_SGU_BIN)}; pg8::gemm_phase(gl, D, D, S, E); } SEAM(9);
    if (IN(10)) { LAUNDER; phase_sgu_stats(F); } SEAM(10);
    if (IN(11)) { LAUNDER; phase_sgu_spatial(F); } SEAM(11);
    if (IN(12)) { LAUNDER; pg8::Sched S = mk_sched(F, RA / 256, 4, (bf16_t*)(P.ws + WS_BIG + BG_Z), 4096, WSP(bf16_t, WS_SGU_WOUT), DSGU);
                  pg8::EpiResid E{out, hctx, out, hctx, MODL(1) + 2 * D, nullptr, nullptr}; pg8::gemm_phase(gl, 4096, DSGU, S, E); cvt_moe_queue(F, 0, 30720, CVT_MOE_ITEMS, 2); } SEAM(12);
    if (IN(13)) { LAUNDER; NormCtx N{out, hctx, INP(F, I_N2G) + D, MODL(1), 1, false}; phase_route(F, N, RA, 0); } SEAM(13);
    if (IN(14)) { LAUNDER; phase_assign_scatter0(F, RA, 0); } SEAM(14);
#define MOE_UP(ph, l2, s) if (IN(ph)) { LAUNDER; const int nt_ = moe_tile_table(F, l2, s, tstart); \
        pg8::Sched S = mk_sched(F, nt_, 28, F.U, D, moe_w13(F, l2), D); S.a_tile = 0; S.b_e = (size_t)2 * DFF * D * 2; S.tstart = tstart; \
        pg8::EpiSwiGLU E{(bf16_t*)(P.ws + WS_BIG + BG_MHID), DFF}; pg8::gemm_phase<pg8::EpiSwiGLU, true>(gl, D, D, S, E, WSP(const int, WS_ROUTE + RT_TOK) + (s) * MPAD, (LAS int*)(F.lds + LDS_AUX + 1024)); } SEAM(ph)
#define MOE_DOWN(ph, l2, s, layer, EPI) if (IN(ph)) { LAUNDER; const int nt_ = moe_tile_table(F, l2, s, tstart); \
        pg8::Sched S = mk_sched(F, nt_, 4, (bf16_t*)(P.ws + WS_BIG + BG_MHID), DFF, moe_w2(F, l2), DFF); S.b_e = (size_t)D * DFF * 2; S.tstart = tstart; S.rev = true; \
        EPI E{out, hctx, P.out, MODL(layer) + 5 * D, WSP(const int, WS_ROUTE + RT_TOK) + (s) * MPAD, WSP(const float, WS_ROUTE + RT_GW) + (s) * MPAD}; pg8::gemm_phase(gl, DFF, DFF, S, E); \
        if ((l2) == 0) cvt_moe_queue(F, 1, (s) ? 10752 : 0, (s) ? 21504 : 10752, 3 + (s)); } SEAM(ph)
    MOE_UP(15, 0, 0); MOE_DOWN(16, 0, 0, 1, pg8::EpiMoeDown); MOE_UP(17, 0, 1); MOE_DOWN(18, 0, 1, 1, pg8::EpiMoeDown);
    if (IN(19)) { LAUNDER; NormCtx N{out, hctx, INP(F, I_N1G) + 2 * D, MODL(2), 0, false}; phase_norm(F, N, RA); } SEAM(19);
    if (IN(20)) { LAUNDER; phase_pool_diff(F); } SEAM(20);
    if (IN(21)) { LAUNDER; pg8::Sched S = mk_sched(F, RA / 256, 4, (bf16_t*)(P.ws + WS_BIG + BG_PD), D, WSP(bf16_t, WS_POOL_W), 256); S.a_pn = 512; S.b_tile = (size_t)256 * 256 * 2;
                  pg8::EpiResidBS E{out, hctx, out, hctx, MODL(2) + 2 * D, INP(F, I_POOL_B), INP(F, I_POOL_S)}; pg8::gemm_phase(gl, D, 256, S, E); } SEAM(21);
    if (IN(22)) { LAUNDER; NormCtx N{out, hctx, INP(F, I_N2G) + 2 * D, MODL(2), 1, false}; phase_norm(F, N, RA); } SEAM(22);
    if (IN(23)) { LAUNDER; pg8::Sched S = mk_sched(F, RA / 256, 28, F.U, D, WSP(bf16_t, WS_FFN_W13) + (size_t)2 * DFF * D, D); pg8::EpiSwiGLU E{(bf16_t*)(P.ws + WS_BIG + BG_HID), DFF}; pg8::gemm_phase(gl, D, D, S, E); } SEAM(23);
    if (IN(24)) { LAUNDER; pg8::Sched S = mk_sched(F, RA / 256, 4, (bf16_t*)(P.ws + WS_BIG + BG_HID), DFF, WSP(bf16_t, WS_FFN_W2) + (size_t)D * DFF, DFF);
                  S.rev = true; pg8::EpiResid E{out, hctx, out, hctx, MODL(2) + 5 * D, nullptr, nullptr}; pg8::gemm_phase(gl, DFF, DFF, S, E); cvt_moe_queue(F, 1, 21504, CVT_MOE_ITEMS, 5); } SEAM(24);
    if (IN(25)) { LAUNDER; NormCtx N{out, hctx, INP(F, I_N1G) + 3 * D, MODL(3), 0, false}; phase_norm(F, N, RA); } SEAM(25);
    if (IN(26)) { LAUNDER;
        { pg8::Sched S = mk_sched(F, RL / 256, 12, F.U, D, WSP(bf16_t, WS_NA_WQKV), D); pg8::EpiBf16<0> E{(bf16_t*)(P.ws + WS_BIG + BG_QKV), 3072, nullptr}; pg8::gemm_phase(gl, D, D, S, E); }
        { pg8::Sched S = mk_sched(F, RC / 256, 8, F.U + (size_t)RL * D, D, WSP(bf16_t, WS_NA_WQKV) + (size_t)D * D, D);
          pg8::EpiBf16<0> E{(bf16_t*)(P.ws + WS_BIG + BG_QKV) + (size_t)RL * 3072 + D, 3072, nullptr}; pg8::gemm_phase(gl, D, D, S, E); } } SEAM(26);
    SEAM(27);
    if (IN(28)) { LAUNDER; phase_na(F); } SEAM(28);
    if (IN(29)) { LAUNDER; pg8::Sched S = mk_sched(F, RL / 256, 4, (bf16_t*)(P.ws + WS_BIG + BG_O), D, WSP(bf16_t, WS_NA_WO), D);
                  pg8::EpiResid E{out, hctx, out, hctx, MODL(3) + 2 * D, nullptr, nullptr}; pg8::gemm_phase(gl, D, D, S, E); } SEAM(29);
    if (IN(30)) { LAUNDER; NormCtx N{out, hctx, INP(F, I_N2G) + 3 * D, MODL(3), 1, false}; phase_route(F, N, RL, 1); } SEAM(30);
    if (IN(31)) { LAUNDER; phase_assign_scatter0(F, RL, 1); } SEAM(31);
    MOE_UP(32, 1, 0); MOE_DOWN(33, 1, 0, 3, pg8::EpiMoeDown); MOE_UP(34, 1, 1); MOE_DOWN(35, 1, 1, 3, pg8::EpiMoeDownOut);
#undef IN
#undef SEAM
    (void)BIG;
    if (PROBE_LO >= 0 && F.bid == 0 && F.tid == 0) { if (PROBE_HI >= NPH) pr_t[1] = PROBE_CLK ? (unsigned long long)clock64() : __builtin_amdgcn_s_memrealtime();
        const unsigned long long t_end = __builtin_amdgcn_s_memrealtime(), wait = PROBE_CLK ? 8ull * (pr_t[1] - pr_t[0]) / 21ull : 8ull * (pr_t[1] - pr_t[0]);
        while (__builtin_amdgcn_s_memrealtime() - t_end < wait) __builtin_amdgcn_s_sleep(32); }
}

extern "C" void kernel_launch(void* const* d_in, const int* in_sizes, int n_in, void* d_out, int out_size, void* d_ws, size_t ws_size, hipStream_t stream) {
    static int grid = 0;
    if (grid == 0) {
        if (n_in != 40 || out_size != RL * D || ws_size < WS_END) { fprintf(stderr, "kernel_launch: unexpected problem (n_in %d out %d ws %zu)\n", n_in, out_size, ws_size); grid = -1; return; }
        int dev = 0, cus = 0;
        if (hipGetDevice(&dev) != hipSuccess || hipDeviceGetAttribute(&cus, hipDeviceAttributeMultiprocessorCount, dev) != hipSuccess) { grid = -1; return; }
        if (hipFuncSetAttribute((const void*)fwd, hipFuncAttributeMaxDynamicSharedMemorySize, LDS_BYTES) != hipSuccess) { fprintf(stderr, "kernel_launch: hipFuncSetAttribute failed\n"); grid = -1; return; }
        int per_cu = 0; (void)hipOccupancyMaxActiveBlocksPerMultiprocessor(&per_cu, (const void*)fwd, NTHR, LDS_BYTES); (void)hipGetLastError();
        if (per_cu < 1) fprintf(stderr, "kernel_launch: occupancy query says %d\n", per_cu);
        grid = cus;
    }
    if (grid < 0) return;
    (void)hipMemsetAsync((char*)d_ws + WS_CTL, 0, CTL_BYTES, stream);
    Params p{};
    for (int i = 0; i < 40; ++i) p.in[i] = (const float*)d_in[i];
    p.out = (float*)d_out; p.ws = (unsigned char*)d_ws;
#if MK_MULTI
    for (int ph = 0; ph < NPH; ++ph) { p.ph_lo = ph; p.ph_hi = ph + 1; hipLaunchKernelGGL(fwd, dim3(grid), dim3(NTHR), LDS_BYTES, stream, p); }
#else
    p.ph_lo = 0; p.ph_hi = NPH;
    hipLaunchKernelGGL(fwd, dim3(grid), dim3(NTHR), LDS_BYTES, stream, p);
#endif
}
```

```cpp
#include <hip/hip_runtime.h>
#include <cstdio>
#include <cstdint>

#ifndef PROBE_CLK
#define PROBE_CLK 0
#endif
#ifndef PROBE_LO
#define PROBE_LO -1
#define PROBE_HI -1
#endif
#ifndef WGM_WIDE
#define WGM_WIDE 4
#define WGM_NARROW 4
#endif
#ifndef MK_MULTI
#define MK_MULTI 0
#endif

#define LAS __attribute__((address_space(3)))
typedef unsigned short bf16_t;
typedef short bf16x8 __attribute__((ext_vector_type(8)));
typedef short s16x4 __attribute__((ext_vector_type(4)));
typedef float f32x4 __attribute__((ext_vector_type(4)));
typedef float f32x2 __attribute__((ext_vector_type(2)));
typedef unsigned u32x4 __attribute__((ext_vector_type(4)));
typedef unsigned u32x2 __attribute__((ext_vector_type(2)));

constexpr int D = 1024, NB = 32, SEQ = 2048, CTXL = 256;
constexpr int RL = NB * SEQ, RC = NB * CTXL, RA = RL + RC;
constexpr int DRNN = 1280, LBW = 160, DSGU = 2048, DFF = 3584, NE = 8;
constexpr int MODW = 6 * D;
constexpr int MPAD = 75776;
constexpr float NORM_EPS = 1e-6f;
constexpr int NWAVES = 8, NTHR = 512;

constexpr size_t MiB = 1u << 20;
constexpr size_t WS_CTL = 0, CTL_BYTES = 1 * MiB;
constexpr size_t WS_MODV = 1 * MiB;
constexpr size_t WS_HCTX = 5 * MiB;
constexpr size_t WS_LRU_WIN = 37 * MiB;
constexpr size_t WS_LRU_WA = WS_LRU_WIN + 5 * MiB;
constexpr size_t WS_LRU_WI = WS_LRU_WA + 1 * MiB;
constexpr size_t WS_LRU_WOUT = WS_LRU_WI + 1 * MiB;
constexpr size_t WS_SGU_WIN = WS_LRU_WOUT + 3 * MiB;
constexpr size_t WS_SGU_WS = WS_SGU_WIN + 8 * MiB;
constexpr size_t WS_SGU_WOUT = WS_SGU_WS + 1 * MiB;
constexpr size_t WS_POOL_W = WS_SGU_WOUT + 4 * MiB;
constexpr size_t WS_NA_WQKV = WS_POOL_W + 1 * MiB;
constexpr size_t WS_NA_WO = WS_NA_WQKV + 6 * MiB;
constexpr size_t WS_FFN_W13 = WS_NA_WO + 2 * MiB;
constexpr size_t WS_FFN_W2 = WS_FFN_W13 + 28 * MiB;
constexpr size_t WS_MOE_W13 = WS_FFN_W2 + 14 * MiB;
constexpr size_t WS_MOE_W2 = WS_MOE_W13 + 112 * MiB;
constexpr size_t WS_ROUTE = WS_MOE_W2 + 56 * MiB;
constexpr size_t WS_H = WS_ROUTE + 4 * MiB;
constexpr size_t WS_BIG = WS_H + 148 * MiB;
constexpr size_t WS_END = WS_BIG + 744 * MiB;
constexpr size_t WS_DBG = WS_END;
static_assert(WS_MOE_W13 == 111 * MiB && WS_BIG == 431 * MiB && WS_END == 1175 * MiB, "ws map");
constexpr size_t RT_E = 0;
constexpr size_t RT_W = 512 * 1024;
constexpr size_t RT_TOK = 1280 * 1024;
constexpr size_t RT_GW = 2048 * 1024;
constexpr size_t RT_ST = 2816 * 1024;
constexpr size_t RT_P1 = 3456 * 1024;
static_assert(RT_W >= (size_t)RA * 4 && RT_TOK - RT_W >= (size_t)RA * 8 && RT_GW - RT_TOK >= (size_t)2 * MPAD * 4 && RT_ST - RT_GW >= (size_t)2 * MPAD * 4 && RT_P1 - RT_ST >= (size_t)RA * 8 && 4 * MiB - RT_P1 >= (size_t)RA * 4, "route map");
constexpr size_t BG_XG = 0, BG_Y = 360 * MiB;
constexpr size_t BG_HID = 0;
constexpr size_t BG_Z = 0;
constexpr size_t BG_FS1 = 0, BG_MHID = 0;
constexpr size_t BG_MW2 = 576 * MiB;
constexpr size_t BG_PD = 0;
constexpr size_t BG_QKV = 0, BG_O = 432 * MiB;
static_assert(BG_MHID + (size_t)MPAD * DFF * 2 <= BG_MW2 && BG_O + (size_t)RL * D * 2 <= BG_MW2 && BG_Y + (size_t)RA * DRNN * 2 <= BG_MW2 && BG_MW2 + 168 * MiB <= 744 * MiB, "big map");
constexpr int CW_BAR = 4096;
constexpr int CW_CNT = 16384;
constexpr int CW_CUR = 16384 + 256;
constexpr int CW_DBG = 32768;
constexpr int CW_CVTQ = 20480;

constexpr int LDS_BYTES = 163840;
constexpr int LDS_AUX = 131072;
constexpr int LDS_CTL = LDS_BYTES - 256;

__device__ __forceinline__ float bf2f(unsigned b) { return __uint_as_float(b << 16); }
__device__ __forceinline__ unsigned pk2(float lo, float hi) { unsigned r; asm volatile("v_cvt_pk_bf16_f32 %0, %1, %2" : "=v"(r) : "v"(lo), "v"(hi)); return r; }
__device__ __forceinline__ float lo_bf(unsigned w) { return __uint_as_float(w << 16); }
__device__ __forceinline__ float hi_bf(unsigned w) { return __uint_as_float(w & 0xffff0000u); }
template <int CTRL> __device__ __forceinline__ float dpp_f(float v) { return __int_as_float(__builtin_amdgcn_update_dpp(0, __float_as_int(v), CTRL, 0xf, 0xf, true)); }
__device__ __forceinline__ float wave_sum(float v) {
    v += dpp_f<0xB1>(v);
    v += dpp_f<0x4E>(v);
    v += dpp_f<0x141>(v);
    v += dpp_f<0x140>(v);
    const int iv = __float_as_int(v);
    return (__int_as_float(__builtin_amdgcn_readlane(iv, 0)) + __int_as_float(__builtin_amdgcn_readlane(iv, 16))) + (__int_as_float(__builtin_amdgcn_readlane(iv, 32)) + __int_as_float(__builtin_amdgcn_readlane(iv, 48)));
}
__device__ __forceinline__ float sigmoid_f(float x) { return __builtin_amdgcn_rcpf(1.0f + __builtin_amdgcn_exp2f(-1.4426950408889634f * x)); }
__device__ __forceinline__ float silu_f(float x) { return x * __builtin_amdgcn_rcpf(1.0f + __builtin_amdgcn_exp2f(-1.4426950408889634f * x)); }
__device__ __forceinline__ float gelu_tanh_f(float x) { const float z2 = -2.0f * 1.4426950408889634f * 0.7978845608028654f * (x + 0.044715f * x * x * x); return x * __builtin_amdgcn_rcpf(1.0f + __builtin_amdgcn_exp2f(z2)); }
__device__ __forceinline__ unsigned lds_add(LAS unsigned* p, unsigned v) { return __hip_atomic_fetch_add(p, v, __ATOMIC_RELAXED, __HIP_MEMORY_SCOPE_WORKGROUP); }
#define LDS_WAIT() asm volatile("s_waitcnt lgkmcnt(0)" ::: "memory")
#define VM_WAIT() asm volatile("s_waitcnt vmcnt(0)" ::: "memory")

#define XB_TMO      128
#define XB_XCNT(j)  (256  + 64 * (j))
#define XB_XSUB(j)  (1280 + 64 * (j))
#define XB_XGEN(j)  (2304 + 64 * (j))
#define XB_TOP      3328
#define XB_TOPGEN   3392
#define XCD_BAR_WORDS 3456
#define XB_SPIN_CAP (1u << 18)
__device__ __forceinline__ unsigned xb_ld(unsigned* p)              { return __hip_atomic_load(p, __ATOMIC_RELAXED, __HIP_MEMORY_SCOPE_AGENT); }
__device__ __forceinline__ unsigned xb_add(unsigned* p, unsigned v) { return __hip_atomic_fetch_add(p, v, __ATOMIC_RELAXED, __HIP_MEMORY_SCOPE_AGENT); }
__device__ __forceinline__ unsigned xb_xcc_id() { return (unsigned)__builtin_amdgcn_s_getreg((3 << 11) | 20) & 0xFu; }
#define XB_SPIN(cond, bar) do { unsigned _sp = 0; while (cond) { __builtin_amdgcn_s_sleep(1); \
    if ((++_sp & 255u) == 0u) { if (xb_ld(&(bar)[XB_TMO])) break; if (_sp > XB_SPIN_CAP) { atomicAdd(&(bar)[XB_TMO], 1u); break; } } } } while (0)
struct XcdBarrier { unsigned* bar; unsigned x; volatile LAS unsigned* st; };
__device__ __forceinline__ XcdBarrier xcd_barrier_post(unsigned* bar, volatile LAS unsigned* st) {
    XcdBarrier b; b.bar = bar; b.x = xb_xcc_id(); b.st = st;
    if (threadIdx.x == 0) (void)xb_add(&bar[XB_XCNT(b.x)], 1u);
    return b;
}
__device__ __forceinline__ void xcd_barrier_complete(unsigned* bar, unsigned x, unsigned& nloc, unsigned& nx) {
    const unsigned G = gridDim.x * gridDim.y * gridDim.z;
    unsigned sum, cnt, mine, sp = 0u;
    for (;;) {
        sum = 0u; cnt = 0u; mine = 0u;
#pragma unroll
        for (unsigned j = 0; j < 16; ++j) { const unsigned c = xb_ld(&bar[XB_XCNT(j)]); sum += c; cnt += (c > 0u) ? 1u : 0u; mine = (j == x) ? c : mine; }
        if (sum == G) break;
        __builtin_amdgcn_s_sleep(1);
        if ((++sp & 255u) == 0u) { if (xb_ld(&bar[XB_TMO])) break; if (sp > XB_SPIN_CAP) { atomicAdd(&bar[XB_TMO], 1u); break; } }
    }
    nloc = mine > 0u ? mine : 1u; nx = cnt > 0u ? cnt : 1u;
}
__device__ __forceinline__ void xcd_barrier(const XcdBarrier& b) {
    asm volatile("s_waitcnt vmcnt(0)" ::: "memory");
    __syncthreads();
    if (threadIdx.x == 0) {
        unsigned* bar = b.bar;
        __builtin_amdgcn_s_waitcnt(0);
        unsigned nloc = b.st[0], nx = b.st[1];
        if (nloc == 0u) { xcd_barrier_complete(bar, b.x, nloc, nx); b.st[0] = nloc; b.st[1] = nx; }
        const unsigned old = xb_add(&bar[XB_XSUB(b.x)], 1u);
        const unsigned gen = old / nloc;
        if (old + 1u == (gen + 1u) * nloc) {
            __builtin_amdgcn_fence(__ATOMIC_RELEASE, "agent");
            asm volatile("s_waitcnt vmcnt(0)" ::: "memory");
            const unsigned og = xb_add(&bar[XB_TOP], 1u);
            const unsigned tg = og / nx;
            if (og + 1u == (tg + 1u) * nx) xb_add(&bar[XB_TOPGEN], 1u);
            else XB_SPIN(xb_ld(&bar[XB_TOPGEN]) == tg, bar);
            __builtin_amdgcn_fence(__ATOMIC_ACQUIRE, "agent");
            xb_add(&bar[XB_XGEN(b.x)], 1u);
            asm volatile("s_waitcnt vmcnt(0)" ::: "memory");
        } else {
            XB_SPIN(xb_ld(&bar[XB_XGEN(b.x)]) == gen, bar);
            __builtin_amdgcn_fence(__ATOMIC_ACQUIRE, "agent");
            asm volatile("s_waitcnt vmcnt(0)" ::: "memory");
        }
    }
    __syncthreads();
}

struct Params {
    const float* in[40];
    float* out; unsigned char* ws;
    int ph_lo, ph_hi;
};
enum In { I_X = 0, I_C, I_CTX, I_CCTX, I_MODW, I_MODB, I_N1G, I_N2G, I_LRU_WIN, I_LRU_CW, I_LRU_CB, I_LRU_WA, I_LRU_BA, I_LRU_WI, I_LRU_BI, I_LRU_LAM, I_LRU_WOUT,
          I_SGU_WIN, I_SGU_BIN, I_SGU_LNG, I_SGU_LNB, I_SGU_WS, I_SGU_BS, I_SGU_WOUT, I_POOL_W, I_POOL_B, I_POOL_S, I_NA_WQKV, I_NA_QG, I_NA_KG, I_NA_RPB, I_NA_WO,
          I_FFN_W1, I_FFN_W3, I_FFN_W2, I_MOE_WR, I_MOE_BR, I_MOE_W1, I_MOE_W3, I_MOE_W2 };

namespace pg8 {
constexpr int BM = 256, BK = 64, HALF = 128, HTB = HALF * BK * 2, STAGE_BYTES = 8 * HTB, NXCD = 8, WGM = 4;
__device__ __forceinline__ int lds_byte(int r, int c) { const int st = (r >> 4) * 2 + (c >> 5), rr = r & 15, cc = c & 31, ob = rr * 64 + cc * 2; return st * 1024 + (ob ^ (((ob >> 9) & 1) << 5)); }
__device__ __forceinline__ void stage_rc(int b, int& R, int& C) { const int st = b / 1024, sb = b % 1024, swz = sb ^ (((sb >> 9) & 1) << 5); R = (st >> 1) * 16 + swz / 64; C = (st & 1) * 32 + (swz % 64) / 2; }
__device__ __forceinline__ int perm32(int rho) { const int n = rho >> 4, i = rho & 15; return 8 * (i >> 2) + 4 * n + (i & 3); }

struct Unit { int pm, pn, e; const char* a; const char* b; };
struct Sched {
    int nM, nN, G, c;
    const char* A; size_t a_tile, a_pn;
    const char* B; size_t b_tile, b_e;
    const LAS int* tstart;
    int wgm = WGM;
    bool rev = false;
    __device__ __forceinline__ bool next(int i, Unit& u) const {
        long L = (long)i * G + c; if (L >= (long)nM * nN) return false;
        if (rev) L = (long)nM * nN - 1 - L;
        int e = 0, t0 = 0, nMe = nM, wgid = (int)L;
        if (tstart) {
#pragma unroll
            for (int k = 1; k < 8; ++k) e += (wgid >= tstart[k] * nN) ? 1 : 0;
            t0 = tstart[e]; nMe = tstart[e + 1] - t0; wgid -= t0 * nN;
        }
        const int nwg = nMe * nN;
        { const int q = nwg / NXCD, r = nwg % NXCD, xcd = wgid % NXCD, off = wgid / NXCD; wgid = (xcd < r ? xcd * (q + 1) : r * (q + 1) + (xcd - r) * q) + off; }
        const int nig = wgm * nN, gid = wgid / nig, fm = gid * wgm, gsz = (nMe - fm) < wgm ? (nMe - fm) : wgm;
        u.pm = t0 + fm + ((wgid % nig) % gsz); u.pn = (wgid % nig) / gsz;
        u.e = e; u.a = A + (size_t)u.pm * a_tile + (size_t)u.pn * a_pn; u.b = B + (size_t)e * b_e + (size_t)u.pn * b_tile;
        return true;
    }
};

template <class Epi, bool GATHER = false>
__device__ __forceinline__ void gemm_phase(LAS unsigned char* lds, const int lda, const int K, const Sched& S, const Epi& E, const int* gidx = nullptr, LAS int* ixt = nullptr) {
    const int tid = threadIdx.x, wid = __builtin_amdgcn_readfirstlane(tid >> 6), lane = tid & 63, wr = wid >> 2, wc = wid & 3, fr = lane & 15, fq = lane >> 4;
    const int nt = K / BK;
    unsigned voffA[2], voffB[2]; int Rl[2]; unsigned cb2[2];
#pragma unroll
    for (int i = 0; i < 2; ++i) { int R, C; stage_rc(tid * 16 + i * 8192, R, C); const int Rb = Epi::PERM ? ((R & ~31) + perm32(R & 31)) : R;
        voffA[i] = (unsigned)(R * lda + C) * 2u; voffB[i] = (unsigned)(Rb * K + C) * 2u; Rl[i] = R; cb2[i] = (unsigned)C * 2u; }
    unsigned cOff[2][2] = {{0u, 0u}, {0u, 0u}}, nOff[2][2] = {{0u, 0u}, {0u, 0u}};
    const size_t kstep = (size_t)(BK * 2);
    const size_t hstepA = (size_t)HALF * lda * 2, hstepB = (size_t)HALF * K * 2;
    const unsigned ldsw = (unsigned)wid * 1024u;
    const int aoff = lds_byte(wr * 64 + fr, fq * 8), boff = lds_byte(wc * 32 + fr, fq * 8);
#define PG8_SA(b, h) (((b) * 2 + (h)) * HTB)
#define PG8_SB(b, h) ((4 + (b) * 2 + (h)) * HTB)
#define PG8_STAGE(bufoff, gbase, voff) do { _Pragma("unroll") for (int _i = 0; _i < 2; ++_i) \
        __builtin_amdgcn_global_load_lds((const unsigned*)((const char*)(gbase) + (voff)[_i]), (LAS unsigned*)(lds + (bufoff) + ldsw + _i * 8192), 16, 0, 0); } while (0)
#define PG8_STAGE_A(bufoff, kptr, h, usenext) do { if constexpr (GATHER) { const unsigned o_[2] = {(usenext) ? nOff[h][0] : cOff[h][0], (usenext) ? nOff[h][1] : cOff[h][1]}; PG8_STAGE(bufoff, kptr, o_); } \
        else PG8_STAGE(bufoff, (kptr) + (h) * hstepA, voffA); } while (0)
#define PG8_LDA(dst, b, h) do { _Pragma("unroll") for (int m = 0; m < 4; ++m) _Pragma("unroll") for (int k = 0; k < 2; ++k) dst[m][k] = *(const LAS bf16x8*)(lds + PG8_SA(b, h) + aoff + m * 2048 + k * 1024); } while (0)
#define PG8_LDB(dst, b, h) do { _Pragma("unroll") for (int n = 0; n < 2; ++n) _Pragma("unroll") for (int k = 0; k < 2; ++k) dst[n][k] = *(const LAS bf16x8*)(lds + PG8_SB(b, h) + boff + n * 2048 + k * 1024); } while (0)
#define PG8_MMA(ai, bj, At, Bt) do { __builtin_amdgcn_s_setprio(1); _Pragma("unroll") for (int m = 0; m < 4; ++m) _Pragma("unroll") for (int n = 0; n < 2; ++n) _Pragma("unroll") for (int k = 0; k < 2; ++k) \
        acc[ai][bj][m][n] = __builtin_amdgcn_mfma_f32_16x16x32_bf16(Bt[n][k], At[m][k], acc[ai][bj][m][n], 0, 0, 0); __builtin_amdgcn_s_setprio(0); } while (0)
#define PG8_WAIT_V(n) asm volatile("s_waitcnt vmcnt(" #n ")" ::: "memory")
#define PG8_WAIT_L(n) asm volatile("s_waitcnt lgkmcnt(" #n ")" ::: "memory")
#define PG8_BAR __builtin_amdgcn_s_barrier()
#define PG8_SCHED __builtin_amdgcn_sched_barrier(0)
    Unit cur, nxt; int ui = 0;
    if (!S.next(0, cur)) return;
    f32x4 acc[2][2][4][2];
#pragma unroll
    for (int a = 0; a < 2; ++a)
#pragma unroll
        for (int b = 0; b < 2; ++b)
#pragma unroll
            for (int m = 0; m < 4; ++m)
#pragma unroll
                for (int n = 0; n < 2; ++n) acc[a][b][m][n] = (f32x4){0.f, 0.f, 0.f, 0.f};
    bf16x8 At[4][2], B0[2][2], B1[2][2];
    const char* cA = cur.a; const char* cB = cur.b;
    if constexpr (GATHER) {
#pragma unroll
        for (int h = 0; h < 2; ++h)
#pragma unroll
            for (int i = 0; i < 2; ++i) { const int ix = gidx[cur.pm * BM + h * HALF + Rl[i]]; cOff[h][i] = (unsigned)(ix < 0 ? 0 : ix) * (unsigned)(lda * 2) + cb2[i]; }
    }
    PG8_STAGE(PG8_SB(0, 0), cB, voffB); PG8_STAGE(PG8_SB(0, 1), cB + hstepB, voffB); PG8_STAGE_A(PG8_SA(0, 0), cA, 0, false); PG8_STAGE_A(PG8_SA(0, 1), cA, 1, false);
    if (wr == 1) PG8_BAR;
    PG8_WAIT_V(2); PG8_BAR;
    PG8_STAGE(PG8_SB(1, 0), cB + kstep, voffB); PG8_STAGE_A(PG8_SA(1, 0), cA + kstep, 0, false); PG8_STAGE(PG8_SB(1, 1), cB + hstepB + kstep, voffB);
    PG8_WAIT_V(6); PG8_BAR;
    for (;;) {
        const bool has_next = S.next(ui + 1, nxt);
        const char* nA = has_next ? nxt.a : cA; const char* nB = has_next ? nxt.b : cB;
        if constexpr (GATHER) { if (has_next && wid == 0) {
#pragma unroll
            for (int k = 0; k < 4; ++k) __builtin_amdgcn_global_load_lds((const unsigned*)(gidx + nxt.pm * BM + k * 64 + lane), (LAS unsigned*)(ixt + ((ui + 1) & 1) * BM + k * 64), 4, 0, 0); } }
#pragma unroll 1
        for (int t = 0; t < nt; t += 2) {
            const bool last = (t == nt - 2); const bool un = last && has_next;
            if constexpr (GATHER) { if (un) {
#pragma unroll
                for (int h = 0; h < 2; ++h)
#pragma unroll
                    for (int i = 0; i < 2; ++i) { const int ix = ixt[((ui + 1) & 1) * BM + h * HALF + Rl[i]]; nOff[h][i] = (unsigned)(ix < 0 ? 0 : ix) * (unsigned)(lda * 2) + cb2[i]; } } }
            const char* a1 = cA + (size_t)(t + 1) * kstep;
            const char* a2 = last ? nA : cA + (size_t)(t + 2) * kstep; const char* b2 = last ? nB : cB + (size_t)(t + 2) * kstep;
            const char* a3 = a2 + kstep; const char* b3 = b2 + kstep;
            PG8_LDB(B0, 0, 0); PG8_LDB(B1, 0, 1); PG8_SCHED; PG8_LDA(At, 0, 0); PG8_STAGE_A(PG8_SA(1, 1), a1, 1, false);
            PG8_WAIT_V(8); PG8_WAIT_L(0); PG8_BAR; PG8_MMA(0, 0, At, B0); PG8_MMA(0, 1, At, B1); PG8_BAR; PG8_SCHED;
            PG8_LDA(At, 0, 1); PG8_STAGE(PG8_SB(0, 0), b2, voffB); PG8_STAGE(PG8_SB(0, 1), b2 + hstepB, voffB); PG8_STAGE_A(PG8_SA(0, 0), a2, 0, un);
            PG8_WAIT_V(8); PG8_WAIT_L(0); PG8_BAR; PG8_MMA(1, 0, At, B0); PG8_MMA(1, 1, At, B1); PG8_BAR; PG8_SCHED;
            PG8_LDB(B0, 1, 0); PG8_LDB(B1, 1, 1); PG8_SCHED; PG8_LDA(At, 1, 0); PG8_STAGE_A(PG8_SA(0, 1), a2, 1, un);
            PG8_WAIT_V(8); PG8_WAIT_L(0); PG8_BAR; PG8_MMA(0, 0, At, B0); PG8_MMA(0, 1, At, B1); PG8_BAR; PG8_SCHED;
            PG8_LDA(At, 1, 1); PG8_STAGE(PG8_SB(1, 0), b3, voffB); PG8_STAGE(PG8_SB(1, 1), b3 + hstepB, voffB); PG8_STAGE_A(PG8_SA(1, 0), a3, 0, un);
            PG8_WAIT_V(8); PG8_WAIT_L(0); PG8_BAR; PG8_MMA(1, 0, At, B0); PG8_MMA(1, 1, At, B1); PG8_BAR; PG8_SCHED;
        }
        if (wr == 0) PG8_BAR;
        E(acc, cur, wr, wc, fr, fq);
        if (!has_next) break;
#pragma unroll
        for (int a = 0; a < 2; ++a)
#pragma unroll
            for (int b = 0; b < 2; ++b)
#pragma unroll
                for (int m = 0; m < 4; ++m)
#pragma unroll
                    for (int n = 0; n < 2; ++n) acc[a][b][m][n] = (f32x4){0.f, 0.f, 0.f, 0.f};
        cur = nxt; cA = nA; cB = nB; ++ui;
        if constexpr (GATHER) {
#pragma unroll
            for (int h = 0; h < 2; ++h)
#pragma unroll
                for (int i = 0; i < 2; ++i) cOff[h][i] = nOff[h][i]; }
        if (wr == 1) PG8_BAR;
    }
    PG8_WAIT_V(0);
    PG8_BAR;
#undef PG8_SA
#undef PG8_SB
#undef PG8_STAGE
#undef PG8_LDA
#undef PG8_STAGE_A
#undef PG8_LDB
#undef PG8_MMA
#undef PG8_WAIT_V
#undef PG8_WAIT_L
#undef PG8_BAR
#undef PG8_SCHED
}

template <int ACT> struct EpiBf16 {
    static constexpr bool PERM = true;
    bf16_t* O; int ldc; const float* bias;
    __device__ __forceinline__ void operator()(const f32x4 (&acc)[2][2][4][2], const Unit& u, int wr, int wc, int fr, int fq) const {
        asm volatile("" : "+v"(fr), "+v"(fq));
        const int row0 = u.pm * BM + wr * 64 + fr; const int col0 = u.pn * BM + wc * 32 + 8 * fq;
        f32x4 bv[2][2];
#pragma unroll
        for (int bj = 0; bj < 2; ++bj)
#pragma unroll
            for (int n = 0; n < 2; ++n) bv[bj][n] = bias ? *(const f32x4*)(bias + col0 + bj * HALF + 4 * n) : (f32x4){0.f, 0.f, 0.f, 0.f};
#pragma unroll
        for (int ai = 0; ai < 2; ++ai)
#pragma unroll
            for (int m = 0; m < 4; ++m) { bf16_t* rowp = O + (size_t)(row0 + ai * HALF + m * 16) * ldc + col0;
#pragma unroll
                for (int bj = 0; bj < 2; ++bj) { f32x4 v0 = acc[ai][bj][m][0] + bv[bj][0], v1 = acc[ai][bj][m][1] + bv[bj][1];
                    if (ACT == 1) {
#pragma unroll
                        for (int j = 0; j < 4; ++j) { v0[j] = gelu_tanh_f(v0[j]); v1[j] = gelu_tanh_f(v1[j]); } }
                    u32x4 w; w.x = pk2(v0[0], v0[1]); w.y = pk2(v0[2], v0[3]); w.z = pk2(v1[0], v1[1]); w.w = pk2(v1[2], v1[3]);
                    *(u32x4*)(rowp + bj * HALF) = w; } }
    }
};
struct EpiSwiGLU {
    static constexpr bool PERM = true;
    bf16_t* H; int ldh;
    __device__ __forceinline__ void operator()(const f32x4 (&acc)[2][2][4][2], const Unit& u, int wr, int wc, int fr, int fq) const {
        asm volatile("" : "+v"(fr), "+v"(fq));
        const int row0 = u.pm * BM + wr * 64 + fr; const int col0 = u.pn * HALF + wc * 32 + 8 * fq;
#pragma unroll
        for (int ai = 0; ai < 2; ++ai)
#pragma unroll
            for (int m = 0; m < 4; ++m) { bf16_t* rowp = H + (size_t)(row0 + ai * HALF + m * 16) * ldh + col0;
                f32x4 h0, h1;
#pragma unroll
                for (int j = 0; j < 4; ++j) { h0[j] = silu_f(acc[ai][0][m][0][j]) * acc[ai][1][m][0][j]; h1[j] = silu_f(acc[ai][0][m][1][j]) * acc[ai][1][m][1][j]; }
                u32x4 w; w.x = pk2(h0[0], h0[1]); w.y = pk2(h0[2], h0[3]); w.z = pk2(h1[0], h1[1]); w.w = pk2(h1[2], h1[3]);
                *(u32x4*)rowp = w; }
    }
};
template <bool HAS_BS, bool SRC32> struct EpiResidT {
    static constexpr bool PERM = false;
    const void* src_lat; const void* src_ctx; bf16_t* dst_lat; bf16_t* dst_ctx; const float* gate;
    const float* bias; const float* cscale;
    __device__ __forceinline__ void operator()(const f32x4 (&acc)[2][2][4][2], const Unit& u, int wr, int wc, int fr, int fq) const {
        asm volatile("" : "+v"(fr), "+v"(fq));
        const bool isctx = u.pm >= RL / BM; const int mb = isctx ? 32 : (u.pm >> 3);
        const size_t trow = isctx ? (size_t)(u.pm - RL / BM) * BM : (size_t)u.pm * BM;
        const float* s32 = (const float*)(isctx ? src_ctx : src_lat) + trow * D; const bf16_t* s16 = (const bf16_t*)(isctx ? src_ctx : src_lat) + trow * D;
        bf16_t* dst = (isctx ? dst_ctx : dst_lat) + trow * D;
        const float* g = gate + (size_t)mb * MODW;
        const int col0 = u.pn * BM + wc * 32 + 4 * fq;
        f32x4 gv[2][2], bv[2][2];
#pragma unroll
        for (int bj = 0; bj < 2; ++bj)
#pragma unroll
            for (int n = 0; n < 2; ++n) { const int c = col0 + bj * HALF + n * 16; gv[bj][n] = *(const f32x4*)(g + c); bv[bj][n] = (f32x4){0.f, 0.f, 0.f, 0.f};
                if (HAS_BS) { gv[bj][n] = gv[bj][n] * *(const f32x4*)(cscale + c); bv[bj][n] = *(const f32x4*)(bias + c); } }
        constexpr int MB = HAS_BS ? 2 : 4;
#pragma unroll
        for (int ai = 0; ai < 2; ++ai)
#pragma unroll
            for (int m0 = 0; m0 < 4; m0 += MB) {
                f32x4 rs[MB][2][2];
#pragma unroll
                for (int mi = 0; mi < MB; ++mi) { const unsigned off = (unsigned)((ai * HALF + wr * 64 + (m0 + mi) * 16 + fr) * D + col0);
#pragma unroll
                    for (int bj = 0; bj < 2; ++bj)
#pragma unroll
                        for (int n = 0; n < 2; ++n) { if (SRC32) rs[mi][bj][n] = *(const f32x4*)(s32 + off + bj * HALF + n * 16);
                            else { const u32x2 q = *(const u32x2*)(s16 + off + bj * HALF + n * 16); rs[mi][bj][n] = (f32x4){lo_bf(q.x), hi_bf(q.x), lo_bf(q.y), hi_bf(q.y)}; } } }
#pragma unroll
                for (int mi = 0; mi < MB; ++mi) { const int m = m0 + mi; const unsigned off = (unsigned)((ai * HALF + wr * 64 + m * 16 + fr) * D + col0);
#pragma unroll
                    for (int bj = 0; bj < 2; ++bj)
#pragma unroll
                        for (int n = 0; n < 2; ++n) { const f32x4 o = rs[mi][bj][n] + gv[bj][n] * (HAS_BS ? (acc[ai][bj][m][n] + bv[bj][n]) : acc[ai][bj][m][n]);
                            u32x2 w; w.x = pk2(o[0], o[1]); w.y = pk2(o[2], o[3]); *(u32x2*)(dst + off + bj * HALF + n * 16) = w; } }
            }
    }
};
typedef EpiResidT<false, false> EpiResid; typedef EpiResidT<true, false> EpiResidBS; typedef EpiResidT<false, true> EpiResidX;
template <bool OUT32> struct EpiMoeDownT {
    static constexpr bool PERM = false;
    bf16_t* h_lat; bf16_t* h_ctx; float* out32; const float* gate; const int* tok; const float* gw;
    __device__ __forceinline__ void operator()(const f32x4 (&acc)[2][2][4][2], const Unit& u, int wr, int wc, int fr, int fq) const {
        asm volatile("" : "+v"(fr), "+v"(fq));
        const int col0 = u.pn * BM + wc * 32 + 4 * fq;
        int tk[2][4]; float wg[2][4];
#pragma unroll
        for (int ai = 0; ai < 2; ++ai)
#pragma unroll
            for (int m = 0; m < 4; ++m) { const int pos = u.pm * BM + ai * HALF + wr * 64 + m * 16 + fr; tk[ai][m] = tok[pos]; wg[ai][m] = gw[pos]; }
#pragma unroll
        for (int ai = 0; ai < 2; ++ai)
#pragma unroll
            for (int mp = 0; mp < 2; ++mp) {
                u32x2 rs[2][2][2]; f32x4 gg[2][2][2]; size_t ro[2]; bool cx[2];
#pragma unroll
                for (int mi = 0; mi < 2; ++mi) { const int t = tk[ai][2 * mp + mi]; const int tt = t >= 0 ? t : 0; cx[mi] = tt >= RL; const int mb = cx[mi] ? 32 : (tt >> 11);
                    ro[mi] = (size_t)(cx[mi] ? tt - RL : tt) * D + col0; const bf16_t* hp = (cx[mi] ? h_ctx : h_lat) + ro[mi]; const float* g = gate + (size_t)mb * MODW + col0;
#pragma unroll
                    for (int bj = 0; bj < 2; ++bj)
#pragma unroll
                        for (int n = 0; n < 2; ++n) { rs[mi][bj][n] = *(const u32x2*)(hp + bj * HALF + n * 16); gg[mi][bj][n] = *(const f32x4*)(g + bj * HALF + n * 16); } }
#pragma unroll
                for (int mi = 0; mi < 2; ++mi) { const int m = 2 * mp + mi;
                    if (tk[ai][m] >= 0) { const float w = wg[ai][m];
#pragma unroll
                        for (int bj = 0; bj < 2; ++bj)
#pragma unroll
                            for (int n = 0; n < 2; ++n) { const u32x2 q = rs[mi][bj][n]; const f32x4 o = (f32x4){lo_bf(q.x), hi_bf(q.x), lo_bf(q.y), hi_bf(q.y)} + gg[mi][bj][n] * (acc[ai][bj][m][n] * w);
                                if (OUT32) *(f32x4*)(out32 + ro[mi] + bj * HALF + n * 16) = o;
                                else { u32x2 wv; wv.x = pk2(o[0], o[1]); wv.y = pk2(o[2], o[3]); *(u32x2*)((cx[mi] ? h_ctx : h_lat) + ro[mi] + bj * HALF + n * 16) = wv; } } } }
            }
    }
};
typedef EpiMoeDownT<false> EpiMoeDown; typedef EpiMoeDownT<true> EpiMoeDownOut;
}

struct Frame {
    LAS unsigned char* lds;
    int tid, lane, wave, bid, G;
    const Params* p;
    unsigned char* ws; unsigned* ctl;
    float* modv; bf16_t* hlat; bf16_t* hctx; bf16_t* U;
};
#define WSP(T, off) ((T*)(F.ws + (off)))
__device__ __forceinline__ const float* INP(const Frame& F, int i) { return F.p->in[i]; }

__device__ __forceinline__ void cvt_item(const float* W, int K, int N, bf16_t* WT, int mode, LAS float* scr, int item, int lane) {
    const int nblk = N / 32, kb = item / nblk, nb = item % nblk, k0 = 64 * kb, n0 = 32 * nb;
#pragma unroll 8
    for (int i = 0; i < 32; ++i) { const int kk = 2 * i + (lane >> 5); scr[kk * 33 + (lane & 31)] = W[(size_t)(k0 + kk) * N + n0 + (lane & 31)]; }
    LDS_WAIT();
    const int c = lane & 7;
#pragma unroll
    for (int j = 0; j < 4; ++j) { const int n = (lane >> 3) + 8 * j; const LAS float* s = scr + (8 * c) * 33 + n;
        u32x4 o; o.x = pk2(s[0 * 33], s[1 * 33]); o.y = pk2(s[2 * 33], s[3 * 33]); o.z = pk2(s[4 * 33], s[5 * 33]); o.w = pk2(s[6 * 33], s[7 * 33]);
        const int nn = n0 + n; const int drow = mode == 0 ? nn : (256 * (nn >> 7) + (nn & 127) + (mode == 2 ? 128 : 0));
        *(u32x4*)(WT + (size_t)drow * K + k0 + 8 * c) = o; }
    LDS_WAIT();
}
struct CvtJob { const float* src; bf16_t* dst; int K, N, mode; };
__device__ __forceinline__ CvtJob cvt_small_job(const Frame& F, int j) {
    switch (j) {
        case 0: return CvtJob{INP(F, I_LRU_WIN), WSP(bf16_t, WS_LRU_WIN), 1024, 2560, 0};
        case 1: return CvtJob{INP(F, I_LRU_WOUT), WSP(bf16_t, WS_LRU_WOUT), 1280, 1024, 0};
        case 2: return CvtJob{INP(F, I_FFN_W1), WSP(bf16_t, WS_FFN_W13), 1024, DFF, 1};
        case 3: return CvtJob{INP(F, I_FFN_W3), WSP(bf16_t, WS_FFN_W13), 1024, DFF, 2};
        case 4: return CvtJob{INP(F, I_FFN_W2), WSP(bf16_t, WS_FFN_W2), DFF, 1024, 0};
        case 5: return CvtJob{INP(F, I_SGU_WIN), WSP(bf16_t, WS_SGU_WIN), 1024, 4096, 0};
        case 6: return CvtJob{INP(F, I_SGU_WOUT), WSP(bf16_t, WS_SGU_WOUT), 2048, 1024, 0};
        case 7: case 8: case 9: case 10: return CvtJob{INP(F, I_POOL_W) + (size_t)(j - 7) * 65536, WSP(bf16_t, WS_POOL_W) + (size_t)(j - 7) * 65536, 256, 256, 0};
        case 11: return CvtJob{INP(F, I_FFN_W1) + (size_t)D * DFF, WSP(bf16_t, WS_FFN_W13) + (size_t)2 * DFF * D, 1024, DFF, 1};
        case 12: return CvtJob{INP(F, I_FFN_W3) + (size_t)D * DFF, WSP(bf16_t, WS_FFN_W13) + (size_t)2 * DFF * D, 1024, DFF, 2};
        case 13: return CvtJob{INP(F, I_FFN_W2) + (size_t)D * DFF, WSP(bf16_t, WS_FFN_W2) + (size_t)D * DFF, DFF, 1024, 0};
        case 14: return CvtJob{INP(F, I_NA_WQKV), WSP(bf16_t, WS_NA_WQKV), 1024, 3072, 0};
        default: return CvtJob{INP(F, I_NA_WO), WSP(bf16_t, WS_NA_WO), 1024, 1024, 0};
    }
}
__device__ __forceinline__ int cvt_job_items(const CvtJob& j) { return (j.K / 64) * (j.N / 32); }
__device__ __forceinline__ void cvt_small_queue(const Frame& F, int j_lo, int j_hi, int qword) {
    LAS float* scr = (LAS float*)(F.lds + F.wave * 16384);
    int total = 0; for (int j = j_lo; j < j_hi; ++j) total += cvt_job_items(cvt_small_job(F, j));
    unsigned* head = F.ctl + CW_CVTQ + 64 * qword;
    for (;;) {
        int base = 0; if (F.lane == 0) base = (int)atomicAdd(head, 4u); base = __builtin_amdgcn_readfirstlane(base);
        if (base >= total) break;
        int j = j_lo, off = 0; CvtJob job = cvt_small_job(F, j);
        for (;;) { const int n = cvt_job_items(job); if (base < off + n) break; off += n; ++j; job = cvt_small_job(F, j); }
        for (int k = 0; k < 4 && base + k < total; ++k) { int it = base + k - off; while (it >= cvt_job_items(job)) { it -= cvt_job_items(job); off += cvt_job_items(job); ++j; job = cvt_small_job(F, j); }
            cvt_item(job.src, job.K, job.N, job.dst, job.mode, scr, it, F.lane); }
    }
}
__device__ __forceinline__ void phase_cvt_small(const Frame& F) {
    const size_t gt = (size_t)F.bid * NTHR + F.tid, GT = (size_t)F.G * NTHR;
    { const float* wa = INP(F, I_LRU_WA); const float* wi = INP(F, I_LRU_WI); bf16_t* da = WSP(bf16_t, WS_LRU_WA); bf16_t* di = WSP(bf16_t, WS_LRU_WI);
      for (size_t i = gt; i < (size_t)16 * 160 * 160; i += GT) { const int mat = (int)(i / 25600), rem = (int)(i % 25600), n = rem / 160, k = rem % 160;
          da[i] = (bf16_t)(pk2(wa[(size_t)mat * 25600 + k * 160 + n], 0.f) & 0xffffu); di[i] = (bf16_t)(pk2(wi[(size_t)mat * 25600 + k * 160 + n], 0.f) & 0xffffu); } }
    { const float* w = INP(F, I_SGU_WS); bf16_t* d = WSP(bf16_t, WS_SGU_WS);
      for (size_t i = gt; i < (size_t)8 * 128 * 128; i += GT) d[i] = (bf16_t)(pk2(w[i], 0.f) & 0xffffu); }
    cvt_small_queue(F, 0, 16, 6);
}
constexpr int CVT_MOE_ITEMS = 24 * 1792;
__device__ __forceinline__ bf16_t* moe_w13(const Frame& F, int l2) { return l2 ? WSP(bf16_t, WS_BIG + BG_MW2) : WSP(bf16_t, WS_MOE_W13); }
__device__ __forceinline__ bf16_t* moe_w2(const Frame& F, int l2) { return l2 ? WSP(bf16_t, WS_BIG + BG_MW2 + 112 * MiB) : WSP(bf16_t, WS_MOE_W2); }
__device__ __forceinline__ void cvt_moe_item(const Frame& F, int l2, int g, LAS float* scr) {
    const int job = g / 1792, it = g - job * 1792, e = job / 3, which = job - 3 * e; const size_t so = ((size_t)l2 * NE + e) * D * DFF;
    if (which == 0) cvt_item(INP(F, I_MOE_W1) + so, 1024, DFF, moe_w13(F, l2) + (size_t)e * 2 * DFF * D, 1, scr, it, F.lane);
    else if (which == 1) cvt_item(INP(F, I_MOE_W3) + so, 1024, DFF, moe_w13(F, l2) + (size_t)e * 2 * DFF * D, 2, scr, it, F.lane);
    else cvt_item(INP(F, I_MOE_W2) + so, DFF, 1024, moe_w2(F, l2) + (size_t)e * D * DFF, 0, scr, it, F.lane);
}
__device__ __forceinline__ void cvt_moe_queue(const Frame& F, int l2, int g_lo, int g_hi, int qword) {
    LAS float* scr = (LAS float*)(F.lds + F.wave * 16384);
    unsigned* head = F.ctl + CW_CVTQ + 64 * qword; const int n = g_hi - g_lo;
    for (;;) {
        int base = 0; if (F.lane == 0) base = (int)atomicAdd(head, 4u); base = __builtin_amdgcn_readfirstlane(base);
        if (base >= n) break;
        for (int k = 0; k < 4 && base + k < n; ++k) cvt_moe_item(F, l2, g_lo + base + k, scr);
    }
}

__device__ __forceinline__ void phase_mod(const Frame& F) {
    LAS float* sL = (LAS float*)F.lds;
    LAS float* pr = (LAS float*)(F.lds + 135168);
    const float* c = INP(F, I_C); const float* cc = INP(F, I_CCTX);
    __syncthreads();
    if (F.bid < 4 * 192) { for (int i = F.tid; i < 33 * 1024; i += NTHR) { const int b = i >> 10, k = i & 1023; const float v = b < 32 ? c[b * 1024 + k] : cc[k]; sL[i] = silu_f(v); } }
    __syncthreads();
    const int cl0 = F.lane & 31, kg = 2 * F.wave + (F.lane >> 5), k0 = 64 * kg;
    for (int unit = F.bid; unit < 4 * 192; unit += F.G) {
        const int l = unit / 192, col = (unit % 192) * 32 + cl0;
        const float* w = INP(F, I_MODW) + (size_t)l * 1024 * MODW + col;
        float acc[33];
#pragma unroll
        for (int b = 0; b < 33; ++b) acc[b] = 0.f;
        for (int k = k0; k < k0 + 64; k += 16) {
            float wv[16];
#pragma unroll
            for (int j = 0; j < 16; ++j) wv[j] = w[(size_t)(k + j) * MODW];
#pragma unroll
            for (int b = 0; b < 33; ++b) {
#pragma unroll
                for (int q = 0; q < 4; ++q) { const f32x4 s0 = *(const LAS f32x4*)(sL + b * 1024 + k + 4 * q); acc[b] += (s0[0] * wv[4 * q] + s0[1] * wv[4 * q + 1]) + (s0[2] * wv[4 * q + 2] + s0[3] * wv[4 * q + 3]); } }
        }
#pragma unroll
        for (int pass = 0; pass < 4; ++pass) {
            __syncthreads();
#pragma unroll
            for (int b = 0; b < 9; ++b) if (pass * 9 + b < 33) pr[(kg * 9 + b) * 32 + cl0] = acc[pass * 9 + b];
            __syncthreads();
            for (int i = F.tid; i < 9 * 32; i += NTHR) { const int b = i >> 5, cl = i & 31, bb = pass * 9 + b;
                if (bb < 33) { float t = 0.f;
#pragma unroll
                    for (int g = 0; g < 16; ++g) t += pr[(g * 9 + b) * 32 + cl];
                    const int cg = (unit % 192) * 32 + cl; F.modv[((size_t)l * 33 + bb) * MODW + cg] = t + INP(F, I_MODB)[l * MODW + cg]; } }
        }
    }
    __syncthreads();
}

struct NormCtx { const void* src_lat; const void* src_ctx; const float* gain; const float* mod; int which; bool f32src; };
struct NormPar { f32x4 gm[4], sh[4]; };
__device__ __forceinline__ void norm_load_par(const Frame& F, const NormCtx& N, int mb, NormPar& P) {
    const float* sh = N.mod + (size_t)mb * MODW + N.which * 3 * D; const float* sc = sh + D;
#pragma unroll
    for (int j = 0; j < 4; ++j) { const int c = 4 * F.lane + 256 * j; P.gm[j] = *(const f32x4*)(N.gain + c) * (*(const f32x4*)(sc + c) + 1.0f); P.sh[j] = *(const f32x4*)(sh + c); }
}
__device__ __forceinline__ void norm_load_row(const Frame& F, const NormCtx& N, int r, f32x4 (&v)[4]) {
    const size_t ro = (size_t)(r < RL ? r : r - RL) * D; const void* sp = r < RL ? N.src_lat : N.src_ctx;
#pragma unroll
    for (int j = 0; j < 4; ++j) {
        if (N.f32src) v[j] = *(const f32x4*)((const float*)sp + ro + 4 * F.lane + 256 * j);
        else { const u32x2 q = *(const u32x2*)((const bf16_t*)sp + ro + 4 * F.lane + 256 * j); v[j] = (f32x4){lo_bf(q.x), hi_bf(q.x), lo_bf(q.y), hi_bf(q.y)}; } }
}
__device__ __forceinline__ void norm_finish(const NormPar& P, const f32x4 (&v)[4], f32x4 (&y)[4]) {
    float ss = 0.f;
#pragma unroll
    for (int j = 0; j < 4; ++j) ss += (v[j][0] * v[j][0] + v[j][1] * v[j][1]) + (v[j][2] * v[j][2] + v[j][3] * v[j][3]);
    const float rstd = 1.0f / sqrtf(wave_sum(ss) * (1.0f / D) + NORM_EPS);
#pragma unroll
    for (int j = 0; j < 4; ++j) y[j] = (v[j] * rstd) * P.gm[j] + P.sh[j];
}
__device__ __forceinline__ void store_row_bf16(const Frame& F, bf16_t* dst, const f32x4 (&y)[4]) {
#pragma unroll
    for (int j = 0; j < 4; ++j) { u32x2 w; w.x = pk2(y[j][0], y[j][1]); w.y = pk2(y[j][2], y[j][3]); *(u32x2*)(dst + 4 * F.lane + 256 * j) = w; }
}
__device__ __forceinline__ void phase_norm(const Frame& F, const NormCtx& N, int nrows) {
    const int gw = F.bid * NWAVES + F.wave, NGW = F.G * NWAVES, RPW = (nrows + NGW - 1) / NGW, r0 = gw * RPW, r1 = min(nrows, r0 + RPW);
    if (r0 >= r1) return;
    NormPar P; int mbcur = -1; f32x4 v[4], vn[4];
    norm_load_row(F, N, r0, v);
    for (int r = r0; r < r1; ++r) {
        if (r + 1 < r1) norm_load_row(F, N, r + 1, vn);
        const int mb = r < RL ? (r >> 11) : 32; if (mb != mbcur) { norm_load_par(F, N, mb, P); mbcur = mb; }
        f32x4 y[4]; norm_finish(P, v, y); store_row_bf16(F, F.U + (size_t)r * D, y);
#pragma unroll
        for (int j = 0; j < 4; ++j) v[j] = vn[j];
    }
}
__device__ __forceinline__ void route_top2(const Frame& F, float (&lg)[NE], const float* br, int& e0, int& e1, float& w0) {
    const bool h5 = F.lane & 32, h4 = F.lane & 16, h3 = F.lane & 8;
    float a4[4];
#pragma unroll
    for (int k = 0; k < 4; ++k) { const float mine = h5 ? lg[4 + k] : lg[k], send = h5 ? lg[k] : lg[4 + k]; a4[k] = mine + __shfl_xor(send, 32); }
    float a2[2];
#pragma unroll
    for (int k = 0; k < 2; ++k) { const float mine = h4 ? a4[2 + k] : a4[k], send = h4 ? a4[k] : a4[2 + k]; a2[k] = mine + __shfl_xor(send, 16); }
    float a1; { const float mine = h3 ? a2[1] : a2[0], send = h3 ? a2[0] : a2[1]; a1 = mine + __shfl_xor(send, 8); }
    a1 += __shfl_xor(a1, 4); a1 += __shfl_xor(a1, 2); a1 += __shfl_xor(a1, 1);
#pragma unroll
    for (int e = 0; e < NE; ++e) lg[e] = __int_as_float(__builtin_amdgcn_readlane(__float_as_int(a1), ((e >> 2) & 1) * 32 + ((e >> 1) & 1) * 16 + (e & 1) * 8)) + br[e];
    e0 = 0; float v0 = lg[0];
#pragma unroll
    for (int e = 1; e < NE; ++e) if (lg[e] > v0) { v0 = lg[e]; e0 = e; }
    e1 = -1; float v1 = -3.0e38f;
#pragma unroll
    for (int e = 0; e < NE; ++e) if (e != e0 && lg[e] > v1) { v1 = lg[e]; e1 = e; }
    w0 = 1.0f / (1.0f + __expf(v1 - v0));
}
__device__ __forceinline__ void phase_route(const Frame& F, const NormCtx& N, int nrows, int l2) {
    LAS float* wrL = (LAS float*)F.lds;
    LAS unsigned* hist = (LAS unsigned*)(F.lds + 32768);
    __syncthreads();
    const float* wr = INP(F, I_MOE_WR) + (size_t)l2 * D * NE; const float* br = INP(F, I_MOE_BR) + l2 * NE;
    for (int i = F.tid; i < D * NE; i += NTHR) wrL[(i & 7) * D + (i >> 3)] = wr[i];
    if (F.tid < 16) hist[F.tid] = 0u;
    __syncthreads();
    int* re = WSP(int, WS_ROUTE + RT_E); float* rw = WSP(float, WS_ROUTE + RT_W);
    const int gw = F.bid * NWAVES + F.wave, NGW = F.G * NWAVES, RPW = (nrows + NGW - 1) / NGW, r0 = gw * RPW, r1 = min(nrows, r0 + RPW);
    NormPar P; int mbcur = -1; f32x4 va[4], vb[4];
    for (int r = r0; r < r1; r += 2) {
        const bool two = r + 1 < r1; const int rb = two ? r + 1 : r;
        norm_load_row(F, N, r, va); norm_load_row(F, N, rb, vb);
        f32x4 ya[4], yb[4];
        { const int mb = r < RL ? (r >> 11) : 32; if (mb != mbcur) { norm_load_par(F, N, mb, P); mbcur = mb; } norm_finish(P, va, ya); store_row_bf16(F, F.U + (size_t)r * D, ya); }
        { const int mb = rb < RL ? (rb >> 11) : 32; if (mb != mbcur) { norm_load_par(F, N, mb, P); mbcur = mb; } norm_finish(P, vb, yb); if (two) store_row_bf16(F, F.U + (size_t)rb * D, yb); }
        float la[NE], lb[NE];
#pragma unroll
        for (int e = 0; e < NE; ++e) { la[e] = 0.f; lb[e] = 0.f; }
#pragma unroll
        for (int j = 0; j < 4; ++j)
#pragma unroll
            for (int e = 0; e < NE; ++e) { const f32x4 wv = *(const LAS f32x4*)(wrL + e * D + 4 * F.lane + 256 * j);
                la[e] += (ya[j][0] * wv[0] + ya[j][1] * wv[1]) + (ya[j][2] * wv[2] + ya[j][3] * wv[3]); lb[e] += (yb[j][0] * wv[0] + yb[j][1] * wv[1]) + (yb[j][2] * wv[2] + yb[j][3] * wv[3]); }
        int e0, e1; float w0;
        route_top2(F, la, br, e0, e1, w0);
        if (F.lane == 0) { re[r] = e0 | (e1 << 8); rw[2 * r] = w0; rw[2 * r + 1] = 1.0f - w0; lds_add(&hist[e0], 1u); lds_add(&hist[8 + e1], 1u); }
        route_top2(F, lb, br, e0, e1, w0);
        if (F.lane == 0 && two) { re[rb] = e0 | (e1 << 8); rw[2 * rb] = w0; rw[2 * rb + 1] = 1.0f - w0; lds_add(&hist[e0], 1u); lds_add(&hist[8 + e1], 1u); }
    }
    __syncthreads();
    if (F.tid < 16 && hist[F.tid]) atomicAdd(F.ctl + CW_CNT + 64 * l2 + F.tid, hist[F.tid]);
    int* tok = WSP(int, WS_ROUTE + RT_TOK);
    for (size_t i = (size_t)F.bid * NTHR + F.tid; i < (size_t)2 * MPAD; i += (size_t)F.G * NTHR) tok[i] = -1;
    __syncthreads();
}
__device__ __forceinline__ int pad256(int x) { return (x + 255) & ~255; }
__device__ __forceinline__ void phase_assign_scatter0(const Frame& F, int nrows, int l2) {
    LAS unsigned* bcnt = (LAS unsigned*)F.lds;
    LAS unsigned* bbase = (LAS unsigned*)(F.lds + 64);
    __syncthreads();
    if (F.tid < 16) bcnt[F.tid] = 0u;
    __syncthreads();
    const int RPB = (nrows + F.G - 1) / F.G, rb0 = F.bid * RPB, rb1 = min(nrows, rb0 + RPB);
    const int* re = WSP(const int, WS_ROUTE + RT_E); const float* rw = WSP(const float, WS_ROUTE + RT_W);
    int* tok = WSP(int, WS_ROUTE + RT_TOK); float* gwl = WSP(float, WS_ROUTE + RT_GW); int* pos1 = WSP(int, WS_ROUTE + RT_P1);
    const int myr = rb0 + F.wave + 8 * F.lane; const bool have = myr < rb1;
    int e0 = 0, e1 = 0; unsigned li0 = 0, li1 = 0; float w0 = 0.f, w1 = 0.f;
    if (have) { const int ee = re[myr]; e0 = ee & 255; e1 = (ee >> 8) & 255; w0 = rw[2 * myr]; w1 = rw[2 * myr + 1]; li0 = lds_add(&bcnt[e0], 1u); li1 = lds_add(&bcnt[8 + e1], 1u); }
    __syncthreads();
    const unsigned* cnt = F.ctl + CW_CNT + 64 * l2;
    if (F.tid < 16) { const int s = F.tid >> 3, e = F.tid & 7; unsigned off = 0; for (int k = 0; k < e; ++k) off += (unsigned)pad256((int)cnt[s * 8 + k]);
        unsigned b = 0; if (bcnt[F.tid]) b = atomicAdd(F.ctl + CW_CUR + 64 * l2 + F.tid, bcnt[F.tid]); bbase[F.tid] = off + b; }
    __syncthreads();
    const int p0 = (int)(bbase[e0] + li0), p1 = (int)(bbase[8 + e1] + li1);
    if (have) { tok[p0] = myr; gwl[p0] = w0; tok[MPAD + p1] = myr; gwl[MPAD + p1] = w1; pos1[myr] = p1; }
    __syncthreads();
}
__device__ __forceinline__ int moe_tile_table(const Frame& F, int l2, int s, LAS int* tstart) {
    __syncthreads();
    if (F.tid == 0) { const unsigned* cnt = F.ctl + CW_CNT + 64 * l2 + 8 * s; int t = 0; for (int e = 0; e < NE; ++e) { tstart[e] = t; t += pad256((int)cnt[e]) >> 8; } tstart[8] = t; }
    __syncthreads();
    return tstart[8];
}

constexpr int SC_RS = 164;
__device__ __forceinline__ void scan_conv_load(const bf16_t* XG, size_t rowbase, int L, int t0, int ch0, int pt, u32x2 (&xr)[11]) {
    const int q4 = pt % 40, rg = pt / 40, ch = ch0 + 4 * q4, ta = t0 + 8 * rg;
#pragma unroll
    for (int i = 0; i < 11; ++i) { const int tp = ta - 2 + i; xr[i] = (tp >= 0 && tp < L) ? *(const u32x2*)(XG + (rowbase + tp) * 2560 + ch) : (u32x2){0u, 0u}; }
}
__device__ __forceinline__ void scan_conv_math(const float* cw, const float* cb, LAS bf16_t* xc, int ch0, int pt, const u32x2 (&xr)[11]) {
    const int q4 = pt % 40, rg = pt / 40, ch = ch0 + 4 * q4;
    const f32x4 bias = *(const f32x4*)(cb + ch); f32x4 wv[4];
#pragma unroll
    for (int k = 0; k < 4; ++k) wv[k] = *(const f32x4*)(cw + k * DRNN + ch);
#pragma unroll
    for (int i = 0; i < 8; ++i) { f32x4 acc = bias;
#pragma unroll
        for (int k = 0; k < 4; ++k) { const u32x2 x = xr[i + k]; acc[0] += lo_bf(x.x) * wv[k][0]; acc[1] += hi_bf(x.x) * wv[k][1]; acc[2] += lo_bf(x.y) * wv[k][2]; acc[3] += hi_bf(x.y) * wv[k][3]; }
        u32x2 o; o.x = pk2(acc[0], acc[1]); o.y = pk2(acc[2], acc[3]); *(LAS u32x2*)(xc + (8 * rg + i) * 168 + 4 * q4) = o; }
}
__device__ __forceinline__ void phase_scan(const Frame& F, bool need_ctx) {
    LAS bf16_t* xcA0 = (LAS bf16_t*)F.lds;
    LAS float* Ra = (LAS float*)(F.lds + 43008);
    LAS float* Ri = (LAS float*)(F.lds + 43008 + 41984);
    LAS float* tab = (LAS float*)(F.lds + 43008 + 2 * 41984);
    LAS bf16_t* Hb = (LAS bf16_t*)(F.lds + 43008 + 2 * 41984 + 2048);
    const bf16_t* XG = WSP(const bf16_t, WS_BIG + BG_XG); bf16_t* Y = WSP(bf16_t, WS_BIG + BG_Y);
    const float* cw = INP(F, I_LRU_CW); const float* cb = INP(F, I_LRU_CB);
    const int fr = F.lane & 15, fq = F.lane >> 4, w = F.wave;
    const int ntA = w, ntB = 8 + (w & 1), mtB = w >> 1;
    for (int unit = F.bid; unit < NB * 8; unit += F.G) {
        const int b = unit >> 3, kb = unit & 7, ch0 = kb * LBW;
        for (int d = 0; d < 2; ++d) {
            float carry = 0.f;
            bf16x8 Ba[5], Bi[5];
            __syncthreads();
            const bf16_t* wa = WSP(const bf16_t, WS_LRU_WA) + (size_t)(d * 8 + kb) * 25600; const bf16_t* wi = WSP(const bf16_t, WS_LRU_WI) + (size_t)(d * 8 + kb) * 25600;
#pragma unroll
            for (int ks = 0; ks < 5; ++ks) { Ba[ks] = *(const bf16x8*)(wa + (16 * ntA + fr) * 160 + 32 * ks + 8 * fq); Bi[ks] = *(const bf16x8*)(wi + (16 * ntA + fr) * 160 + 32 * ks + 8 * fq); }
            if (F.tid < LBW) { const int c = ch0 + F.tid; tab[F.tid] = INP(F, I_LRU_BA)[d * DRNN + c]; tab[160 + F.tid] = INP(F, I_LRU_BI)[d * DRNN + c];
                const float lam = INP(F, I_LRU_LAM)[d * DRNN + c]; tab[320 + F.tid] = 8.0f * 1.4426950408889634f * (lam > 0.f ? log1pf(expf(-lam)) : (-lam + log1pf(expf(lam)))); }
            if (F.tid >= 192) { u32x2 xr[11]; scan_conv_load(XG, (size_t)RL + (size_t)b * CTXL, CTXL, d ? CTXL - 64 : 0, ch0, F.tid - 192, xr); scan_conv_math(cw, cb, xcA0, ch0, F.tid - 192, xr); }
            __syncthreads();
            for (int cidx = 0; cidx <= 36; ++cidx) {
                const int seg = cidx >= 4, ci = seg ? cidx - 4 : cidx, L = seg ? SEQ : CTXL; const size_t rowbase = seg ? (size_t)b * SEQ : (size_t)RL + (size_t)b * CTXL;
                const int t0 = d ? L - 64 * (ci + 1) : 64 * ci;
                LAS bf16_t* xc = xcA0 + (cidx & 1) * (64 * 168);
                const int pc = cidx - 1; const int pseg = pc >= 4, pci = pseg ? pc - 4 : pc, pL = pseg ? SEQ : CTXL; const size_t prow = pseg ? (size_t)b * SEQ : (size_t)RL + (size_t)b * CTXL;
                const int pt0 = d ? pL - 64 * (pci + 1) : 64 * pci; const bool p_out = pc >= 0 && (pseg == 1 || need_ctx);
                u32x2 pv[5], gv[5];
#pragma unroll
                for (int it = 0; it < 5; ++it) { const int e = F.tid + NTHR * it, tt = e / 40, c4 = e % 40;
                    if (d == 1 && p_out) { const size_t row = prow + pt0 + tt; pv[it] = *(const u32x2*)(Y + row * DRNN + ch0 + 4 * c4); gv[it] = *(const u32x2*)(XG + row * 2560 + DRNN + ch0 + 4 * c4); } else { pv[it] = (u32x2){0u, 0u}; gv[it] = (u32x2){0u, 0u}; } }
                if (cidx < 36) {
                    bf16x8 Xa[5], Xi[5];
#pragma unroll
                    for (int ks = 0; ks < 5; ++ks) { Xa[ks] = *(const bf16x8*)(wa + (16 * ntB + fr) * 160 + 32 * ks + 8 * fq); Xi[ks] = *(const bf16x8*)(wi + (16 * ntB + fr) * 160 + 32 * ks + 8 * fq); }
#pragma unroll 1
                    for (int mt = 0; mt < 4; ++mt) {
                        f32x4 ra = {0.f, 0.f, 0.f, 0.f}, ri = {0.f, 0.f, 0.f, 0.f};
#pragma unroll
                        for (int ks = 0; ks < 5; ++ks) { const bf16x8 a = *(const LAS bf16x8*)(xc + (16 * mt + fr) * 168 + 32 * ks + 8 * fq);
                            ra = __builtin_amdgcn_mfma_f32_16x16x32_bf16(Ba[ks], a, ra, 0, 0, 0); ri = __builtin_amdgcn_mfma_f32_16x16x32_bf16(Bi[ks], a, ri, 0, 0, 0); }
                        const int o = (16 * mt + fr) * SC_RS + 16 * ntA + 4 * fq; *(LAS f32x4*)(Ra + o) = ra; *(LAS f32x4*)(Ri + o) = ri;
                    }
                    {
                        f32x4 ra = {0.f, 0.f, 0.f, 0.f}, ri = {0.f, 0.f, 0.f, 0.f};
#pragma unroll
                        for (int ks = 0; ks < 5; ++ks) { const bf16x8 a = *(const LAS bf16x8*)(xc + (16 * mtB + fr) * 168 + 32 * ks + 8 * fq);
                            ra = __builtin_amdgcn_mfma_f32_16x16x32_bf16(Xa[ks], a, ra, 0, 0, 0); ri = __builtin_amdgcn_mfma_f32_16x16x32_bf16(Xi[ks], a, ri, 0, 0, 0); }
                        const int o = (16 * mtB + fr) * SC_RS + 16 * ntB + 4 * fq; *(LAS f32x4*)(Ra + o) = ra; *(LAS f32x4*)(Ri + o) = ri;
                    }
                }
                if (p_out) {
#pragma unroll
                    for (int it = 0; it < 5; ++it) { const int e = F.tid + NTHR * it, tt = e / 40, c4 = e % 40; const u32x2 hb = *(const LAS u32x2*)(Hb + tt * 168 + 4 * c4);
                        u32x2* yp = (u32x2*)(Y + (prow + pt0 + tt) * DRNN + ch0 + 4 * c4); u32x2 o;
                        if (d == 0) o = hb;
                        else { o.x = pk2((lo_bf(pv[it].x) + lo_bf(hb.x)) * gelu_tanh_f(lo_bf(gv[it].x)), (hi_bf(pv[it].x) + hi_bf(hb.x)) * gelu_tanh_f(hi_bf(gv[it].x)));
                               o.y = pk2((lo_bf(pv[it].y) + lo_bf(hb.y)) * gelu_tanh_f(lo_bf(gv[it].y)), (hi_bf(pv[it].y) + hi_bf(hb.y)) * gelu_tanh_f(hi_bf(gv[it].y))); }
                        *yp = o; }
                }
                if (cidx == 36) break;
                __syncthreads();
                const bool do_conv = F.tid >= 192 && cidx + 1 < 36;
                u32x2 xr[11];
                if (do_conv) { const int nseg = (cidx + 1) >= 4, nci = nseg ? cidx + 1 - 4 : cidx + 1, nL = nseg ? SEQ : CTXL;
                    scan_conv_load(XG, nseg ? (size_t)b * SEQ : (size_t)RL + (size_t)b * CTXL, nL, d ? nL - 64 * (nci + 1) : 64 * nci, ch0, F.tid - 192, xr); }
#pragma unroll 1
                for (int it = 0; it < 5; ++it) { const int e = F.tid + NTHR * it, tt = e / 40, c4 = e % 40; const int o = tt * SC_RS + 4 * c4;
                    const f32x4 va = *(const LAS f32x4*)(Ra + o) + *(const LAS f32x4*)(tab + 4 * c4), vi = *(const LAS f32x4*)(Ri + o) + *(const LAS f32x4*)(tab + 160 + 4 * c4), sp = *(const LAS f32x4*)(tab + 320 + 4 * c4);
                    const u32x2 xv = *(const LAS u32x2*)(xc + tt * 168 + 4 * c4); const float xf[4] = {lo_bf(xv.x), hi_bf(xv.x), lo_bf(xv.y), hi_bf(xv.y)};
                    f32x4 av, bv;
#pragma unroll
                    for (int j = 0; j < 4; ++j) { const float r = __builtin_amdgcn_rcpf(1.0f + __builtin_amdgcn_exp2f(-1.4426950408889634f * va[j])), ig = __builtin_amdgcn_rcpf(1.0f + __builtin_amdgcn_exp2f(-1.4426950408889634f * vi[j]));
                        const float a = __builtin_amdgcn_exp2f(-r * sp[j]); av[j] = a; bv[j] = __builtin_amdgcn_sqrtf(fmaxf(1.0f - a * a, 0.f)) * (ig * xf[j]); }
                    *(LAS f32x4*)(Ra + o) = av; *(LAS f32x4*)(Ri + o) = bv; }
                __syncthreads();
                if (F.tid < LBW) { float h = carry;
#pragma unroll 1
                    for (int s0 = 0; s0 < 64; s0 += 16) {
                        float av[16], bv[16], hv[16];
#pragma unroll
                        for (int k = 0; k < 16; ++k) { const int tt = d ? 63 - (s0 + k) : s0 + k; av[k] = Ra[tt * SC_RS + F.tid]; bv[k] = Ri[tt * SC_RS + F.tid]; }
#pragma unroll
                        for (int k = 0; k < 16; ++k) { h = av[k] * h + bv[k]; hv[k] = h; }
#pragma unroll
                        for (int k = 0; k < 16; ++k) { const int tt = d ? 63 - (s0 + k) : s0 + k; Hb[tt * 168 + F.tid] = (bf16_t)(pk2(hv[k], 0.f) & 0xffffu); }
                    }
                    carry = h; }
                else if (do_conv) scan_conv_math(cw, cb, xcA0 + ((cidx + 1) & 1) * (64 * 168), ch0, F.tid - 192, xr);
                __syncthreads();
            }
        }
    }
}

__device__ __forceinline__ void phase_sgu_stats(const Frame& F) {
    const bf16_t* Z = WSP(const bf16_t, WS_BIG + BG_Z); float* st = WSP(float, WS_ROUTE + RT_ST);
    const int gw = F.bid * NWAVES + F.wave, NGW = F.G * NWAVES, RPW = (RA + NGW - 1) / NGW, r0 = gw * RPW, r1 = min(RA, r0 + RPW);
    if (r0 >= r1) return;
    u32x4 q[4], qn[4];
#pragma unroll
    for (int j = 0; j < 4; ++j) q[j] = *(const u32x4*)(Z + (size_t)r0 * 4096 + DSGU + 8 * F.lane + 512 * j);
    for (int r = r0; r < r1; ++r) {
        if (r + 1 < r1) {
#pragma unroll
            for (int j = 0; j < 4; ++j) qn[j] = *(const u32x4*)(Z + (size_t)(r + 1) * 4096 + DSGU + 8 * F.lane + 512 * j); }
        float x[32]; float s = 0.f;
#pragma unroll
        for (int j = 0; j < 4; ++j) { x[8 * j + 0] = lo_bf(q[j].x); x[8 * j + 1] = hi_bf(q[j].x); x[8 * j + 2] = lo_bf(q[j].y); x[8 * j + 3] = hi_bf(q[j].y); x[8 * j + 4] = lo_bf(q[j].z); x[8 * j + 5] = hi_bf(q[j].z); x[8 * j + 6] = lo_bf(q[j].w); x[8 * j + 7] = hi_bf(q[j].w); }
#pragma unroll
        for (int i = 0; i < 32; ++i) s += x[i];
        const float mean = wave_sum(s) * (1.0f / DSGU); float q2 = 0.f;
#pragma unroll
        for (int i = 0; i < 32; ++i) { const float dlt = x[i] - mean; q2 += dlt * dlt; }
        const float rstd = 1.0f / sqrtf(wave_sum(q2) * (1.0f / DSGU) + NORM_EPS);
        if (F.lane == 0) { st[2 * r] = mean; st[2 * r + 1] = rstd; }
#pragma unroll
        for (int j = 0; j < 4; ++j) q[j] = qn[j];
    }
}
__device__ __forceinline__ size_t sgu_row0(int cu) { return cu < 512 ? (size_t)(cu >> 4) * SEQ + (size_t)(cu & 15) * 128 : (size_t)RL + (size_t)((cu - 512) >> 1) * CTXL + (size_t)((cu - 512) & 1) * 128; }
__device__ __forceinline__ void phase_sgu_spatial(const Frame& F) {
    LAS bf16_t* vT = (LAS bf16_t*)F.lds;
    LAS bf16_t* uT = (LAS bf16_t*)(F.lds + 69632);
    bf16_t* Z = WSP(bf16_t, WS_BIG + BG_Z); const float* st = WSP(const float, WS_ROUTE + RT_ST);
    const bf16_t* wsb = WSP(const bf16_t, WS_SGU_WS);
    const float* lng = INP(F, I_SGU_LNG); const float* lnb = INP(F, I_SGU_LNB); const float* bs = INP(F, I_SGU_BS);
    const int fr = F.lane & 15, fq = F.lane >> 4, w = F.wave;
    const int q8 = F.tid >> 5, d8 = F.tid & 31;
    const int urow = F.tid >> 5, uch = F.tid & 31;
    u32x4 vq[8], uq[8]; f32x2 sq[8];
    int unit = F.bid;
    if (unit < 576 * 8) { const int cu = unit >> 3, g = unit & 7; const size_t row0 = sgu_row0(cu);
#pragma unroll
        for (int i = 0; i < 8; ++i) { const size_t r = row0 + 8 * q8 + i; vq[i] = *(const u32x4*)(Z + r * 4096 + DSGU + 256 * g + 8 * d8); sq[i] = *(const f32x2*)(st + 2 * r);
            uq[i] = *(const u32x4*)(Z + (row0 + urow + 16 * i) * 4096 + 256 * g + 8 * uch); } }
    for (; unit < 576 * 8; unit += F.G) {
        const int cu = unit >> 3, g = unit & 7; const size_t row0 = sgu_row0(cu);
        {
            const int dcol = 256 * g + 8 * d8; float gg[8], bb[8];
#pragma unroll
            for (int j = 0; j < 8; ++j) { gg[j] = lng[dcol + j]; bb[j] = lnb[dcol + j]; }
            float x[8][8];
#pragma unroll
            for (int i = 0; i < 8; ++i) { const u32x4 q = vq[i]; const float mean = sq[i][0], rstd = sq[i][1];
                const float raw[8] = {lo_bf(q.x), hi_bf(q.x), lo_bf(q.y), hi_bf(q.y), lo_bf(q.z), hi_bf(q.z), lo_bf(q.w), hi_bf(q.w)};
#pragma unroll
                for (int j = 0; j < 8; ++j) x[i][j] = (raw[j] - mean) * rstd * gg[j] + bb[j]; }
#pragma unroll
            for (int j = 0; j < 8; ++j) { u32x4 o; o.x = pk2(x[0][j], x[1][j]); o.y = pk2(x[2][j], x[3][j]); o.z = pk2(x[4][j], x[5][j]); o.w = pk2(x[6][j], x[7][j]);
                *(LAS u32x4*)(vT + (8 * d8 + j) * 136 + 8 * (q8 ^ (d8 & 15))) = o; }
#pragma unroll
            for (int i = 0; i < 8; ++i) *(LAS u32x4*)(uT + (urow + 16 * i) * 264 + 8 * uch) = uq[i];
        }
        __syncthreads();
        {
            const int nu = unit + F.G;
            if (nu < 576 * 8) { const int ncu = nu >> 3, ng = nu & 7; const size_t nrow0 = sgu_row0(ncu);
#pragma unroll
                for (int i = 0; i < 8; ++i) { const size_t r = nrow0 + 8 * q8 + i; vq[i] = *(const u32x4*)(Z + r * 4096 + DSGU + 256 * ng + 8 * d8); sq[i] = *(const f32x2*)(st + 2 * r);
                    uq[i] = *(const u32x4*)(Z + (nrow0 + urow + 16 * i) * 4096 + 256 * ng + 8 * uch); } }
            const int p = 16 * w + fr; LAS u32x2* urow_l = (LAS u32x2*)(uT + p * 264 + 4 * fq);
            bf16x8 af[4];
#pragma unroll
            for (int ks = 0; ks < 4; ++ks) af[ks] = *(const bf16x8*)(wsb + ((size_t)g * 128 + p) * 128 + 32 * ks + 8 * fq);
            const float bias = bs[g * 128 + p];
#pragma unroll 4
            for (int nt = 0; nt < 16; ++nt) { f32x4 acc = {0.f, 0.f, 0.f, 0.f};
#pragma unroll
                for (int ks = 0; ks < 4; ++ks) { const bf16x8 bfv = *(const LAS bf16x8*)(vT + (16 * nt + fr) * 136 + 8 * ((4 * ks + fq) ^ ((2 * nt + (fr >> 3)) & 15))); acc = __builtin_amdgcn_mfma_f32_16x16x32_bf16(bfv, af[ks], acc, 0, 0, 0); }
                const u32x2 u2 = urow_l[4 * nt]; u32x2 o; o.x = pk2(lo_bf(u2.x) * (acc[0] + bias), hi_bf(u2.x) * (acc[1] + bias)); o.y = pk2(lo_bf(u2.y) * (acc[2] + bias), hi_bf(u2.y) * (acc[3] + bias)); urow_l[4 * nt] = o; }
        }
        __syncthreads();
#pragma unroll
        for (int i = 0; i < 8; ++i) *(u32x4*)(Z + (row0 + urow + 16 * i) * 4096 + 256 * g + 8 * uch) = *(const LAS u32x4*)(uT + (urow + 16 * i) * 264 + 8 * uch);
        __syncthreads();
    }
}

template <int WN> __device__ __forceinline__ void pool_item(const bf16_t* U, bf16_t* PD, int r, int cg) {
    int t, L; size_t base; if (r < RL) { t = r & (SEQ - 1); L = SEQ; base = (size_t)(r - t); } else { t = (r - RL) & (CTXL - 1); L = CTXL; base = (size_t)(r - t); }
    const int lo = max(t - WN / 2, 0), hi = min(t + WN / 2 - 1, L - 1);
    u32x4 v[WN];
#pragma unroll
    for (int k = 0; k < WN; ++k) { const int q = min(max(t - WN / 2 + k, 0), L - 1); v[k] = *(const u32x4*)(U + (base + q) * D + 8 * cg); }
    float s[8] = {0.f, 0.f, 0.f, 0.f, 0.f, 0.f, 0.f, 0.f};
#pragma unroll
    for (int k = 0; k < WN; ++k) { const int q = t - WN / 2 + k; const float m = (q >= lo && q <= hi) ? 1.f : 0.f;
        s[0] += m * lo_bf(v[k].x); s[1] += m * hi_bf(v[k].x); s[2] += m * lo_bf(v[k].y); s[3] += m * hi_bf(v[k].y); s[4] += m * lo_bf(v[k].z); s[5] += m * hi_bf(v[k].z); s[6] += m * lo_bf(v[k].w); s[7] += m * hi_bf(v[k].w); }
    const u32x4 sv = v[WN / 2];
    const float inv = 1.0f / (float)(hi - lo + 1);
    u32x4 o; o.x = pk2(s[0] * inv - lo_bf(sv.x), s[1] * inv - hi_bf(sv.x)); o.y = pk2(s[2] * inv - lo_bf(sv.y), s[3] * inv - hi_bf(sv.y));
    o.z = pk2(s[4] * inv - lo_bf(sv.z), s[5] * inv - hi_bf(sv.z)); o.w = pk2(s[6] * inv - lo_bf(sv.w), s[7] * inv - hi_bf(sv.w));
    *(u32x4*)(PD + (size_t)r * D + 8 * cg) = o;
}
__device__ __forceinline__ void phase_pool_diff(const Frame& F) {
    bf16_t* PD = WSP(bf16_t, WS_BIG + BG_PD);
    const size_t T0 = (size_t)F.bid * NTHR + F.tid, TS = (size_t)F.G * NTHR, NI = (size_t)RA * 32;
#define POOL_LOOP(g_, WN_, K_) for (size_t i = T0; i < NI; i += K_ * TS) { _Pragma("unroll") for (int k_ = 0; k_ < K_; ++k_) { const size_t ii = i + k_ * TS; if (ii < NI) pool_item<WN_>(F.U, PD, (int)(ii >> 5), 32 * g_ + (int)(ii & 31)); } }
    POOL_LOOP(0, 2, 8) POOL_LOOP(1, 4, 4) POOL_LOOP(2, 8, 2) POOL_LOOP(3, 16, 1)
#undef POOL_LOOP
}

__device__ __forceinline__ void phase_na(const Frame& F) {
    const bf16_t* QKV = WSP(const bf16_t, WS_BIG + BG_QKV); bf16_t* O = WSP(bf16_t, WS_BIG + BG_O); const float* rpb = INP(F, I_NA_RPB);
    const int w = F.wave, rsub = w >> 1, chh = w & 1, fr = F.lane & 15, fq = F.lane >> 4;
    const int skey = F.tid >> 3, sd8 = F.tid & 7;
    LAS float* bt = (LAS float*)(F.lds + 36864);
    const unsigned trl = (unsigned)((fr >> 2) * 144 + (fr & 3) * 8);
    float kgain[8];
#pragma unroll
    for (int j = 0; j < 8; ++j) kgain[j] = INP(F, I_NA_KG)[8 * sd8 + j];
#define NA_KNORM(kr) do { float x_[8] = {lo_bf(kr.x), hi_bf(kr.x), lo_bf(kr.y), hi_bf(kr.y), lo_bf(kr.z), hi_bf(kr.z), lo_bf(kr.w), hi_bf(kr.w)}; float ss_ = 0.f; \
        _Pragma("unroll") for (int j_ = 0; j_ < 8; ++j_) ss_ += x_[j_] * x_[j_]; \
        ss_ += dpp_f<0xB1>(ss_); ss_ += dpp_f<0x4E>(ss_); ss_ += dpp_f<0x141>(ss_); \
        const float rs_ = __builtin_amdgcn_rsqf(ss_ * (1.0f / 64.0f) + NORM_EPS); \
        kr.x = pk2(x_[0] * rs_ * kgain[0], x_[1] * rs_ * kgain[1]); kr.y = pk2(x_[2] * rs_ * kgain[2], x_[3] * rs_ * kgain[3]); \
        kr.z = pk2(x_[4] * rs_ * kgain[4], x_[5] * rs_ * kgain[5]); kr.w = pk2(x_[6] * rs_ * kgain[6], x_[7] * rs_ * kgain[7]); } while (0)
    float gqm = 0.f, gkm = 0.f; for (int i = 0; i < 64; ++i) { gqm = fmaxf(gqm, fabsf(INP(F, I_NA_QG)[i])); gkm = fmaxf(gkm, fabsf(INP(F, I_NA_KG)[i])); }
    const float M0 = 8.0f * gqm * gkm * 1.4426950408889634f;
    for (int unit = F.bid; unit < NB * 16 * 8; unit += F.G) {
        const int rg = unit & 7, h = (unit >> 3) & 15, b = unit >> 7;
        const int r = 4 * rg + rsub, r0 = min(max(r - 4, 0), 24);
        const int ulo = min(max(4 * rg - 4, 0), 24), uhi = min(max(4 * rg - 1, 0), 24) + 8, nnb = uhi - ulo, ntile = nnb + 4;
        bf16x8 qf[2][2]; size_t qrow[2];
#pragma unroll
        for (int qt = 0; qt < 2; ++qt) { qrow[qt] = (size_t)b * SEQ + (size_t)r * 64 + 32 * chh + 16 * qt + fr;
            u32x4 raw[2]; float xv[2][8]; float ss = 0.f;
#pragma unroll
            for (int ks = 0; ks < 2; ++ks) { raw[ks] = *(const u32x4*)(QKV + qrow[qt] * 3072 + h * 64 + 32 * ks + 8 * fq);
                xv[ks][0] = lo_bf(raw[ks].x); xv[ks][1] = hi_bf(raw[ks].x); xv[ks][2] = lo_bf(raw[ks].y); xv[ks][3] = hi_bf(raw[ks].y); xv[ks][4] = lo_bf(raw[ks].z); xv[ks][5] = hi_bf(raw[ks].z); xv[ks][6] = lo_bf(raw[ks].w); xv[ks][7] = hi_bf(raw[ks].w);
#pragma unroll
                for (int j = 0; j < 8; ++j) ss += xv[ks][j] * xv[ks][j]; }
            ss += __shfl_xor(ss, 16); ss += __shfl_xor(ss, 32);
            const float rs = __builtin_amdgcn_rsqf(ss * (1.0f / 64.0f) + NORM_EPS) * (0.125f * 1.4426950408889634f);
#pragma unroll
            for (int ks = 0; ks < 2; ++ks) { const float* gq = INP(F, I_NA_QG) + 32 * ks + 8 * fq; u32x4 pw;
                pw.x = pk2(xv[ks][0] * rs * gq[0], xv[ks][1] * rs * gq[1]); pw.y = pk2(xv[ks][2] * rs * gq[2], xv[ks][3] * rs * gq[3]); pw.z = pk2(xv[ks][4] * rs * gq[4], xv[ks][5] * rs * gq[5]); pw.w = pk2(xv[ks][6] * rs * gq[6], xv[ks][7] * rs * gq[7]);
                qf[qt][ks] = __builtin_bit_cast(bf16x8, pw); } }
        f32x4 o[2][4]; float lrun[2] = {0.f, 0.f};
#pragma unroll
        for (int qt = 0; qt < 2; ++qt)
#pragma unroll
            for (int dt = 0; dt < 4; ++dt) o[qt][dt] = (f32x4){0.f, 0.f, 0.f, 0.f};
        for (int i = F.tid; i < 15 * 31; i += NTHR) bt[i] = rpb[(size_t)h * 465 + i] * 1.4426950408889634f - M0;
        u32x4 kreg, vreg;
        { const size_t krow = (size_t)b * SEQ + (size_t)ulo * 64 + skey; const bf16_t* kp = QKV + krow * 3072 + D + h * 64 + 8 * sd8; kreg = *(const u32x4*)kp; vreg = *(const u32x4*)(kp + D); }
        NA_KNORM(kreg);
        *(LAS u32x4*)(F.lds + skey * 144 + sd8 * 16) = kreg; *(LAS u32x4*)(F.lds + 9216 + skey * 144 + sd8 * 16) = vreg;
        __syncthreads();
        for (int i = 0; i < ntile; ++i) {
            if (i + 1 < ntile) { const size_t krow = (i + 1 < nnb ? (size_t)b * SEQ + (size_t)(ulo + i + 1) * 64 : (size_t)RL + (size_t)b * CTXL + (size_t)(i + 1 - nnb) * 64) + skey;
                const bf16_t* kp = QKV + krow * 3072 + D + h * 64 + 8 * sd8; kreg = *(const u32x4*)kp; vreg = *(const u32x4*)(kp + D); }
            LAS unsigned char* Kb = F.lds + (i & 1) * 18432; LAS unsigned char* Vb = Kb + 9216;
            const bool isnb = i < nnb; const int ra = ulo + i;
            if (isnb) {
                if (ra >= r0 && ra < r0 + 8) {
                    const LAS float* bp = bt + (ra - r + 7) * 31;
#pragma unroll
                    for (int qt = 0; qt < 2; ++qt) {
                        const int g4 = 2 * chh + qt, ws = min(max(16 * g4 - 8, 0), 32);
                        const int cq = 16 * g4 + fr, cstart = min(max(cq - 8, 0), 48);
                        f32x4 st[2]; float psum = 0.f;
#pragma unroll
                        for (int kt = 0; kt < 2; ++kt) {
                            f32x4 a = {0.f, 0.f, 0.f, 0.f};
#pragma unroll
                            for (int ks = 0; ks < 2; ++ks) { const bf16x8 kf = *(const LAS bf16x8*)(Kb + (ws + 16 * kt + fr) * 144 + (32 * ks + 8 * fq) * 2); a = __builtin_amdgcn_mfma_f32_16x16x32_bf16(kf, qf[qt][ks], a, 0, 0, 0); }
#pragma unroll
                            for (int j = 0; j < 4; ++j) { const int ck = ws + 16 * kt + 4 * fq + j; const bool valid = (unsigned)(ck - cstart) < 16u; const int dc = min(max(ck - cq, -15), 15) + 15;
                                const float pv = __builtin_amdgcn_exp2f(a[j] + bp[dc]); a[j] = valid ? pv : 0.f; }
                            psum += (a[0] + a[1]) + (a[2] + a[3]); st[kt] = a;
                        }
                        lrun[qt] += psum;
                        u32x4 pw; pw.x = pk2(st[0][0], st[0][1]); pw.y = pk2(st[0][2], st[0][3]); pw.z = pk2(st[1][0], st[1][1]); pw.w = pk2(st[1][2], st[1][3]);
                        const bf16x8 pb = __builtin_bit_cast(bf16x8, pw);
#pragma unroll
                        for (int dt = 0; dt < 4; ++dt) { const s16x4 v0 = __builtin_amdgcn_ds_read_tr16_b64_v4i16((LAS s16x4*)(Vb + (ws + 4 * fq) * 144 + 32 * dt + trl)), v1 = __builtin_amdgcn_ds_read_tr16_b64_v4i16((LAS s16x4*)(Vb + (ws + 16 + 4 * fq) * 144 + 32 * dt + trl));
                            const bf16x8 va = {v0[0], v0[1], v0[2], v0[3], v1[0], v1[1], v1[2], v1[3]};
                            o[qt][dt] = __builtin_amdgcn_mfma_f32_16x16x32_bf16(va, pb, o[qt][dt], 0, 0, 0); }
                    }
                }
            } else {
                bf16x8 kf[4][2];
#pragma unroll
                for (int kt = 0; kt < 4; ++kt)
#pragma unroll
                    for (int ks = 0; ks < 2; ++ks) kf[kt][ks] = *(const LAS bf16x8*)(Kb + (16 * kt + fr) * 144 + (32 * ks + 8 * fq) * 2);
                s16x4 vA[2][4][2];
#pragma unroll
                for (int s2 = 0; s2 < 2; ++s2)
#pragma unroll
                    for (int dt = 0; dt < 4; ++dt)
#pragma unroll
                        for (int hh = 0; hh < 2; ++hh) vA[s2][dt][hh] = __builtin_amdgcn_ds_read_tr16_b64_v4i16((LAS s16x4*)(Vb + (32 * s2 + 16 * hh + 4 * fq) * 144 + 32 * dt + trl));
#pragma unroll
                for (int qt = 0; qt < 2; ++qt) {
                    f32x4 st[4]; float psum = 0.f;
#pragma unroll
                    for (int kt = 0; kt < 4; ++kt) {
                        f32x4 a = {0.f, 0.f, 0.f, 0.f};
                        a = __builtin_amdgcn_mfma_f32_16x16x32_bf16(kf[kt][0], qf[qt][0], a, 0, 0, 0); a = __builtin_amdgcn_mfma_f32_16x16x32_bf16(kf[kt][1], qf[qt][1], a, 0, 0, 0);
#pragma unroll
                        for (int j = 0; j < 4; ++j) a[j] = __builtin_amdgcn_exp2f(a[j] - M0);
                        psum += (a[0] + a[1]) + (a[2] + a[3]); st[kt] = a;
                    }
                    lrun[qt] += psum;
#pragma unroll
                    for (int s2 = 0; s2 < 2; ++s2) {
                        u32x4 pw; pw.x = pk2(st[2 * s2][0], st[2 * s2][1]); pw.y = pk2(st[2 * s2][2], st[2 * s2][3]); pw.z = pk2(st[2 * s2 + 1][0], st[2 * s2 + 1][1]); pw.w = pk2(st[2 * s2 + 1][2], st[2 * s2 + 1][3]);
                        const bf16x8 pb = __builtin_bit_cast(bf16x8, pw);
#pragma unroll
                        for (int dt = 0; dt < 4; ++dt) { const s16x4 v0 = vA[s2][dt][0], v1 = vA[s2][dt][1]; const bf16x8 va = {v0[0], v0[1], v0[2], v0[3], v1[0], v1[1], v1[2], v1[3]};
                            o[qt][dt] = __builtin_amdgcn_mfma_f32_16x16x32_bf16(va, pb, o[qt][dt], 0, 0, 0); }
                    }
                }
            }
            if (i + 1 < ntile) { NA_KNORM(kreg); LAS unsigned char* Kn = F.lds + ((i + 1) & 1) * 18432; *(LAS u32x4*)(Kn + skey * 144 + sd8 * 16) = kreg; *(LAS u32x4*)(Kn + 9216 + skey * 144 + sd8 * 16) = vreg; }
            __syncthreads();
        }
#pragma unroll
        for (int qt = 0; qt < 2; ++qt) { float lt = lrun[qt]; lt += __shfl_xor(lt, 16); lt += __shfl_xor(lt, 32); const float inv = 1.0f / lt;
#pragma unroll
            for (int dt = 0; dt < 4; ++dt) { u32x2 w2; w2.x = pk2(o[qt][dt][0] * inv, o[qt][dt][1] * inv); w2.y = pk2(o[qt][dt][2] * inv, o[qt][dt][3] * inv); *(u32x2*)(O + qrow[qt] * D + h * 64 + 16 * dt + 4 * fq) = w2; } }
    }
    __syncthreads();
}

#undef NA_KNORM
constexpr int NPH = 36;
__device__ __forceinline__ pg8::Sched mk_sched(const Frame& F, int nM, int nN, const bf16_t* A, int lda, const bf16_t* B, int K) {
    pg8::Sched S; S.nM = nM; S.nN = nN; S.G = F.G; S.c = F.bid; S.A = (const char*)A; S.a_tile = (size_t)256 * lda * 2; S.a_pn = 0;
    S.B = (const char*)B; S.b_tile = (size_t)256 * K * 2; S.b_e = 0; S.tstart = nullptr; S.rev = false; S.wgm = nN >= 8 ? WGM_WIDE : WGM_NARROW; return S;
}
__global__ void __launch_bounds__(NTHR, 2) fwd(Params P) {
    extern __shared__ __attribute__((aligned(16))) unsigned char lds_raw[];
    Frame F; F.lds = (LAS unsigned char*)lds_raw; F.tid = threadIdx.x; F.lane = F.tid & 63; F.wave = __builtin_amdgcn_readfirstlane(F.tid >> 6); F.bid = blockIdx.x; F.G = gridDim.x;
    F.p = &P; F.ws = P.ws; F.ctl = (unsigned*)(P.ws + WS_CTL); F.modv = (float*)(P.ws + WS_MODV); F.hlat = (bf16_t*)(P.ws + WS_H); F.hctx = F.hlat + (size_t)RL * D; F.U = (bf16_t*)P.out;
    if (F.tid < 64) ((LAS unsigned*)(F.lds + LDS_CTL))[F.tid] = 0u;
    __syncthreads();
    const int lo = P.ph_lo, hi = P.ph_hi;
    XcdBarrier bar; bar.bar = F.ctl + CW_BAR; bar.x = 0; bar.st = (volatile LAS unsigned*)(F.lds + LDS_CTL);
    if (hi - lo > 1) bar = xcd_barrier_post(F.ctl + CW_BAR, (volatile LAS unsigned*)(F.lds + LDS_CTL));
#define IN(k) (lo <= (k) && (k) < hi)
#define SEAM(k) do { if (IN(k) && IN((k) + 1)) xcd_barrier(bar); \
        if (PROBE_LO >= 0 && F.bid == 0 && F.tid == 0) { if ((k) + 1 == PROBE_LO) pr_t[0] = PROBE_CLK ? (unsigned long long)clock64() : __builtin_amdgcn_s_memrealtime(); if ((k) + 1 == PROBE_HI) pr_t[1] = PROBE_CLK ? (unsigned long long)clock64() : __builtin_amdgcn_s_memrealtime(); } } while (0)
    volatile LAS unsigned long long* const pr_t = (volatile LAS unsigned long long*)(F.lds + LDS_CTL + 16);
    if (PROBE_LO == 0 && F.bid == 0 && F.tid == 0) pr_t[0] = PROBE_CLK ? (unsigned long long)clock64() : __builtin_amdgcn_s_memrealtime();
    bf16_t* const out = F.hlat; bf16_t* const hctx = F.hctx;
    const float* const x = INP(F, I_X); const float* const ctx = INP(F, I_CTX);
    LAS unsigned char* const gl = F.lds;
    LAS int* const tstart = (LAS int*)(F.lds + LDS_AUX);
    bf16_t* const BIG = (bf16_t*)(P.ws + WS_BIG);
#define MODL(l) (F.modv + (size_t)(l) * 33 * MODW)
#define LAUNDER do { asm volatile("" : "+v"(F.tid)); F.lane = F.tid & 63; } while (0)

    if (IN(0)) { LAUNDER; phase_mod(F); phase_cvt_small(F); } SEAM(0);
    if (IN(1)) { LAUNDER; NormCtx N{x, ctx, INP(F, I_N1G), MODL(0), 0, true}; phase_norm(F, N, RA); } SEAM(1);
    if (IN(2)) { LAUNDER; pg8::Sched S = mk_sched(F, RA / 256, 10, F.U, D, WSP(bf16_t, WS_LRU_WIN), D); pg8::EpiBf16<0> E{(bf16_t*)(P.ws + WS_BIG + BG_XG), 2560, nullptr}; pg8::gemm_phase(gl, D, D, S, E); } SEAM(2);
    if (IN(3)) { LAUNDER; phase_scan(F, true); } SEAM(3);
    if (IN(4)) { LAUNDER; pg8::Sched S = mk_sched(F, RA / 256, 4, (bf16_t*)(P.ws + WS_BIG + BG_Y), DRNN, WSP(bf16_t, WS_LRU_WOUT), DRNN);
                 pg8::EpiResidX E{x, ctx, out, hctx, MODL(0) + 2 * D, nullptr, nullptr}; pg8::gemm_phase(gl, DRNN, DRNN, S, E); cvt_moe_queue(F, 0, 0, 8192, 0); } SEAM(4);
    if (IN(5)) { LAUNDER; NormCtx N{out, hctx, INP(F, I_N2G), MODL(0), 1, false}; phase_norm(F, N, RA); } SEAM(5);
    if (IN(6)) { LAUNDER; pg8::Sched S = mk_sched(F, RA / 256, 28, F.U, D, WSP(bf16_t, WS_FFN_W13), D); pg8::EpiSwiGLU E{(bf16_t*)(P.ws + WS_BIG + BG_HID), DFF}; pg8::gemm_phase(gl, D, D, S, E); } SEAM(6);
    if (IN(7)) { LAUNDER; pg8::Sched S = mk_sched(F, RA / 256, 4, (bf16_t*)(P.ws + WS_BIG + BG_HID), DFF, WSP(bf16_t, WS_FFN_W2), DFF);
                 S.rev = true; pg8::EpiResid E{out, hctx, out, hctx, MODL(0) + 5 * D, nullptr, nullptr}; pg8::gemm_phase(gl, DFF, DFF, S, E); cvt_moe_queue(F, 0, 8192, 30720, 1); } SEAM(7);
    if (IN(8)) { LAUNDER; NormCtx N{out, hctx, INP(F, I_N1G) + D, MODL(1), 0, false}; phase_norm(F, N, RA); } SEAM(8);
    if (IN(9)) { LAUNDER; pg8::Sched S = mk_sched(F, RA / 256, 16, F.U, D, WSP(bf16_t, WS_SGU_WIN), D); pg8::EpiBf16<1> E{(bf16_t*)(P.ws + WS_BIG + BG_Z), 4096, INP(F, I_SGU_BIN)}; pg8::gemm_phase(gl, D, D, S, E); } SEAM(9);
    if (IN(10)) { LAUNDER; phase_sgu_stats(F); } SEAM(10);
    if (IN(11)) { LAUNDER; phase_sgu_spatial(F); } SEAM(11);
    if (IN(12)) { LAUNDER; pg8::Sched S = mk_sched(F, RA / 256, 4, (bf16_t*)(P.ws + WS_BIG + BG_Z), 4096, WSP(bf16_t, WS_SGU_WOUT), DSGU);
                  pg8::EpiResid E{out, hctx, out, hctx, MODL(1) + 2 * D, nullptr, nullptr}; pg8::gemm_phase(gl, 4096, DSGU, S, E); cvt_moe_queue(F, 0, 30720, CVT_MOE_ITEMS, 2); } SEAM(12);
    if (IN(13)) { LAUNDER; NormCtx N{out, hctx, INP(F, I_N2G) + D, MODL(1), 1, false}; phase_route(F, N, RA, 0); } SEAM(13);
    if (IN(14)) { LAUNDER; phase_assign_scatter0(F, RA, 0); } SEAM(14);
#define MOE_UP(ph, l2, s) if (IN(ph)) { LAUNDER; const int nt_ = moe_tile_table(F, l2, s, tstart); \
        pg8::Sched S = mk_sched(F, nt_, 28, F.U, D, moe_w13(F, l2), D); S.a_tile = 0; S.b_e = (size_t)2 * DFF * D * 2; S.tstart = tstart; \
        pg8::EpiSwiGLU E{(bf16_t*)(P.ws + WS_BIG + BG_MHID), DFF}; pg8::gemm_phase<pg8::EpiSwiGLU, true>(gl, D, D, S, E, WSP(const int, WS_ROUTE + RT_TOK) + (s) * MPAD, (LAS int*)(F.lds + LDS_AUX + 1024)); } SEAM(ph)
#define MOE_DOWN(ph, l2, s, layer, EPI) if (IN(ph)) { LAUNDER; const int nt_ = moe_tile_table(F, l2, s, tstart); \
        pg8::Sched S = mk_sched(F, nt_, 4, (bf16_t*)(P.ws + WS_BIG + BG_MHID), DFF, moe_w2(F, l2), DFF); S.b_e = (size_t)D * DFF * 2; S.tstart = tstart; S.rev = true; \
        EPI E{out, hctx, P.out, MODL(layer) + 5 * D, WSP(const int, WS_ROUTE + RT_TOK) + (s) * MPAD, WSP(const float, WS_ROUTE + RT_GW) + (s) * MPAD}; pg8::gemm_phase(gl, DFF, DFF, S, E); \
        if ((l2) == 0) cvt_moe_queue(F, 1, (s) ? 10752 : 0, (s) ? 21504 : 10752, 3 + (s)); } SEAM(ph)
    MOE_UP(15, 0, 0); MOE_DOWN(16, 0, 0, 1, pg8::EpiMoeDown); MOE_UP(17, 0, 1); MOE_DOWN(18, 0, 1, 1, pg8::EpiMoeDown);
    if (IN(19)) { LAUNDER; NormCtx N{out, hctx, INP(F, I_N1G) + 2 * D, MODL(2), 0, false}; phase_norm(F, N, RA); } SEAM(19);
    if (IN(20)) { LAUNDER; phase_pool_diff(F); } SEAM(20);
    if (IN(21)) { LAUNDER; pg8::Sched S = mk_sched(F, RA / 256, 4, (bf16_t*)(P.ws + WS_BIG + BG_PD), D, WSP(bf16_t, WS_POOL_W), 256); S.a_pn = 512; S.b_tile = (size_t)256 * 256 * 2;
                  pg8::EpiResidBS E{out, hctx, out, hctx, MODL(2) + 2 * D, INP(F, I_POOL_B), INP(F, I_POOL_S)}; pg8::gemm_phase(gl, D, 256, S, E); } SEAM(21);
    if (IN(22)) { LAUNDER; NormCtx N{out, hctx, INP(F, I_N2G) + 2 * D, MODL(2), 1, false}; phase_norm(F, N, RA); } SEAM(22);
    if (IN(23)) { LAUNDER; pg8::Sched S = mk_sched(F, RA / 256, 28, F.U, D, WSP(bf16_t, WS_FFN_W13) + (size_t)2 * DFF * D, D); pg8::EpiSwiGLU E{(bf16_t*)(P.ws + WS_BIG + BG_HID), DFF}; pg8::gemm_phase(gl, D, D, S, E); } SEAM(23);
    if (IN(24)) { LAUNDER; pg8::Sched S = mk_sched(F, RA / 256, 4, (bf16_t*)(P.ws + WS_BIG + BG_HID), DFF, WSP(bf16_t, WS_FFN_W2) + (size_t)D * DFF, DFF);
                  S.rev = true; pg8::EpiResid E{out, hctx, out, hctx, MODL(2) + 5 * D, nullptr, nullptr}; pg8::gemm_phase(gl, DFF, DFF, S, E); cvt_moe_queue(F, 1, 21504, CVT_MOE_ITEMS, 5); } SEAM(24);
    if (IN(25)) { LAUNDER; NormCtx N{out, hctx, INP(F, I_N1G) + 3 * D, MODL(3), 0, false}; phase_norm(F, N, RA); } SEAM(25);
    if (IN(26)) { LAUNDER;
        { pg8::Sched S = mk_sched(F, RL / 256, 12, F.U, D, WSP(bf16_t, WS_NA_WQKV), D); pg8::EpiBf16<0> E{(bf16_t*)(P.ws + WS_BIG + BG_QKV), 3072, nullptr}; pg8::gemm_phase(gl, D, D, S, E); }
        { pg8::Sched S = mk_sched(F, RC / 256, 8, F.U + (size_t)RL * D, D, WSP(bf16_t, WS_NA_WQKV) + (size_t)D * D, D);
          pg8::EpiBf16<0> E{(bf16_t*)(P.ws + WS_BIG + BG_QKV) + (size_t)RL * 3072 + D, 3072, nullptr}; pg8::gemm_phase(gl, D, D, S, E); } } SEAM(26);
    SEAM(27);
    if (IN(28)) { LAUNDER; phase_na(F); } SEAM(28);
    if (IN(29)) { LAUNDER; pg8::Sched S = mk_sched(F, RL / 256, 4, (bf16_t*)(P.ws + WS_BIG + BG_O), D, WSP(bf16_t, WS_NA_WO), D);
                  pg8::EpiResid E{out, hctx, out, hctx, MODL(3) + 2 * D, nullptr, nullptr}; pg8::gemm_phase(gl, D, D, S, E); } SEAM(29);
    if (IN(30)) { LAUNDER; NormCtx N{out, hctx, INP(F, I_N2G) + 3 * D, MODL(3), 1, false}; phase_route(F, N, RL, 1); } SEAM(30);
    if (IN(31)) { LAUNDER; phase_assign_scatter0(F, RL, 1); } SEAM(31);
    MOE_UP(32, 1, 0); MOE_DOWN(33, 1, 0, 3, pg8::EpiMoeDown); MOE_UP(34, 1, 1); MOE_DOWN(35, 1, 1, 3, pg8::EpiMoeDownOut);
#undef IN
#undef SEAM
    (void)BIG;
    if (PROBE_LO >= 0 && F.bid == 0 && F.tid == 0) { if (PROBE_HI >= NPH) pr_t[1] = PROBE_CLK ? (unsigned long long)clock64() : __builtin_amdgcn_s_memrealtime();
        const unsigned long long t_end = __builtin_amdgcn_s_memrealtime(), wait = PROBE_CLK ? 8ull * (pr_t[1] - pr_t[0]) / 21ull : 8ull * (pr_t[1] - pr_t[0]);
        while (__builtin_amdgcn_s_memrealtime() - t_end < wait) __builtin_amdgcn_s_sleep(32); }
}

extern "C" void kernel_launch(void* const* d_in, const int* in_sizes, int n_in, void* d_out, int out_size, void* d_ws, size_t ws_size, hipStream_t stream) {
    static int grid = 0;
    if (grid == 0) {
        if (n_in != 40 || out_size != RL * D || ws_size < WS_END) { fprintf(stderr, "kernel_launch: unexpected problem (n_in %d out %d ws %zu)\n", n_in, out_size, ws_size); grid = -1; return; }
        int dev = 0, cus = 0;
        if (hipGetDevice(&dev) != hipSuccess || hipDeviceGetAttribute(&cus, hipDeviceAttributeMultiprocessorCount, dev) != hipSuccess) { grid = -1; return; }
        if (hipFuncSetAttribute((const void*)fwd, hipFuncAttributeMaxDynamicSharedMemorySize, LDS_BYTES) != hipSuccess) { fprintf(stderr, "kernel_launch: hipFuncSetAttribute failed\n"); grid = -1; return; }
        int per_cu = 0; (void)hipOccupancyMaxActiveBlocksPerMultiprocessor(&per_cu, (const void*)fwd, NTHR, LDS_BYTES); (void)hipGetLastError();
        if (per_cu < 1) fprintf(stderr, "kernel_launch: occupancy query says %d\n", per_cu);
        grid = cus;
    }
    if (grid < 0) return;
    (void)hipMemsetAsync((char*)d_ws + WS_CTL, 0, CTL_BYTES, stream);
    Params p{};
    for (int i = 0; i < 40; ++i) p.in[i] = (const float*)d_in[i];
    p.out = (float*)d_out; p.ws = (unsigned char*)d_ws;
#if MK_MULTI
    for (int ph = 0; ph < NPH; ++ph) { p.ph_lo = ph; p.ph_hi = ph + 1; hipLaunchKernelGGL(fwd, dim3(grid), dim3(NTHR), LDS_BYTES, stream, p); }
#else
    p.ph_lo = 0; p.ph_hi = NPH;
    hipLaunchKernelGGL(fwd, dim3(grid), dim3(NTHR), LDS_BYTES, stream, p);
#endif
}
```

```cpp
#include <hip/hip_runtime.h>
#include <cstdio>
#include <cstdint>

#ifndef PROBE_CLK
#define PROBE_CLK 0
#endif
#ifndef PROBE_ACC
#define PROBE_ACC 0
#endif
#define PR_BEG(n, lds_) do { if (PROBE_ACC == (n) && blockIdx.x == 0 && threadIdx.x == 0) ((volatile LAS unsigned long long*)((lds_) + LDS_CTL + 40))[0] = __builtin_amdgcn_s_memrealtime(); } while (0)
#define PR_END(n, lds_) do { if (PROBE_ACC == (n) && blockIdx.x == 0 && threadIdx.x == 0) { volatile LAS unsigned long long* p_ = (volatile LAS unsigned long long*)((lds_) + LDS_CTL + 32); p_[0] = p_[0] + (__builtin_amdgcn_s_memrealtime() - p_[1]); } } while (0)
#ifndef PROBE_LO
#define PROBE_LO -1
#define PROBE_HI -1
#endif
#ifndef WGM_WIDE
#define WGM_WIDE 4
#define WGM_NARROW 4
#endif
#ifndef MK_MULTI
#define MK_MULTI 0
#define EPI_PIPE_MOE 1
#endif

#define LAS __attribute__((address_space(3)))
typedef unsigned short bf16_t;
typedef short bf16x8 __attribute__((ext_vector_type(8)));
typedef short s16x4 __attribute__((ext_vector_type(4)));
typedef float f32x4 __attribute__((ext_vector_type(4)));
typedef float f32x2 __attribute__((ext_vector_type(2)));
typedef unsigned u32x4 __attribute__((ext_vector_type(4)));
typedef unsigned u32x2 __attribute__((ext_vector_type(2)));

constexpr int D = 1024, NB = 32, SEQ = 2048, CTXL = 256;
constexpr int RL = NB * SEQ, RC = NB * CTXL, RA = RL + RC;
constexpr int DRNN = 1280, LBW = 160, DSGU = 2048, DFF = 3584, NE = 8;
constexpr int MODW = 6 * D;
constexpr int MPAD = 75776;
constexpr float NORM_EPS = 1e-6f;
constexpr int NWAVES = 8, NTHR = 512;

constexpr size_t MiB = 1u << 20;
constexpr size_t WS_CTL = 0, CTL_BYTES = 1 * MiB;
constexpr size_t WS_MODV = 1 * MiB;
constexpr size_t WS_HCTX = 5 * MiB;
constexpr size_t WS_LRU_WIN = 37 * MiB;
constexpr size_t WS_LRU_WA = WS_LRU_WIN + 5 * MiB;
constexpr size_t WS_LRU_WI = WS_LRU_WA + 1 * MiB;
constexpr size_t WS_LRU_WOUT = WS_LRU_WI + 1 * MiB;
constexpr size_t WS_SGU_WIN = WS_LRU_WOUT + 3 * MiB;
constexpr size_t WS_SGU_WS = WS_SGU_WIN + 8 * MiB;
constexpr size_t WS_SGU_WOUT = WS_SGU_WS + 1 * MiB;
constexpr size_t WS_POOL_W = WS_SGU_WOUT + 4 * MiB;
constexpr size_t WS_NA_WQKV = WS_POOL_W + 1 * MiB;
constexpr size_t WS_NA_WO = WS_NA_WQKV + 6 * MiB;
constexpr size_t WS_FFN_W13 = WS_NA_WO + 2 * MiB;
constexpr size_t WS_FFN_W2 = WS_FFN_W13 + 28 * MiB;
constexpr size_t WS_MOE_W13 = WS_FFN_W2 + 14 * MiB;
constexpr size_t WS_MOE_W2 = WS_MOE_W13 + 112 * MiB;
constexpr size_t WS_ROUTE = WS_MOE_W2 + 56 * MiB;
constexpr size_t WS_H = WS_ROUTE + 4 * MiB;
constexpr size_t WS_BIG = WS_H + 148 * MiB;
constexpr size_t WS_END = WS_BIG + 744 * MiB;
constexpr size_t WS_DBG = WS_END;
static_assert(WS_MOE_W13 == 111 * MiB && WS_BIG == 431 * MiB && WS_END == 1175 * MiB, "ws map");
constexpr size_t RT_E = 0;
constexpr size_t RT_W = 512 * 1024;
constexpr size_t RT_TOK = 1280 * 1024;
constexpr size_t RT_GW = 2048 * 1024;
constexpr size_t RT_ST = 2816 * 1024;
constexpr size_t RT_P1 = 3456 * 1024;
static_assert(RT_W >= (size_t)RA * 4 && RT_TOK - RT_W >= (size_t)RA * 8 && RT_GW - RT_TOK >= (size_t)2 * MPAD * 4 && RT_ST - RT_GW >= (size_t)2 * MPAD * 4 && RT_P1 - RT_ST >= (size_t)RA * 8 && 4 * MiB - RT_P1 >= (size_t)RA * 4, "route map");
constexpr size_t BG_XG = 0, BG_Y = 360 * MiB;
constexpr size_t BG_HID = 0;
constexpr size_t BG_Z = 0;
constexpr size_t BG_FS1 = 0, BG_MHID = 0;
constexpr size_t BG_MW2 = 576 * MiB;
constexpr size_t BG_PD = 0;
constexpr size_t BG_QKV = 0, BG_O = 432 * MiB;
static_assert(BG_MHID + (size_t)MPAD * DFF * 2 <= BG_MW2 && BG_O + (size_t)RL * D * 2 <= BG_MW2 && BG_Y + (size_t)RA * DRNN * 2 <= BG_MW2 && BG_MW2 + 168 * MiB <= 744 * MiB, "big map");
constexpr int CW_BAR = 4096;
constexpr int CW_CNT = 16384;
constexpr int CW_CUR = 16384 + 256;
constexpr int CW_DBG = 32768;
constexpr int CW_CVTQ = 20480;

constexpr int LDS_BYTES = 163840;
constexpr int LDS_AUX = 131072;
constexpr int LDS_CTL = LDS_BYTES - 256;

__device__ __forceinline__ float bf2f(unsigned b) { return __uint_as_float(b << 16); }
__device__ __forceinline__ unsigned pk2(float lo, float hi) { unsigned r; asm volatile("v_cvt_pk_bf16_f32 %0, %1, %2" : "=v"(r) : "v"(lo), "v"(hi)); return r; }
__device__ __forceinline__ float lo_bf(unsigned w) { return __uint_as_float(w << 16); }
__device__ __forceinline__ float hi_bf(unsigned w) { return __uint_as_float(w & 0xffff0000u); }
template <int CTRL> __device__ __forceinline__ float dpp_f(float v) { return __int_as_float(__builtin_amdgcn_update_dpp(0, __float_as_int(v), CTRL, 0xf, 0xf, true)); }
__device__ __forceinline__ float wave_sum(float v) {
    v += dpp_f<0xB1>(v);
    v += dpp_f<0x4E>(v);
    v += dpp_f<0x141>(v);
    v += dpp_f<0x140>(v);
    const int iv = __float_as_int(v);
    return (__int_as_float(__builtin_amdgcn_readlane(iv, 0)) + __int_as_float(__builtin_amdgcn_readlane(iv, 16))) + (__int_as_float(__builtin_amdgcn_readlane(iv, 32)) + __int_as_float(__builtin_amdgcn_readlane(iv, 48)));
}
__device__ __forceinline__ float sigmoid_f(float x) { return __builtin_amdgcn_rcpf(1.0f + __builtin_amdgcn_exp2f(-1.4426950408889634f * x)); }
__device__ __forceinline__ float silu_f(float x) { return x * __builtin_amdgcn_rcpf(1.0f + __builtin_amdgcn_exp2f(-1.4426950408889634f * x)); }
__device__ __forceinline__ float gelu_tanh_f(float x) { const float z2 = -2.0f * 1.4426950408889634f * 0.7978845608028654f * (x + 0.044715f * x * x * x); return x * __builtin_amdgcn_rcpf(1.0f + __builtin_amdgcn_exp2f(z2)); }
__device__ __forceinline__ unsigned lds_add(LAS unsigned* p, unsigned v) { return __hip_atomic_fetch_add(p, v, __ATOMIC_RELAXED, __HIP_MEMORY_SCOPE_WORKGROUP); }
#define LDS_WAIT() asm volatile("s_waitcnt lgkmcnt(0)" ::: "memory")
#define VM_WAIT() asm volatile("s_waitcnt vmcnt(0)" ::: "memory")

#define XB_TMO      128
#define XB_XCNT(j)  (256  + 64 * (j))
#define XB_XSUB(j)  (1280 + 64 * (j))
#define XB_XGEN(j)  (2304 + 64 * (j))
#define XB_TOP      3328
#define XB_TOPGEN   3392
#define XCD_BAR_WORDS 3456
#define XB_SPIN_CAP (1u << 18)
__device__ __forceinline__ unsigned xb_ld(unsigned* p)              { return __hip_atomic_load(p, __ATOMIC_RELAXED, __HIP_MEMORY_SCOPE_AGENT); }
__device__ __forceinline__ unsigned xb_add(unsigned* p, unsigned v) { return __hip_atomic_fetch_add(p, v, __ATOMIC_RELAXED, __HIP_MEMORY_SCOPE_AGENT); }
__device__ __forceinline__ unsigned xb_xcc_id() { return (unsigned)__builtin_amdgcn_s_getreg((3 << 11) | 20) & 0xFu; }
#define XB_SPIN(cond, bar) do { unsigned _sp = 0; while (cond) { __builtin_amdgcn_s_sleep(1); \
    if ((++_sp & 255u) == 0u) { if (xb_ld(&(bar)[XB_TMO])) break; if (_sp > XB_SPIN_CAP) { atomicAdd(&(bar)[XB_TMO], 1u); break; } } } } while (0)
struct XcdBarrier { unsigned* bar; unsigned x; volatile LAS unsigned* st; };
__device__ __forceinline__ XcdBarrier xcd_barrier_post(unsigned* bar, volatile LAS unsigned* st) {
    XcdBarrier b; b.bar = bar; b.x = xb_xcc_id(); b.st = st;
    if (threadIdx.x == 0) (void)xb_add(&bar[XB_XCNT(b.x)], 1u);
    return b;
}
__device__ __forceinline__ void xcd_barrier_complete(unsigned* bar, unsigned x, unsigned& nloc, unsigned& nx) {
    const unsigned G = gridDim.x * gridDim.y * gridDim.z;
    unsigned sum, cnt, mine, sp = 0u;
    for (;;) {
        sum = 0u; cnt = 0u; mine = 0u;
#pragma unroll
        for (unsigned j = 0; j < 16; ++j) { const unsigned c = xb_ld(&bar[XB_XCNT(j)]); sum += c; cnt += (c > 0u) ? 1u : 0u; mine = (j == x) ? c : mine; }
        if (sum == G) break;
        __builtin_amdgcn_s_sleep(1);
        if ((++sp & 255u) == 0u) { if (xb_ld(&bar[XB_TMO])) break; if (sp > XB_SPIN_CAP) { atomicAdd(&bar[XB_TMO], 1u); break; } }
    }
    nloc = mine > 0u ? mine : 1u; nx = cnt > 0u ? cnt : 1u;
}
__device__ __forceinline__ void xcd_barrier(const XcdBarrier& b) {
    asm volatile("s_waitcnt vmcnt(0)" ::: "memory");
    __syncthreads();
    if (threadIdx.x == 0) {
        unsigned* bar = b.bar;
        __builtin_amdgcn_s_waitcnt(0);
        unsigned nloc = b.st[0], nx = b.st[1];
        if (nloc == 0u) { xcd_barrier_complete(bar, b.x, nloc, nx); b.st[0] = nloc; b.st[1] = nx; }
        const unsigned old = xb_add(&bar[XB_XSUB(b.x)], 1u);
        const unsigned gen = old / nloc;
        if (old + 1u == (gen + 1u) * nloc) {
            __builtin_amdgcn_fence(__ATOMIC_RELEASE, "agent");
            asm volatile("s_waitcnt vmcnt(0)" ::: "memory");
            const unsigned og = xb_add(&bar[XB_TOP], 1u);
            const unsigned tg = og / nx;
            if (og + 1u == (tg + 1u) * nx) xb_add(&bar[XB_TOPGEN], 1u);
            else XB_SPIN(xb_ld(&bar[XB_TOPGEN]) == tg, bar);
            __builtin_amdgcn_fence(__ATOMIC_ACQUIRE, "agent");
            xb_add(&bar[XB_XGEN(b.x)], 1u);
            asm volatile("s_waitcnt vmcnt(0)" ::: "memory");
        } else {
            XB_SPIN(xb_ld(&bar[XB_XGEN(b.x)]) == gen, bar);
            __builtin_amdgcn_fence(__ATOMIC_ACQUIRE, "agent");
            asm volatile("s_waitcnt vmcnt(0)" ::: "memory");
        }
    }
    __syncthreads();
}

struct Params {
    const float* in[40];
    float* out; unsigned char* ws;
    int ph_lo, ph_hi;
};
enum In { I_X = 0, I_C, I_CTX, I_CCTX, I_MODW, I_MODB, I_N1G, I_N2G, I_LRU_WIN, I_LRU_CW, I_LRU_CB, I_LRU_WA, I_LRU_BA, I_LRU_WI, I_LRU_BI, I_LRU_LAM, I_LRU_WOUT,
          I_SGU_WIN, I_SGU_BIN, I_SGU_LNG, I_SGU_LNB, I_SGU_WS, I_SGU_BS, I_SGU_WOUT, I_POOL_W, I_POOL_B, I_POOL_S, I_NA_WQKV, I_NA_QG, I_NA_KG, I_NA_RPB, I_NA_WO,
          I_FFN_W1, I_FFN_W3, I_FFN_W2, I_MOE_WR, I_MOE_BR, I_MOE_W1, I_MOE_W3, I_MOE_W2 };

namespace pg8 {
constexpr int BM = 256, BK = 64, HALF = 128, HTB = HALF * BK * 2, STAGE_BYTES = 8 * HTB, NXCD = 8, WGM = 4;
__device__ __forceinline__ int lds_byte(int r, int c) { const int st = (r >> 4) * 2 + (c >> 5), rr = r & 15, cc = c & 31, ob = rr * 64 + cc * 2; return st * 1024 + (ob ^ (((ob >> 9) & 1) << 5)); }
__device__ __forceinline__ void stage_rc(int b, int& R, int& C) { const int st = b / 1024, sb = b % 1024, swz = sb ^ (((sb >> 9) & 1) << 5); R = (st >> 1) * 16 + swz / 64; C = (st & 1) * 32 + (swz % 64) / 2; }
__device__ __forceinline__ int perm32(int rho) { const int n = rho >> 4, i = rho & 15; return 8 * (i >> 2) + 4 * n + (i & 3); }

struct Unit { int pm, pn, e; const char* a; const char* b; };
struct Sched {
    int nM, nN, G, c;
    const char* A; size_t a_tile, a_pn;
    const char* B; size_t b_tile, b_e;
    const LAS int* tstart;
    int wgm = WGM;
    bool rev = false;
    __device__ __forceinline__ bool next(int i, Unit& u) const {
        long L = (long)i * G + c; if (L >= (long)nM * nN) return false;
        if (rev) L = (long)nM * nN - 1 - L;
        int e = 0, t0 = 0, nMe = nM, wgid = (int)L;
        if (tstart) {
#pragma unroll
            for (int k = 1; k < 8; ++k) e += (wgid >= tstart[k] * nN) ? 1 : 0;
            t0 = tstart[e]; nMe = tstart[e + 1] - t0; wgid -= t0 * nN;
        }
        const int nwg = nMe * nN;
        { const int q = nwg / NXCD, r = nwg % NXCD, xcd = wgid % NXCD, off = wgid / NXCD; wgid = (xcd < r ? xcd * (q + 1) : r * (q + 1) + (xcd - r) * q) + off; }
        const int nig = wgm * nN, gid = wgid / nig, fm = gid * wgm, gsz = (nMe - fm) < wgm ? (nMe - fm) : wgm;
        u.pm = t0 + fm + ((wgid % nig) % gsz); u.pn = (wgid % nig) / gsz;
        u.e = e; u.a = A + (size_t)u.pm * a_tile + (size_t)u.pn * a_pn; u.b = B + (size_t)e * b_e + (size_t)u.pn * b_tile;
        return true;
    }
};

template <class Epi, bool GATHER = false>
__device__ __forceinline__ void gemm_phase(LAS unsigned char* lds, const int lda, const int K, const Sched& S, const Epi& E, const int* gidx = nullptr, LAS int* ixt = nullptr) {
    const int tid = threadIdx.x, wid = __builtin_amdgcn_readfirstlane(tid >> 6), lane = tid & 63, wr = wid >> 2, wc = wid & 3, fr = lane & 15, fq = lane >> 4;
    const int nt = K / BK;
    unsigned voffA[2], voffB[2]; int Rl[2]; unsigned cb2[2];
#pragma unroll
    for (int i = 0; i < 2; ++i) { int R, C; stage_rc(tid * 16 + i * 8192, R, C); const int Rb = Epi::PERM ? ((R & ~31) + perm32(R & 31)) : R;
        voffA[i] = (unsigned)(R * lda + C) * 2u; voffB[i] = (unsigned)(Rb * K + C) * 2u; Rl[i] = R; cb2[i] = (unsigned)C * 2u; }
    unsigned cOff[2][2] = {{0u, 0u}, {0u, 0u}}, nOff[2][2] = {{0u, 0u}, {0u, 0u}};
    const size_t kstep = (size_t)(BK * 2);
    const size_t hstepA = (size_t)HALF * lda * 2, hstepB = (size_t)HALF * K * 2;
    const unsigned ldsw = (unsigned)wid * 1024u;
    const int aoff = lds_byte(wr * 64 + fr, fq * 8), boff = lds_byte(wc * 32 + fr, fq * 8);
#define PG8_SA(b, h) (((b) * 2 + (h)) * HTB)
#define PG8_SB(b, h) ((4 + (b) * 2 + (h)) * HTB)
#define PG8_STAGE(bufoff, gbase, voff) do { _Pragma("unroll") for (int _i = 0; _i < 2; ++_i) \
        __builtin_amdgcn_global_load_lds((const unsigned*)((const char*)(gbase) + (voff)[_i]), (LAS unsigned*)(lds + (bufoff) + ldsw + _i * 8192), 16, 0, 0); } while (0)
#define PG8_STAGE_A(bufoff, kptr, h, usenext) do { if constexpr (GATHER) { const unsigned o_[2] = {(usenext) ? nOff[h][0] : cOff[h][0], (usenext) ? nOff[h][1] : cOff[h][1]}; PG8_STAGE(bufoff, kptr, o_); } \
        else PG8_STAGE(bufoff, (kptr) + (h) * hstepA, voffA); } while (0)
#define PG8_LDA(dst, b, h) do { _Pragma("unroll") for (int m = 0; m < 4; ++m) _Pragma("unroll") for (int k = 0; k < 2; ++k) dst[m][k] = *(const LAS bf16x8*)(lds + PG8_SA(b, h) + aoff + m * 2048 + k * 1024); } while (0)
#define PG8_LDB(dst, b, h) do { _Pragma("unroll") for (int n = 0; n < 2; ++n) _Pragma("unroll") for (int k = 0; k < 2; ++k) dst[n][k] = *(const LAS bf16x8*)(lds + PG8_SB(b, h) + boff + n * 2048 + k * 1024); } while (0)
#define PG8_MMA(ai, bj, At, Bt) do { __builtin_amdgcn_s_setprio(1); _Pragma("unroll") for (int m = 0; m < 4; ++m) _Pragma("unroll") for (int n = 0; n < 2; ++n) _Pragma("unroll") for (int k = 0; k < 2; ++k) \
        acc[ai][bj][m][n] = __builtin_amdgcn_mfma_f32_16x16x32_bf16(Bt[n][k], At[m][k], acc[ai][bj][m][n], 0, 0, 0); __builtin_amdgcn_s_setprio(0); } while (0)
#define PG8_WAIT_V(n) asm volatile("s_waitcnt vmcnt(" #n ")" ::: "memory")
#define PG8_WAIT_L(n) asm volatile("s_waitcnt lgkmcnt(" #n ")" ::: "memory")
#define PG8_BAR __builtin_amdgcn_s_barrier()
#define PG8_SCHED __builtin_amdgcn_sched_barrier(0)
    Unit cur, nxt; int ui = 0;
    if (!S.next(0, cur)) return;
    f32x4 acc[2][2][4][2];
#pragma unroll
    for (int a = 0; a < 2; ++a)
#pragma unroll
        for (int b = 0; b < 2; ++b)
#pragma unroll
            for (int m = 0; m < 4; ++m)
#pragma unroll
                for (int n = 0; n < 2; ++n) acc[a][b][m][n] = (f32x4){0.f, 0.f, 0.f, 0.f};
    bf16x8 At[4][2], B0[2][2], B1[2][2];
    const char* cA = cur.a; const char* cB = cur.b;
    if constexpr (GATHER) {
#pragma unroll
        for (int h = 0; h < 2; ++h)
#pragma unroll
            for (int i = 0; i < 2; ++i) { const int ix = gidx[cur.pm * BM + h * HALF + Rl[i]]; cOff[h][i] = (unsigned)(ix < 0 ? 0 : ix) * (unsigned)(lda * 2) + cb2[i]; }
    }
    PG8_STAGE(PG8_SB(0, 0), cB, voffB); PG8_STAGE(PG8_SB(0, 1), cB + hstepB, voffB); PG8_STAGE_A(PG8_SA(0, 0), cA, 0, false); PG8_STAGE_A(PG8_SA(0, 1), cA, 1, false);
    if (wr == 1) PG8_BAR;
    PG8_WAIT_V(2); PG8_BAR;
    PG8_STAGE(PG8_SB(1, 0), cB + kstep, voffB); PG8_STAGE_A(PG8_SA(1, 0), cA + kstep, 0, false); PG8_STAGE(PG8_SB(1, 1), cB + hstepB + kstep, voffB);
    PG8_WAIT_V(6); PG8_BAR;
    for (;;) {
        const bool has_next = S.next(ui + 1, nxt);
        const char* nA = has_next ? nxt.a : cA; const char* nB = has_next ? nxt.b : cB;
        if constexpr (GATHER) { if (has_next && wid == 0) {
#pragma unroll
            for (int k = 0; k < 4; ++k) __builtin_amdgcn_global_load_lds((const unsigned*)(gidx + nxt.pm * BM + k * 64 + lane), (LAS unsigned*)(ixt + ((ui + 1) & 1) * BM + k * 64), 4, 0, 0); } }
#pragma unroll 1
        for (int t = 0; t < nt; t += 2) {
            const bool last = (t == nt - 2); const bool un = last && has_next;
            if constexpr (GATHER) { if (un) {
#pragma unroll
                for (int h = 0; h < 2; ++h)
#pragma unroll
                    for (int i = 0; i < 2; ++i) { const int ix = ixt[((ui + 1) & 1) * BM + h * HALF + Rl[i]]; nOff[h][i] = (unsigned)(ix < 0 ? 0 : ix) * (unsigned)(lda * 2) + cb2[i]; } } }
            const char* a1 = cA + (size_t)(t + 1) * kstep;
            const char* a2 = last ? nA : cA + (size_t)(t + 2) * kstep; const char* b2 = last ? nB : cB + (size_t)(t + 2) * kstep;
            const char* a3 = a2 + kstep; const char* b3 = b2 + kstep;
            PG8_LDB(B0, 0, 0); PG8_LDB(B1, 0, 1); PG8_SCHED; PG8_LDA(At, 0, 0); PG8_STAGE_A(PG8_SA(1, 1), a1, 1, false);
            PG8_WAIT_V(8); PG8_WAIT_L(0); PG8_BAR; PG8_MMA(0, 0, At, B0); PG8_MMA(0, 1, At, B1); PG8_BAR; PG8_SCHED;
            PG8_LDA(At, 0, 1); PG8_STAGE(PG8_SB(0, 0), b2, voffB); PG8_STAGE(PG8_SB(0, 1), b2 + hstepB, voffB); PG8_STAGE_A(PG8_SA(0, 0), a2, 0, un);
            PG8_WAIT_V(8); PG8_WAIT_L(0); PG8_BAR; PG8_MMA(1, 0, At, B0); PG8_MMA(1, 1, At, B1); PG8_BAR; PG8_SCHED;
            PG8_LDB(B0, 1, 0); PG8_LDB(B1, 1, 1); PG8_SCHED; PG8_LDA(At, 1, 0); PG8_STAGE_A(PG8_SA(0, 1), a2, 1, un);
            PG8_WAIT_V(8); PG8_WAIT_L(0); PG8_BAR; PG8_MMA(0, 0, At, B0); PG8_MMA(0, 1, At, B1); PG8_BAR; PG8_SCHED;
            PG8_LDA(At, 1, 1); PG8_STAGE(PG8_SB(1, 0), b3, voffB); PG8_STAGE(PG8_SB(1, 1), b3 + hstepB, voffB); PG8_STAGE_A(PG8_SA(1, 0), a3, 0, un);
            PG8_WAIT_V(8); PG8_WAIT_L(0); PG8_BAR; PG8_MMA(1, 0, At, B0); PG8_MMA(1, 1, At, B1); PG8_BAR; PG8_SCHED;
        }
        if (wr == 0) PG8_BAR;
        E(acc, cur, wr, wc, fr, fq);
        if (!has_next) break;
#pragma unroll
        for (int a = 0; a < 2; ++a)
#pragma unroll
            for (int b = 0; b < 2; ++b)
#pragma unroll
                for (int m = 0; m < 4; ++m)
#pragma unroll
                    for (int n = 0; n < 2; ++n) acc[a][b][m][n] = (f32x4){0.f, 0.f, 0.f, 0.f};
        cur = nxt; cA = nA; cB = nB; ++ui;
        if constexpr (GATHER) {
#pragma unroll
            for (int h = 0; h < 2; ++h)
#pragma unroll
                for (int i = 0; i < 2; ++i) cOff[h][i] = nOff[h][i]; }
        if (wr == 1) PG8_BAR;
    }
    PG8_WAIT_V(0);
    PG8_BAR;
#undef PG8_SA
#undef PG8_SB
#undef PG8_STAGE
#undef PG8_LDA
#undef PG8_STAGE_A
#undef PG8_LDB
#undef PG8_MMA
#undef PG8_WAIT_V
#undef PG8_WAIT_L
#undef PG8_BAR
#undef PG8_SCHED
}

template <int ACT> struct EpiBf16 {
    static constexpr bool PERM = true;
    bf16_t* O; int ldc; const float* bias;
    __device__ __forceinline__ void operator()(const f32x4 (&acc)[2][2][4][2], const Unit& u, int wr, int wc, int fr, int fq) const {
        asm volatile("" : "+v"(fr), "+v"(fq));
        const int row0 = u.pm * BM + wr * 64 + fr; const int col0 = u.pn * BM + wc * 32 + 8 * fq;
        f32x4 bv[2][2];
#pragma unroll
        for (int bj = 0; bj < 2; ++bj)
#pragma unroll
            for (int n = 0; n < 2; ++n) bv[bj][n] = bias ? *(const f32x4*)(bias + col0 + bj * HALF + 4 * n) : (f32x4){0.f, 0.f, 0.f, 0.f};
#pragma unroll
        for (int ai = 0; ai < 2; ++ai)
#pragma unroll
            for (int m = 0; m < 4; ++m) { bf16_t* rowp = O + (size_t)(row0 + ai * HALF + m * 16) * ldc + col0;
#pragma unroll
                for (int bj = 0; bj < 2; ++bj) { f32x4 v0 = acc[ai][bj][m][0] + bv[bj][0], v1 = acc[ai][bj][m][1] + bv[bj][1];
                    if (ACT == 1) {
#pragma unroll
                        for (int j = 0; j < 4; ++j) { v0[j] = gelu_tanh_f(v0[j]); v1[j] = gelu_tanh_f(v1[j]); } }
                    u32x4 w; w.x = pk2(v0[0], v0[1]); w.y = pk2(v0[2], v0[3]); w.z = pk2(v1[0], v1[1]); w.w = pk2(v1[2], v1[3]);
                    *(u32x4*)(rowp + bj * HALF) = w; } }
    }
};
struct EpiSwiGLU {
    static constexpr bool PERM = true;
    bf16_t* H; int ldh;
    __device__ __forceinline__ void operator()(const f32x4 (&acc)[2][2][4][2], const Unit& u, int wr, int wc, int fr, int fq) const {
        asm volatile("" : "+v"(fr), "+v"(fq));
        const int row0 = u.pm * BM + wr * 64 + fr; const int col0 = u.pn * HALF + wc * 32 + 8 * fq;
#pragma unroll
        for (int ai = 0; ai < 2; ++ai)
#pragma unroll
            for (int m = 0; m < 4; ++m) { bf16_t* rowp = H + (size_t)(row0 + ai * HALF + m * 16) * ldh + col0;
                f32x4 h0, h1;
#pragma unroll
                for (int j = 0; j < 4; ++j) { h0[j] = silu_f(acc[ai][0][m][0][j]) * acc[ai][1][m][0][j]; h1[j] = silu_f(acc[ai][0][m][1][j]) * acc[ai][1][m][1][j]; }
                u32x4 w; w.x = pk2(h0[0], h0[1]); w.y = pk2(h0[2], h0[3]); w.z = pk2(h1[0], h1[1]); w.w = pk2(h1[2], h1[3]);
                *(u32x4*)rowp = w; }
    }
};
template <bool HAS_BS, bool SRC32> struct EpiResidT {
    static constexpr bool PERM = false;
    const void* src_lat; const void* src_ctx; bf16_t* dst_lat; bf16_t* dst_ctx; const float* gate;
    const float* bias; const float* cscale;
    __device__ __forceinline__ void operator()(const f32x4 (&acc)[2][2][4][2], const Unit& u, int wr, int wc, int fr, int fq) const {
        asm volatile("" : "+v"(fr), "+v"(fq));
        const bool isctx = u.pm >= RL / BM; const int mb = isctx ? 32 : (u.pm >> 3);
        const size_t trow = isctx ? (size_t)(u.pm - RL / BM) * BM : (size_t)u.pm * BM;
        const float* s32 = (const float*)(isctx ? src_ctx : src_lat) + trow * D; const bf16_t* s16 = (const bf16_t*)(isctx ? src_ctx : src_lat) + trow * D;
        bf16_t* dst = (isctx ? dst_ctx : dst_lat) + trow * D;
        const float* g = gate + (size_t)mb * MODW;
        const int col0 = u.pn * BM + wc * 32 + 4 * fq;
        f32x4 gv[2][2], bv[2][2];
#pragma unroll
        for (int bj = 0; bj < 2; ++bj)
#pragma unroll
            for (int n = 0; n < 2; ++n) { const int c = col0 + bj * HALF + n * 16; gv[bj][n] = *(const f32x4*)(g + c); bv[bj][n] = (f32x4){0.f, 0.f, 0.f, 0.f};
                if (HAS_BS) { gv[bj][n] = gv[bj][n] * *(const f32x4*)(cscale + c); bv[bj][n] = *(const f32x4*)(bias + c); } }
        if constexpr (!SRC32) {
            constexpr int NAI = 1;
#pragma unroll
            for (int a0 = 0; a0 < 2; a0 += NAI) {
            u32x2 rq[NAI][4][2][2];
#pragma unroll
            for (int ai = 0; ai < NAI; ++ai)
#pragma unroll
                for (int m = 0; m < 4; ++m) { const unsigned off = (unsigned)(((a0 + ai) * HALF + wr * 64 + m * 16 + fr) * D + col0);
#pragma unroll
                    for (int bj = 0; bj < 2; ++bj)
#pragma unroll
                        for (int n = 0; n < 2; ++n) rq[ai][m][bj][n] = *(const u32x2*)(s16 + off + bj * HALF + n * 16); }
#pragma unroll
            for (int ai = 0; ai < NAI; ++ai)
#pragma unroll
                for (int m = 0; m < 4; ++m) { const unsigned off = (unsigned)(((a0 + ai) * HALF + wr * 64 + m * 16 + fr) * D + col0);
#pragma unroll
                    for (int bj = 0; bj < 2; ++bj)
#pragma unroll
                        for (int n = 0; n < 2; ++n) { const u32x2 q = rq[ai][m][bj][n];
                            const f32x4 o = (f32x4){lo_bf(q.x), hi_bf(q.x), lo_bf(q.y), hi_bf(q.y)} + gv[bj][n] * (HAS_BS ? (acc[a0 + ai][bj][m][n] + bv[bj][n]) : acc[a0 + ai][bj][m][n]);
                            u32x2 w; w.x = pk2(o[0], o[1]); w.y = pk2(o[2], o[3]); *(u32x2*)(dst + off + bj * HALF + n * 16) = w; } }
            }
        } else {
        constexpr int MB = 4;
#pragma unroll
        for (int ai = 0; ai < 2; ++ai)
#pragma unroll
            for (int m0 = 0; m0 < 4; m0 += MB) {
                f32x4 rs[MB][2][2];
#pragma unroll
                for (int mi = 0; mi < MB; ++mi) { const unsigned off = (unsigned)((ai * HALF + wr * 64 + (m0 + mi) * 16 + fr) * D + col0);
#pragma unroll
                    for (int bj = 0; bj < 2; ++bj)
#pragma unroll
                        for (int n = 0; n < 2; ++n) rs[mi][bj][n] = *(const f32x4*)(s32 + off + bj * HALF + n * 16); }
#pragma unroll
                for (int mi = 0; mi < MB; ++mi) { const int m = m0 + mi; const unsigned off = (unsigned)((ai * HALF + wr * 64 + m * 16 + fr) * D + col0);
#pragma unroll
                    for (int bj = 0; bj < 2; ++bj)
#pragma unroll
                        for (int n = 0; n < 2; ++n) { const f32x4 o = rs[mi][bj][n] + gv[bj][n] * (HAS_BS ? (acc[ai][bj][m][n] + bv[bj][n]) : acc[ai][bj][m][n]);
                            u32x2 w; w.x = pk2(o[0], o[1]); w.y = pk2(o[2], o[3]); *(u32x2*)(dst + off + bj * HALF + n * 16) = w; } }
            }
        }
    }
};
typedef EpiResidT<false, false> EpiResid; typedef EpiResidT<true, false> EpiResidBS; typedef EpiResidT<false, true> EpiResidX;
template <bool OUT32> struct EpiMoeDownT {
    static constexpr bool PERM = false;
    bf16_t* h_lat; bf16_t* h_ctx; float* out32; const float* gate; const int* tok; const float* gw;
    __device__ __forceinline__ void operator()(const f32x4 (&acc)[2][2][4][2], const Unit& u, int wr, int wc, int fr, int fq) const {
        asm volatile("" : "+v"(fr), "+v"(fq));
        const int col0 = u.pn * BM + wc * 32 + 4 * fq;
        int tk[2][4]; float wg[2][4];
#pragma unroll
        for (int ai = 0; ai < 2; ++ai)
#pragma unroll
            for (int m = 0; m < 4; ++m) { const int pos = u.pm * BM + ai * HALF + wr * 64 + m * 16 + fr; tk[ai][m] = tok[pos]; wg[ai][m] = gw[pos]; }
        const int ttA = max(tk[0][0], 0), ttB = max(tk[1][3], 0); const int mbA = ttA >= RL ? 32 : (ttA >> 11), mbB = ttB >= RL ? 32 : (ttB >> 11);
        f32x4 gA[2][2], gB[2][2];
#pragma unroll
        for (int bj = 0; bj < 2; ++bj)
#pragma unroll
            for (int n = 0; n < 2; ++n) { gA[bj][n] = *(const f32x4*)(gate + (size_t)mbA * MODW + col0 + bj * HALF + n * 16); gB[bj][n] = *(const f32x4*)(gate + (size_t)mbB * MODW + col0 + bj * HALF + n * 16); }
        u32x2 rs[2][2][2][2];
#define MD_LOAD(k_) do { const int ai_ = (k_) >> 1, mp_ = (k_) & 1; _Pragma("unroll") for (int mi = 0; mi < 2; ++mi) { const int t = tk[ai_][2 * mp_ + mi]; const int tt = t >= 0 ? t : 0; const bool cx_ = tt >= RL; \
            const bf16_t* hp = (cx_ ? h_ctx : h_lat) + (unsigned)((cx_ ? tt - RL : tt) * D + col0); \
            _Pragma("unroll") for (int bj = 0; bj < 2; ++bj) _Pragma("unroll") for (int n = 0; n < 2; ++n) rs[mp_][mi][bj][n] = *(const u32x2*)(hp + bj * HALF + n * 16); } } while (0)
        if (EPI_PIPE_MOE) MD_LOAD(0);
#pragma unroll
        for (int k = 0; k < 4; ++k) {
            if (EPI_PIPE_MOE) { if (k + 1 < 4) MD_LOAD(k + 1); } else MD_LOAD(k);
            const int ai = k >> 1, mp = k & 1;
#pragma unroll
            for (int mi = 0; mi < 2; ++mi) { const int m = 2 * mp + mi;
                if (tk[ai][m] >= 0) { const float w = wg[ai][m]; const int tt = tk[ai][m]; const bool cx = tt >= RL; const int mb = cx ? 32 : (tt >> 11);
                    const unsigned ro = (unsigned)((cx ? tt - RL : tt) * D + col0);
                    f32x4 gg[2][2];
#pragma unroll
                    for (int bj = 0; bj < 2; ++bj)
#pragma unroll
                        for (int n = 0; n < 2; ++n) gg[bj][n] = mb == mbA ? gA[bj][n] : gB[bj][n];
                    if (mb != mbA && mb != mbB) {
#pragma unroll
                        for (int bj = 0; bj < 2; ++bj)
#pragma unroll
                            for (int n = 0; n < 2; ++n) gg[bj][n] = *(const f32x4*)(gate + (size_t)mb * MODW + col0 + bj * HALF + n * 16); }
#pragma unroll
                    for (int bj = 0; bj < 2; ++bj)
#pragma unroll
                        for (int n = 0; n < 2; ++n) { const u32x2 q = rs[mp][mi][bj][n]; const f32x4 o = (f32x4){lo_bf(q.x), hi_bf(q.x), lo_bf(q.y), hi_bf(q.y)} + gg[bj][n] * (acc[ai][bj][m][n] * w);
                            if (OUT32) *(f32x4*)(out32 + ro + bj * HALF + n * 16) = o;
                            else { u32x2 wv; wv.x = pk2(o[0], o[1]); wv.y = pk2(o[2], o[3]); *(u32x2*)((cx ? h_ctx : h_lat) + ro + bj * HALF + n * 16) = wv; } } } }
        }
#undef MD_LOAD
    }
};
typedef EpiMoeDownT<false> EpiMoeDown; typedef EpiMoeDownT<true> EpiMoeDownOut;
}

struct Frame {
    LAS unsigned char* lds;
    int tid, lane, wave, bid, G;
    const Params* p;
    unsigned char* ws; unsigned* ctl;
    float* modv; bf16_t* hlat; bf16_t* hctx; bf16_t* U;
};
#define WSP(T, off) ((T*)(F.ws + (off)))
__device__ __forceinline__ const float* INP(const Frame& F, int i) { return F.p->in[i]; }

__device__ __forceinline__ void cvt_item(const float* W, int K, int N, bf16_t* WT, int mode, LAS float* scr, int item, int lane) {
    const int nblk = N / 32, kb = item / nblk, nb = item % nblk, k0 = 64 * kb, n0 = 32 * nb;
#pragma unroll 8
    for (int i = 0; i < 32; ++i) { const int kk = 2 * i + (lane >> 5); scr[kk * 33 + (lane & 31)] = W[(size_t)(k0 + kk) * N + n0 + (lane & 31)]; }
    LDS_WAIT();
    const int c = lane & 7;
#pragma unroll
    for (int j = 0; j < 4; ++j) { const int n = (lane >> 3) + 8 * j; const LAS float* s = scr + (8 * c) * 33 + n;
        u32x4 o; o.x = pk2(s[0 * 33], s[1 * 33]); o.y = pk2(s[2 * 33], s[3 * 33]); o.z = pk2(s[4 * 33], s[5 * 33]); o.w = pk2(s[6 * 33], s[7 * 33]);
        const int nn = n0 + n; const int drow = mode == 0 ? nn : (256 * (nn >> 7) + (nn & 127) + (mode == 2 ? 128 : 0));
        *(u32x4*)(WT + (size_t)drow * K + k0 + 8 * c) = o; }
    LDS_WAIT();
}
struct CvtJob { const float* src; bf16_t* dst; int K, N, mode; };
__device__ __forceinline__ CvtJob cvt_small_job(const Frame& F, int j) {
    switch (j) {
        case 0: return CvtJob{INP(F, I_LRU_WIN), WSP(bf16_t, WS_LRU_WIN), 1024, 2560, 0};
        case 1: return CvtJob{INP(F, I_LRU_WOUT), WSP(bf16_t, WS_LRU_WOUT), 1280, 1024, 0};
        case 2: return CvtJob{INP(F, I_FFN_W1), WSP(bf16_t, WS_FFN_W13), 1024, DFF, 1};
        case 3: return CvtJob{INP(F, I_FFN_W3), WSP(bf16_t, WS_FFN_W13), 1024, DFF, 2};
        case 4: return CvtJob{INP(F, I_FFN_W2), WSP(bf16_t, WS_FFN_W2), DFF, 1024, 0};
        case 5: return CvtJob{INP(F, I_SGU_WIN), WSP(bf16_t, WS_SGU_WIN), 1024, 4096, 0};
        case 6: return CvtJob{INP(F, I_SGU_WOUT), WSP(bf16_t, WS_SGU_WOUT), 2048, 1024, 0};
        case 7: case 8: case 9: case 10: return CvtJob{INP(F, I_POOL_W) + (size_t)(j - 7) * 65536, WSP(bf16_t, WS_POOL_W) + (size_t)(j - 7) * 65536, 256, 256, 0};
        case 11: return CvtJob{INP(F, I_FFN_W1) + (size_t)D * DFF, WSP(bf16_t, WS_FFN_W13) + (size_t)2 * DFF * D, 1024, DFF, 1};
        case 12: return CvtJob{INP(F, I_FFN_W3) + (size_t)D * DFF, WSP(bf16_t, WS_FFN_W13) + (size_t)2 * DFF * D, 1024, DFF, 2};
        case 13: return CvtJob{INP(F, I_FFN_W2) + (size_t)D * DFF, WSP(bf16_t, WS_FFN_W2) + (size_t)D * DFF, DFF, 1024, 0};
        case 14: return CvtJob{INP(F, I_NA_WQKV), WSP(bf16_t, WS_NA_WQKV), 1024, 3072, 0};
        default: return CvtJob{INP(F, I_NA_WO), WSP(bf16_t, WS_NA_WO), 1024, 1024, 0};
    }
}
__device__ __forceinline__ int cvt_job_items(const CvtJob& j) { return (j.K / 64) * (j.N / 32); }
__device__ __forceinline__ void cvt_small_queue(const Frame& F, int j_lo, int j_hi, int qword) {
    LAS float* scr = (LAS float*)(F.lds + F.wave * 16384);
    int total = 0; for (int j = j_lo; j < j_hi; ++j) total += cvt_job_items(cvt_small_job(F, j));
    unsigned* head = F.ctl + CW_CVTQ + 64 * qword;
    for (;;) {
        int base = 0; if (F.lane == 0) base = (int)atomicAdd(head, 4u); base = __builtin_amdgcn_readfirstlane(base);
        if (base >= total) break;
        int j = j_lo, off = 0; CvtJob job = cvt_small_job(F, j);
        for (;;) { const int n = cvt_job_items(job); if (base < off + n) break; off += n; ++j; job = cvt_small_job(F, j); }
        for (int k = 0; k < 4 && base + k < total; ++k) { int it = base + k - off; while (it >= cvt_job_items(job)) { it -= cvt_job_items(job); off += cvt_job_items(job); ++j; job = cvt_small_job(F, j); }
            cvt_item(job.src, job.K, job.N, job.dst, job.mode, scr, it, F.lane); }
    }
}
__device__ __forceinline__ void phase_cvt_small(const Frame& F) {
    const size_t gt = (size_t)F.bid * NTHR + F.tid, GT = (size_t)F.G * NTHR;
    { const float* wa = INP(F, I_LRU_WA); const float* wi = INP(F, I_LRU_WI); bf16_t* da = WSP(bf16_t, WS_LRU_WA); bf16_t* di = WSP(bf16_t, WS_LRU_WI);
      for (size_t i = gt; i < (size_t)16 * 160 * 160; i += GT) { const int mat = (int)(i / 25600), rem = (int)(i % 25600), n = rem / 160, k = rem % 160;
          da[i] = (bf16_t)(pk2(wa[(size_t)mat * 25600 + k * 160 + n], 0.f) & 0xffffu); di[i] = (bf16_t)(pk2(wi[(size_t)mat * 25600 + k * 160 + n], 0.f) & 0xffffu); } }
    { const float* w = INP(F, I_SGU_WS); bf16_t* d = WSP(bf16_t, WS_SGU_WS);
      for (size_t i = gt; i < (size_t)8 * 128 * 128; i += GT) d[i] = (bf16_t)(pk2(w[i], 0.f) & 0xffffu); }
    cvt_small_queue(F, 0, 16, 6);
}
constexpr int CVT_MOE_ITEMS = 24 * 1792;
__device__ __forceinline__ bf16_t* moe_w13(const Frame& F, int l2) { return l2 ? WSP(bf16_t, WS_BIG + BG_MW2) : WSP(bf16_t, WS_MOE_W13); }
__device__ __forceinline__ bf16_t* moe_w2(const Frame& F, int l2) { return l2 ? WSP(bf16_t, WS_BIG + BG_MW2 + 112 * MiB) : WSP(bf16_t, WS_MOE_W2); }
__device__ __forceinline__ void cvt_moe_item(const Frame& F, int l2, int g, LAS float* scr) {
    const int job = g / 1792, it = g - job * 1792, e = job / 3, which = job - 3 * e; const size_t so = ((size_t)l2 * NE + e) * D * DFF;
    if (which == 0) cvt_item(INP(F, I_MOE_W1) + so, 1024, DFF, moe_w13(F, l2) + (size_t)e * 2 * DFF * D, 1, scr, it, F.lane);
    else if (which == 1) cvt_item(INP(F, I_MOE_W3) + so, 1024, DFF, moe_w13(F, l2) + (size_t)e * 2 * DFF * D, 2, scr, it, F.lane);
    else cvt_item(INP(F, I_MOE_W2) + so, DFF, 1024, moe_w2(F, l2) + (size_t)e * D * DFF, 0, scr, it, F.lane);
}
__device__ __forceinline__ void cvt_moe_queue(const Frame& F, int l2, int g_lo, int g_hi, int qword) {
    LAS float* scr = (LAS float*)(F.lds + F.wave * 16384);
    unsigned* head = F.ctl + CW_CVTQ + 64 * qword; const int n = g_hi - g_lo;
    for (;;) {
        int base = 0; if (F.lane == 0) base = (int)atomicAdd(head, 4u); base = __builtin_amdgcn_readfirstlane(base);
        if (base >= n) break;
        for (int k = 0; k < 4 && base + k < n; ++k) cvt_moe_item(F, l2, g_lo + base + k, scr);
    }
}

__device__ __forceinline__ void phase_mod(const Frame& F) {
    LAS float* sL = (LAS float*)F.lds;
    LAS float* pr = (LAS float*)(F.lds + 135168);
    const float* c = INP(F, I_C); const float* cc = INP(F, I_CCTX);
    __syncthreads();
    if (F.bid < 4 * 192) { for (int i = F.tid; i < 33 * 1024; i += NTHR) { const int b = i >> 10, k = i & 1023; const float v = b < 32 ? c[b * 1024 + k] : cc[k]; sL[i] = silu_f(v); } }
    __syncthreads();
    const int cl0 = F.lane & 31, kg = 2 * F.wave + (F.lane >> 5), k0 = 64 * kg;
    for (int unit = F.bid; unit < 4 * 192; unit += F.G) {
        const int l = unit / 192, col = (unit % 192) * 32 + cl0;
        const float* w = INP(F, I_MODW) + (size_t)l * 1024 * MODW + col;
        float acc[33];
#pragma unroll
        for (int b = 0; b < 33; ++b) acc[b] = 0.f;
        for (int k = k0; k < k0 + 64; k += 16) {
            float wv[16];
#pragma unroll
            for (int j = 0; j < 16; ++j) wv[j] = w[(size_t)(k + j) * MODW];
#pragma unroll
            for (int b = 0; b < 33; ++b) {
#pragma unroll
                for (int q = 0; q < 4; ++q) { const f32x4 s0 = *(const LAS f32x4*)(sL + b * 1024 + k + 4 * q); acc[b] += (s0[0] * wv[4 * q] + s0[1] * wv[4 * q + 1]) + (s0[2] * wv[4 * q + 2] + s0[3] * wv[4 * q + 3]); } }
        }
#pragma unroll
        for (int pass = 0; pass < 4; ++pass) {
            __syncthreads();
#pragma unroll
            for (int b = 0; b < 9; ++b) if (pass * 9 + b < 33) pr[(kg * 9 + b) * 32 + cl0] = acc[pass * 9 + b];
            __syncthreads();
            for (int i = F.tid; i < 9 * 32; i += NTHR) { const int b = i >> 5, cl = i & 31, bb = pass * 9 + b;
                if (bb < 33) { float t = 0.f;
#pragma unroll
                    for (int g = 0; g < 16; ++g) t += pr[(g * 9 + b) * 32 + cl];
                    const int cg = (unit % 192) * 32 + cl; F.modv[((size_t)l * 33 + bb) * MODW + cg] = t + INP(F, I_MODB)[l * MODW + cg]; } }
        }
    }
    __syncthreads();
}

struct NormCtx { const void* src_lat; const void* src_ctx; const float* gain; const float* mod; int which; bool f32src; };
struct NormPar { f32x4 gm[4], sh[4]; };
__device__ __forceinline__ void norm_load_par(const Frame& F, const NormCtx& N, int mb, NormPar& P) {
    const float* sh = N.mod + (size_t)mb * MODW + N.which * 3 * D; const float* sc = sh + D;
#pragma unroll
    for (int j = 0; j < 4; ++j) { const int c = 4 * F.lane + 256 * j; P.gm[j] = *(const f32x4*)(N.gain + c) * (*(const f32x4*)(sc + c) + 1.0f); P.sh[j] = *(const f32x4*)(sh + c); }
}
__device__ __forceinline__ void norm_load_row(const Frame& F, const NormCtx& N, int r, f32x4 (&v)[4]) {
    const size_t ro = (size_t)(r < RL ? r : r - RL) * D; const void* sp = r < RL ? N.src_lat : N.src_ctx;
#pragma unroll
    for (int j = 0; j < 4; ++j) {
        if (N.f32src) v[j] = *(const f32x4*)((const float*)sp + ro + 4 * F.lane + 256 * j);
        else { const u32x2 q = *(const u32x2*)((const bf16_t*)sp + ro + 4 * F.lane + 256 * j); v[j] = (f32x4){lo_bf(q.x), hi_bf(q.x), lo_bf(q.y), hi_bf(q.y)}; } }
}
__device__ __forceinline__ void norm_finish(const NormPar& P, const f32x4 (&v)[4], f32x4 (&y)[4]) {
    float ss = 0.f;
#pragma unroll
    for (int j = 0; j < 4; ++j) ss += (v[j][0] * v[j][0] + v[j][1] * v[j][1]) + (v[j][2] * v[j][2] + v[j][3] * v[j][3]);
    const float rstd = 1.0f / sqrtf(wave_sum(ss) * (1.0f / D) + NORM_EPS);
#pragma unroll
    for (int j = 0; j < 4; ++j) y[j] = (v[j] * rstd) * P.gm[j] + P.sh[j];
}
__device__ __forceinline__ void store_row_bf16(const Frame& F, bf16_t* dst, const f32x4 (&y)[4]) {
#pragma unroll
    for (int j = 0; j < 4; ++j) { u32x2 w; w.x = pk2(y[j][0], y[j][1]); w.y = pk2(y[j][2], y[j][3]); *(u32x2*)(dst + 4 * F.lane + 256 * j) = w; }
}
__device__ __forceinline__ void phase_norm(const Frame& F, const NormCtx& N, int nrows) {
    const int gw = F.bid * NWAVES + F.wave, NGW = F.G * NWAVES, RPW = (nrows + NGW - 1) / NGW, r0 = gw * RPW, r1 = min(nrows, r0 + RPW);
    if (r0 >= r1) return;
    NormPar P; int mbcur = -1; f32x4 v[4], vn[4];
    norm_load_row(F, N, r0, v);
    for (int r = r0; r < r1; ++r) {
        if (r + 1 < r1) norm_load_row(F, N, r + 1, vn);
        const int mb = r < RL ? (r >> 11) : 32; if (mb != mbcur) { norm_load_par(F, N, mb, P); mbcur = mb; }
        f32x4 y[4]; norm_finish(P, v, y); store_row_bf16(F, F.U + (size_t)r * D, y);
#pragma unroll
        for (int j = 0; j < 4; ++j) v[j] = vn[j];
    }
}
__device__ __forceinline__ void route_top2(const Frame& F, float (&lg)[NE], const float* br, int& e0, int& e1, float& w0) {
    const bool h5 = F.lane & 32, h4 = F.lane & 16, h3 = F.lane & 8;
    float a4[4];
#pragma unroll
    for (int k = 0; k < 4; ++k) { const float mine = h5 ? lg[4 + k] : lg[k], send = h5 ? lg[k] : lg[4 + k]; a4[k] = mine + __shfl_xor(send, 32); }
    float a2[2];
#pragma unroll
    for (int k = 0; k < 2; ++k) { const float mine = h4 ? a4[2 + k] : a4[k], send = h4 ? a4[k] : a4[2 + k]; a2[k] = mine + __shfl_xor(send, 16); }
    float a1; { const float mine = h3 ? a2[1] : a2[0], send = h3 ? a2[0] : a2[1]; a1 = mine + __shfl_xor(send, 8); }
    a1 += __shfl_xor(a1, 4); a1 += __shfl_xor(a1, 2); a1 += __shfl_xor(a1, 1);
#pragma unroll
    for (int e = 0; e < NE; ++e) lg[e] = __int_as_float(__builtin_amdgcn_readlane(__float_as_int(a1), ((e >> 2) & 1) * 32 + ((e >> 1) & 1) * 16 + (e & 1) * 8)) + br[e];
    e0 = 0; float v0 = lg[0];
#pragma unroll
    for (int e = 1; e < NE; ++e) if (lg[e] > v0) { v0 = lg[e]; e0 = e; }
    e1 = -1; float v1 = -3.0e38f;
#pragma unroll
    for (int e = 0; e < NE; ++e) if (e != e0 && lg[e] > v1) { v1 = lg[e]; e1 = e; }
    w0 = 1.0f / (1.0f + __expf(v1 - v0));
}
__device__ __forceinline__ void phase_route(const Frame& F, const NormCtx& N, int nrows, int l2) {
    LAS float* wrL = (LAS float*)F.lds;
    LAS unsigned* hist = (LAS unsigned*)(F.lds + 32768);
    __syncthreads();
    const float* wr = INP(F, I_MOE_WR) + (size_t)l2 * D * NE; const float* br = INP(F, I_MOE_BR) + l2 * NE;
    for (int i = F.tid; i < D * NE; i += NTHR) wrL[(i & 7) * D + (i >> 3)] = wr[i];
    if (F.tid < 16) hist[F.tid] = 0u;
    __syncthreads();
    int* re = WSP(int, WS_ROUTE + RT_E); float* rw = WSP(float, WS_ROUTE + RT_W);
    const int gw = F.bid * NWAVES + F.wave, NGW = F.G * NWAVES, RPW = (nrows + NGW - 1) / NGW, r0 = gw * RPW, r1 = min(nrows, r0 + RPW);
    NormPar P; int mbcur = -1; f32x4 va[4], vb[4], na[4], nb[4];
    if (r0 < r1) { norm_load_row(F, N, r0, va); norm_load_row(F, N, min(r0 + 1, r1 - 1), vb); }
    for (int r = r0; r < r1; r += 2) {
        const bool two = r + 1 < r1; const int rb = two ? r + 1 : r;
        if (r + 2 < r1) { norm_load_row(F, N, r + 2, na); norm_load_row(F, N, min(r + 3, r1 - 1), nb); }
        f32x4 ya[4], yb[4];
        { const int mb = r < RL ? (r >> 11) : 32; if (mb != mbcur) { norm_load_par(F, N, mb, P); mbcur = mb; } norm_finish(P, va, ya); store_row_bf16(F, F.U + (size_t)r * D, ya); }
        { const int mb = rb < RL ? (rb >> 11) : 32; if (mb != mbcur) { norm_load_par(F, N, mb, P); mbcur = mb; } norm_finish(P, vb, yb); if (two) store_row_bf16(F, F.U + (size_t)rb * D, yb); }
        float la[NE], lb[NE];
#pragma unroll
        for (int e = 0; e < NE; ++e) { la[e] = 0.f; lb[e] = 0.f; }
#pragma unroll
        for (int j = 0; j < 4; ++j)
#pragma unroll
            for (int e = 0; e < NE; ++e) { const f32x4 wv = *(const LAS f32x4*)(wrL + e * D + 4 * F.lane + 256 * j);
                la[e] += (ya[j][0] * wv[0] + ya[j][1] * wv[1]) + (ya[j][2] * wv[2] + ya[j][3] * wv[3]); lb[e] += (yb[j][0] * wv[0] + yb[j][1] * wv[1]) + (yb[j][2] * wv[2] + yb[j][3] * wv[3]); }
        int e0, e1; float w0;
        route_top2(F, la, br, e0, e1, w0);
        if (F.lane == 0) { re[r] = e0 | (e1 << 8); rw[2 * r] = w0; rw[2 * r + 1] = 1.0f - w0; lds_add(&hist[e0], 1u); lds_add(&hist[8 + e1], 1u); }
        route_top2(F, lb, br, e0, e1, w0);
        if (F.lane == 0 && two) { re[rb] = e0 | (e1 << 8); rw[2 * rb] = w0; rw[2 * rb + 1] = 1.0f - w0; lds_add(&hist[e0], 1u); lds_add(&hist[8 + e1], 1u); }
#pragma unroll
        for (int j = 0; j < 4; ++j) { va[j] = na[j]; vb[j] = nb[j]; }
    }
    __syncthreads();
    if (F.tid < 16 && hist[F.tid]) atomicAdd(F.ctl + CW_CNT + 64 * l2 + F.tid, hist[F.tid]);
    int* tok = WSP(int, WS_ROUTE + RT_TOK);
    for (size_t i = (size_t)F.bid * NTHR + F.tid; i < (size_t)2 * MPAD; i += (size_t)F.G * NTHR) tok[i] = -1;
    __syncthreads();
}
__device__ __forceinline__ int pad256(int x) { return (x + 255) & ~255; }
__device__ __forceinline__ void phase_assign_scatter0(const Frame& F, int nrows, int l2) {
    LAS unsigned* bcnt = (LAS unsigned*)F.lds;
    LAS unsigned* bbase = (LAS unsigned*)(F.lds + 64);
    __syncthreads();
    if (F.tid < 16) bcnt[F.tid] = 0u;
    __syncthreads();
    const int RPB = (nrows + F.G - 1) / F.G, rb0 = F.bid * RPB, rb1 = min(nrows, rb0 + RPB);
    const int* re = WSP(const int, WS_ROUTE + RT_E); const float* rw = WSP(const float, WS_ROUTE + RT_W);
    int* tok = WSP(int, WS_ROUTE + RT_TOK); float* gwl = WSP(float, WS_ROUTE + RT_GW); int* pos1 = WSP(int, WS_ROUTE + RT_P1);
    const int myr = rb0 + F.wave + 8 * F.lane; const bool have = myr < rb1;
    int e0 = 0, e1 = 0; unsigned li0 = 0, li1 = 0; float w0 = 0.f, w1 = 0.f;
    if (have) { const int ee = re[myr]; e0 = ee & 255; e1 = (ee >> 8) & 255; w0 = rw[2 * myr]; w1 = rw[2 * myr + 1]; li0 = lds_add(&bcnt[e0], 1u); li1 = lds_add(&bcnt[8 + e1], 1u); }
    __syncthreads();
    const unsigned* cnt = F.ctl + CW_CNT + 64 * l2;
    if (F.tid < 16) { const int s = F.tid >> 3, e = F.tid & 7; unsigned off = 0; for (int k = 0; k < e; ++k) off += (unsigned)pad256((int)cnt[s * 8 + k]);
        unsigned b = 0; if (bcnt[F.tid]) b = atomicAdd(F.ctl + CW_CUR + 64 * l2 + F.tid, bcnt[F.tid]); bbase[F.tid] = off + b; }
    __syncthreads();
    const int p0 = (int)(bbase[e0] + li0), p1 = (int)(bbase[8 + e1] + li1);
    if (have) { tok[p0] = myr; gwl[p0] = w0; tok[MPAD + p1] = myr; gwl[MPAD + p1] = w1; pos1[myr] = p1; }
    __syncthreads();
}
__device__ __forceinline__ int moe_tile_table(const Frame& F, int l2, int s, LAS int* tstart) {
    __syncthreads();
    if (F.tid == 0) { const unsigned* cnt = F.ctl + CW_CNT + 64 * l2 + 8 * s; int t = 0; for (int e = 0; e < NE; ++e) { tstart[e] = t; t += pad256((int)cnt[e]) >> 8; } tstart[8] = t; }
    __syncthreads();
    return tstart[8];
}

constexpr int SC_RS = 164;
__device__ __forceinline__ void scan_conv_load(const bf16_t* XG, size_t rowbase, int L, int t0, int ch0, int pt, u32x2 (&xr)[11]) {
    const int q4 = pt % 40, rg = pt / 40, ch = ch0 + 4 * q4, ta = t0 + 8 * rg;
#pragma unroll
    for (int i = 0; i < 11; ++i) { const int tp = ta - 2 + i; xr[i] = (tp >= 0 && tp < L) ? *(const u32x2*)(XG + (rowbase + tp) * 2560 + ch) : (u32x2){0u, 0u}; }
}
__device__ __forceinline__ void scan_conv_math(const LAS float* cwL, LAS bf16_t* xc, int pt, const u32x2 (&xr)[11]) {
    const int q4 = pt % 40, rg = pt / 40;
    const f32x4 bias = *(const LAS f32x4*)(cwL + 4 * 160 + 4 * q4); f32x4 wv[4];
#pragma unroll
    for (int k = 0; k < 4; ++k) wv[k] = *(const LAS f32x4*)(cwL + k * 160 + 4 * q4);
#pragma unroll
    for (int i = 0; i < 8; ++i) { f32x4 acc = bias;
#pragma unroll
        for (int k = 0; k < 4; ++k) { const u32x2 x = xr[i + k]; acc[0] += lo_bf(x.x) * wv[k][0]; acc[1] += hi_bf(x.x) * wv[k][1]; acc[2] += lo_bf(x.y) * wv[k][2]; acc[3] += hi_bf(x.y) * wv[k][3]; }
        u32x2 o; o.x = pk2(acc[0], acc[1]); o.y = pk2(acc[2], acc[3]); *(LAS u32x2*)(xc + (8 * rg + i) * 168 + 4 * q4) = o; }
}
__device__ __forceinline__ void phase_scan(const Frame& F, bool need_ctx) {
    LAS bf16_t* xcA0 = (LAS bf16_t*)F.lds;
    LAS float* Ra = (LAS float*)(F.lds + 43008);
    LAS float* Ri = (LAS float*)(F.lds + 43008 + 41984);
    LAS float* tab = (LAS float*)(F.lds + 43008 + 2 * 41984);
    LAS bf16_t* Hb = (LAS bf16_t*)(F.lds + 43008 + 2 * 41984 + 2048);
    LAS float* cwL = (LAS float*)(F.lds + 43008 + 2 * 41984 + 2048 + 21504);
    const bf16_t* XG = WSP(const bf16_t, WS_BIG + BG_XG); bf16_t* Y = WSP(bf16_t, WS_BIG + BG_Y);
    const float* cw = INP(F, I_LRU_CW); const float* cb = INP(F, I_LRU_CB);
    const int fr = F.lane & 15, fq = F.lane >> 4, w = F.wave;
    const int ntA = w, ntB = 8 + (w & 1), mtB = w >> 1;
    for (int unit = F.bid; unit < NB * 8; unit += F.G) {
        const int b = unit >> 3, kb = unit & 7, ch0 = kb * LBW;
        __syncthreads();
        for (int i = F.tid; i < 5 * LBW; i += NTHR) { const int k = i / LBW, c = i - k * LBW; cwL[i] = k < 4 ? cw[k * DRNN + ch0 + c] : cb[ch0 + c]; }
        for (int d = 0; d < 2; ++d) {
            float carry = 0.f;
            bf16x8 Ba[5], Bi[5];
            __syncthreads();
            const bf16_t* wa = WSP(const bf16_t, WS_LRU_WA) + (size_t)(d * 8 + kb) * 25600; const bf16_t* wi = WSP(const bf16_t, WS_LRU_WI) + (size_t)(d * 8 + kb) * 25600;
#pragma unroll
            for (int ks = 0; ks < 5; ++ks) { Ba[ks] = *(const bf16x8*)(wa + (16 * ntA + fr) * 160 + 32 * ks + 8 * fq); Bi[ks] = *(const bf16x8*)(wi + (16 * ntA + fr) * 160 + 32 * ks + 8 * fq); }
            if (F.tid < LBW) { const int c = ch0 + F.tid; tab[F.tid] = INP(F, I_LRU_BA)[d * DRNN + c]; tab[160 + F.tid] = INP(F, I_LRU_BI)[d * DRNN + c];
                const float lam = INP(F, I_LRU_LAM)[d * DRNN + c]; tab[320 + F.tid] = 8.0f * 1.4426950408889634f * (lam > 0.f ? log1pf(expf(-lam)) : (-lam + log1pf(expf(lam)))); }
            if (F.tid >= 192) { u32x2 xr[11]; scan_conv_load(XG, (size_t)RL + (size_t)b * CTXL, CTXL, d ? CTXL - 64 : 0, ch0, F.tid - 192, xr); scan_conv_math(cwL, xcA0, F.tid - 192, xr); }
            __syncthreads();
            for (int cidx = 0; cidx <= 36; ++cidx) {
                const int seg = cidx >= 4, ci = seg ? cidx - 4 : cidx, L = seg ? SEQ : CTXL; const size_t rowbase = seg ? (size_t)b * SEQ : (size_t)RL + (size_t)b * CTXL;
                const int t0 = d ? L - 64 * (ci + 1) : 64 * ci;
                LAS bf16_t* xc = xcA0 + (cidx & 1) * (64 * 168);
                PR_BEG(1, F.lds);
                const int pc = cidx - 1; const int pseg = pc >= 4, pci = pseg ? pc - 4 : pc, pL = pseg ? SEQ : CTXL; const size_t prow = pseg ? (size_t)b * SEQ : (size_t)RL + (size_t)b * CTXL;
                const int pt0 = d ? pL - 64 * (pci + 1) : 64 * pci; const bool p_out = pc >= 0 && (pseg == 1 || need_ctx);
                u32x2 pv[5], gv[5];
#pragma unroll
                for (int it = 0; it < 5; ++it) { const int e = F.tid + NTHR * it, tt = e / 40, c4 = e % 40;
                    if (d == 1 && p_out) { const size_t row = prow + pt0 + tt; pv[it] = *(const u32x2*)(Y + row * DRNN + ch0 + 4 * c4); gv[it] = *(const u32x2*)(XG + row * 2560 + DRNN + ch0 + 4 * c4); } else { pv[it] = (u32x2){0u, 0u}; gv[it] = (u32x2){0u, 0u}; } }
                if (cidx < 36) {
                    bf16x8 Xa[5], Xi[5];
#pragma unroll
                    for (int ks = 0; ks < 5; ++ks) { Xa[ks] = *(const bf16x8*)(wa + (16 * ntB + fr) * 160 + 32 * ks + 8 * fq); Xi[ks] = *(const bf16x8*)(wi + (16 * ntB + fr) * 160 + 32 * ks + 8 * fq); }
#pragma unroll 1
                    for (int mt = 0; mt < 4; ++mt) {
                        f32x4 ra = {0.f, 0.f, 0.f, 0.f}, ri = {0.f, 0.f, 0.f, 0.f};
#pragma unroll
                        for (int ks = 0; ks < 5; ++ks) { const bf16x8 a = *(const LAS bf16x8*)(xc + (16 * mt + fr) * 168 + 32 * ks + 8 * fq);
                            ra = __builtin_amdgcn_mfma_f32_16x16x32_bf16(Ba[ks], a, ra, 0, 0, 0); ri = __builtin_amdgcn_mfma_f32_16x16x32_bf16(Bi[ks], a, ri, 0, 0, 0); }
                        const int o = (16 * mt + fr) * SC_RS + 16 * ntA + 4 * fq; *(LAS f32x4*)(Ra + o) = ra; *(LAS f32x4*)(Ri + o) = ri;
                    }
                    {
                        f32x4 ra = {0.f, 0.f, 0.f, 0.f}, ri = {0.f, 0.f, 0.f, 0.f};
#pragma unroll
                        for (int ks = 0; ks < 5; ++ks) { const bf16x8 a = *(const LAS bf16x8*)(xc + (16 * mtB + fr) * 168 + 32 * ks + 8 * fq);
                            ra = __builtin_amdgcn_mfma_f32_16x16x32_bf16(Xa[ks], a, ra, 0, 0, 0); ri = __builtin_amdgcn_mfma_f32_16x16x32_bf16(Xi[ks], a, ri, 0, 0, 0); }
                        const int o = (16 * mtB + fr) * SC_RS + 16 * ntB + 4 * fq; *(LAS f32x4*)(Ra + o) = ra; *(LAS f32x4*)(Ri + o) = ri;
                    }
                }
                if (p_out) {
#pragma unroll
                    for (int it = 0; it < 5; ++it) { const int e = F.tid + NTHR * it, tt = e / 40, c4 = e % 40; const u32x2 hb = *(const LAS u32x2*)(Hb + tt * 168 + 4 * c4);
                        u32x2* yp = (u32x2*)(Y + (prow + pt0 + tt) * DRNN + ch0 + 4 * c4); u32x2 o;
                        if (d == 0) o = hb;
                        else { o.x = pk2((lo_bf(pv[it].x) + lo_bf(hb.x)) * gelu_tanh_f(lo_bf(gv[it].x)), (hi_bf(pv[it].x) + hi_bf(hb.x)) * gelu_tanh_f(hi_bf(gv[it].x)));
                               o.y = pk2((lo_bf(pv[it].y) + lo_bf(hb.y)) * gelu_tanh_f(lo_bf(gv[it].y)), (hi_bf(pv[it].y) + hi_bf(hb.y)) * gelu_tanh_f(hi_bf(gv[it].y))); }
                        *yp = o; }
                }
                if (cidx == 36) break;
                __syncthreads();
                PR_END(1, F.lds); PR_BEG(2, F.lds);
                const bool do_conv = F.tid >= 192 && cidx + 1 < 36;
                u32x2 xr[11];
                if (do_conv) { const int nseg = (cidx + 1) >= 4, nci = nseg ? cidx + 1 - 4 : cidx + 1, nL = nseg ? SEQ : CTXL;
                    scan_conv_load(XG, nseg ? (size_t)b * SEQ : (size_t)RL + (size_t)b * CTXL, nL, d ? nL - 64 * (nci + 1) : 64 * nci, ch0, F.tid - 192, xr); }
#pragma unroll 1
                for (int it = 0; it < 5; ++it) { const int e = F.tid + NTHR * it, tt = e / 40, c4 = e % 40; const int o = tt * SC_RS + 4 * c4;
                    const f32x4 va = *(const LAS f32x4*)(Ra + o) + *(const LAS f32x4*)(tab + 4 * c4), vi = *(const LAS f32x4*)(Ri + o) + *(const LAS f32x4*)(tab + 160 + 4 * c4), sp = *(const LAS f32x4*)(tab + 320 + 4 * c4);
                    const u32x2 xv = *(const LAS u32x2*)(xc + tt * 168 + 4 * c4); const float xf[4] = {lo_bf(xv.x), hi_bf(xv.x), lo_bf(xv.y), hi_bf(xv.y)};
                    f32x4 av, bv;
#pragma unroll
                    for (int j = 0; j < 4; ++j) { const float r = __builtin_amdgcn_rcpf(1.0f + __builtin_amdgcn_exp2f(-1.4426950408889634f * va[j])), ig = __builtin_amdgcn_rcpf(1.0f + __builtin_amdgcn_exp2f(-1.4426950408889634f * vi[j]));
                        const float a = __builtin_amdgcn_exp2f(-r * sp[j]); av[j] = a; bv[j] = __builtin_amdgcn_sqrtf(fmaxf(1.0f - a * a, 0.f)) * (ig * xf[j]); }
                    *(LAS f32x4*)(Ra + o) = av; *(LAS f32x4*)(Ri + o) = bv; }
                __syncthreads();
                PR_END(2, F.lds); PR_BEG(3, F.lds);
                if (F.tid < LBW) { float h = carry;
                    __builtin_amdgcn_s_setprio(3);
#pragma unroll 1
                    for (int s0 = 0; s0 < 64; s0 += 16) {
                        float av[16], bv[16], hv[16];
#pragma unroll
                        for (int k = 0; k < 16; ++k) { const int tt = d ? 63 - (s0 + k) : s0 + k; av[k] = Ra[tt * SC_RS + F.tid]; bv[k] = Ri[tt * SC_RS + F.tid]; }
#pragma unroll
                        for (int k = 0; k < 16; ++k) { h = av[k] * h + bv[k]; hv[k] = h; }
#pragma unroll
                        for (int k = 0; k < 16; ++k) { const int tt = d ? 63 - (s0 + k) : s0 + k; Hb[tt * 168 + F.tid] = (bf16_t)(pk2(hv[k], 0.f) & 0xffffu); }
                    }
                    __builtin_amdgcn_s_setprio(0);
                    carry = h; }
                else if (do_conv) scan_conv_math(cwL, xcA0 + ((cidx + 1) & 1) * (64 * 168), F.tid - 192, xr);
                __syncthreads();
                PR_END(3, F.lds);
            }
        }
    }
}

__device__ __forceinline__ void phase_sgu_stats(const Frame& F) {
    const bf16_t* Z = WSP(const bf16_t, WS_BIG + BG_Z); float* st = WSP(float, WS_ROUTE + RT_ST);
    const int gw = F.bid * NWAVES + F.wave, NGW = F.G * NWAVES, RPW = (RA + NGW - 1) / NGW, r0 = gw * RPW, r1 = min(RA, r0 + RPW);
    if (r0 >= r1) return;
    u32x4 q[4], qn[4];
#pragma unroll
    for (int j = 0; j < 4; ++j) q[j] = *(const u32x4*)(Z + (size_t)r0 * 4096 + DSGU + 8 * F.lane + 512 * j);
    for (int r = r0; r < r1; ++r) {
        if (r + 1 < r1) {
#pragma unroll
            for (int j = 0; j < 4; ++j) qn[j] = *(const u32x4*)(Z + (size_t)(r + 1) * 4096 + DSGU + 8 * F.lane + 512 * j); }
        float x[32]; float s = 0.f;
#pragma unroll
        for (int j = 0; j < 4; ++j) { x[8 * j + 0] = lo_bf(q[j].x); x[8 * j + 1] = hi_bf(q[j].x); x[8 * j + 2] = lo_bf(q[j].y); x[8 * j + 3] = hi_bf(q[j].y); x[8 * j + 4] = lo_bf(q[j].z); x[8 * j + 5] = hi_bf(q[j].z); x[8 * j + 6] = lo_bf(q[j].w); x[8 * j + 7] = hi_bf(q[j].w); }
#pragma unroll
        for (int i = 0; i < 32; ++i) s += x[i];
        const float mean = wave_sum(s) * (1.0f / DSGU); float q2 = 0.f;
#pragma unroll
        for (int i = 0; i < 32; ++i) { const float dlt = x[i] - mean; q2 += dlt * dlt; }
        const float rstd = 1.0f / sqrtf(wave_sum(q2) * (1.0f / DSGU) + NORM_EPS);
        if (F.lane == 0) { st[2 * r] = mean; st[2 * r + 1] = rstd; }
#pragma unroll
        for (int j = 0; j < 4; ++j) q[j] = qn[j];
    }
}
__device__ __forceinline__ size_t sgu_row0(int cu) { return cu < 512 ? (size_t)(cu >> 4) * SEQ + (size_t)(cu & 15) * 128 : (size_t)RL + (size_t)((cu - 512) >> 1) * CTXL + (size_t)((cu - 512) & 1) * 128; }
__device__ __forceinline__ void phase_sgu_spatial(const Frame& F) {
    LAS bf16_t* vT = (LAS bf16_t*)F.lds;
    LAS bf16_t* uT = (LAS bf16_t*)(F.lds + 69632);
    bf16_t* Z = WSP(bf16_t, WS_BIG + BG_Z); const float* st = WSP(const float, WS_ROUTE + RT_ST);
    const bf16_t* wsb = WSP(const bf16_t, WS_SGU_WS);
    const float* lng = INP(F, I_SGU_LNG); const float* lnb = INP(F, I_SGU_LNB); const float* bs = INP(F, I_SGU_BS);
    const int fr = F.lane & 15, fq = F.lane >> 4, w = F.wave;
    const int q8 = F.tid >> 5, d8 = F.tid & 31;
    const int urow = F.tid >> 5, uch = F.tid & 31;
    u32x4 vq[8], uq[8]; f32x2 sq[8];
    int unit = F.bid;
    if (unit < 576 * 8) { const int cu = unit >> 3, g = unit & 7; const size_t row0 = sgu_row0(cu);
#pragma unroll
        for (int i = 0; i < 8; ++i) { const size_t r = row0 + 8 * q8 + i; vq[i] = *(const u32x4*)(Z + r * 4096 + DSGU + 256 * g + 8 * d8); sq[i] = *(const f32x2*)(st + 2 * r);
            uq[i] = *(const u32x4*)(Z + (row0 + urow + 16 * i) * 4096 + 256 * g + 8 * uch); } }
    for (; unit < 576 * 8; unit += F.G) {
        const int cu = unit >> 3, g = unit & 7; const size_t row0 = sgu_row0(cu);
        {
            const int dcol = 256 * g + 8 * d8; float gg[8], bb[8];
#pragma unroll
            for (int j = 0; j < 8; ++j) { gg[j] = lng[dcol + j]; bb[j] = lnb[dcol + j]; }
            float x[8][8];
#pragma unroll
            for (int i = 0; i < 8; ++i) { const u32x4 q = vq[i]; const float mean = sq[i][0], rstd = sq[i][1];
                const float raw[8] = {lo_bf(q.x), hi_bf(q.x), lo_bf(q.y), hi_bf(q.y), lo_bf(q.z), hi_bf(q.z), lo_bf(q.w), hi_bf(q.w)};
#pragma unroll
                for (int j = 0; j < 8; ++j) x[i][j] = (raw[j] - mean) * rstd * gg[j] + bb[j]; }
#pragma unroll
            for (int j = 0; j < 8; ++j) { u32x4 o; o.x = pk2(x[0][j], x[1][j]); o.y = pk2(x[2][j], x[3][j]); o.z = pk2(x[4][j], x[5][j]); o.w = pk2(x[6][j], x[7][j]);
                *(LAS u32x4*)(vT + (8 * d8 + j) * 136 + 8 * (q8 ^ (d8 & 15))) = o; }
#pragma unroll
            for (int i = 0; i < 8; ++i) *(LAS u32x4*)(uT + (urow + 16 * i) * 264 + 8 * uch) = uq[i];
        }
        __syncthreads();
        {
            const int nu = unit + F.G;
            if (nu < 576 * 8) { const int ncu = nu >> 3, ng = nu & 7; const size_t nrow0 = sgu_row0(ncu);
#pragma unroll
                for (int i = 0; i < 8; ++i) { const size_t r = nrow0 + 8 * q8 + i; vq[i] = *(const u32x4*)(Z + r * 4096 + DSGU + 256 * ng + 8 * d8); sq[i] = *(const f32x2*)(st + 2 * r);
                    uq[i] = *(const u32x4*)(Z + (nrow0 + urow + 16 * i) * 4096 + 256 * ng + 8 * uch); } }
            const int p = 16 * w + fr; LAS u32x2* urow_l = (LAS u32x2*)(uT + p * 264 + 4 * fq);
            bf16x8 af[4];
#pragma unroll
            for (int ks = 0; ks < 4; ++ks) af[ks] = *(const bf16x8*)(wsb + ((size_t)g * 128 + p) * 128 + 32 * ks + 8 * fq);
            const float bias = bs[g * 128 + p];
#pragma unroll 4
            for (int nt = 0; nt < 16; ++nt) { f32x4 acc = {0.f, 0.f, 0.f, 0.f};
#pragma unroll
                for (int ks = 0; ks < 4; ++ks) { const bf16x8 bfv = *(const LAS bf16x8*)(vT + (16 * nt + fr) * 136 + 8 * ((4 * ks + fq) ^ ((2 * nt + (fr >> 3)) & 15))); acc = __builtin_amdgcn_mfma_f32_16x16x32_bf16(bfv, af[ks], acc, 0, 0, 0); }
                const u32x2 u2 = urow_l[4 * nt]; u32x2 o; o.x = pk2(lo_bf(u2.x) * (acc[0] + bias), hi_bf(u2.x) * (acc[1] + bias)); o.y = pk2(lo_bf(u2.y) * (acc[2] + bias), hi_bf(u2.y) * (acc[3] + bias)); urow_l[4 * nt] = o; }
        }
        __syncthreads();
#pragma unroll
        for (int i = 0; i < 8; ++i) *(u32x4*)(Z + (row0 + urow + 16 * i) * 4096 + 256 * g + 8 * uch) = *(const LAS u32x4*)(uT + (urow + 16 * i) * 264 + 8 * uch);
        __syncthreads();
    }
}

template <int WN> __device__ __forceinline__ void pool_item(const bf16_t* U, bf16_t* PD, int r, int cg) {
    int t, L; size_t base; if (r < RL) { t = r & (SEQ - 1); L = SEQ; base = (size_t)(r - t); } else { t = (r - RL) & (CTXL - 1); L = CTXL; base = (size_t)(r - t); }
    const int lo = max(t - WN / 2, 0), hi = min(t + WN / 2 - 1, L - 1);
    u32x4 v[WN];
#pragma unroll
    for (int k = 0; k < WN; ++k) { const int q = min(max(t - WN / 2 + k, 0), L - 1); v[k] = *(const u32x4*)(U + (base + q) * D + 8 * cg); }
    float s[8] = {0.f, 0.f, 0.f, 0.f, 0.f, 0.f, 0.f, 0.f};
#pragma unroll
    for (int k = 0; k < WN; ++k) { const int q = t - WN / 2 + k; const float m = (q >= lo && q <= hi) ? 1.f : 0.f;
        s[0] += m * lo_bf(v[k].x); s[1] += m * hi_bf(v[k].x); s[2] += m * lo_bf(v[k].y); s[3] += m * hi_bf(v[k].y); s[4] += m * lo_bf(v[k].z); s[5] += m * hi_bf(v[k].z); s[6] += m * lo_bf(v[k].w); s[7] += m * hi_bf(v[k].w); }
    const u32x4 sv = v[WN / 2];
    const float inv = 1.0f / (float)(hi - lo + 1);
    u32x4 o; o.x = pk2(s[0] * inv - lo_bf(sv.x), s[1] * inv - hi_bf(sv.x)); o.y = pk2(s[2] * inv - lo_bf(sv.y), s[3] * inv - hi_bf(sv.y));
    o.z = pk2(s[4] * inv - lo_bf(sv.z), s[5] * inv - hi_bf(sv.z)); o.w = pk2(s[6] * inv - lo_bf(sv.w), s[7] * inv - hi_bf(sv.w));
    *(u32x4*)(PD + (size_t)r * D + 8 * cg) = o;
}
__device__ __forceinline__ void phase_pool_diff(const Frame& F) {
    bf16_t* PD = WSP(bf16_t, WS_BIG + BG_PD);
    const size_t T0 = (size_t)F.bid * NTHR + F.tid, TS = (size_t)F.G * NTHR, NI = (size_t)RA * 32;
#define POOL_LOOP(g_, WN_, K_) for (size_t i = T0; i < NI; i += K_ * TS) { _Pragma("unroll") for (int k_ = 0; k_ < K_; ++k_) { const size_t ii = i + k_ * TS; if (ii < NI) pool_item<WN_>(F.U, PD, (int)(ii >> 5), 32 * g_ + (int)(ii & 31)); } }
    POOL_LOOP(0, 2, 8) POOL_LOOP(1, 4, 4) POOL_LOOP(2, 8, 2) POOL_LOOP(3, 16, 1)
#undef POOL_LOOP
}

__device__ __forceinline__ void phase_na(const Frame& F) {
    const bf16_t* QKV = WSP(const bf16_t, WS_BIG + BG_QKV); bf16_t* O = WSP(bf16_t, WS_BIG + BG_O); const float* rpb = INP(F, I_NA_RPB);
    const int w = F.wave, rsub = w >> 1, chh = w & 1, fr = F.lane & 15, fq = F.lane >> 4;
    const int skey = F.tid >> 3, sd8 = F.tid & 7;
    LAS float* bt = (LAS float*)(F.lds + 36864);
    const unsigned trl = (unsigned)((fr >> 2) * 144 + (fr & 3) * 8);
    float kgain[8];
#pragma unroll
    for (int j = 0; j < 8; ++j) kgain[j] = INP(F, I_NA_KG)[8 * sd8 + j];
#define NA_KNORM(kr) do { float x_[8] = {lo_bf(kr.x), hi_bf(kr.x), lo_bf(kr.y), hi_bf(kr.y), lo_bf(kr.z), hi_bf(kr.z), lo_bf(kr.w), hi_bf(kr.w)}; float ss_ = 0.f; \
        _Pragma("unroll") for (int j_ = 0; j_ < 8; ++j_) ss_ += x_[j_] * x_[j_]; \
        ss_ += dpp_f<0xB1>(ss_); ss_ += dpp_f<0x4E>(ss_); ss_ += dpp_f<0x141>(ss_); \
        const float rs_ = __builtin_amdgcn_rsqf(ss_ * (1.0f / 64.0f) + NORM_EPS); \
        kr.x = pk2(x_[0] * rs_ * kgain[0], x_[1] * rs_ * kgain[1]); kr.y = pk2(x_[2] * rs_ * kgain[2], x_[3] * rs_ * kgain[3]); \
        kr.z = pk2(x_[4] * rs_ * kgain[4], x_[5] * rs_ * kgain[5]); kr.w = pk2(x_[6] * rs_ * kgain[6], x_[7] * rs_ * kgain[7]); } while (0)
    float gqm = 0.f, gkm = 0.f; for (int i = 0; i < 64; ++i) { gqm = fmaxf(gqm, fabsf(INP(F, I_NA_QG)[i])); gkm = fmaxf(gkm, fabsf(INP(F, I_NA_KG)[i])); }
    const float M0 = 8.0f * gqm * gkm * 1.4426950408889634f;
    u32x4 qraw[2][2]; float btv; u32x4 kreg, vreg;
#define NA_ISSUE(u_) do { const int rg_ = (u_) & 7, h_ = ((u_) >> 3) & 15, b_ = (u_) >> 7; const int ulo_ = min(max(4 * rg_ - 4, 0), 24); \
        _Pragma("unroll") for (int qt_ = 0; qt_ < 2; ++qt_) _Pragma("unroll") for (int ks_ = 0; ks_ < 2; ++ks_) \
            qraw[qt_][ks_] = *(const u32x4*)(QKV + ((size_t)b_ * SEQ + (size_t)(4 * rg_ + rsub) * 64 + 32 * chh + 16 * qt_ + fr) * 3072 + h_ * 64 + 32 * ks_ + 8 * fq); \
        btv = F.tid < 465 ? rpb[(size_t)h_ * 465 + F.tid] : 0.f; \
        const bf16_t* kp_ = QKV + ((size_t)b_ * SEQ + (size_t)ulo_ * 64 + skey) * 3072 + D + h_ * 64 + 8 * sd8; kreg = *(const u32x4*)kp_; vreg = *(const u32x4*)(kp_ + D); } while (0)
    if (F.bid < NB * 16 * 8) NA_ISSUE(F.bid);
    for (int unit = F.bid; unit < NB * 16 * 8; unit += F.G) {
        const int rg = unit & 7, h = (unit >> 3) & 15, b = unit >> 7;
        const int r = 4 * rg + rsub, r0 = min(max(r - 4, 0), 24);
        const int ulo = min(max(4 * rg - 4, 0), 24), uhi = min(max(4 * rg - 1, 0), 24) + 8, nnb = uhi - ulo, ntile = nnb + 4;
        bf16x8 qf[2][2]; size_t qrow[2];
#pragma unroll
        for (int qt = 0; qt < 2; ++qt) { qrow[qt] = (size_t)b * SEQ + (size_t)r * 64 + 32 * chh + 16 * qt + fr;
            u32x4 raw[2]; float xv[2][8]; float ss = 0.f;
#pragma unroll
            for (int ks = 0; ks < 2; ++ks) { raw[ks] = qraw[qt][ks];
                xv[ks][0] = lo_bf(raw[ks].x); xv[ks][1] = hi_bf(raw[ks].x); xv[ks][2] = lo_bf(raw[ks].y); xv[ks][3] = hi_bf(raw[ks].y); xv[ks][4] = lo_bf(raw[ks].z); xv[ks][5] = hi_bf(raw[ks].z); xv[ks][6] = lo_bf(raw[ks].w); xv[ks][7] = hi_bf(raw[ks].w);
#pragma unroll
                for (int j = 0; j < 8; ++j) ss += xv[ks][j] * xv[ks][j]; }
            ss += __shfl_xor(ss, 16); ss += __shfl_xor(ss, 32);
            const float rs = __builtin_amdgcn_rsqf(ss * (1.0f / 64.0f) + NORM_EPS) * (0.125f * 1.4426950408889634f);
#pragma unroll
            for (int ks = 0; ks < 2; ++ks) { const float* gq = INP(F, I_NA_QG) + 32 * ks + 8 * fq; u32x4 pw;
                pw.x = pk2(xv[ks][0] * rs * gq[0], xv[ks][1] * rs * gq[1]); pw.y = pk2(xv[ks][2] * rs * gq[2], xv[ks][3] * rs * gq[3]); pw.z = pk2(xv[ks][4] * rs * gq[4], xv[ks][5] * rs * gq[5]); pw.w = pk2(xv[ks][6] * rs * gq[6], xv[ks][7] * rs * gq[7]);
                qf[qt][ks] = __builtin_bit_cast(bf16x8, pw); } }
        f32x4 o[2][4]; float lrun[2] = {0.f, 0.f};
#pragma unroll
        for (int qt = 0; qt < 2; ++qt)
#pragma unroll
            for (int dt = 0; dt < 4; ++dt) o[qt][dt] = (f32x4){0.f, 0.f, 0.f, 0.f};
        if (F.tid < 465) bt[F.tid] = btv * 1.4426950408889634f - M0;
        NA_KNORM(kreg);
        *(LAS u32x4*)(F.lds + skey * 144 + sd8 * 16) = kreg; *(LAS u32x4*)(F.lds + 9216 + skey * 144 + sd8 * 16) = vreg;
        __syncthreads();
        for (int i = 0; i < ntile; ++i) {
            if (i + 1 < ntile) { const size_t krow = (i + 1 < nnb ? (size_t)b * SEQ + (size_t)(ulo + i + 1) * 64 : (size_t)RL + (size_t)b * CTXL + (size_t)(i + 1 - nnb) * 64) + skey;
                const bf16_t* kp = QKV + krow * 3072 + D + h * 64 + 8 * sd8; kreg = *(const u32x4*)kp; vreg = *(const u32x4*)(kp + D); }
            else if (unit + F.G < NB * 16 * 8) NA_ISSUE(unit + F.G);
            LAS unsigned char* Kb = F.lds + (i & 1) * 18432; LAS unsigned char* Vb = Kb + 9216;
            const bool isnb = i < nnb; const int ra = ulo + i;
            if (isnb) {
                if (ra >= r0 && ra < r0 + 8) {
                    const LAS float* bp = bt + (ra - r + 7) * 31;
#pragma unroll
                    for (int qt = 0; qt < 2; ++qt) {
                        const int g4 = 2 * chh + qt, ws = min(max(16 * g4 - 8, 0), 32);
                        const int cq = 16 * g4 + fr, cstart = min(max(cq - 8, 0), 48);
                        f32x4 st[2]; float psum = 0.f;
#pragma unroll
                        for (int kt = 0; kt < 2; ++kt) {
                            f32x4 a = {0.f, 0.f, 0.f, 0.f};
#pragma unroll
                            for (int ks = 0; ks < 2; ++ks) { const bf16x8 kf = *(const LAS bf16x8*)(Kb + (ws + 16 * kt + fr) * 144 + (32 * ks + 8 * fq) * 2); a = __builtin_amdgcn_mfma_f32_16x16x32_bf16(kf, qf[qt][ks], a, 0, 0, 0); }
#pragma unroll
                            for (int j = 0; j < 4; ++j) { const int ck = ws + 16 * kt + 4 * fq + j; const bool valid = (unsigned)(ck - cstart) < 16u; const int dc = min(max(ck - cq, -15), 15) + 15;
                                const float pv = __builtin_amdgcn_exp2f(a[j] + bp[dc]); a[j] = valid ? pv : 0.f; }
                            psum += (a[0] + a[1]) + (a[2] + a[3]); st[kt] = a;
                        }
                        lrun[qt] += psum;
                        u32x4 pw; pw.x = pk2(st[0][0], st[0][1]); pw.y = pk2(st[0][2], st[0][3]); pw.z = pk2(st[1][0], st[1][1]); pw.w = pk2(st[1][2], st[1][3]);
                        const bf16x8 pb = __builtin_bit_cast(bf16x8, pw);
#pragma unroll
                        for (int dt = 0; dt < 4; ++dt) { const s16x4 v0 = __builtin_amdgcn_ds_read_tr16_b64_v4i16((LAS s16x4*)(Vb + (ws + 4 * fq) * 144 + 32 * dt + trl)), v1 = __builtin_amdgcn_ds_read_tr16_b64_v4i16((LAS s16x4*)(Vb + (ws + 16 + 4 * fq) * 144 + 32 * dt + trl));
                            const bf16x8 va = {v0[0], v0[1], v0[2], v0[3], v1[0], v1[1], v1[2], v1[3]};
                            o[qt][dt] = __builtin_amdgcn_mfma_f32_16x16x32_bf16(va, pb, o[qt][dt], 0, 0, 0); }
                    }
                }
            } else {
                s16x4 vA[2][4][2];
#pragma unroll
                for (int s2 = 0; s2 < 2; ++s2)
#pragma unroll
                    for (int dt = 0; dt < 4; ++dt)
#pragma unroll
                        for (int hh = 0; hh < 2; ++hh) vA[s2][dt][hh] = __builtin_amdgcn_ds_read_tr16_b64_v4i16((LAS s16x4*)(Vb + (32 * s2 + 16 * hh + 4 * fq) * 144 + 32 * dt + trl));
#pragma unroll
                for (int qt = 0; qt < 2; ++qt) {
                    f32x4 st[4]; float psum = 0.f;
#pragma unroll
                    for (int kt = 0; kt < 4; ++kt) {
                        f32x4 a = {0.f, 0.f, 0.f, 0.f};
                        const bf16x8 kf0 = *(const LAS bf16x8*)(Kb + (16 * kt + fr) * 144 + 8 * fq * 2), kf1 = *(const LAS bf16x8*)(Kb + (16 * kt + fr) * 144 + (32 + 8 * fq) * 2);
                        __builtin_amdgcn_s_setprio(1); a = __builtin_amdgcn_mfma_f32_16x16x32_bf16(kf0, qf[qt][0], a, 0, 0, 0); a = __builtin_amdgcn_mfma_f32_16x16x32_bf16(kf1, qf[qt][1], a, 0, 0, 0); __builtin_amdgcn_s_setprio(0);
#pragma unroll
                        for (int j = 0; j < 4; ++j) a[j] = __builtin_amdgcn_exp2f(a[j] - M0);
                        psum += (a[0] + a[1]) + (a[2] + a[3]); st[kt] = a;
                    }
                    lrun[qt] += psum;
#pragma unroll
                    for (int s2 = 0; s2 < 2; ++s2) {
                        u32x4 pw; pw.x = pk2(st[2 * s2][0], st[2 * s2][1]); pw.y = pk2(st[2 * s2][2], st[2 * s2][3]); pw.z = pk2(st[2 * s2 + 1][0], st[2 * s2 + 1][1]); pw.w = pk2(st[2 * s2 + 1][2], st[2 * s2 + 1][3]);
                        const bf16x8 pb = __builtin_bit_cast(bf16x8, pw);
                        __builtin_amdgcn_s_setprio(1);
#pragma unroll
                        for (int dt = 0; dt < 4; ++dt) { const s16x4 v0 = vA[s2][dt][0], v1 = vA[s2][dt][1]; const bf16x8 va = {v0[0], v0[1], v0[2], v0[3], v1[0], v1[1], v1[2], v1[3]};
                            o[qt][dt] = __builtin_amdgcn_mfma_f32_16x16x32_bf16(va, pb, o[qt][dt], 0, 0, 0); }
                        __builtin_amdgcn_s_setprio(0);
                    }
                }
            }
            if (i + 1 < ntile) { NA_KNORM(kreg); LAS unsigned char* Kn = F.lds + ((i + 1) & 1) * 18432; *(LAS u32x4*)(Kn + skey * 144 + sd8 * 16) = kreg; *(LAS u32x4*)(Kn + 9216 + skey * 144 + sd8 * 16) = vreg; }
            __syncthreads();
        }
#pragma unroll
        for (int qt = 0; qt < 2; ++qt) { float lt = lrun[qt]; lt += __shfl_xor(lt, 16); lt += __shfl_xor(lt, 32); const float inv = 1.0f / lt;
#pragma unroll
            for (int dt = 0; dt < 4; ++dt) { u32x2 w2; w2.x = pk2(o[qt][dt][0] * inv, o[qt][dt][1] * inv); w2.y = pk2(o[qt][dt][2] * inv, o[qt][dt][3] * inv); *(u32x2*)(O + qrow[qt] * D + h * 64 + 16 * dt + 4 * fq) = w2; } }
    }
    __syncthreads();
}

#undef NA_KNORM
#undef NA_ISSUE
constexpr int NPH = 36;
__device__ __forceinline__ pg8::Sched mk_sched(const Frame& F, int nM, int nN, const bf16_t* A, int lda, const bf16_t* B, int K) {
    pg8::Sched S; S.nM = nM; S.nN = nN; S.G = F.G; S.c = F.bid; S.A = (const char*)A; S.a_tile = (size_t)256 * lda * 2; S.a_pn = 0;
    S.B = (const char*)B; S.b_tile = (size_t)256 * K * 2; S.b_e = 0; S.tstart = nullptr; S.rev = false; S.wgm = nN >= 8 ? WGM_WIDE : WGM_NARROW; return S;
}
__global__ void __launch_bounds__(NTHR, 2) fwd(Params P) {
    extern __shared__ __attribute__((aligned(16))) unsigned char lds_raw[];
    Frame F; F.lds = (LAS unsigned char*)lds_raw; F.tid = threadIdx.x; F.lane = F.tid & 63; F.wave = __builtin_amdgcn_readfirstlane(F.tid >> 6); F.bid = blockIdx.x; F.G = gridDim.x;
    F.p = &P; F.ws = P.ws; F.ctl = (unsigned*)(P.ws + WS_CTL); F.modv = (float*)(P.ws + WS_MODV); F.hlat = (bf16_t*)(P.ws + WS_H); F.hctx = F.hlat + (size_t)RL * D; F.U = (bf16_t*)P.out;
    if (F.tid < 64) ((LAS unsigned*)(F.lds + LDS_CTL))[F.tid] = 0u;
    __syncthreads();
    const int lo = P.ph_lo, hi = P.ph_hi;
    XcdBarrier bar; bar.bar = F.ctl + CW_BAR; bar.x = 0; bar.st = (volatile LAS unsigned*)(F.lds + LDS_CTL);
    if (hi - lo > 1) bar = xcd_barrier_post(F.ctl + CW_BAR, (volatile LAS unsigned*)(F.lds + LDS_CTL));
#define IN(k) (lo <= (k) && (k) < hi)
#define SEAM(k) do { if (IN(k) && IN((k) + 1)) xcd_barrier(bar); \
        if (PROBE_LO >= 0 && F.bid == 0 && F.tid == 0) { if ((k) + 1 == PROBE_LO) pr_t[0] = PROBE_CLK ? (unsigned long long)clock64() : __builtin_amdgcn_s_memrealtime(); if ((k) + 1 == PROBE_HI) pr_t[1] = PROBE_CLK ? (unsigned long long)clock64() : __builtin_amdgcn_s_memrealtime(); } } while (0)
    volatile LAS unsigned long long* const pr_t = (volatile LAS unsigned long long*)(F.lds + LDS_CTL + 16);
    if (PROBE_LO == 0 && F.bid == 0 && F.tid == 0) pr_t[0] = PROBE_CLK ? (unsigned long long)clock64() : __builtin_amdgcn_s_memrealtime();
    bf16_t* const out = F.hlat; bf16_t* const hctx = F.hctx;
    const float* const x = INP(F, I_X); const float* const ctx = INP(F, I_CTX);
    LAS unsigned char* const gl = F.lds;
    LAS int* const tstart = (LAS int*)(F.lds + LDS_AUX);
    bf16_t* const BIG = (bf16_t*)(P.ws + WS_BIG);
#define MODL(l) (F.modv + (size_t)(l) * 33 * MODW)
#define LAUNDER do { asm volatile("" : "+v"(F.tid)); F.lane = F.tid & 63; } while (0)

    if (IN(0)) { LAUNDER; phase_mod(F); phase_cvt_small(F); } SEAM(0);
    if (IN(1)) { LAUNDER; NormCtx N{x, ctx, INP(F, I_N1G), MODL(0), 0, true}; phase_norm(F, N, RA); } SEAM(1);
    if (IN(2)) { LAUNDER; pg8::Sched S = mk_sched(F, RA / 256, 10, F.U, D, WSP(bf16_t, WS_LRU_WIN), D); pg8::EpiBf16<0> E{(bf16_t*)(P.ws + WS_BIG + BG_XG), 2560, nullptr}; pg8::gemm_phase(gl, D, D, S, E); } SEAM(2);
    if (IN(3)) { LAUNDER; phase_scan(F, true); } SEAM(3);
    if (IN(4)) { LAUNDER; pg8::Sched S = mk_sched(F, RA / 256, 4, (bf16_t*)(P.ws + WS_BIG + BG_Y), DRNN, WSP(bf16_t, WS_LRU_WOUT), DRNN);
                 pg8::EpiResidX E{x, ctx, out, hctx, MODL(0) + 2 * D, nullptr, nullptr}; pg8::gemm_phase(gl, DRNN, DRNN, S, E); cvt_moe_queue(F, 0, 0, 4096, 0); } SEAM(4);
    if (IN(5)) { LAUNDER; NormCtx N{out, hctx, INP(F, I_N2G), MODL(0), 1, false}; phase_norm(F, N, RA); } SEAM(5);
    if (IN(6)) { LAUNDER; pg8::Sched S = mk_sched(F, RA / 256, 28, F.U, D, WSP(bf16_t, WS_FFN_W13), D); pg8::EpiSwiGLU E{(bf16_t*)(P.ws + WS_BIG + BG_HID), DFF}; pg8::gemm_phase(gl, D, D, S, E); } SEAM(6);
    if (IN(7)) { LAUNDER; pg8::Sched S = mk_sched(F, RA / 256, 4, (bf16_t*)(P.ws + WS_BIG + BG_HID), DFF, WSP(bf16_t, WS_FFN_W2), DFF);
                 S.rev = true; pg8::EpiResid E{out, hctx, out, hctx, MODL(0) + 5 * D, nullptr, nullptr}; pg8::gemm_phase(gl, DFF, DFF, S, E); cvt_moe_queue(F, 0, 4096, 26624, 1); } SEAM(7);
    if (IN(8)) { LAUNDER; NormCtx N{out, hctx, INP(F, I_N1G) + D, MODL(1), 0, false}; phase_norm(F, N, RA); } SEAM(8);
    if (IN(9)) { LAUNDER; pg8::Sched S = mk_sched(F, RA / 256, 16, F.U, D, WSP(bf16_t, WS_SGU_WIN), D); pg8::EpiBf16<1> E{(bf16_t*)(P.ws + WS_BIG + BG_Z), 4096, INP(F, I_SGU_BIN)}; pg8::gemm_phase(gl, D, D, S, E); } SEAM(9);
    if (IN(10)) { LAUNDER; phase_sgu_stats(F); } SEAM(10);
    if (IN(11)) { LAUNDER; phase_sgu_spatial(F); } SEAM(11);
    if (IN(12)) { LAUNDER; pg8::Sched S = mk_sched(F, RA / 256, 4, (bf16_t*)(P.ws + WS_BIG + BG_Z), 4096, WSP(bf16_t, WS_SGU_WOUT), DSGU);
                  pg8::EpiResid E{out, hctx, out, hctx, MODL(1) + 2 * D, nullptr, nullptr}; pg8::gemm_phase(gl, 4096, DSGU, S, E); cvt_moe_queue(F, 0, 26624, CVT_MOE_ITEMS, 2); } SEAM(12);
    if (IN(13)) { LAUNDER; NormCtx N{out, hctx, INP(F, I_N2G) + D, MODL(1), 1, false}; phase_route(F, N, RA, 0); } SEAM(13);
    if (IN(14)) { LAUNDER; phase_assign_scatter0(F, RA, 0); } SEAM(14);
#define MOE_UP(ph, l2, s) if (IN(ph)) { LAUNDER; const int nt_ = moe_tile_table(F, l2, s, tstart); \
        pg8::Sched S = mk_sched(F, nt_, 28, F.U, D, moe_w13(F, l2), D); S.a_tile = 0; S.b_e = (size_t)2 * DFF * D * 2; S.tstart = tstart; \
        pg8::EpiSwiGLU E{(bf16_t*)(P.ws + WS_BIG + BG_MHID), DFF}; pg8::gemm_phase<pg8::EpiSwiGLU, true>(gl, D, D, S, E, WSP(const int, WS_ROUTE + RT_TOK) + (s) * MPAD, (LAS int*)(F.lds + LDS_AUX + 1024)); } SEAM(ph)
#define MOE_DOWN(ph, l2, s, layer, EPI) if (IN(ph)) { LAUNDER; const int nt_ = moe_tile_table(F, l2, s, tstart); \
        pg8::Sched S = mk_sched(F, nt_, 4, (bf16_t*)(P.ws + WS_BIG + BG_MHID), DFF, moe_w2(F, l2), DFF); S.b_e = (size_t)D * DFF * 2; S.tstart = tstart; S.rev = true; \
        EPI E{out, hctx, P.out, MODL(layer) + 5 * D, WSP(const int, WS_ROUTE + RT_TOK) + (s) * MPAD, WSP(const float, WS_ROUTE + RT_GW) + (s) * MPAD}; pg8::gemm_phase(gl, DFF, DFF, S, E); \
        if ((l2) == 0) cvt_moe_queue(F, 1, (s) ? 10752 : 0, (s) ? 21504 : 10752, 3 + (s)); } SEAM(ph)
    MOE_UP(15, 0, 0); MOE_DOWN(16, 0, 0, 1, pg8::EpiMoeDown); MOE_UP(17, 0, 1); MOE_DOWN(18, 0, 1, 1, pg8::EpiMoeDown);
    if (IN(19)) { LAUNDER; NormCtx N{out, hctx, INP(F, I_N1G) + 2 * D, MODL(2), 0, false}; phase_norm(F, N, RA); } SEAM(19);
    if (IN(20)) { LAUNDER; phase_pool_diff(F); } SEAM(20);
    if (IN(21)) { LAUNDER; pg8::Sched S = mk_sched(F, RA / 256, 4, (bf16_t*)(P.ws + WS_BIG + BG_PD), D, WSP(bf16_t, WS_POOL_W), 256); S.a_pn = 512; S.b_tile = (size_t)256 * 256 * 2;
                  pg8::EpiResidBS E{out, hctx, out, hctx, MODL(2) + 2 * D, INP(F, I_POOL_B), INP(F, I_POOL_S)}; pg8::gemm_phase(gl, D, 256, S, E); } SEAM(21);
    if (IN(22)) { LAUNDER; NormCtx N{out, hctx, INP(F, I_N2G) + 2 * D, MODL(2), 1, false}; phase_norm(F, N, RA); } SEAM(22);
    if (IN(23)) { LAUNDER; pg8::Sched S = mk_sched(F, RA / 256, 28, F.U, D, WSP(bf16_t, WS_FFN_W13) + (size_t)2 * DFF * D, D); pg8::EpiSwiGLU E{(bf16_t*)(P.ws + WS_BIG + BG_HID), DFF}; pg8::gemm_phase(gl, D, D, S, E); } SEAM(23);
    if (IN(24)) { LAUNDER; pg8::Sched S = mk_sched(F, RA / 256, 4, (bf16_t*)(P.ws + WS_BIG + BG_HID), DFF, WSP(bf16_t, WS_FFN_W2) + (size_t)D * DFF, DFF);
                  S.rev = true; pg8::EpiResid E{out, hctx, out, hctx, MODL(2) + 5 * D, nullptr, nullptr}; pg8::gemm_phase(gl, DFF, DFF, S, E); cvt_moe_queue(F, 1, 21504, CVT_MOE_ITEMS, 5); } SEAM(24);
    if (IN(25)) { LAUNDER; NormCtx N{out, hctx, INP(F, I_N1G) + 3 * D, MODL(3), 0, false}; phase_norm(F, N, RA); } SEAM(25);
    if (IN(26)) { LAUNDER;
        { pg8::Sched S = mk_sched(F, RL / 256, 12, F.U, D, WSP(bf16_t, WS_NA_WQKV), D); pg8::EpiBf16<0> E{(bf16_t*)(P.ws + WS_BIG + BG_QKV), 3072, nullptr}; pg8::gemm_phase(gl, D, D, S, E); }
        { pg8::Sched S = mk_sched(F, RC / 256, 8, F.U + (size_t)RL * D, D, WSP(bf16_t, WS_NA_WQKV) + (size_t)D * D, D);
          pg8::EpiBf16<0> E{(bf16_t*)(P.ws + WS_BIG + BG_QKV) + (size_t)RL * 3072 + D, 3072, nullptr}; pg8::gemm_phase(gl, D, D, S, E); } } SEAM(26);
    if (IN(28)) { LAUNDER; phase_na(F); } SEAM(28);
    if (IN(29)) { LAUNDER; pg8::Sched S = mk_sched(F, RL / 256, 4, (bf16_t*)(P.ws + WS_BIG + BG_O), D, WSP(bf16_t, WS_NA_WO), D);
                  pg8::EpiResid E{out, hctx, out, hctx, MODL(3) + 2 * D, nullptr, nullptr}; pg8::gemm_phase(gl, D, D, S, E); } SEAM(29);
    if (IN(30)) { LAUNDER; NormCtx N{out, hctx, INP(F, I_N2G) + 3 * D, MODL(3), 1, false}; phase_route(F, N, RL, 1); } SEAM(30);
    if (IN(31)) { LAUNDER; phase_assign_scatter0(F, RL, 1); } SEAM(31);
    MOE_UP(32, 1, 0); MOE_DOWN(33, 1, 0, 3, pg8::EpiMoeDown); MOE_UP(34, 1, 1); MOE_DOWN(35, 1, 1, 3, pg8::EpiMoeDownOut);
#undef IN
#undef SEAM
    (void)BIG;
    if (PROBE_ACC > 0 && F.bid == 0 && F.tid == 0) { const unsigned long long t_end = __builtin_amdgcn_s_memrealtime(), wait = 8ull * ((volatile LAS unsigned long long*)(F.lds + LDS_CTL + 32))[0];
        while (__builtin_amdgcn_s_memrealtime() - t_end < wait) __builtin_amdgcn_s_sleep(32); }
    if (PROBE_LO >= 0 && F.bid == 0 && F.tid == 0) { if (PROBE_HI >= NPH) pr_t[1] = PROBE_CLK ? (unsigned long long)clock64() : __builtin_amdgcn_s_memrealtime();
        const unsigned long long t_end = __builtin_amdgcn_s_memrealtime(), wait = PROBE_CLK ? 8ull * (pr_t[1] - pr_t[0]) / 21ull : 8ull * (pr_t[1] - pr_t[0]);
        while (__builtin_amdgcn_s_memrealtime() - t_end < wait) __builtin_amdgcn_s_sleep(32); }
}

extern "C" void kernel_launch(void* const* d_in, const int* in_sizes, int n_in, void* d_out, int out_size, void* d_ws, size_t ws_size, hipStream_t stream) {
    static int grid = 0;
    if (grid == 0) {
        if (n_in != 40 || out_size != RL * D || ws_size < WS_END) { fprintf(stderr, "kernel_launch: unexpected problem (n_in %d out %d ws %zu)\n", n_in, out_size, ws_size); grid = -1; return; }
        int dev = 0, cus = 0;
        if (hipGetDevice(&dev) != hipSuccess || hipDeviceGetAttribute(&cus, hipDeviceAttributeMultiprocessorCount, dev) != hipSuccess) { grid = -1; return; }
        if (hipFuncSetAttribute((const void*)fwd, hipFuncAttributeMaxDynamicSharedMemorySize, LDS_BYTES) != hipSuccess) { fprintf(stderr, "kernel_launch: hipFuncSetAttribute failed\n"); grid = -1; return; }
        int per_cu = 0; (void)hipOccupancyMaxActiveBlocksPerMultiprocessor(&per_cu, (const void*)fwd, NTHR, LDS_BYTES); (void)hipGetLastError();
        if (per_cu < 1) fprintf(stderr, "kernel_launch: occupancy query says %d\n", per_cu);
        grid = cus;
    }
    if (grid < 0) return;
    (void)hipMemsetAsync((char*)d_ws + WS_CTL, 0, CTL_BYTES, stream);
    Params p{};
    for (int i = 0; i < 40; ++i) p.in[i] = (const float*)d_in[i];
    p.out = (float*)d_out; p.ws = (unsigned char*)d_ws;
#if MK_MULTI
    for (int ph = 0; ph < NPH; ++ph) { p.ph_lo = ph; p.ph_hi = ph + 1; hipLaunchKernelGGL(fwd, dim3(grid), dim3(NTHR), LDS_BYTES, stream, p); }
#else
    p.ph_lo = 0; p.ph_hi = NPH;
    hipLaunchKernelGGL(fwd, dim3(grid), dim3(NTHR), LDS_BYTES, stream, p);
#endif
}
```
